# Optimizing an MI355X kernel written in HIP

```python
import math
import jax, jax.numpy as jnp
from jax import lax
import numpy as np

D_MODEL = 1024
BATCH = 2
SEQ = 16384
DEPTH = 2

GRID_W = 64
CTX_LEN = 256
HEAD_DIM = 64
BRANCH_WIDTH = D_MODEL // 2
N_BRANCH = 4
NA_HEADS = BRANCH_WIDTH // HEAD_DIM
NA_KR = 8
NA_KC = 16
SW_HEADS = BRANCH_WIDTH // HEAD_DIM
SW_KV_HEADS = 2
SW_WINDOW = 128
SW_BLOCK = 128
GLA_HEADS = 4
GLA_DK = BRANCH_WIDTH // 2
GLA_DV = BRANCH_WIDTH
GLA_RANK = 16
GLA_TAU = 16.0
GLA_CHUNK = 64
HY_WIDTH = BRANCH_WIDTH
HY_CONV = 3
HY_EMB = 33
HY_FFN = 64
HY_TARGET = 1e-2
HY_FAST_PCT = 0.3
HY_SLOW_PCT = 1.5
ROPE_BASE = 10000.0
EPS = 1e-6
NEG_INF = -1e30
F32 = jnp.float32

IN_WIDTHS = (
    BRANCH_WIDTH, BRANCH_WIDTH, BRANCH_WIDTH, BRANCH_WIDTH,
    BRANCH_WIDTH, SW_KV_HEADS * HEAD_DIM, SW_KV_HEADS * HEAD_DIM, BRANCH_WIDTH,
    GLA_DK, GLA_DK, GLA_DV, GLA_RANK, GLA_RANK, BRANCH_WIDTH,
    3 * HY_WIDTH, BRANCH_WIDTH,
    N_BRANCH * D_MODEL,
)
IN_TOTAL = sum(IN_WIDTHS)

kernel_name = "hybrid_dit_parallel_mixers"


def rmsnorm(x, w):
    xf = x.astype(F32)
    y = xf * lax.rsqrt(jnp.mean(xf * xf, axis=-1, keepdims=True) + EPS)
    return (y * w.astype(F32)).astype(x.dtype)


def split_cols(p):
    idx = [int(i) for i in np.cumsum(IN_WIDTHS)[:-1]]
    return jnp.split(p, idx, axis=-1)


def heads(x, n):
    b, t, _ = x.shape
    return x.reshape(b, t, n, -1).transpose(0, 2, 1, 3)


def merge_heads(x):
    b, h, t, d = x.shape
    return x.transpose(0, 2, 1, 3).reshape(b, t, h * d)


def softmax_f32(s):
    return jax.nn.softmax(s.astype(F32), axis=-1)


def axial_rope(length):
    t = jnp.arange(length, dtype=jnp.int32)
    row = (t // GRID_W).astype(F32)
    col = (t % GRID_W).astype(F32)
    n_freq = HEAD_DIM // 4
    inv = ROPE_BASE ** (-jnp.arange(n_freq, dtype=F32) / n_freq)
    ang = jnp.concatenate([row[:, None] * inv, col[:, None] * inv], axis=-1)
    return jnp.cos(ang), jnp.sin(ang)


def rope_2d(x, cos, sin):
    half = x.shape[-1] // 2
    x1, x2 = x[..., :half], x[..., half:]
    return jnp.concatenate([x1 * cos - x2 * sin, x1 * sin + x2 * cos], axis=-1).astype(x.dtype)


def ctx_attention(q, k, v, sink):
    b, hq, t, d = q.shape
    hkv = k.shape[1]
    g = hq // hkv
    qg = q.reshape(b, hkv, g, t, d)
    s = jnp.einsum('bkgqd,bkcd->bkgqc', qg, k).astype(F32) * (d ** -0.5)
    if sink is not None:
        s_sink = jnp.broadcast_to(sink.astype(F32).reshape(1, hkv, g, 1, 1), (b, hkv, g, t, 1))
        s = jnp.concatenate([s, s_sink], axis=-1)
    p = softmax_f32(s)[..., :k.shape[2]].astype(v.dtype)
    return jnp.einsum('bkgqc,bkcd->bkgqd', p, v).reshape(b, hq, t, d)


def natten_mixer(q_l, k_l, v_l, q_c, k_c, v_c, rpb, with_ctx_out):
    b, h, length, d = q_l.shape
    rows = length // GRID_W
    kr = min(NA_KR, rows)
    ncb = GRID_W // NA_KC
    kw = 2 * NA_KC
    scale = d ** -0.5
    qcol = np.arange(GRID_W).reshape(ncb, NA_KC)
    kc0 = np.clip(np.arange(ncb) * NA_KC - NA_KC // 2, 0, GRID_W - kw)
    kcol = kc0[:, None] + np.arange(kw)[None, :]
    cs = np.clip(qcol - NA_KC // 2, 0, GRID_W - NA_KC)
    colmask = (kcol[:, None, :] >= cs[..., None]) & (kcol[:, None, :] < cs[..., None] + NA_KC)
    dc_idx = np.clip(kcol[:, None, :] - qcol[..., None] + (NA_KC - 1), 0, 2 * NA_KC - 2)
    mask = jnp.asarray(np.broadcast_to(colmask[:, :, None, :], (ncb, NA_KC, kr, kw)).reshape(ncb, NA_KC, kr * kw))
    qg = q_l.reshape(b, h, rows, GRID_W, d)
    kg = k_l.reshape(b, h, rows, GRID_W, d)
    vg = v_l.reshape(b, h, rows, GRID_W, d)
    n_nb = kr * kw

    def row_block(r):
        rs = jnp.clip(r - kr // 2, 0, rows - kr)
        q_r = lax.dynamic_index_in_dim(qg, r, axis=2, keepdims=False).reshape(b, h, ncb, NA_KC, d)

        def gather(t):
            t_r = lax.dynamic_slice_in_dim(t, rs, kr, axis=2)
            t_b = t_r[:, :, :, kcol]
            return t_b.transpose(0, 1, 3, 2, 4, 5).reshape(b, h, ncb, n_nb, d)

        k_b, v_b = gather(kg), gather(vg)
        dr_idx = rs + jnp.arange(kr) - r + (NA_KR - 1)
        bias = rpb[:, dr_idx[None, None, :, None], dc_idx[:, :, None, :]].reshape(h, ncb, NA_KC, n_nb)
        s_nb = jnp.einsum('bhjqd,bhjkd->bhjqk', q_r, k_b).astype(F32) * scale + bias.astype(F32)
        s_nb = jnp.where(mask, s_nb, NEG_INF)
        s_cx = jnp.einsum('bhjqd,bhkd->bhjqk', q_r, k_c).astype(F32) * scale
        p = softmax_f32(jnp.concatenate([s_nb, s_cx], axis=-1)).astype(v_l.dtype)
        o = (jnp.einsum('bhjqk,bhjkd->bhjqd', p[..., :n_nb], v_b)
             + jnp.einsum('bhjqk,bhkd->bhjqd', p[..., n_nb:], v_c))
        return o.reshape(b, h, GRID_W, d)

    o = lax.map(row_block, jnp.arange(rows))
    o_l = o.transpose(1, 2, 0, 3, 4).reshape(b, h, length, d)
    o_c = ctx_attention(q_c, k_c, v_c, None) if with_ctx_out else None
    return o_c, o_l


def swa_mixer(q_l, k_l, v_l, q_c, k_c, v_c, sink, with_ctx_out):
    b, hq, length, d = q_l.shape
    hkv = k_l.shape[1]
    g = hq // hkv
    nb = length // SW_BLOCK
    kw = 3 * SW_BLOCK
    lc = k_c.shape[2]
    scale = d ** -0.5
    qb = q_l.reshape(b, hkv, g, nb, SW_BLOCK, d)

    def band(t):
        tp = jnp.pad(t, ((0, 0), (0, 0), (SW_BLOCK, SW_BLOCK), (0, 0))).reshape(b, hkv, nb + 2, SW_BLOCK, d)
        return jnp.concatenate([tp[:, :, :-2], tp[:, :, 1:-1], tp[:, :, 2:]], axis=3)

    k_w, v_w = band(k_l), band(v_l)
    qpos = jnp.arange(length).reshape(nb, SW_BLOCK)
    kpos = (jnp.arange(nb)[:, None] - 1) * SW_BLOCK + jnp.arange(kw)[None, :]
    mask = ((jnp.abs(qpos[:, :, None] - kpos[:, None, :]) <= SW_WINDOW)
            & (kpos[:, None, :] >= 0) & (kpos[:, None, :] < length))
    s_w = jnp.einsum('bkgnqd,bknwd->bkgnqw', qb, k_w).astype(F32) * scale
    s_w = jnp.where(mask, s_w, NEG_INF)
    s_c = jnp.einsum('bkgnqd,bkcd->bkgnqc', qb, k_c).astype(F32) * scale
    s_sink = jnp.broadcast_to(sink.astype(F32).reshape(1, hkv, g, 1, 1, 1), (b, hkv, g, nb, SW_BLOCK, 1))
    p = softmax_f32(jnp.concatenate([s_w, s_c, s_sink], axis=-1)).astype(v_l.dtype)
    o = (jnp.einsum('bkgnqw,bknwd->bkgnqd', p[..., :kw], v_w)
         + jnp.einsum('bkgnqc,bkcd->bkgnqd', p[..., kw:kw + lc], v_c))
    o_l = o.reshape(b, hq, length, d)
    o_c = ctx_attention(q_c, k_c, v_c, sink) if with_ctx_out else None
    return o_c, o_l


def gla_direction(q, k, v, log_a, s0, with_out):
    b, h, t, dk = k.shape
    dv = v.shape[-1]
    n = t // GLA_CHUNK
    kc = k.reshape(b, h, n, GLA_CHUNK, dk)
    vc = v.reshape(b, h, n, GLA_CHUNK, dv)
    cum = jnp.cumsum(log_a.reshape(b, h, n, GLA_CHUNK, dk), axis=3)
    cum_end = cum[:, :, :, -1:]
    kv = jnp.einsum('bhncd,bhnce->bhnde', kc * jnp.exp(cum_end - cum), vc)
    g = jnp.exp(cum_end[:, :, :, 0])

    def step(s, inp):
        g_n, kv_n = inp
        return g_n[..., None] * s + kv_n, s

    s_fin, s_prev = lax.scan(step, s0, (jnp.moveaxis(g, 2, 0), jnp.moveaxis(kv, 2, 0)))
    if not with_out:
        return None, s_fin
    qc = q.reshape(b, h, n, GLA_CHUNK, dk)
    qd = qc * jnp.exp(cum)
    kd = kc * jnp.exp(-cum)
    tril = jnp.tril(jnp.ones((GLA_CHUNK, GLA_CHUNK), dtype=bool))
    a = jnp.where(tril, jnp.einsum('bhnid,bhnjd->bhnij', qd, kd), 0.0)
    o = jnp.einsum('bhnij,bhnje->bhnie', a, vc) + jnp.einsum('bhnid,nbhde->bhnie', qd, s_prev)
    return o.reshape(b, h, t, dv), s_fin


def gla_mixer(q_l, k_l, v_l, laf_l, lab_l, q_c, k_c, v_c, laf_c, lab_c, norm_w, with_ctx_out):
    b, h, _, dk = k_l.shape
    dv = v_l.shape[-1]
    s0 = jnp.zeros((b, h, dk, dv), F32)
    flip = lambda t: t[:, :, ::-1]
    o_cf, s_cf = gla_direction(q_c, k_c, v_c, laf_c, s0, with_ctx_out)
    o_cb, s_cb = gla_direction(flip(q_c), flip(k_c), flip(v_c), flip(lab_c), s0, with_ctx_out)
    o_lf, _ = gla_direction(q_l, k_l, v_l, laf_l, s_cf, True)
    o_lb, _ = gla_direction(flip(q_l), flip(k_l), flip(v_l), flip(lab_l), s_cb, True)
    o_l = rmsnorm(o_lf + flip(o_lb), norm_w)
    o_c = rmsnorm(o_cf + flip(o_cb), norm_w) if with_ctx_out else None
    return o_c, o_l


def short_conv(u, w, bias):
    t = u.shape[1]
    pad = HY_CONV // 2
    up = jnp.pad(u, ((0, 0), (pad, HY_CONV - 1 - pad), (0, 0)))
    out = up[:, 0:t] * w[0]
    for i in range(1, HY_CONV):
        out = out + up[:, i:i + t] * w[i]
    return out + bias


def hyena_filter(t_len, w1, b1, w2, b2, w3, b3, freq, wout):
    t = jnp.linspace(0.0, 1.0, t_len, dtype=F32)[:, None]
    bands = (HY_EMB - 1) // 2
    w_ang = 2.0 * math.pi * jnp.arange(t_len, dtype=F32)[:, None] / t_len
    f = jnp.linspace(1e-4, bands - 1, bands, dtype=F32)[None, :]
    z = jnp.concatenate([t, jnp.cos(f * w_ang), -jnp.sin(f * w_ang)], axis=-1)
    fr = freq.astype(F32)
    hh = jnp.sin(fr * (z @ w1.astype(F32) + b1.astype(F32)))
    hh = jnp.sin(fr * (hh @ w2.astype(F32) + b2.astype(F32)))
    hh = jnp.sin(fr * (hh @ w3.astype(F32) + b3.astype(F32)))
    hh = hh @ wout.astype(F32)
    deltas = jnp.abs(jnp.linspace(math.log(HY_TARGET) / HY_SLOW_PCT, math.log(HY_TARGET) / HY_FAST_PCT,
                                  HY_WIDTH, dtype=F32))
    decay = jnp.exp(-t * deltas)
    h_f = hh[:, :HY_WIDTH] * decay
    h_b = hh[:, HY_WIDTH:] * decay
    l1 = jnp.sum(jnp.abs(h_f), axis=0) + jnp.sum(jnp.abs(h_b[1:]), axis=0)
    k2 = jnp.concatenate([h_f, jnp.zeros((1, HY_WIDTH), F32), h_b[:0:-1]], axis=0)
    return k2 / l1


def hyena_mixer(u_proj, conv_w, conv_b, w1, b1, w2, b2, w3, b3, freq, wout, filt_bias):
    t_len = u_proj.shape[1]
    u = short_conv(u_proj, conv_w, conv_b)
    x0, x1, v = jnp.split(u, 3, axis=-1)
    z = x1 * v
    k2 = hyena_filter(t_len, w1, b1, w2, b2, w3, b3, freq, wout)
    zf = jnp.fft.rfft(z.astype(F32), n=2 * t_len, axis=1)
    kf = jnp.fft.rfft(k2, axis=0)
    y = jnp.fft.irfft(zf * kf[None], n=2 * t_len, axis=1)[:, :t_len].astype(z.dtype)
    return x0 * (y + z * filt_bias)


def layer(xc, xl, c, c_ctx, cos, sin, norm_w, w_mod, b_mod, w_in, rpb, sink, w_alpha_up, b_alpha,
          gla_norm_w, conv_w, conv_b, filt_w1, filt_b1, filt_w2, filt_b2, filt_w3, filt_b3, filt_freq,
          filt_wout, filt_bias, w_branch, w_out, with_ctx_out):
    mod_l = jax.nn.silu(c) @ w_mod + b_mod
    mod_c = jax.nn.silu(c_ctx) @ w_mod + b_mod
    sh_l, sc_l, g_l = jnp.split(mod_l[:, None, :], 3, axis=-1)
    sh_c, sc_c, g_c = jnp.split(mod_c, 3, axis=-1)
    hl = rmsnorm(xl, norm_w) * (1.0 + sc_l) + sh_l
    hc = rmsnorm(xc, norm_w) * (1.0 + sc_c) + sh_c
    (qa_l, ka_l, va_l, ga_l, qb_l, kb_l, vb_l, gb_l, qg_l, kg_l, vg_l, lrf_l, lrb_l, gg_l,
     uh_l, gh_l, gm_l) = split_cols(hl @ w_in)
    (qa_c, ka_c, va_c, ga_c, qb_c, kb_c, vb_c, gb_c, qg_c, kg_c, vg_c, lrf_c, lrb_c, gg_c,
     uh_c, gh_c, gm_c) = split_cols(hc @ w_in)

    a_c, a_l = natten_mixer(heads(qa_l, NA_HEADS), heads(ka_l, NA_HEADS), heads(va_l, NA_HEADS),
                            heads(qa_c, NA_HEADS), heads(ka_c, NA_HEADS), heads(va_c, NA_HEADS),
                            rpb, with_ctx_out)
    b_c, b_l = swa_mixer(rope_2d(heads(qb_l, SW_HEADS), cos, sin), rope_2d(heads(kb_l, SW_KV_HEADS), cos, sin),
                         heads(vb_l, SW_KV_HEADS),
                         heads(qb_c, SW_HEADS), heads(kb_c, SW_KV_HEADS), heads(vb_c, SW_KV_HEADS),
                         sink, with_ctx_out)
    dk_h = GLA_DK // GLA_HEADS

    def log_decay(lr, direction):
        return heads(jax.nn.log_sigmoid((lr @ w_alpha_up[direction] + b_alpha[direction]).astype(F32)) / GLA_TAU,
                     GLA_HEADS)

    c_c, c_l = gla_mixer(heads(qg_l, GLA_HEADS) * dk_h ** -0.5, heads(kg_l, GLA_HEADS), heads(vg_l, GLA_HEADS),
                         log_decay(lrf_l, 0), log_decay(lrb_l, 1),
                         heads(qg_c, GLA_HEADS) * dk_h ** -0.5, heads(kg_c, GLA_HEADS), heads(vg_c, GLA_HEADS),
                         log_decay(lrf_c, 0), log_decay(lrb_c, 1), gla_norm_w, with_ctx_out)
    d_l = hyena_mixer(uh_l, conv_w, conv_b, filt_w1, filt_b1, filt_w2, filt_b2, filt_w3, filt_b3,
                      filt_freq, filt_wout, filt_bias)

    def merge(ys, gm):
        gates = jax.nn.sigmoid(gm.reshape(gm.shape[:-1] + (N_BRANCH, D_MODEL)))
        acc = gates[..., 0, :] * (ys[0] @ w_branch[0])
        for i in range(1, N_BRANCH):
            acc = acc + gates[..., i, :] * (ys[i] @ w_branch[i])
        return acc @ w_out

    ys_l = [merge_heads(a_l) * jax.nn.silu(ga_l), merge_heads(b_l) * jax.nn.silu(gb_l),
            merge_heads(c_l) * jax.nn.silu(gg_l), d_l * jax.nn.silu(gh_l)]
    xl_new = xl + g_l * merge(ys_l, gm_l)
    if with_ctx_out:
        d_c = hyena_mixer(uh_c, conv_w, conv_b, filt_w1, filt_b1, filt_w2, filt_b2, filt_w3, filt_b3,
                          filt_freq, filt_wout, filt_bias)
        ys_c = [merge_heads(a_c) * jax.nn.silu(ga_c), merge_heads(b_c) * jax.nn.silu(gb_c),
                merge_heads(c_c) * jax.nn.silu(gg_c), d_c * jax.nn.silu(gh_c)]
        xc = xc + g_c * merge(ys_c, gm_c)
    return xc, xl_new


def setup_inputs(seed: int = 0) -> dict:
    key = jax.random.key(seed)
    ks = jax.random.split(key, 28)
    nrm = lambda k, shape, scale: jax.random.normal(k, shape, jnp.float32) * scale
    d = D_MODEL
    return {
        "x": nrm(ks[0], (BATCH, SEQ, d), 1.0),
        "c": nrm(ks[1], (BATCH, d), 1.0),
        "ctx": nrm(ks[2], (BATCH, CTX_LEN, d), 1.0),
        "c_ctx": nrm(ks[3], (d,), 1.0),
        "norm_w": 1.0 + nrm(ks[4], (DEPTH, d), 0.02),
        "w_mod": nrm(ks[5], (DEPTH, d, 3 * d), d ** -0.5),
        "b_mod": nrm(ks[6], (DEPTH, 3 * d), 0.01),
        "w_in": nrm(ks[7], (DEPTH, d, IN_TOTAL), d ** -0.5),
        "rpb": nrm(ks[8], (DEPTH, NA_HEADS, 2 * NA_KR - 1, 2 * NA_KC - 1), 0.5),
        "sink": nrm(ks[9], (DEPTH, SW_HEADS), 0.5),
        "w_alpha_up": nrm(ks[10], (DEPTH, 2, GLA_RANK, GLA_DK), GLA_RANK ** -0.5),
        "b_alpha": nrm(ks[11], (DEPTH, 2, GLA_DK), 0.1),
        "gla_norm_w": 1.0 + nrm(ks[12], (DEPTH, GLA_DV // GLA_HEADS), 0.02),
        "conv_w": nrm(ks[13], (DEPTH, HY_CONV, 3 * HY_WIDTH), HY_CONV ** -0.5),
        "conv_b": nrm(ks[14], (DEPTH, 3 * HY_WIDTH), 0.01),
        "filt_w1": nrm(ks[15], (DEPTH, HY_EMB, HY_FFN), HY_EMB ** -0.5),
        "filt_b1": nrm(ks[16], (DEPTH, HY_FFN), 0.1),
        "filt_w2": nrm(ks[17], (DEPTH, HY_FFN, HY_FFN), HY_FFN ** -0.5),
        "filt_b2": nrm(ks[18], (DEPTH, HY_FFN), 0.1),
        "filt_w3": nrm(ks[19], (DEPTH, HY_FFN, HY_FFN), HY_FFN ** -0.5),
        "filt_b3": nrm(ks[20], (DEPTH, HY_FFN), 0.1),
        "filt_freq": 1.0 + nrm(ks[21], (DEPTH, HY_FFN), 0.02),
        "filt_wout": nrm(ks[22], (DEPTH, HY_FFN, 2 * HY_WIDTH), HY_FFN ** -0.5),
        "filt_bias": nrm(ks[23], (DEPTH, HY_WIDTH), 0.5),
        "w_branch": nrm(ks[24], (DEPTH, N_BRANCH, BRANCH_WIDTH, d), BRANCH_WIDTH ** -0.5),
        "w_out": nrm(ks[25], (DEPTH, d, d), d ** -0.5),
        "final_norm_w": 1.0 + nrm(ks[26], (d,), 0.02),
    }


def reference(x, c, ctx, c_ctx, norm_w, w_mod, b_mod, w_in, rpb, sink, w_alpha_up, b_alpha, gla_norm_w,
              conv_w, conv_b, filt_w1, filt_b1, filt_w2, filt_b2, filt_w3, filt_b3, filt_freq, filt_wout,
              filt_bias, w_branch, w_out, final_norm_w):
    cos, sin = axial_rope(x.shape[1])
    xc, xl = ctx, x
    for i in range(DEPTH):
        xc, xl = layer(xc, xl, c, c_ctx, cos, sin, norm_w[i], w_mod[i], b_mod[i], w_in[i], rpb[i], sink[i],
                       w_alpha_up[i], b_alpha[i], gla_norm_w[i], conv_w[i], conv_b[i], filt_w1[i], filt_b1[i],
                       filt_w2[i], filt_b2[i], filt_w3[i], filt_b3[i], filt_freq[i], filt_wout[i], filt_bias[i],
                       w_branch[i], w_out[i], with_ctx_out=(i < DEPTH - 1))
    return rmsnorm(xl, final_norm_w)
```

```cpp
#include <hip/hip_runtime.h>
#include <hip/hip_cooperative_groups.h>
#include <cstdio>
#include <cstdint>
namespace cg = cooperative_groups;

#ifndef N_LAUNCH_MODE
#define N_LAUNCH_MODE 1
#endif

#define DEVI __device__ __forceinline__
typedef unsigned short bf16_t;
typedef short bf16x8 __attribute__((ext_vector_type(8)));
typedef float f32x4 __attribute__((ext_vector_type(4)));
typedef float f32x16 __attribute__((ext_vector_type(16)));

constexpr int D = 1024, T = 16384, NB = 2, NL = NB * T, CL = 256, NC = NB * CL, NR = NL + NC;
constexpr int IN_TOTAL = 11040;
constexpr int COL_A = 0, COL_B = 2048, COL_C = 3328, COL_D = 4896, COL_GM = 6944;
constexpr float EPS = 1e-6f;
constexpr int NTHR = 512;
constexpr int LDS_BYTES = 140 * 1024;

constexpr size_t al256(size_t x) { return (x + 255) & ~(size_t)255; }
constexpr size_t OFF_MOD = 0;
constexpr size_t OFF_ROPE = al256(OFF_MOD + (size_t)2 * 3 * 3072 * 4);
constexpr size_t OFF_HH3T = al256(OFF_ROPE + (size_t)2 * T * 32 * 4);
constexpr size_t OFF_HH3C = al256(OFF_HH3T + (size_t)2 * 64 * T * 4);
constexpr size_t OFF_XC1 = al256(OFF_HH3C + (size_t)64 * CL * 4);
constexpr size_t OFF_WINT = al256(OFF_XC1 + (size_t)NC * D * 4);
constexpr size_t OFF_WBT = al256(OFF_WINT + (size_t)2 * IN_TOTAL * D * 2);
constexpr size_t OFF_WOT = al256(OFF_WBT + (size_t)2 * 4 * D * 512 * 2);
constexpr size_t OFF_HL = al256(OFF_WOT + (size_t)2 * D * D * 2);
constexpr size_t OFF_YS = al256(OFF_HL + (size_t)NR * D * 2);
constexpr size_t SZ512 = (size_t)NR * 512 * 2, SZ256 = (size_t)NR * 256 * 2, SZ128 = (size_t)NR * 128 * 2;
constexpr size_t OFF_SCR = al256(OFF_YS + 4 * SZ512);
constexpr size_t SA_Q = 0, SA_K = SZ512, SA_VT = 2 * SZ512;
constexpr size_t SB_Q = 0, SB_K = SZ512, SB_VT = SZ512 + SZ128;
constexpr size_t SC_Q = 0, SC_K = SZ256, SC_VT = 2 * SZ256, SC_LR = 2 * SZ256 + SZ512;
constexpr size_t SC_SB = al256(SC_LR + (size_t)NR * 32 * 4);
constexpr int NCH = 260;
constexpr size_t SC_GD = al256(SC_SB + (size_t)16 * NCH * 8192 * 2);
constexpr size_t SD_U = 0, SD_ZT = al256((size_t)NR * 1536 * 2), SD_ZTC = al256(SD_ZT + (size_t)NB * 512 * T * 4);
constexpr size_t SD_END = al256(SD_ZTC + (size_t)NB * 512 * CL * 4);
constexpr size_t OFF_KF = OFF_SCR + SD_END;
constexpr int MAXGRID = 256;
constexpr size_t WS_END = OFF_KF + (size_t)MAXGRID * 8192 * 16;

struct P {
    const float *x, *c, *ctx, *c_ctx, *norm_w, *w_mod, *b_mod, *w_in, *rpb, *sink, *w_alpha_up, *b_alpha, *gla_norm_w,
        *conv_w, *conv_b, *fw1, *fb1, *fw2, *fb2, *fw3, *fb3, *ffreq, *fwout, *fbias, *w_branch, *w_out, *final_norm_w;
    float* out;
    unsigned char* ws;
    int ph_lo, ph_hi;
};

DEVI int ltid() { int t = threadIdx.x; asm volatile("" : "+v"(t)); return t; }
DEVI float bf2f(bf16_t v) { return __uint_as_float(((unsigned)v) << 16); }
typedef __bf16 bf16v2 __attribute__((ext_vector_type(2)));
typedef float f32v2 __attribute__((ext_vector_type(2)));
DEVI unsigned pk2(float lo, float hi) { f32v2 v = {lo, hi}; bf16v2 b = __builtin_convertvector(v, bf16v2); return __builtin_bit_cast(unsigned, b); }
DEVI bf16_t f2bf(float f) { return (bf16_t)(pk2(f, 0.f) & 0xffff); }
DEVI float lo_bf(unsigned u) { return __uint_as_float(u << 16); }
DEVI float hi_bf(unsigned u) { return __uint_as_float(u & 0xffff0000u); }
DEVI float siluf(float v) { return v / (1.f + __expf(-v)); }
DEVI float sigmf(float v) { return 1.f / (1.f + __expf(-v)); }
DEVI void row_decode(int row, int& b, int& t, bool& isctx) {
    if (row < NL) { b = row >> 14; t = row & (T - 1); isctx = false; }
    else { int r = row - NL; b = r >> 8; t = r & (CL - 1); isctx = true; }
}
DEVI float wave_sum(float v) {
#pragma unroll
    for (int o = 32; o >= 1; o >>= 1) v += __shfl_xor(v, o);
    return v;
}
DEVI float block_sum(float v, float* red  ) {
    v = wave_sum(v);
    __syncthreads();
    if ((ltid() & 63) == 0) red[ltid() >> 6] = v;
    __syncthreads();
    float s = 0.f;
#pragma unroll
    for (int i = 0; i < NTHR / 64; ++i) s += red[i];
    return s;
}

constexpr int LSTR = 72;
constexpr int GA_EL = 256 * LSTR, GB_EL = 128 * LSTR;
template <int NT> struct GAcc { f32x16 a[2][NT]; };

template <int NT>
DEVI void gemm_kloop(const bf16_t* __restrict__ A, int lda, const bf16_t* __restrict__ Bt, int ldb, int K, int m0, int n0,
                     bf16_t* sm, GAcc<NT>& acc) {
    const int tid = ltid(), lane = tid & 63, wave = tid >> 6, wm = wave >> 1, wn = wave & 1;
    const int lr = tid >> 3, lc = tid & 7;
    constexpr int BROWS = 64 * NT;
    const bf16_t* ap = A + (size_t)(m0 + lr) * lda + lc * 8;
    const bf16_t* bp = Bt + (size_t)(n0 + lr) * ldb + lc * 8;
    uint4 ra[4], rb[NT];
    const int KT = K / 64;
    __syncthreads();
#pragma unroll
    for (int i = 0; i < 4; ++i) ra[i] = *(const uint4*)(ap + (size_t)(64 * i) * lda);
#pragma unroll
    for (int i = 0; i < NT; ++i) rb[i] = *(const uint4*)(bp + (size_t)(64 * i) * ldb);
    {
        bf16_t* sa = sm; bf16_t* sb = sm + GA_EL;
#pragma unroll
        for (int i = 0; i < 4; ++i) *(uint4*)(sa + (lr + 64 * i) * LSTR + lc * 8) = ra[i];
#pragma unroll
        for (int i = 0; i < NT; ++i) *(uint4*)(sb + (lr + 64 * i) * LSTR + lc * 8) = rb[i];
    }
    __syncthreads();
    const int frow = lane & 31, fk = (lane >> 5) * 8;
    for (int kt = 0; kt < KT; ++kt) {
        const int cur = kt & 1;
        if (kt + 1 < KT) {
            const int ko = (kt + 1) * 64;
#pragma unroll
            for (int i = 0; i < 4; ++i) ra[i] = *(const uint4*)(ap + (size_t)(64 * i) * lda + ko);
#pragma unroll
            for (int i = 0; i < NT; ++i) rb[i] = *(const uint4*)(bp + (size_t)(64 * i) * ldb + ko);
        }
        const bf16_t* sa = sm + cur * (GA_EL + GB_EL) + (wm * 64 + frow) * LSTR + fk;
        const bf16_t* sb = sm + cur * (GA_EL + GB_EL) + GA_EL + (wn * 32 * NT + frow) * LSTR + fk;
#pragma unroll
        for (int ks = 0; ks < 4; ++ks) {
            bf16x8 tf[2], cf[NT];
#pragma unroll
            for (int mt = 0; mt < 2; ++mt) tf[mt] = *(const bf16x8*)(sa + mt * 32 * LSTR + ks * 16);
#pragma unroll
            for (int nt = 0; nt < NT; ++nt) cf[nt] = *(const bf16x8*)(sb + nt * 32 * LSTR + ks * 16);
#pragma unroll
            for (int mt = 0; mt < 2; ++mt)
#pragma unroll
                for (int nt = 0; nt < NT; ++nt)
                    acc.a[mt][nt] = __builtin_amdgcn_mfma_f32_32x32x16_bf16(cf[nt], tf[mt], acc.a[mt][nt], 0, 0, 0);
        }
        if (kt + 1 < KT) {
            bf16_t* wa = sm + (cur ^ 1) * (GA_EL + GB_EL); bf16_t* wb = wa + GA_EL;
#pragma unroll
            for (int i = 0; i < 4; ++i) *(uint4*)(wa + (lr + 64 * i) * LSTR + lc * 8) = ra[i];
#pragma unroll
            for (int i = 0; i < NT; ++i) *(uint4*)(wb + (lr + 64 * i) * LSTR + lc * 8) = rb[i];
        }
        __syncthreads();
    }
}
template <int NT> DEVI void acc_zero(GAcc<NT>& acc) {
#pragma unroll
    for (int mt = 0; mt < 2; ++mt)
#pragma unroll
        for (int nt = 0; nt < NT; ++nt)
#pragma unroll
            for (int i = 0; i < 16; ++i) acc.a[mt][nt][i] = 0.f;
}
template <int NT, class F> DEVI void acc_foreach(const GAcc<NT>& acc, int m0, int n0, F f) {
    const int lane = ltid() & 63, wave = ltid() >> 6, wm = wave >> 1, wn = wave & 1;
#pragma unroll
    for (int mt = 0; mt < 2; ++mt) {
        const int row = m0 + wm * 64 + mt * 32 + (lane & 31);
#pragma unroll
        for (int nt = 0; nt < NT; ++nt)
#pragma unroll
            for (int q = 0; q < 4; ++q) {
                const int col = n0 + wn * 32 * NT + nt * 32 + q * 8 + (lane >> 5) * 4;
                f(row, col, acc.a[mt][nt][q * 4 + 0], acc.a[mt][nt][q * 4 + 1], acc.a[mt][nt][q * 4 + 2], acc.a[mt][nt][q * 4 + 3]);
            }
    }
}
DEVI void st4bf(bf16_t* p, float a, float b, float c, float d) { uint2 w; w.x = pk2(a, b); w.y = pk2(c, d); *(uint2*)p = w; }
template <int H, int DH> DEVI void store_vt(bf16_t* VT, int row, int colv, float v0, float v1, float v2, float v3) {
    int b, t; bool ic; row_decode(row, b, t, ic);
    const int h = colv / DH, d = colv % DH;
    bf16_t* p = ic ? (VT + (size_t)NB * H * DH * T + ((size_t)(b * H + h) * DH + d) * CL + t) : (VT + ((size_t)(b * H + h) * DH + d) * T + t);
    const size_t st = ic ? CL : T;
    p[0] = f2bf(v0); p[st] = f2bf(v1); p[2 * st] = f2bf(v2); p[3 * st] = f2bf(v3);
}

template <int BR>
DEVI void phase_inproj(const P& p, int l, bf16_t* sm) {
    unsigned char* ws = p.ws;
    const bf16_t* HL = (const bf16_t*)(ws + OFF_HL);
    constexpr int colbase = BR == 0 ? COL_A : BR == 1 ? COL_B : BR == 2 ? COL_C : COL_D;
    constexpr int N = BR == 0 ? 2048 : BR == 1 ? 1280 : BR == 2 ? 1568 : 2048;
    const bf16_t* Wt = (const bf16_t*)(ws + OFF_WINT) + ((size_t)l * IN_TOTAL + colbase) * D;
    unsigned char* scr = ws + OFF_SCR;
    bf16_t* YSb = (bf16_t*)(ws + OFF_YS + BR * SZ512);
    const float* rope = (const float*)(ws + OFF_ROPE);
    constexpr int tilesN = (N + 127) / 128, tilesM = NR / 256;
    for (int tile = blockIdx.x; tile < tilesM * tilesN; tile += gridDim.x) {
        const int tm = tile / tilesN, tn = tile % tilesN;
        const int m0 = tm * 256, n0 = tn * 128;
        GAcc<2> acc; acc_zero(acc);
        gemm_kloop<2>(HL, D, Wt, D, D, m0, n0, sm, acc);
        if constexpr (BR == 0) {
            bf16_t* Q = (bf16_t*)(scr + SA_Q); bf16_t* Kb = (bf16_t*)(scr + SA_K); bf16_t* VT = (bf16_t*)(scr + SA_VT);
            acc_foreach<2>(acc, m0, n0, [&](int row, int col, float v0, float v1, float v2, float v3) {
                const int seg = col >> 9, cc = col & 511;
                if (seg == 0) st4bf(Q + (size_t)row * 512 + cc, v0, v1, v2, v3);
                else if (seg == 1) st4bf(Kb + (size_t)row * 512 + cc, v0, v1, v2, v3);
                else if (seg == 2) store_vt<8, 64>(VT, row, cc, v0, v1, v2, v3);
                else st4bf(YSb + (size_t)row * 512 + cc, siluf(v0), siluf(v1), siluf(v2), siluf(v3));
            });
        } else if constexpr (BR == 1) {
            bf16_t* Q = (bf16_t*)(scr + SB_Q); bf16_t* Kb = (bf16_t*)(scr + SB_K); bf16_t* VT = (bf16_t*)(scr + SB_VT);
            const int lane = ltid() & 63, wave = ltid() >> 6, wm = wave >> 1, wn = wave & 1;
            const int cb = n0 + wn * 64;
            if (cb < 640) {
#pragma unroll
                for (int mt = 0; mt < 2; ++mt) {
                    const int row = m0 + wm * 64 + mt * 32 + (lane & 31);
                    if (row < NL) {
                        const int t = row & (T - 1);
                        const float* cs = rope + (size_t)t * 32; const float* sn = rope + (size_t)T * 32 + (size_t)t * 32;
#pragma unroll
                        for (int i = 0; i < 16; ++i) {
                            const int c = (i & 3) + 8 * (i >> 2) + 4 * (lane >> 5);
                            const float co = cs[c], si = sn[c];
                            const float x1 = acc.a[mt][0][i], x2 = acc.a[mt][1][i];
                            acc.a[mt][0][i] = x1 * co - x2 * si; acc.a[mt][1][i] = x1 * si + x2 * co;
                        }
                    }
                }
            }
            acc_foreach<2>(acc, m0, n0, [&](int row, int col, float v0, float v1, float v2, float v3) {
                if (col < 512) st4bf(Q + (size_t)row * 512 + col, v0, v1, v2, v3);
                else if (col < 640) st4bf(Kb + (size_t)row * 128 + (col - 512), v0, v1, v2, v3);
                else if (col < 768) store_vt<2, 64>(VT, row, col - 640, v0, v1, v2, v3);
                else st4bf(YSb + (size_t)row * 512 + (col - 768), siluf(v0), siluf(v1), siluf(v2), siluf(v3));
            });
        } else if constexpr (BR == 2) {
            bf16_t* Q = (bf16_t*)(scr + SC_Q); bf16_t* Kb = (bf16_t*)(scr + SC_K); bf16_t* VT = (bf16_t*)(scr + SC_VT);
            float* LR = (float*)(scr + SC_LR);
            acc_foreach<2>(acc, m0, n0, [&](int row, int col, float v0, float v1, float v2, float v3) {
                if (col < 256) st4bf(Q + (size_t)row * 256 + col, v0 * 0.125f, v1 * 0.125f, v2 * 0.125f, v3 * 0.125f);
                else if (col < 512) st4bf(Kb + (size_t)row * 256 + (col - 256), v0, v1, v2, v3);
                else if (col < 1024) store_vt<4, 128>(VT, row, col - 512, v0, v1, v2, v3);
                else if (col < 1056) { float4 w = {v0, v1, v2, v3}; *(float4*)(LR + (size_t)row * 32 + (col - 1024)) = w; }
                else if (col < 1568) st4bf(YSb + (size_t)row * 512 + (col - 1056), siluf(v0), siluf(v1), siluf(v2), siluf(v3));
            });
        } else {
            bf16_t* U = (bf16_t*)(scr + SD_U);
            acc_foreach<2>(acc, m0, n0, [&](int row, int col, float v0, float v1, float v2, float v3) {
                if (col < 1536) st4bf(U + (size_t)row * 1536 + col, v0, v1, v2, v3);
                else st4bf(YSb + (size_t)row * 512 + (col - 1536), siluf(v0), siluf(v1), siluf(v2), siluf(v3));
            });
        }
    }
}

DEVI void phase_merge(const P& p, int l, bf16_t* sm) {
    unsigned char* ws = p.ws;
    const bf16_t* HL = (const bf16_t*)(ws + OFF_HL);
    const bf16_t* Wgm = (const bf16_t*)(ws + OFF_WINT) + ((size_t)l * IN_TOTAL + COL_GM) * D;
    const bf16_t* Wb = (const bf16_t*)(ws + OFF_WBT) + (size_t)l * 4 * D * 512;
    bf16_t* ACCM = (bf16_t*)(ws + OFF_SCR);
    const int M = (l == 0) ? NR : NL;
    const int tilesM = M / 256, tilesN = D / 64;
    for (int tile = blockIdx.x; tile < tilesM * tilesN; tile += gridDim.x) {
        const int tm = tile / tilesN, tn = tile % tilesN;
        const int m0 = tm * 256, n0 = tn * 64;
        GAcc<1> tot; acc_zero(tot);
#pragma unroll 1
        for (int i = 0; i < 4; ++i) {
            GAcc<1> g; acc_zero(g);
            gemm_kloop<1>(HL, D, Wgm + (size_t)i * D * D, D, D, m0, n0, sm, g);
            GAcc<1> pr; acc_zero(pr);
            gemm_kloop<1>((const bf16_t*)(ws + OFF_YS + i * SZ512), 512, Wb + (size_t)i * D * 512, 512, 512, m0, n0, sm, pr);
#pragma unroll
            for (int mt = 0; mt < 2; ++mt)
#pragma unroll
                for (int e = 0; e < 16; ++e) tot.a[mt][0][e] += sigmf(g.a[mt][0][e]) * pr.a[mt][0][e];
        }
        acc_foreach<1>(tot, m0, n0, [&](int row, int col, float v0, float v1, float v2, float v3) {
            st4bf(ACCM + (size_t)row * D + col, v0, v1, v2, v3);
        });
    }
}

DEVI void phase_out(const P& p, int l, bf16_t* sm) {
    unsigned char* ws = p.ws;
    const bf16_t* ACCM = (const bf16_t*)(ws + OFF_SCR);
    const bf16_t* Wo = (const bf16_t*)(ws + OFF_WOT) + (size_t)l * D * D;
    const float* MOD = (const float*)(ws + OFF_MOD) + (size_t)l * 3 * 3072;
    float* XC1 = (float*)(ws + OFF_XC1);
    const int M = (l == 0) ? NR : NL;
    const int tilesM = M / 256, tilesN = D / 128;
    for (int tile = blockIdx.x; tile < tilesM * tilesN; tile += gridDim.x) {
        const int tm = tile / tilesN, tn = tile % tilesN;
        const int m0 = tm * 256, n0 = tn * 128;
        GAcc<2> acc; acc_zero(acc);
        gemm_kloop<2>(ACCM, D, Wo, D, D, m0, n0, sm, acc);
        acc_foreach<2>(acc, m0, n0, [&](int row, int col, float v0, float v1, float v2, float v3) {
            int b, t; bool ic; row_decode(row, b, t, ic);
            const int mi = ic ? 2 : b;
            const float4 g = *(const float4*)(MOD + mi * 3072 + 2048 + col);
            const float* src; float* dst;
            if (ic) { src = (l == 0 ? p.ctx : XC1) + (size_t)(row - NL) * D + col; dst = XC1 + (size_t)(row - NL) * D + col; }
            else { src = (l == 0 ? p.x : p.out) + (size_t)row * D + col; dst = p.out + (size_t)row * D + col; }
            const float4 xo = *(const float4*)src;
            float4 r = {xo.x + g.x * v0, xo.y + g.y * v1, xo.z + g.z * v2, xo.w + g.w * v3};
            *(float4*)dst = r;
        });
    }
}

DEVI void transpose_tile(const float* __restrict__ src, int K, int N, bf16_t* __restrict__ dst, int k0, int n0, float* sm) {
    const int tid = ltid();
    __syncthreads();
    {
        const int kr = tid >> 4, nc = (tid & 15) * 4;
#pragma unroll
        for (int i = 0; i < 2; ++i) {
            const int k = kr + 32 * i;
            float4 v = {0.f, 0.f, 0.f, 0.f};
            if (n0 + nc < N) v = *(const float4*)(src + (size_t)(k0 + k) * N + n0 + nc);
            sm[k * 65 + nc + 0] = v.x; sm[k * 65 + nc + 1] = v.y; sm[k * 65 + nc + 2] = v.z; sm[k * 65 + nc + 3] = v.w;
        }
    }
    __syncthreads();
    {
        const int n = tid >> 3, kc = (tid & 7) * 8;
        if (n0 + n < N) {
            uint4 w;
            w.x = pk2(sm[(kc + 0) * 65 + n], sm[(kc + 1) * 65 + n]); w.y = pk2(sm[(kc + 2) * 65 + n], sm[(kc + 3) * 65 + n]);
            w.z = pk2(sm[(kc + 4) * 65 + n], sm[(kc + 5) * 65 + n]); w.w = pk2(sm[(kc + 6) * 65 + n], sm[(kc + 7) * 65 + n]);
            *(uint4*)(dst + (size_t)(n0 + n) * K + k0 + kc) = w;
        }
    }
}

DEVI void hyena_mlp_task(const P& p, int l, int L, int p0, float* HT, float* sm) {
    const int tid = ltid();
    float* zb = sm;
    float* h1 = sm + 64 * 33;
    float* h2 = h1 + 64 * 65;
    const float* w1 = p.fw1 + (size_t)l * 33 * 64; const float* b1 = p.fb1 + l * 64;
    const float* w2 = p.fw2 + (size_t)l * 64 * 64; const float* b2 = p.fb2 + l * 64;
    const float* w3 = p.fw3 + (size_t)l * 64 * 64; const float* b3 = p.fb3 + l * 64;
    const float* fr = p.ffreq + l * 64;
    __syncthreads();
#pragma unroll 1
    for (int e = tid; e < 64 * 33; e += NTHR) {
        const int pos = e / 33, k = e % 33;
        const int pp = p0 + pos;
        float v;
        if (k == 0) v = (float)pp / (float)(L - 1);
        else {
            const int j = (k - 1) & 15;
            const float f = 1e-4f + (float)j * ((15.0f - 1e-4f) / 15.0f);
            const float wa = 6.283185307179586f * (float)pp / (float)L;
            v = (k <= 16) ? cosf(f * wa) : -sinf(f * wa);
        }
        zb[e] = v;
    }
    __syncthreads();
    const int pos = tid >> 3, fg = (tid & 7) * 8;
    {
        float a[8];
#pragma unroll
        for (int j = 0; j < 8; ++j) a[j] = b1[fg + j];
#pragma unroll 1
        for (int k = 0; k < 33; ++k) {
            const float zv = zb[pos * 33 + k];
#pragma unroll
            for (int j = 0; j < 8; ++j) a[j] += zv * w1[k * 64 + fg + j];
        }
#pragma unroll
        for (int j = 0; j < 8; ++j) h1[pos * 65 + fg + j] = sinf(fr[fg + j] * a[j]);
    }
    __syncthreads();
    {
        float a[8];
#pragma unroll
        for (int j = 0; j < 8; ++j) a[j] = b2[fg + j];
#pragma unroll 2
        for (int k = 0; k < 64; ++k) {
            const float zv = h1[pos * 65 + k];
#pragma unroll
            for (int j = 0; j < 8; ++j) a[j] += zv * w2[k * 64 + fg + j];
        }
#pragma unroll
        for (int j = 0; j < 8; ++j) h2[pos * 65 + fg + j] = sinf(fr[fg + j] * a[j]);
    }
    __syncthreads();
    {
        float a[8];
#pragma unroll
        for (int j = 0; j < 8; ++j) a[j] = b3[fg + j];
#pragma unroll 2
        for (int k = 0; k < 64; ++k) {
            const float zv = h2[pos * 65 + k];
#pragma unroll
            for (int j = 0; j < 8; ++j) a[j] += zv * w3[k * 64 + fg + j];
        }
#pragma unroll
        for (int j = 0; j < 8; ++j) HT[(size_t)(fg + j) * L + p0 + pos] = sinf(fr[fg + j] * a[j]);
    }
}

DEVI void phase_prep(const P& p, float* sm) {
    unsigned char* ws = p.ws;
    const int tid = ltid();
    constexpr int TN_IN = (IN_TOTAL + 63) / 64;
    constexpr int T_WIN = 2 * 16 * TN_IN;
    constexpr int T_WB = 2 * 4 * 8 * 16;
    constexpr int T_WO = 2 * 16 * 16;
    constexpr int T_MOD = 2 * 48;
    constexpr int T_ROPE = T * 32 / NTHR;
    constexpr int T_MLP = 2 * 256 + 4;
    constexpr int E0 = T_WIN, E1 = E0 + T_WB, E2 = E1 + T_WO, E3 = E2 + T_MOD, E4 = E3 + T_ROPE, E5 = E4 + T_MLP;
    for (int task = blockIdx.x; task < E5; task += gridDim.x) {
        if (task < E0) {
            const int l = task / (16 * TN_IN), r = task % (16 * TN_IN), kt = r / TN_IN, nt = r % TN_IN;
            transpose_tile(p.w_in + (size_t)l * D * IN_TOTAL, D, IN_TOTAL, (bf16_t*)(ws + OFF_WINT) + (size_t)l * IN_TOTAL * D, kt * 64, nt * 64, sm);
        } else if (task < E1) {
            const int q = task - E0, li = q / 128, r = q % 128, kt = r / 16, nt = r % 16;
            transpose_tile(p.w_branch + (size_t)li * 512 * D, 512, D, (bf16_t*)(ws + OFF_WBT) + (size_t)li * D * 512, kt * 64, nt * 64, sm);
        } else if (task < E2) {
            const int q = task - E1, l = q / 256, r = q % 256, kt = r / 16, nt = r % 16;
            transpose_tile(p.w_out + (size_t)l * D * D, D, D, (bf16_t*)(ws + OFF_WOT) + (size_t)l * D * D, kt * 64, nt * 64, sm);
        } else if (task < E3) {
            const int q = task - E2, l = q / 48, jb = q % 48;
            float* sc = sm;
            float* red = sm + 3072;
            __syncthreads();
#pragma unroll 1
            for (int e = tid; e < 3072; e += NTHR) {
                const int mi = e >> 10, k = e & 1023;
                const float v = (mi < 2) ? p.c[mi * D + k] : p.c_ctx[k];
                sc[e] = siluf(v);
            }
            __syncthreads();
            const int kg = tid >> 6, jj = tid & 63, j = jb * 64 + jj;
            const float* w = p.w_mod + (size_t)l * D * 3072 + j;
            float a0 = 0.f, a1 = 0.f, a2 = 0.f;
#pragma unroll 8
            for (int k = kg * 128; k < kg * 128 + 128; ++k) {
                const float wv = w[(size_t)k * 3072];
                a0 += sc[k] * wv; a1 += sc[1024 + k] * wv; a2 += sc[2048 + k] * wv;
            }
            red[(0 * 8 + kg) * 64 + jj] = a0; red[(1 * 8 + kg) * 64 + jj] = a1; red[(2 * 8 + kg) * 64 + jj] = a2;
            __syncthreads();
            if (tid < 192) {
                const int mi = tid >> 6, j2 = tid & 63;
                float s = p.b_mod[l * 3072 + jb * 64 + j2];
#pragma unroll
                for (int g = 0; g < 8; ++g) s += red[(mi * 8 + g) * 64 + j2];
                ((float*)(ws + OFF_MOD))[((size_t)l * 3 + mi) * 3072 + jb * 64 + j2] = s;
            }
        } else if (task < E4) {
            const int e = (task - E3) * NTHR + tid;
            const int t = e >> 5, c = e & 31;
            const float inv = powf(10000.0f, -(float)(c & 15) / 16.0f);
            const float pos = (c < 16) ? (float)(t >> 6) : (float)(t & 63);
            const float ang = pos * inv;
            float* rope = (float*)(ws + OFF_ROPE);
            rope[e] = cosf(ang); rope[(size_t)T * 32 + e] = sinf(ang);
        } else {
            const int q = task - E4;
            if (q < 512) { const int l = q >> 8; hyena_mlp_task(p, l, T, (q & 255) * 64, (float*)(ws + OFF_HH3T) + (size_t)l * 64 * T, sm); }
            else hyena_mlp_task(p, 0, CL, (q - 512) * 64, (float*)(ws + OFF_HH3C), sm);
        }
    }
}

DEVI void phase_hl(const P& p, int l) {
    unsigned char* ws = p.ws;
    const int lane = ltid() & 63, wave = ltid() >> 6;
    const float* MOD = (const float*)(ws + OFF_MOD) + (size_t)l * 3 * 3072;
    const float* nw = p.norm_w + l * D;
    bf16_t* HL = (bf16_t*)(ws + OFF_HL);
    const float* XC1 = (const float*)(ws + OFF_XC1);
    for (int row = blockIdx.x * 8 + wave; row < NR; row += gridDim.x * 8) {
        const float* src; int mi;
        if (row < NL) { src = (l == 0 ? p.x : p.out) + (size_t)row * D; mi = row >> 14; }
        else { src = (l == 0 ? p.ctx : XC1) + (size_t)(row - NL) * D; mi = 2; }
        float4 v[4]; float ss = 0.f;
#pragma unroll
        for (int i = 0; i < 4; ++i) { v[i] = *(const float4*)(src + lane * 4 + 256 * i); ss += v[i].x * v[i].x + v[i].y * v[i].y + v[i].z * v[i].z + v[i].w * v[i].w; }
        ss = wave_sum(ss);
        const float rs = rsqrtf(ss * (1.0f / D) + EPS);
        const float* sh = MOD + mi * 3072; const float* sc = sh + 1024;
#pragma unroll
        for (int i = 0; i < 4; ++i) {
            const int c = lane * 4 + 256 * i;
            const float4 w = *(const float4*)(nw + c), s1 = *(const float4*)(sc + c), s0 = *(const float4*)(sh + c);
            st4bf(HL + (size_t)row * D + c, v[i].x * rs * w.x * (1.f + s1.x) + s0.x, v[i].y * rs * w.y * (1.f + s1.y) + s0.y,
                  v[i].z * rs * w.z * (1.f + s1.z) + s0.z, v[i].w * rs * w.w * (1.f + s1.w) + s0.w);
        }
    }
}
DEVI void phase_final(const P& p) {
    const int lane = ltid() & 63, wave = ltid() >> 6;
    for (int row = blockIdx.x * 8 + wave; row < NL; row += gridDim.x * 8) {
        float* src = p.out + (size_t)row * D;
        float4 v[4]; float ss = 0.f;
#pragma unroll
        for (int i = 0; i < 4; ++i) { v[i] = *(const float4*)(src + lane * 4 + 256 * i); ss += v[i].x * v[i].x + v[i].y * v[i].y + v[i].z * v[i].z + v[i].w * v[i].w; }
        ss = wave_sum(ss);
        const float rs = rsqrtf(ss * (1.0f / D) + EPS);
#pragma unroll
        for (int i = 0; i < 4; ++i) {
            const int c = lane * 4 + 256 * i;
            const float4 w = *(const float4*)(p.final_norm_w + c);
            float4 r = {v[i].x * rs * w.x, v[i].y * rs * w.y, v[i].z * rs * w.z, v[i].w * rs * w.w};
            *(float4*)(src + c) = r;
        }
    }
}

union U8 { bf16x8 v; uint4 u; uint2 h[2]; unsigned w[4]; };
struct AttSt { float m, l; f32x4 o[4]; };
constexpr float L2E = 1.4426950408889634f;
constexpr float NEG_INF = -__builtin_huge_valf();

DEVI void att_step(AttSt& st, const bf16x8& q0, const bf16x8& q1, const bf16_t* k0p, const bf16_t* k1p,
                   const bf16_t* v0p, const bf16_t* v1p, size_t ldv, f32x4 b0, f32x4 b1, float scale2) {
    const bf16x8 ka = *(const bf16x8*)k0p, kb = *(const bf16x8*)(k0p + 32);
    const bf16x8 kc = *(const bf16x8*)k1p, kd = *(const bf16x8*)(k1p + 32);
    U8 vf[4];
#pragma unroll
    for (int dt = 0; dt < 4; ++dt) { vf[dt].h[0] = *(const uint2*)(v0p + (size_t)dt * 16 * ldv); vf[dt].h[1] = *(const uint2*)(v1p + (size_t)dt * 16 * ldv); }
    f32x4 s0 = {0.f, 0.f, 0.f, 0.f}, s1 = {0.f, 0.f, 0.f, 0.f};
    s0 = __builtin_amdgcn_mfma_f32_16x16x32_bf16(ka, q0, s0, 0, 0, 0);
    s0 = __builtin_amdgcn_mfma_f32_16x16x32_bf16(kb, q1, s0, 0, 0, 0);
    s1 = __builtin_amdgcn_mfma_f32_16x16x32_bf16(kc, q0, s1, 0, 0, 0);
    s1 = __builtin_amdgcn_mfma_f32_16x16x32_bf16(kd, q1, s1, 0, 0, 0);
    s0 = s0 * scale2 + b0; s1 = s1 * scale2 + b1;
    float mx = fmaxf(fmaxf(fmaxf(s0[0], s0[1]), fmaxf(s0[2], s0[3])), fmaxf(fmaxf(s1[0], s1[1]), fmaxf(s1[2], s1[3])));
    mx = fmaxf(mx, __shfl_xor(mx, 16)); mx = fmaxf(mx, __shfl_xor(mx, 32));
    const float mn = fmaxf(st.m, mx);
    const float alpha = __builtin_amdgcn_exp2f(st.m - mn);
    float pa[8];
#pragma unroll
    for (int i = 0; i < 4; ++i) { pa[i] = __builtin_amdgcn_exp2f(s0[i] - mn); pa[4 + i] = __builtin_amdgcn_exp2f(s1[i] - mn); }
    st.l = st.l * alpha + ((pa[0] + pa[1]) + (pa[2] + pa[3])) + ((pa[4] + pa[5]) + (pa[6] + pa[7]));
    st.m = mn;
    U8 pf; pf.w[0] = pk2(pa[0], pa[1]); pf.w[1] = pk2(pa[2], pa[3]); pf.w[2] = pk2(pa[4], pa[5]); pf.w[3] = pk2(pa[6], pa[7]);
#pragma unroll
    for (int dt = 0; dt < 4; ++dt) {
        st.o[dt] = st.o[dt] * alpha;
        st.o[dt] = __builtin_amdgcn_mfma_f32_16x16x32_bf16(vf[dt].v, pf.v, st.o[dt], 0, 0, 0);
    }
}
DEVI void att_ctx_steps(AttSt& st, const bf16x8& q0, const bf16x8& q1, const bf16_t* Kc, int ldk, const bf16_t* Vc, float scale2) {
    const int lane = ltid() & 63;
    const f32x4 z = {0.f, 0.f, 0.f, 0.f};
#pragma unroll 2
    for (int s = 0; s < 8; ++s) {
        const bf16_t* k0 = Kc + (size_t)(s * 32 + (lane & 15)) * ldk;
        att_step(st, q0, q1, k0, k0 + (size_t)16 * ldk, Vc + s * 32, Vc + s * 32 + 16, CL, z, z, scale2);
    }
}
DEVI void att_finish(const AttSt& st, float extra_l, bf16_t* G  ) {
    const int lane = ltid() & 63, g = lane >> 4;
    float lt = st.l; lt += __shfl_xor(lt, 16); lt += __shfl_xor(lt, 32);
    lt += extra_l;
    const float inv = 1.f / lt;
#pragma unroll
    for (int dt = 0; dt < 4; ++dt) {
        bf16_t* gp = G + dt * 16 + 4 * g;
        const uint2 gv = *(const uint2*)gp;
        st4bf(gp, st.o[dt][0] * inv * lo_bf(gv.x), st.o[dt][1] * inv * hi_bf(gv.x), st.o[dt][2] * inv * lo_bf(gv.y), st.o[dt][3] * inv * hi_bf(gv.y));
    }
}

DEVI void phase_att_a(const P& p, int l, float* smf) {
    unsigned char* ws = p.ws; unsigned char* scr = ws + OFF_SCR;
    const bf16_t* Q = (const bf16_t*)(scr + SA_Q); const bf16_t* K = (const bf16_t*)(scr + SA_K); const bf16_t* VT = (const bf16_t*)(scr + SA_VT);
    const bf16_t* VTC = VT + (size_t)NB * 8 * 64 * T;
    bf16_t* G = (bf16_t*)(ws + OFF_YS);
    const int tid = ltid(), lane = tid & 63, h = tid >> 6, q = lane & 15, g = lane >> 4;
    __syncthreads();
    for (int e = tid; e < 8 * 465; e += NTHR) smf[e] = p.rpb[(size_t)l * 8 * 465 + e] * L2E;
    __syncthreads();
    const float* tab = smf + h * 465;
    const float scale2 = 0.125f * L2E;
    const int ntask = 2048 + (l == 0 ? 32 : 0);
    for (int task = blockIdx.x; task < ntask; task += gridDim.x) {
        AttSt st; st.m = -1e30f; st.l = 0.f;
#pragma unroll
        for (int dt = 0; dt < 4; ++dt) st.o[dt] = (f32x4){0.f, 0.f, 0.f, 0.f};
        int b, qrow;
        const bool lat = task < 2048;
        int r = 0, j = 0;
        if (lat) { b = task >> 10; r = (task >> 2) & 255; j = task & 3; qrow = b * T + r * 64 + j * 16 + q; }
        else { const int tt = task - 2048; b = tt >> 4; qrow = NL + b * CL + (tt & 15) * 16 + q; }
        const bf16_t* qp = Q + (size_t)qrow * 512 + h * 64 + g * 8;
        const bf16x8 q0 = *(const bf16x8*)qp, q1 = *(const bf16x8*)(qp + 32);
        if (lat) {
            const int rs = min(max(r - 4, 0), 248), kc0 = min(max(j * 16 - 8, 0), 32);
            const int qc = j * 16 + q, cs = min(max(qc - 8, 0), 48);
#pragma unroll 2
            for (int kr = 0; kr < 8; ++kr) {
                const int trow = (rs + kr) * 64 + kc0;
                const bf16_t* k0 = K + (size_t)(b * T + trow + (lane & 15)) * 512 + h * 64 + g * 8;
                const bf16_t* v0 = VT + ((size_t)(b * 8 + h) * 64 + (lane & 15)) * T + trow + 4 * g;
                const float* trw = tab + (rs + kr - r + 7) * 31;
                f32x4 b0, b1;
#pragma unroll
                for (int i = 0; i < 4; ++i) {
                    const int kc_a = kc0 + 4 * g + i, kc_b = kc_a + 16;
                    b0[i] = (kc_a >= cs && kc_a < cs + 16) ? trw[min(max(kc_a - qc + 15, 0), 30)] : NEG_INF;
                    b1[i] = (kc_b >= cs && kc_b < cs + 16) ? trw[min(max(kc_b - qc + 15, 0), 30)] : NEG_INF;
                }
                att_step(st, q0, q1, k0, k0 + 16 * 512, v0, v0 + 16, T, b0, b1, scale2);
            }
        }
        att_ctx_steps(st, q0, q1, K + (size_t)(NL + b * CL) * 512 + h * 64 + g * 8, 512, VTC + ((size_t)(b * 8 + h) * 64 + (lane & 15)) * CL + 4 * g, scale2);
        att_finish(st, 0.f, G + (size_t)qrow * 512 + h * 64);
    }
}

DEVI void phase_att_b(const P& p, int l) {
    unsigned char* ws = p.ws; unsigned char* scr = ws + OFF_SCR;
    const bf16_t* Q = (const bf16_t*)(scr + SB_Q); const bf16_t* K = (const bf16_t*)(scr + SB_K); const bf16_t* VT = (const bf16_t*)(scr + SB_VT);
    const bf16_t* VTC = VT + (size_t)NB * 2 * 64 * T;
    bf16_t* G = (bf16_t*)(ws + OFF_YS + SZ512);
    const int tid = ltid(), lane = tid & 63, h = tid >> 6, kvh = h >> 2, q = lane & 15, g = lane >> 4;
    const float scale2 = 0.125f * L2E;
    const float sink2 = p.sink[l * 8 + h] * L2E;
    const int ntask = 2048 + (l == 0 ? 32 : 0);
    for (int task = blockIdx.x; task < ntask; task += gridDim.x) {
        AttSt st; st.m = -1e30f; st.l = 0.f;
#pragma unroll
        for (int dt = 0; dt < 4; ++dt) st.o[dt] = (f32x4){0.f, 0.f, 0.f, 0.f};
        int b, qrow;
        const bool lat = task < 2048;
        int q0t = 0;
        if (lat) { b = task >> 10; q0t = (task & 1023) * 16; qrow = b * T + q0t + q; }
        else { const int tt = task - 2048; b = tt >> 4; qrow = NL + b * CL + (tt & 15) * 16 + q; }
        const bf16_t* qp = Q + (size_t)qrow * 512 + h * 64 + g * 8;
        const bf16x8 q0 = *(const bf16x8*)qp, q1 = *(const bf16x8*)(qp + 32);
        if (lat) {
            const int tq = q0t + q;
#pragma unroll 1
            for (int s = 0; s < 9; ++s) {
                const int tbase = q0t - 128 + 32 * s;
                const int ta = min(max(tbase + (lane & 15), 0), T - 1), tb = min(max(tbase + 16 + (lane & 15), 0), T - 1);
                const bf16_t* k0 = K + (size_t)(b * T + ta) * 128 + kvh * 64 + g * 8;
                const bf16_t* k1 = K + (size_t)(b * T + tb) * 128 + kvh * 64 + g * 8;
                const int va = min(max(tbase + 4 * g, 0), T - 4), vb = min(max(tbase + 16 + 4 * g, 0), T - 4);
                const bf16_t* vbase = VT + ((size_t)(b * 2 + kvh) * 64 + (lane & 15)) * T;
                f32x4 b0, b1;
#pragma unroll
                for (int i = 0; i < 4; ++i) {
                    const int t0 = tbase + 4 * g + i, t1 = t0 + 16;
                    b0[i] = (t0 >= 0 && t0 < T && abs(tq - t0) <= 128) ? 0.f : NEG_INF;
                    b1[i] = (t1 >= 0 && t1 < T && abs(tq - t1) <= 128) ? 0.f : NEG_INF;
                }
                att_step(st, q0, q1, k0, k1, vbase + va, vbase + vb, T, b0, b1, scale2);
            }
        }
        att_ctx_steps(st, q0, q1, K + (size_t)(NL + b * CL) * 128 + kvh * 64 + g * 8, 128, VTC + ((size_t)(b * 2 + kvh) * 64 + (lane & 15)) * CL + 4 * g, scale2);
        att_finish(st, __builtin_amdgcn_exp2f(sink2 - st.m), G + (size_t)qrow * 512 + h * 64);
    }
}

constexpr int GL_CUM = 0;
constexpr int GL_LR = 32768;
constexpr int GL_T0 = GL_LR + 8192;
constexpr int GL_TSZ = 64 * LSTR * 2;
constexpr int GL_X = GL_T0 + 4 * GL_TSZ;

DEVI float logsigmoidf(float x) { return fminf(x, 0.f) - log1pf(expf(-fabsf(x))); }

DEVI void gla_cum(const P& p, int l, int h, int rowbase, unsigned char* sm) {
    const int tid = ltid();
    float* cum = (float*)(sm + GL_CUM); float* lrs = (float*)(sm + GL_LR);
    const float* LR = (const float*)(p.ws + OFF_SCR + SC_LR);
    __syncthreads();
    { const int t = tid >> 3, c4 = (tid & 7) * 4; *(float4*)(lrs + t * 32 + c4) = *(const float4*)(LR + (size_t)(rowbase + t) * 32 + c4); }
    __syncthreads();
    const int d = tid & 63, tg = tid >> 6;
#pragma unroll
    for (int dir = 0; dir < 2; ++dir) {
        const float* W = p.w_alpha_up + ((size_t)(l * 2 + dir) * 16) * 256 + h * 64 + d;
        float w[16];
#pragma unroll
        for (int r = 0; r < 16; ++r) w[r] = W[r * 256];
        const float bia = p.b_alpha[(l * 2 + dir) * 256 + h * 64 + d];
#pragma unroll
        for (int tt = 0; tt < 8; ++tt) {
            const int t = tg * 8 + tt;
            float x = bia;
#pragma unroll
            for (int r = 0; r < 16; ++r) x += lrs[t * 32 + dir * 16 + r] * w[r];
            cum[(dir * 64 + t) * 64 + d] = logsigmoidf(x) * (1.0f / 16.0f);
        }
    }
    __syncthreads();
    if (tid < 128) {
        const int dir = tid >> 6;
        float run = 0.f;
        if (dir == 0) { for (int t = 0; t < 64; ++t) { run += cum[t * 64 + d]; cum[t * 64 + d] = run; } }
        else { for (int t = 63; t >= 0; --t) { run += cum[(64 + t) * 64 + d]; cum[(64 + t) * 64 + d] = run; } }
    }
    __syncthreads();
}
DEVI void gla_chunk_geom(int b, int c, int& rowbase, size_t& vt_off  , size_t& vld, int& ci_f, int& ci_b) {
    if (c < 4) { rowbase = NL + b * CL + c * 64; vld = CL; ci_f = c; ci_b = 3 - c; }
    else { rowbase = b * T + (c - 4) * 64; vld = T; ci_f = c; ci_b = 4 + 255 - (c - 4); }
}
DEVI const bf16_t* gla_vt_ptr(const bf16_t* VT, int b, int h, int c) {
    if (c < 4) return VT + (size_t)NB * 4 * 128 * T + ((size_t)(b * 4 + h) * 128) * CL + c * 64;
    return VT + ((size_t)(b * 4 + h) * 128) * T + (size_t)(c - 4) * 64;
}

DEVI void phase_gla1(const P& p, int l, unsigned char* sm) {
    unsigned char* scr = p.ws + OFF_SCR;
    const bf16_t* KG = (const bf16_t*)(scr + SC_K); const bf16_t* VT = (const bf16_t*)(scr + SC_VT);
    bf16_t* SB = (bf16_t*)(scr + SC_SB); float* GD = (float*)(scr + SC_GD);
    const int tid = ltid(), lane = tid & 63, wave = tid >> 6;
    const float* cum = (const float*)(sm + GL_CUM);
    bf16_t* kdT = (bf16_t*)(sm + GL_T0);
    for (int task = blockIdx.x; task < 8 * NCH; task += gridDim.x) {
        const int bh = task / NCH, c = task % NCH, b = bh >> 2, h = bh & 3;
        int rowbase, ci_f, ci_b; size_t vo, vld;
        gla_chunk_geom(b, c, rowbase, vo, vld, ci_f, ci_b);
        gla_cum(p, l, h, rowbase, sm);
        {
            const int d = tid & 63, tg = tid >> 6;
            const float ce_f = cum[63 * 64 + d], ce_b = cum[64 * 64 + d];
            float vf[8], vb[8];
#pragma unroll
            for (int j = 0; j < 8; ++j) {
                const int t = tg * 8 + j;
                const float kf = bf2f(KG[(size_t)(rowbase + t) * 256 + h * 64 + d]);
                vf[j] = kf * __expf(ce_f - cum[t * 64 + d]);
                vb[j] = kf * __expf(ce_b - cum[(64 + t) * 64 + d]);
            }
            uint4 wf, wb;
            wf.x = pk2(vf[0], vf[1]); wf.y = pk2(vf[2], vf[3]); wf.z = pk2(vf[4], vf[5]); wf.w = pk2(vf[6], vf[7]);
            wb.x = pk2(vb[0], vb[1]); wb.y = pk2(vb[2], vb[3]); wb.z = pk2(vb[4], vb[5]); wb.w = pk2(vb[6], vb[7]);
            *(uint4*)(kdT + d * LSTR + tg * 8) = wf;
            *(uint4*)(kdT + (64 + d) * LSTR + tg * 8) = wb;
        }
        __syncthreads();
        {
            const int dir = wave >> 2, dvt = wave & 3;
            const bf16_t* vp = gla_vt_ptr(VT, b, h, c) + (size_t)(dvt * 32 + (lane & 31)) * vld + (lane >> 5) * 8;
            const bf16_t* ap = kdT + (dir * 64 + (lane & 31)) * LSTR + (lane >> 5) * 8;
            f32x16 acc[2];
#pragma unroll
            for (int i = 0; i < 16; ++i) { acc[0][i] = 0.f; acc[1][i] = 0.f; }
#pragma unroll
            for (int ks = 0; ks < 4; ++ks) {
                const bf16x8 vb = *(const bf16x8*)(vp + ks * 16);
#pragma unroll
                for (int mt = 0; mt < 2; ++mt) {
                    const bf16x8 ka = *(const bf16x8*)(ap + mt * 32 * LSTR + ks * 16);
                    acc[mt] = __builtin_amdgcn_mfma_f32_32x32x16_bf16(ka, vb, acc[mt], 0, 0, 0);
                }
            }
            const int bhd = bh * 2 + dir, ci = dir ? ci_b : ci_f;
            bf16_t* out = SB + ((size_t)bhd * NCH + ci) * 8192 + (size_t)(dvt * 32 + (lane & 31)) * 64;
#ifdef EXP_C
            for (int mt = 0; mt < 2; ++mt) for (int i = 0; i < 16; ++i) { const int dk = mt * 32 + (i & 3) + 8 * (i >> 2) + 4 * (lane >> 5); acc[mt][i] = bf2f(kdT[(dir * 64 + dk) * LSTR + ((dvt * 32 + (lane & 31)) & 63)]); }
#endif
#pragma unroll
            for (int mt = 0; mt < 2; ++mt)
#pragma unroll
                for (int q4 = 0; q4 < 4; ++q4)
                    st4bf(out + mt * 32 + q4 * 8 + (lane >> 5) * 4, acc[mt][q4 * 4 + 0], acc[mt][q4 * 4 + 1], acc[mt][q4 * 4 + 2], acc[mt][q4 * 4 + 3]);
        }
        if (tid < 128) {
            const int dir = tid >> 6, d = tid & 63;
            const int bhd = bh * 2 + dir, ci = dir ? ci_b : ci_f;
            GD[((size_t)bhd * NCH + ci) * 64 + d] = __expf(dir ? cum[64 * 64 + d] : cum[63 * 64 + d]);
        }
    }
}

DEVI void phase_gla2(const P& p) {
    unsigned char* scr = p.ws + OFF_SCR;
    bf16_t* SB = (bf16_t*)(scr + SC_SB); const float* GD = (const float*)(scr + SC_GD);
    for (int idx = blockIdx.x * NTHR + ltid(); idx < 16 * 8192; idx += gridDim.x * NTHR) {
        const int bhd = idx >> 13, e = idx & 8191, dk = e & 63;
        bf16_t* base = SB + (size_t)bhd * NCH * 8192 + e;
        const float* gd = GD + (size_t)bhd * NCH * 64 + dk;
        float S = 0.f;
        for (int ci = 0; ci < NCH; ci += 4) {
            float kv[4], g[4];
#pragma unroll
            for (int u = 0; u < 4; ++u) { kv[u] = bf2f(base[(size_t)(ci + u) * 8192]); g[u] = gd[(ci + u) * 64]; }
#pragma unroll
            for (int u = 0; u < 4; ++u) { base[(size_t)(ci + u) * 8192] = f2bf(S); S = g[u] * S + kv[u]; }
        }
    }
}

DEVI void phase_gla3(const P& p, int l, unsigned char* sm) {
    unsigned char* scr = p.ws + OFF_SCR;
    const bf16_t* QG = (const bf16_t*)(scr + SC_Q); const bf16_t* KG = (const bf16_t*)(scr + SC_K); const bf16_t* VT = (const bf16_t*)(scr + SC_VT);
    const bf16_t* SB = (const bf16_t*)(scr + SC_SB);
    bf16_t* G = (bf16_t*)(p.ws + OFF_YS + 2 * SZ512);
    const float* gnw = p.gla_norm_w + l * 128;
    const int tid = ltid(), lane = tid & 63, wave = tid >> 6, q = lane & 15, g = lane >> 4;
    const float* cum = (const float*)(sm + GL_CUM);
    bf16_t* tiles = (bf16_t*)(sm + GL_T0);
    float* X = (float*)(sm + GL_X);
    const int c_lo = (l == 0) ? 0 : 4;
    const int nper = NCH - c_lo;
    for (int task = blockIdx.x; task < 8 * nper; task += gridDim.x) {
        const int bh = task / nper, c = c_lo + task % nper, b = bh >> 2, h = bh & 3;
        int rowbase, ci_f, ci_b; size_t vo, vld;
        gla_chunk_geom(b, c, rowbase, vo, vld, ci_f, ci_b);
        gla_cum(p, l, h, rowbase, sm);
        {
            const int t = tid >> 3, dg = (tid & 7) * 8;
            U8 qv, kv; qv.u = *(const uint4*)(QG + (size_t)(rowbase + t) * 256 + h * 64 + dg); kv.u = *(const uint4*)(KG + (size_t)(rowbase + t) * 256 + h * 64 + dg);
            float o[4][8];
#pragma unroll
            for (int j = 0; j < 8; ++j) {
                const int d = dg + j;
                const float qf = (j & 1) ? hi_bf(qv.w[j >> 1]) : lo_bf(qv.w[j >> 1]);
                const float kf = (j & 1) ? hi_bf(kv.w[j >> 1]) : lo_bf(kv.w[j >> 1]);
                const float cf = cum[t * 64 + d], cb = cum[(64 + t) * 64 + d];
                o[0][j] = qf * __expf(cf); o[1][j] = kf * __expf(-cf); o[2][j] = qf * __expf(cb); o[3][j] = kf * __expf(-cb);
            }
#pragma unroll
            for (int k = 0; k < 4; ++k) {
                uint4 w; w.x = pk2(o[k][0], o[k][1]); w.y = pk2(o[k][2], o[k][3]); w.z = pk2(o[k][4], o[k][5]); w.w = pk2(o[k][6], o[k][7]);
                *(uint4*)(tiles + k * 64 * LSTR + t * LSTR + dg) = w;
            }
        }
        __syncthreads();
        const int qi = wave & 3, dir = wave >> 2;
        f32x4 O[8];
#pragma unroll
        for (int i = 0; i < 8; ++i) O[i] = (f32x4){0.f, 0.f, 0.f, 0.f};
        {
            const bf16_t* Qd = tiles + (dir * 2) * 64 * LSTR; const bf16_t* Kd = tiles + (dir * 2 + 1) * 64 * LSTR;
            const bf16x8 qf0 = *(const bf16x8*)(Qd + (qi * 16 + q) * LSTR + g * 8), qf1 = *(const bf16x8*)(Qd + (qi * 16 + q) * LSTR + 32 + g * 8);
            const int iq = qi * 16 + q;
            U8 pf[2];
#pragma unroll
            for (int jt = 0; jt < 4; ++jt) {
                const bf16_t* kp = Kd + (jt * 16 + (lane & 15)) * LSTR + g * 8;
                f32x4 s = {0.f, 0.f, 0.f, 0.f};
                s = __builtin_amdgcn_mfma_f32_16x16x32_bf16(*(const bf16x8*)kp, qf0, s, 0, 0, 0);
                s = __builtin_amdgcn_mfma_f32_16x16x32_bf16(*(const bf16x8*)(kp + 32), qf1, s, 0, 0, 0);
#pragma unroll
                for (int i = 0; i < 4; ++i) { const int jk = jt * 16 + 4 * g + i; const bool ok = dir ? (jk >= iq) : (jk <= iq); s[i] = ok ? s[i] : 0.f; }
                pf[jt >> 1].w[(jt & 1) * 2 + 0] = pk2(s[0], s[1]); pf[jt >> 1].w[(jt & 1) * 2 + 1] = pk2(s[2], s[3]);
            }
            const bf16_t* vp = gla_vt_ptr(VT, b, h, c) + (size_t)(lane & 15) * vld + 4 * g;
            const int bhd = bh * 2 + dir, ci = dir ? ci_b : ci_f;
            const bf16_t* sp = SB + ((size_t)bhd * NCH + ci) * 8192 + (size_t)(lane & 15) * 64 + g * 8;
#pragma unroll
            for (int dvt = 0; dvt < 8; ++dvt) {
#pragma unroll
                for (int st = 0; st < 2; ++st) {
                    U8 vf; vf.h[0] = *(const uint2*)(vp + (size_t)dvt * 16 * vld + st * 32); vf.h[1] = *(const uint2*)(vp + (size_t)dvt * 16 * vld + st * 32 + 16);
                    O[dvt] = __builtin_amdgcn_mfma_f32_16x16x32_bf16(vf.v, pf[st].v, O[dvt], 0, 0, 0);
                }
                O[dvt] = __builtin_amdgcn_mfma_f32_16x16x32_bf16(*(const bf16x8*)(sp + dvt * 16 * 64), qf0, O[dvt], 0, 0, 0);
                O[dvt] = __builtin_amdgcn_mfma_f32_16x16x32_bf16(*(const bf16x8*)(sp + dvt * 16 * 64 + 32), qf1, O[dvt], 0, 0, 0);
            }
        }
        if (dir == 1) {
#pragma unroll
            for (int dvt = 0; dvt < 8; ++dvt)
#pragma unroll
                for (int i = 0; i < 4; ++i) X[(qi * 128 + dvt * 16 + 4 * g + i) * 16 + q] = O[dvt][i];
        }
        __syncthreads();
        if (dir == 0) {
            float ss = 0.f;
#pragma unroll
            for (int dvt = 0; dvt < 8; ++dvt)
#pragma unroll
                for (int i = 0; i < 4; ++i) { O[dvt][i] += X[(qi * 128 + dvt * 16 + 4 * g + i) * 16 + q]; ss += O[dvt][i] * O[dvt][i]; }
            ss += __shfl_xor(ss, 16); ss += __shfl_xor(ss, 32);
            const float rs = rsqrtf(ss * (1.0f / 128.0f) + EPS);
            bf16_t* gp = G + (size_t)(rowbase + qi * 16 + q) * 512 + h * 128;
#pragma unroll
            for (int dvt = 0; dvt < 8; ++dvt) {
                const int dv = dvt * 16 + 4 * g;
                const float4 w = *(const float4*)(gnw + dv);
                const uint2 gv = *(const uint2*)(gp + dv);
                st4bf(gp + dv, O[dvt][0] * rs * w.x * lo_bf(gv.x), O[dvt][1] * rs * w.y * hi_bf(gv.x), O[dvt][2] * rs * w.z * lo_bf(gv.y), O[dvt][3] * rs * w.w * hi_bf(gv.y));
            }
        }
    }
}

constexpr int LF = 16384;
DEVI float2 cmul(float2 a, float2 b) { return make_float2(a.x * b.x - a.y * b.y, a.x * b.y + a.y * b.x); }
DEVI float2 cadd(float2 a, float2 b) { return make_float2(a.x + b.x, a.y + b.y); }
DEVI float2 csub(float2 a, float2 b) { return make_float2(a.x - b.x, a.y - b.y); }
DEVI float2 twid(float frac) { return make_float2(__builtin_amdgcn_cosf(frac), __builtin_amdgcn_sinf(frac)); }

DEVI void fft_fwd(float2* F) {
    const int tid = ltid();
#pragma unroll 1
    for (int s = LF / 2; s >= 2; s >>= 2) {
        const int h = s >> 1;
        const int lh = 31 - __clz(h);
        const float inv2s = 1.0f / (float)(2 * s);
#pragma unroll 2
        for (int qq = tid; qq < LF / 4; qq += NTHR) {
            const int blk = qq >> lh, j = qq & (h - 1);
            const int i = blk * (2 * s) + j;
            const float2 x0 = F[i], x1 = F[i + h], x2 = F[i + s], x3 = F[i + s + h];
            float2 w1 = twid((float)j * inv2s); w1.y = -w1.y;
            const float2 w2 = cmul(w1, w1);
            const float2 y0 = cadd(x0, x2), y2 = cmul(csub(x0, x2), w1);
            const float2 y1 = cadd(x1, x3); const float2 tt = csub(x1, x3);
            const float2 y3 = cmul(make_float2(tt.y, -tt.x), w1);
            F[i] = cadd(y0, y1); F[i + h] = cmul(csub(y0, y1), w2);
            F[i + s] = cadd(y2, y3); F[i + s + h] = cmul(csub(y2, y3), w2);
        }
        __syncthreads();
    }
}
DEVI void fft_inv(float2* F) {
    const int tid = ltid();
#pragma unroll 1
    for (int h = 1; h <= LF / 4; h <<= 2) {
        const int s = 2 * h;
        const int lh = 31 - __clz(h);
        const float inv2s = 1.0f / (float)(2 * s);
#pragma unroll 2
        for (int qq = tid; qq < LF / 4; qq += NTHR) {
            const int blk = qq >> lh, j = qq & (h - 1);
            const int i = blk * (2 * s) + j;
            const float2 x0 = F[i], x1 = F[i + h], x2 = F[i + s], x3 = F[i + s + h];
            const float2 w1 = twid((float)j * inv2s);
            const float2 w2 = cmul(w1, w1);
            const float2 a1 = cmul(x1, w2), a3 = cmul(x3, w2);
            const float2 u0 = cadd(x0, a1), u1 = csub(x0, a1), u2 = cadd(x2, a3), u3 = csub(x2, a3);
            const float2 b2 = cmul(u2, w1); const float2 t3 = cmul(u3, w1); const float2 b3 = make_float2(-t3.y, t3.x);
            F[i] = cadd(u0, b2); F[i + s] = csub(u0, b2); F[i + h] = cadd(u1, b3); F[i + s + h] = csub(u1, b3);
        }
        __syncthreads();
    }
}
DEVI int rev14(int k) { return (int)(__brev((unsigned)k) >> 18); }
DEVI float hy_delta(int ch) {
    const float a = -3.0701134573253946f, b = -15.350567286626973f;
    return fabsf(a + (b - a) * ((float)ch / 511.0f));
}

DEVI void conv8(const bf16_t* U, const float* cw, const float* cb, int seq0, int Lseq, int t, int col0, float* out) {
    U8 r[3];
#pragma unroll
    for (int i = 0; i < 3; ++i) {
        const int tt = t - 1 + i;
        if (tt >= 0 && tt < Lseq) r[i].u = *(const uint4*)(U + (size_t)(seq0 + tt) * 1536 + col0);
        else r[i].u = make_uint4(0, 0, 0, 0);
    }
#pragma unroll
    for (int j = 0; j < 8; ++j) {
        float a = cb[col0 + j];
#pragma unroll
        for (int i = 0; i < 3; ++i) { const float uv = (j & 1) ? hi_bf(r[i].w[j >> 1]) : lo_bf(r[i].w[j >> 1]); a += uv * cw[i * 1536 + col0 + j]; }
        out[j] = a;
    }
}
DEVI void hy_task_geom(int task, int& b, int& t0, int& ch0, int& seq0, int& Lseq, float*& zt, unsigned char* scr) {
    if (task < 4096) { b = task >> 11; t0 = ((task >> 3) & 255) * 64; ch0 = (task & 7) * 64; seq0 = b * T; Lseq = T; zt = (float*)(scr + SD_ZT) + (size_t)b * 512 * T; }
    else { const int q = task - 4096; b = q >> 5; t0 = ((q >> 3) & 3) * 64; ch0 = (q & 7) * 64; seq0 = NL + b * CL; Lseq = CL; zt = (float*)(scr + SD_ZTC) + (size_t)b * 512 * CL; }
}
DEVI void phase_hy1(const P& p, int l, float* sm) {
    unsigned char* scr = p.ws + OFF_SCR;
    const bf16_t* U = (const bf16_t*)(scr + SD_U);
    const float* cw = p.conv_w + (size_t)l * 3 * 1536; const float* cb = p.conv_b + l * 1536;
    const int tid = ltid();
    const int ntask = 4096 + (l == 0 ? 64 : 0);
    for (int task = blockIdx.x; task < ntask; task += gridDim.x) {
        int b, t0, ch0, seq0, Lseq; float* zt;
        hy_task_geom(task, b, t0, ch0, seq0, Lseq, zt, scr);
        __syncthreads();
        {
            const int tt = tid >> 3, cg = (tid & 7) * 8;
            float a1[8], a2[8];
            conv8(U, cw, cb, seq0, Lseq, t0 + tt, 512 + ch0 + cg, a1);
            conv8(U, cw, cb, seq0, Lseq, t0 + tt, 1024 + ch0 + cg, a2);
#pragma unroll
            for (int j = 0; j < 8; ++j) sm[(cg + j) * 65 + tt] = a1[j] * a2[j];
        }
        __syncthreads();
        {
            const int ch = tid >> 3, t8 = (tid & 7) * 8;
            float4 w0 = {sm[ch * 65 + t8 + 0], sm[ch * 65 + t8 + 1], sm[ch * 65 + t8 + 2], sm[ch * 65 + t8 + 3]};
            float4 w1 = {sm[ch * 65 + t8 + 4], sm[ch * 65 + t8 + 5], sm[ch * 65 + t8 + 6], sm[ch * 65 + t8 + 7]};
            float* dst = zt + (size_t)(ch0 + ch) * Lseq + t0 + t8;
            *(float4*)dst = w0; *(float4*)(dst + 4) = w1;
        }
    }
}
DEVI void phase_hy3(const P& p, int l, float* sm) {
    unsigned char* scr = p.ws + OFF_SCR;
    const bf16_t* U = (const bf16_t*)(scr + SD_U);
    bf16_t* G = (bf16_t*)(p.ws + OFF_YS + 3 * SZ512);
    const float* cw = p.conv_w + (size_t)l * 3 * 1536; const float* cb = p.conv_b + l * 1536;
    const int tid = ltid();
    const int ntask = 4096 + (l == 0 ? 64 : 0);
    for (int task = blockIdx.x; task < ntask; task += gridDim.x) {
        int b, t0, ch0, seq0, Lseq; float* zt;
        hy_task_geom(task, b, t0, ch0, seq0, Lseq, zt, scr);
        __syncthreads();
        {
            const int ch = tid >> 3, t8 = (tid & 7) * 8;
            const float* src = zt + (size_t)(ch0 + ch) * Lseq + t0 + t8;
            const float4 w0 = *(const float4*)src, w1 = *(const float4*)(src + 4);
            float* d = sm + ch * 65 + t8;
            d[0] = w0.x; d[1] = w0.y; d[2] = w0.z; d[3] = w0.w; d[4] = w1.x; d[5] = w1.y; d[6] = w1.z; d[7] = w1.w;
        }
        __syncthreads();
        {
            const int tt = tid >> 3, cg = (tid & 7) * 8;
            float a0[8];
            conv8(U, cw, cb, seq0, Lseq, t0 + tt, ch0 + cg, a0);
            bf16_t* gp = G + (size_t)(seq0 + t0 + tt) * 512 + ch0 + cg;
            U8 gv; gv.u = *(const uint4*)gp;
            float o[8];
#pragma unroll
            for (int j = 0; j < 8; ++j) { const float gg = (j & 1) ? hi_bf(gv.w[j >> 1]) : lo_bf(gv.w[j >> 1]); o[j] = a0[j] * sm[(cg + j) * 65 + tt] * gg; }
            uint4 w; w.x = pk2(o[0], o[1]); w.y = pk2(o[2], o[3]); w.z = pk2(o[4], o[5]); w.w = pk2(o[6], o[7]);
            *(uint4*)gp = w;
        }
    }
}

DEVI void phase_hy2(const P& p, int l, unsigned char* smem) {
    unsigned char* scr = p.ws + OFF_SCR;
    const int tid = ltid();
    float* Ff = (float*)smem; float2* F2 = (float2*)smem;
    float* red = (float*)(smem + 131072);
    float* spec = red + 16;
    const float* HT = (const float*)(p.ws + OFF_HH3T) + (size_t)l * 64 * T;
    const float* HC = (const float*)(p.ws + OFF_HH3C);
    const float* wout = p.fwout + (size_t)l * 64 * 1024;
    const int ntask = 512 + (l == 0 ? 512 : 0);
    for (int task = blockIdx.x; task < ntask; task += gridDim.x) {
        __syncthreads();
        if (task < 512) {
            const int ch = task;
            const float delta = hy_delta(ch);
            float l1 = 0.f;
#pragma unroll 1
            for (int i = 0; i < 32; ++i) {
                const int m = tid + NTHR * i;
                float af = 0.f, ab = 0.f;
#pragma unroll 8
                for (int j = 0; j < 64; ++j) { const float hv = HT[(size_t)j * T + m]; af += hv * wout[j * 1024 + ch]; ab += hv * wout[j * 1024 + 512 + ch]; }
                const float dec = expf(-((float)m / (float)(T - 1)) * delta);
                af *= dec; ab *= dec;
                Ff[m] = af;
                if (m >= 1) { Ff[2 * T - m] = ab; l1 += fabsf(ab); } else Ff[T] = 0.f;
                l1 += fabsf(af);
            }
            l1 = block_sum(l1, red);
            __syncthreads();
            fft_fwd(F2);
            const float scale = 1.0f / ((float)LF * l1);
            float4* KF = (float4*)(p.ws + OFF_KF) + (size_t)blockIdx.x * 8192;
#pragma unroll 2
            for (int i = 0; i < 16; ++i) {
                const int k = tid + NTHR * i;
                const float2 ck = F2[rev14(k)], cm = F2[rev14((LF - k) & (LF - 1))];
                KF[k] = make_float4((ck.x + cm.x) * 0.5f * scale, (ck.y - cm.y) * 0.5f * scale, (ck.y + cm.y) * 0.5f * scale, -(ck.x - cm.x) * 0.5f * scale);
            }
            if (tid == 0) { const float2 c = F2[1]; spec[0] = c.x * scale; spec[1] = c.y * scale; }
            const float fb = p.fbias[l * 512 + ch];
#pragma unroll 1
            for (int b = 0; b < NB; ++b) {
                float* zt = (float*)(scr + SD_ZT) + ((size_t)b * 512 + ch) * T;
                __syncthreads();
#pragma unroll
                for (int i = 0; i < 8; ++i) {
                    const int e = (tid + NTHR * i) * 4;
                    *(float4*)(Ff + e) = *(const float4*)(zt + e);
                    *(float4*)(Ff + T + e) = make_float4(0.f, 0.f, 0.f, 0.f);
                }
                __syncthreads();
                fft_fwd(F2);
#pragma unroll 2
                for (int i = 0; i < 16; ++i) {
                    const int k = tid + NTHR * i;
                    const int pk = rev14(k), pm = rev14((LF - k) & (LF - 1));
                    const float2 ck = F2[pk], cm = F2[pm];
                    const float4 kf = KF[k];
                    const float2 He = make_float2(kf.x, kf.y), Ho = make_float2(kf.z, kf.w);
                    const float2 E = make_float2((ck.x + cm.x) * 0.5f, (ck.y - cm.y) * 0.5f);
                    const float2 O = make_float2((ck.y + cm.y) * 0.5f, -(ck.x - cm.x) * 0.5f);
                    float2 w2 = twid((float)k * (1.0f / (float)LF)); w2.y = -w2.y;
                    const float2 Ye = cadd(cmul(E, He), cmul(w2, cmul(O, Ho)));
                    const float2 Yo = cadd(cmul(E, Ho), cmul(O, He));
                    F2[pk] = make_float2(Ye.x - Yo.y, Ye.y + Yo.x);
                    F2[pm] = make_float2(Ye.x + Yo.y, -Ye.y + Yo.x);
                }
                if (tid == 0) {
                    const float2 c = F2[1]; const float he = spec[0], ho = spec[1];
                    F2[1] = make_float2(c.x * he - c.y * ho, c.x * ho + c.y * he);
                }
                __syncthreads();
                fft_inv(F2);
#pragma unroll
                for (int i = 0; i < 8; ++i) {
                    const int e = (tid + NTHR * i) * 4;
                    const float4 zv = *(const float4*)(zt + e); const float4 yv = *(const float4*)(Ff + e);
                    *(float4*)(zt + e) = make_float4(yv.x + zv.x * fb, yv.y + zv.y * fb, yv.z + zv.z * fb, yv.w + zv.w * fb);
                }
            }
        } else {
            const int ch = task - 512;
            const float delta = hy_delta(ch);
            float* hf = Ff; float* hb = Ff + 256; float* zs = Ff + 512;
            {
                const int m = tid & 255, side = tid >> 8;
                float a = 0.f;
#pragma unroll 4
                for (int j = 0; j < 64; ++j) a += HC[j * CL + m] * wout[j * 1024 + side * 512 + ch];
                a *= expf(-((float)m / (float)(CL - 1)) * delta);
                Ff[side * 256 + m] = a;
                float l1 = (side == 1 && m == 0) ? 0.f : fabsf(a);
                zs[tid] = ((const float*)(scr + SD_ZTC))[((size_t)(tid >> 8) * 512 + ch) * CL + (tid & 255)];
                l1 = block_sum(l1, red);
                const int b = tid >> 8, t = tid & 255;
                float y = 0.f;
#pragma unroll 4
                for (int s = 0; s <= t; ++s) y += zs[b * 256 + s] * hf[t - s];
#pragma unroll 4
                for (int s = t + 1; s < CL; ++s) y += zs[b * 256 + s] * hb[s - t];
                const float fb = p.fbias[l * 512 + ch];
                ((float*)(scr + SD_ZTC))[((size_t)b * 512 + ch) * CL + t] = y / l1 + zs[tid] * fb;
            }
        }
    }
}

constexpr int NPH = 32;
#ifndef ONLY
#define ONLY -1
#endif
#define CASE(n) case n: if (ONLY < 0 || ONLY == n)
DEVI void run_phase(const P& p, int ph, unsigned char* smem) {
    if (ph == 0) { if (ONLY < 0 || ONLY == 100) phase_prep(p, (float*)smem); return; }
    if (ph == NPH - 1) { if (ONLY < 0 || ONLY == 101) phase_final(p); return; }
    const int l = (ph - 1) / 15, k = (ph - 1) % 15;
    switch (k) {
        CASE(0) phase_hl(p, l); break;
        CASE(1) phase_inproj<0>(p, l, (bf16_t*)smem); break;
        CASE(2) phase_att_a(p, l, (float*)smem); break;
        CASE(3) phase_inproj<1>(p, l, (bf16_t*)smem); break;
        CASE(4) phase_att_b(p, l); break;
        CASE(5) phase_inproj<2>(p, l, (bf16_t*)smem); break;
        CASE(6) phase_gla1(p, l, smem); break;
        CASE(7) phase_gla2(p); break;
        CASE(8) phase_gla3(p, l, smem); break;
        CASE(9) phase_inproj<3>(p, l, (bf16_t*)smem); break;
        CASE(10) phase_hy1(p, l, (float*)smem); break;
        CASE(11) phase_hy2(p, l, smem); break;
        CASE(12) phase_hy3(p, l, (float*)smem); break;
        CASE(13) phase_merge(p, l, (bf16_t*)smem); break;
        CASE(14) phase_out(p, l, (bf16_t*)smem); break;
    }
}

__global__ void __launch_bounds__(NTHR) mega(P p) {
    extern __shared__ __attribute__((aligned(16))) unsigned char smem[];
    cg::grid_group grid = cg::this_grid();
    for (int ph = p.ph_lo; ph < p.ph_hi; ++ph) {
        run_phase(p, ph, smem);
        if (ph + 1 < p.ph_hi) grid.sync();
    }
}

#ifdef DIAG_OFF
__global__ void diag_dump(const unsigned char* src, float* out, size_t n) {
    for (size_t i = (size_t)blockIdx.x * blockDim.x + threadIdx.x; i < n; i += (size_t)gridDim.x * blockDim.x) {
#if DIAG_F32
        out[i] = ((const float*)src)[i % (size_t)(DIAG_N)];
#else
        { float v = bf2f(((const bf16_t*)src)[i % (size_t)(DIAG_N)]);
#ifdef EXP_FIN
          if (!(fabsf(v) < 1e30f)) v = 12345.f;
#endif
          out[i] = v; }
#endif
    }
}
#endif
extern "C" void kernel_launch(void* const* d_in, const int* in_sizes, int n_in, void* d_out, int out_size, void* d_ws, size_t ws_size, hipStream_t stream) {
    static int grid = 0;
    if (grid == 0) {
        if (n_in != 27 || ws_size < WS_END) { fprintf(stderr, "kernel_launch: unexpected n_in %d or ws_size %zu (need %zu)\n", n_in, ws_size, (size_t)WS_END); grid = -1; return; }
        int dev = 0, cus = 0, per_cu = 0;
        hipGetDevice(&dev);
        hipDeviceGetAttribute(&cus, hipDeviceAttributeMultiprocessorCount, dev);
        if (hipFuncSetAttribute((const void*)mega, hipFuncAttributeMaxDynamicSharedMemorySize, LDS_BYTES) != hipSuccess) { fprintf(stderr, "kernel_launch: hipFuncSetAttribute failed\n"); grid = -1; return; }
        if (hipOccupancyMaxActiveBlocksPerMultiprocessor(&per_cu, (const void*)mega, NTHR, LDS_BYTES) != hipSuccess || per_cu < 1) { fprintf(stderr, "kernel_launch: occupancy query failed (%d)\n", per_cu); grid = -1; return; }
        grid = cus * per_cu; if (grid > MAXGRID) grid = MAXGRID;
        fprintf(stderr, "kernel_launch: grid %d (cus %d x %d)\n", grid, cus, per_cu);
    }
    if (grid < 0) return;
    P p{};
    const float** pp = (const float**)&p;
    for (int i = 0; i < 27; ++i) pp[i] = (const float*)d_in[i];
    p.out = (float*)d_out; p.ws = (unsigned char*)d_ws;
#if N_LAUNCH_MODE == 1
    p.ph_lo = 0; p.ph_hi = NPH;
    void* args[] = {&p};
    hipError_t e = hipLaunchCooperativeKernel((const void*)mega, dim3(grid), dim3(NTHR), args, LDS_BYTES, stream);
    if (e != hipSuccess) fprintf(stderr, "cooperative launch failed: %s (grid %d)\n", hipGetErrorString(e), grid);
#else
#ifndef DIAG_STOP
#define DIAG_STOP NPH
#endif
    for (int ph = 0; ph < DIAG_STOP; ++ph) {
        p.ph_lo = ph; p.ph_hi = ph + 1;
        hipLaunchKernelGGL(mega, dim3(grid), dim3(NTHR), LDS_BYTES, stream, p);
    }
#ifdef DIAG_OFF
    hipLaunchKernelGGL(diag_dump, dim3(1024), dim3(256), 0, stream, (const unsigned char*)d_ws + (size_t)(DIAG_OFF), (float*)d_out, (size_t)out_size);
#endif
#endif
}
```

```cpp
#include <hip/hip_runtime.h>
#include <hip/hip_cooperative_groups.h>
#include <cstdio>
#include <cstdint>
namespace cg = cooperative_groups;

#ifndef N_LAUNCH_MODE
#define N_LAUNCH_MODE 1
#endif

#define DEVI __device__ __forceinline__
typedef unsigned short bf16_t;
typedef short bf16x8 __attribute__((ext_vector_type(8)));
typedef float f32x4 __attribute__((ext_vector_type(4)));
typedef float f32x16 __attribute__((ext_vector_type(16)));

constexpr int D = 1024, T = 16384, NB = 2, NL = NB * T, CL = 256, NC = NB * CL, NR = NL + NC;
constexpr int IN_TOTAL = 11040;
constexpr int COL_A = 0, COL_B = 2048, COL_C = 3328, COL_D = 4896, COL_GM = 6944;
constexpr float EPS = 1e-6f;
constexpr int NTHR = 512;
constexpr int LDS_BYTES = 140 * 1024;

constexpr size_t al256(size_t x) { return (x + 255) & ~(size_t)255; }
constexpr size_t OFF_MOD = 0;
constexpr size_t OFF_ROPE = al256(OFF_MOD + (size_t)2 * 3 * 3072 * 4);
constexpr size_t OFF_HH3T = al256(OFF_ROPE + (size_t)2 * T * 32 * 4);
constexpr size_t OFF_HH3C = al256(OFF_HH3T + (size_t)2 * 64 * T * 4);
constexpr size_t OFF_XC1 = al256(OFF_HH3C + (size_t)64 * CL * 4);
constexpr size_t OFF_WINT = al256(OFF_XC1 + (size_t)NC * D * 4);
constexpr size_t OFF_WBT = al256(OFF_WINT + (size_t)2 * IN_TOTAL * D * 2);
constexpr size_t OFF_WOT = al256(OFF_WBT + (size_t)2 * 4 * D * 512 * 2);
constexpr size_t OFF_HL = al256(OFF_WOT + (size_t)2 * D * D * 2);
constexpr size_t OFF_YS = al256(OFF_HL + (size_t)NR * D * 2);
constexpr size_t SZ512 = (size_t)NR * 512 * 2, SZ256 = (size_t)NR * 256 * 2, SZ128 = (size_t)NR * 128 * 2;
constexpr size_t OFF_SCR = al256(OFF_YS + 4 * SZ512);
constexpr size_t SA_Q = 0, SA_K = SZ512, SA_VT = 2 * SZ512;
constexpr size_t SB_Q = 0, SB_K = SZ512, SB_VT = SZ512 + SZ128;
constexpr size_t SC_Q = 0, SC_K = SZ256, SC_VT = 2 * SZ256, SC_LR = 2 * SZ256 + SZ512;
constexpr size_t SC_SB = al256(SC_LR + (size_t)NR * 32 * 4);
constexpr int NCH = 260;
constexpr size_t SC_GD = al256(SC_SB + (size_t)16 * NCH * 8192 * 2);
constexpr size_t SD_U = 0, SD_ZT = al256((size_t)NR * 1536 * 2), SD_ZTC = al256(SD_ZT + (size_t)NB * 512 * T * 4);
constexpr size_t SD_END = al256(SD_ZTC + (size_t)NB * 512 * CL * 4);
constexpr size_t OFF_KF = OFF_SCR + SD_END;
constexpr int MAXGRID = 256;
constexpr size_t OFF_K2 = al256(OFF_KF + (size_t)MAXGRID * 8192 * 16);
constexpr size_t OFF_L1P = al256(OFF_K2 + (size_t)1024 * T * 2);
constexpr size_t WS_END = al256(OFF_L1P + (size_t)(T / 64) * 1024 * 4);

struct P {
    const float *x, *c, *ctx, *c_ctx, *norm_w, *w_mod, *b_mod, *w_in, *rpb, *sink, *w_alpha_up, *b_alpha, *gla_norm_w,
        *conv_w, *conv_b, *fw1, *fb1, *fw2, *fb2, *fw3, *fb3, *ffreq, *fwout, *fbias, *w_branch, *w_out, *final_norm_w;
    float* out;
    unsigned char* ws;
    int ph_lo, ph_hi;
    int dry, pad_;
};

DEVI int ltid() { int t = threadIdx.x; asm volatile("" : "+v"(t)); return t; }
DEVI float bf2f(bf16_t v) { return __uint_as_float(((unsigned)v) << 16); }
typedef __bf16 bf16v2 __attribute__((ext_vector_type(2)));
typedef float f32v2 __attribute__((ext_vector_type(2)));
DEVI unsigned pk2(float lo, float hi) { f32v2 v = {lo, hi}; bf16v2 b = __builtin_convertvector(v, bf16v2); return __builtin_bit_cast(unsigned, b); }
DEVI bf16_t f2bf(float f) { return (bf16_t)(pk2(f, 0.f) & 0xffff); }
DEVI float lo_bf(unsigned u) { return __uint_as_float(u << 16); }
DEVI float hi_bf(unsigned u) { return __uint_as_float(u & 0xffff0000u); }
DEVI float siluf(float v) { return v / (1.f + __expf(-v)); }
DEVI float sigmf(float v) { return 1.f / (1.f + __expf(-v)); }
DEVI void row_decode(int row, int& b, int& t, bool& isctx) {
    if (row < NL) { b = row >> 14; t = row & (T - 1); isctx = false; }
    else { int r = row - NL; b = r >> 8; t = r & (CL - 1); isctx = true; }
}
DEVI float wave_sum(float v) {
#pragma unroll
    for (int o = 32; o >= 1; o >>= 1) v += __shfl_xor(v, o);
    return v;
}
DEVI float block_sum(float v, float* red  ) {
    v = wave_sum(v);
    __syncthreads();
    if ((ltid() & 63) == 0) red[ltid() >> 6] = v;
    __syncthreads();
    float s = 0.f;
#pragma unroll
    for (int i = 0; i < NTHR / 64; ++i) s += red[i];
    return s;
}

constexpr int LSTR = 72;
constexpr int GA_EL = 256 * LSTR, GB_EL = 128 * LSTR;
template <int NT> struct GAcc { f32x16 a[2][NT]; };

template <int NT, int DEPTH = 1>
DEVI void gemm_kloop(const bf16_t* __restrict__ A, int lda, const bf16_t* __restrict__ Bt, int ldb, int K, int m0, int n0,
                     bf16_t* sm, GAcc<NT>& acc) {
    const int tid = ltid(), lane = tid & 63, wave = tid >> 6, wm = wave >> 1, wn = wave & 1;
    const int lr = tid >> 3, lc = tid & 7;
    const char* Ab = (const char*)(A + (size_t)m0 * lda); const char* Bb = (const char*)(Bt + (size_t)n0 * ldb);
    const unsigned aoff = (unsigned)(lr * lda + lc * 8) * 2u, boff = (unsigned)(lr * ldb + lc * 8) * 2u;
    uint4 xa0, xa1, xa2, xa3, xb0, xb1 = {0, 0, 0, 0};
    uint4 ya0, ya1, ya2, ya3, yb0, yb1 = {0, 0, 0, 0};
    const int KT = K / 64;
    const int frow = lane & 31, fk = (lane >> 5) * 8;
    const unsigned sa64 = 128u * (unsigned)lda, sb64 = 128u * (unsigned)ldb;
#define GLOAD(P, KTI) { const unsigned ko_ = (unsigned)(KTI) * 128u; P##a0 = *(const uint4*)(Ab + (aoff + ko_)); P##a1 = *(const uint4*)(Ab + (aoff + sa64 + ko_)); P##a2 = *(const uint4*)(Ab + (aoff + 2 * sa64 + ko_)); \
                        P##a3 = *(const uint4*)(Ab + (aoff + 3 * sa64 + ko_)); P##b0 = *(const uint4*)(Bb + (boff + ko_)); if constexpr (NT > 1) P##b1 = *(const uint4*)(Bb + (boff + sb64 + ko_)); }
#define LWRITE(P, BUF) { bf16_t* wa_ = sm + (BUF) * (GA_EL + GB_EL) + lr * LSTR + lc * 8; bf16_t* wb_ = wa_ + GA_EL; \
                        *(uint4*)(wa_) = P##a0; *(uint4*)(wa_ + 64 * LSTR) = P##a1; *(uint4*)(wa_ + 128 * LSTR) = P##a2; *(uint4*)(wa_ + 192 * LSTR) = P##a3; \
                        *(uint4*)(wb_) = P##b0; if constexpr (NT > 1) *(uint4*)(wb_ + 64 * LSTR) = P##b1; }
    auto compute = [&](int buf) {
        const bf16_t* sa = sm + buf * (GA_EL + GB_EL) + (wm * 64 + frow) * LSTR + fk;
        const bf16_t* sb = sm + buf * (GA_EL + GB_EL) + GA_EL + (wn * 32 * NT + frow) * LSTR + fk;
#pragma unroll
        for (int ks = 0; ks < 4; ++ks) {
            bf16x8 tf[2], cf[NT];
#pragma unroll
            for (int mt = 0; mt < 2; ++mt) tf[mt] = *(const bf16x8*)(sa + mt * 32 * LSTR + ks * 16);
#pragma unroll
            for (int nt = 0; nt < NT; ++nt) cf[nt] = *(const bf16x8*)(sb + nt * 32 * LSTR + ks * 16);
#pragma unroll
            for (int mt = 0; mt < 2; ++mt)
#pragma unroll
                for (int nt = 0; nt < NT; ++nt)
                    acc.a[mt][nt] = __builtin_amdgcn_mfma_f32_32x32x16_bf16(cf[nt], tf[mt], acc.a[mt][nt], 0, 0, 0);
        }
    };
    __syncthreads();
    if constexpr (DEPTH == 1) {
        GLOAD(x, 0); LWRITE(x, 0); GLOAD(x, 1);
        __syncthreads();
        for (int kt = 0; kt < KT; ++kt) {
            if (kt + 1 < KT) LWRITE(x, (kt + 1) & 1);
            if (kt + 2 < KT) GLOAD(x, kt + 2);
            compute(kt & 1);
            __syncthreads();
        }
    } else {
        GLOAD(x, 0); LWRITE(x, 0); GLOAD(x, 1); GLOAD(y, 2);
        __syncthreads();
        for (int kt = 0; kt < KT; kt += 2) {
            LWRITE(x, 1);
            if (kt + 3 < KT) GLOAD(x, kt + 3);
            compute(0);
            __syncthreads();
            if (kt + 2 < KT) LWRITE(y, 0);
            if (kt + 4 < KT) GLOAD(y, kt + 4);
            compute(1);
            __syncthreads();
        }
    }
#undef GLOAD
#undef LWRITE
}
DEVI int tile_of(int it) {
    const int per = gridDim.x >> 3;
    if ((gridDim.x & 7) != 0 || per == 0) return it * gridDim.x + blockIdx.x;
    return it * gridDim.x + (blockIdx.x & 7) * per + (blockIdx.x >> 3);
}
template <int NT> DEVI void acc_zero(GAcc<NT>& acc) {
#pragma unroll
    for (int mt = 0; mt < 2; ++mt)
#pragma unroll
        for (int nt = 0; nt < NT; ++nt)
#pragma unroll
            for (int i = 0; i < 16; ++i) acc.a[mt][nt][i] = 0.f;
}
template <int NT, class F> DEVI void acc_foreach(const GAcc<NT>& acc, int m0, int n0, F f) {
    const int lane = ltid() & 63, wave = ltid() >> 6, wm = wave >> 1, wn = wave & 1;
#pragma unroll
    for (int mt = 0; mt < 2; ++mt) {
        const int row = m0 + wm * 64 + mt * 32 + (lane & 31);
#pragma unroll
        for (int nt = 0; nt < NT; ++nt)
#pragma unroll
            for (int q = 0; q < 4; ++q) {
                const int col = n0 + wn * 32 * NT + nt * 32 + q * 8 + (lane >> 5) * 4;
                f(row, col, acc.a[mt][nt][q * 4 + 0], acc.a[mt][nt][q * 4 + 1], acc.a[mt][nt][q * 4 + 2], acc.a[mt][nt][q * 4 + 3]);
            }
    }
}
constexpr int EST = 68;
template <int NT> DEVI void epi_stage(const GAcc<NT>& acc, int mt, float* reg) {
    const int lane = ltid() & 63;
    __syncthreads();
#pragma unroll
    for (int nt = 0; nt < NT; ++nt)
#pragma unroll
        for (int q = 0; q < 4; ++q) {
            float4 w = {acc.a[mt][nt][q * 4 + 0], acc.a[mt][nt][q * 4 + 1], acc.a[mt][nt][q * 4 + 2], acc.a[mt][nt][q * 4 + 3]};
            *(float4*)(reg + (lane & 31) * EST + nt * 32 + q * 8 + (lane >> 5) * 4) = w;
        }
    __syncthreads();
}
template <int NT, class F> DEVI void epi_rows8(const float* reg, F f) {
    const int lane = ltid() & 63;
#pragma unroll
    for (int it = 0; it < 2 * NT; ++it) {
        const int idx = it * 64 + lane, rl = idx / (NT * 4), ch = idx % (NT * 4);
        const float4 a = *(const float4*)(reg + rl * EST + ch * 8), b = *(const float4*)(reg + rl * EST + ch * 8 + 4);
        f(rl, ch * 8, a, b);
    }
}
DEVI void st8bf(bf16_t* p, float4 a, float4 b) { uint4 w; w.x = pk2(a.x, a.y); w.y = pk2(a.z, a.w); w.z = pk2(b.x, b.y); w.w = pk2(b.z, b.w); *(uint4*)p = w; }
DEVI float4 silu4(float4 a) { return make_float4(siluf(a.x), siluf(a.y), siluf(a.z), siluf(a.w)); }
template <int H, int DH> DEVI void epi_vt(const float* reg, bf16_t* VT, int row0  , int colv0) {
    const int lane = ltid() & 63;
    int b, t; bool ic; row_decode(row0, b, t, ic);
    const int tp = lane & 15, cg = lane >> 4;
#pragma unroll 4
    for (int it = 0; it < 16; ++it) {
        const int c = it * 4 + cg, colv = colv0 + c, h = colv / DH, d = colv % DH;
        const float v0 = reg[(2 * tp) * EST + c], v1 = reg[(2 * tp + 1) * EST + c];
        bf16_t* pp = ic ? (VT + (size_t)NB * H * DH * T + ((size_t)(b * H + h) * DH + d) * CL + t + 2 * tp) : (VT + ((size_t)(b * H + h) * DH + d) * T + t + 2 * tp);
        *(unsigned*)pp = pk2(v0, v1);
    }
}
DEVI void st4bf(bf16_t* p, float a, float b, float c, float d) { uint2 w; w.x = pk2(a, b); w.y = pk2(c, d); *(uint2*)p = w; }
template <int H, int DH> DEVI void store_vt(bf16_t* VT, int row, int colv, float v0, float v1, float v2, float v3) {
    int b, t; bool ic; row_decode(row, b, t, ic);
    const int h = colv / DH, d = colv % DH;
    bf16_t* p = ic ? (VT + (size_t)NB * H * DH * T + ((size_t)(b * H + h) * DH + d) * CL + t) : (VT + ((size_t)(b * H + h) * DH + d) * T + t);
    const size_t st = ic ? CL : T;
    p[0] = f2bf(v0); p[st] = f2bf(v1); p[2 * st] = f2bf(v2); p[3 * st] = f2bf(v3);
}

template <int BR>
DEVI void phase_inproj(const P& p, int l, bf16_t* sm) {
    unsigned char* ws = p.ws;
    const bf16_t* HL = (const bf16_t*)(ws + OFF_HL);
    constexpr int colbase = BR == 0 ? COL_A : BR == 1 ? COL_B : BR == 2 ? COL_C : COL_D;
    constexpr int N = BR == 0 ? 2048 : BR == 1 ? 1280 : BR == 2 ? 1568 : 2048;
    const bf16_t* Wt = (const bf16_t*)(ws + OFF_WINT) + ((size_t)l * IN_TOTAL + colbase) * D;
    unsigned char* scr = ws + OFF_SCR;
    bf16_t* YSb = (bf16_t*)(ws + OFF_YS + BR * SZ512);
    const float* rope = (const float*)(ws + OFF_ROPE);
    constexpr int tilesN = (N + 127) / 128, tilesM = NR / 256;
    for (int it = 0;; ++it) {
        const int tile = tile_of(it);
        if (it * (int)gridDim.x >= tilesM * tilesN) break;
        if (tile >= tilesM * tilesN) continue;
        const int tm = tile / tilesN, tn = tile % tilesN;
        const int m0 = tm * 256, n0 = tn * 128;
        GAcc<2> acc; acc_zero(acc);
        gemm_kloop<2, 1>(HL, D, Wt, D, D, m0, n0, sm, acc);
        const int lane = ltid() & 63, wave = ltid() >> 6, wm = wave >> 1, wn = wave & 1;
        float* reg = (float*)sm + wave * (32 * EST);
        const int cb = n0 + wn * 64;
#pragma unroll
        for (int mt = 0; mt < 2; ++mt) {
            epi_stage<2>(acc, mt, reg);
            const int rbase = m0 + wm * 64 + mt * 32;
            if constexpr (BR == 0) {
                bf16_t* Q = (bf16_t*)(scr + SA_Q); bf16_t* Kb = (bf16_t*)(scr + SA_K); bf16_t* VT = (bf16_t*)(scr + SA_VT);
                const int seg = cb >> 9, cc0 = cb & 511;
                if (seg == 2) epi_vt<8, 64>(reg, VT, rbase, cc0);
                else epi_rows8<2>(reg, [&](int rl, int cl, float4 a, float4 b) {
                    const size_t o = (size_t)(rbase + rl) * 512 + cc0 + cl;
                    if (seg == 0) st8bf(Q + o, a, b); else if (seg == 1) st8bf(Kb + o, a, b); else st8bf(YSb + o, silu4(a), silu4(b));
                });
            } else if constexpr (BR == 1) {
                bf16_t* Q = (bf16_t*)(scr + SB_Q); bf16_t* Kb = (bf16_t*)(scr + SB_K); bf16_t* VT = (bf16_t*)(scr + SB_VT);
                if (cb >= 640 && cb < 768) epi_vt<2, 64>(reg, VT, rbase, cb - 640);
                else epi_rows8<2>(reg, [&](int rl, int cl, float4 a, float4 b) {
                    const int row = rbase + rl;
                    if (cb < 640) {
                        if (row < NL) {
                            const float4 pa = *(const float4*)(reg + rl * EST + (cl ^ 32)), pb = *(const float4*)(reg + rl * EST + (cl ^ 32) + 4);
                            const int t = row & (T - 1), c = cl & 31;
                            const float4 c0 = *(const float4*)(rope + (size_t)t * 32 + c), c1 = *(const float4*)(rope + (size_t)t * 32 + c + 4);
                            const float4 s0 = *(const float4*)(rope + (size_t)T * 32 + (size_t)t * 32 + c), s1 = *(const float4*)(rope + (size_t)T * 32 + (size_t)t * 32 + c + 4);
                            if (cl < 32) {
                                a = make_float4(a.x * c0.x - pa.x * s0.x, a.y * c0.y - pa.y * s0.y, a.z * c0.z - pa.z * s0.z, a.w * c0.w - pa.w * s0.w);
                                b = make_float4(b.x * c1.x - pb.x * s1.x, b.y * c1.y - pb.y * s1.y, b.z * c1.z - pb.z * s1.z, b.w * c1.w - pb.w * s1.w);
                            } else {
                                a = make_float4(pa.x * s0.x + a.x * c0.x, pa.y * s0.y + a.y * c0.y, pa.z * s0.z + a.z * c0.z, pa.w * s0.w + a.w * c0.w);
                                b = make_float4(pb.x * s1.x + b.x * c1.x, pb.y * s1.y + b.y * c1.y, pb.z * s1.z + b.z * c1.z, pb.w * s1.w + b.w * c1.w);
                            }
                        }
                        if (cb < 512) st8bf(Q + (size_t)row * 512 + cb + cl, a, b);
                        else st8bf(Kb + (size_t)row * 128 + (cb - 512) + cl, a, b);
                    } else st8bf(YSb + (size_t)row * 512 + (cb - 768) + cl, silu4(a), silu4(b));
                });
            } else if constexpr (BR == 2) {
                bf16_t* Q = (bf16_t*)(scr + SC_Q); bf16_t* Kb = (bf16_t*)(scr + SC_K); bf16_t* VT = (bf16_t*)(scr + SC_VT);
                float* LR = (float*)(scr + SC_LR);
                if (cb >= 512 && cb < 1024) epi_vt<4, 128>(reg, VT, rbase, cb - 512);
                else epi_rows8<2>(reg, [&](int rl, int cl, float4 a, float4 b) {
                    const int row = rbase + rl, col = cb + cl;
                    if (col < 256) { const float sc = 0.125f; st8bf(Q + (size_t)row * 256 + col, make_float4(a.x * sc, a.y * sc, a.z * sc, a.w * sc), make_float4(b.x * sc, b.y * sc, b.z * sc, b.w * sc)); }
                    else if (col < 512) st8bf(Kb + (size_t)row * 256 + (col - 256), a, b);
                    else if (col < 1056) { *(float4*)(LR + (size_t)row * 32 + (col - 1024)) = a; *(float4*)(LR + (size_t)row * 32 + (col - 1024) + 4) = b; }
                    else if (col < 1568) st8bf(YSb + (size_t)row * 512 + (col - 1056), silu4(a), silu4(b));
                });
            } else {
                bf16_t* U = (bf16_t*)(scr + SD_U);
                epi_rows8<2>(reg, [&](int rl, int cl, float4 a, float4 b) {
                    const int row = rbase + rl, col = cb + cl;
                    if (col < 1536) st8bf(U + (size_t)row * 1536 + col, a, b);
                    else st8bf(YSb + (size_t)row * 512 + (col - 1536), silu4(a), silu4(b));
                });
            }
        }
    }
}

DEVI void phase_merge(const P& p, int l, bf16_t* sm) {
    unsigned char* ws = p.ws;
    const bf16_t* HL = (const bf16_t*)(ws + OFF_HL);
    const bf16_t* Wgm = (const bf16_t*)(ws + OFF_WINT) + ((size_t)l * IN_TOTAL + COL_GM) * D;
    const bf16_t* Wb = (const bf16_t*)(ws + OFF_WBT) + (size_t)l * 4 * D * 512;
    bf16_t* ACCM = (bf16_t*)(ws + OFF_SCR);
    const int M = (l == 0) ? NR : NL;
    const int tilesM = M / 256, tilesN = D / 128;
    for (int it = 0;; ++it) {
        const int tile = tile_of(it);
        if (it * (int)gridDim.x >= tilesM * tilesN) break;
        if (tile >= tilesM * tilesN) continue;
        const int tm = tile / tilesN, tn = tile % tilesN;
        const int m0 = tm * 256, n0 = tn * 128;
        GAcc<2> tot; acc_zero(tot);
        unsigned totp[2][2][8];
#pragma unroll
        for (int mt = 0; mt < 2; ++mt)
#pragma unroll
            for (int nt = 0; nt < 2; ++nt)
#pragma unroll
                for (int e = 0; e < 8; ++e) totp[mt][nt][e] = 0u;
#pragma unroll 1
        for (int i = 0; i < 4; ++i) {
#ifdef TIMING_A
            gemm_kloop<2>((const bf16_t*)(ws + OFF_YS + i * SZ512), 512, Wb + (size_t)i * D * 512, 512, 512, m0, n0, sm, tot);
            GAcc<2> g; acc_zero(g);
            gemm_kloop<2>(HL, D, Wgm + (size_t)i * D * D, D, D, m0, n0, sm, g);
#pragma unroll
            for (int mt = 0; mt < 2; ++mt)
#pragma unroll
                for (int nt = 0; nt < 2; ++nt)
#pragma unroll
                    for (int e = 0; e < 16; ++e) tot.a[mt][nt][e] += sigmf(g.a[mt][nt][e]);
        }
#else
            unsigned pp[2][2][8];
            {
                GAcc<2> pr; acc_zero(pr);
                gemm_kloop<2>((const bf16_t*)(ws + OFF_YS + i * SZ512), 512, Wb + (size_t)i * D * 512, 512, 512, m0, n0, sm, pr);
#pragma unroll
                for (int mt = 0; mt < 2; ++mt)
#pragma unroll
                    for (int nt = 0; nt < 2; ++nt)
#pragma unroll
                        for (int e = 0; e < 8; ++e) pp[mt][nt][e] = pk2(pr.a[mt][nt][2 * e], pr.a[mt][nt][2 * e + 1]);
            }
            GAcc<2> g; acc_zero(g);
            gemm_kloop<2>(HL, D, Wgm + (size_t)i * D * D, D, D, m0, n0, sm, g);
#pragma unroll
            for (int mt = 0; mt < 2; ++mt)
#pragma unroll
                for (int nt = 0; nt < 2; ++nt)
#pragma unroll
                    for (int e = 0; e < 8; ++e) {
                        const float t0 = lo_bf(totp[mt][nt][e]) + sigmf(g.a[mt][nt][2 * e]) * lo_bf(pp[mt][nt][e]);
                        const float t1 = hi_bf(totp[mt][nt][e]) + sigmf(g.a[mt][nt][2 * e + 1]) * hi_bf(pp[mt][nt][e]);
                        totp[mt][nt][e] = pk2(t0, t1);
                    }
        }
#pragma unroll
        for (int mt = 0; mt < 2; ++mt)
#pragma unroll
            for (int nt = 0; nt < 2; ++nt)
#pragma unroll
                for (int e = 0; e < 8; ++e) { tot.a[mt][nt][2 * e] = lo_bf(totp[mt][nt][e]); tot.a[mt][nt][2 * e + 1] = hi_bf(totp[mt][nt][e]); }
#endif
        {
            const int wave = ltid() >> 6, wm = wave >> 1, wn = wave & 1;
            float* reg = (float*)sm + wave * (32 * EST);
#pragma unroll
            for (int mt = 0; mt < 2; ++mt) {
                epi_stage<2>(tot, mt, reg);
                epi_rows8<2>(reg, [&](int rl, int cl, float4 a, float4 b) { st8bf(ACCM + (size_t)(m0 + wm * 64 + mt * 32 + rl) * D + n0 + wn * 64 + cl, a, b); });
            }
        }
    }
}

DEVI void phase_out(const P& p, int l, bf16_t* sm) {
    unsigned char* ws = p.ws;
    const bf16_t* ACCM = (const bf16_t*)(ws + OFF_SCR);
    const bf16_t* Wo = (const bf16_t*)(ws + OFF_WOT) + (size_t)l * D * D;
    const float* MOD = (const float*)(ws + OFF_MOD) + (size_t)l * 3 * 3072;
    float* XC1 = (float*)(ws + OFF_XC1);
    const int M = (l == 0) ? NR : NL;
    const int tilesM = M / 256, tilesN = D / 128;
    for (int it = 0;; ++it) {
        const int tile = tile_of(it);
        if (it * (int)gridDim.x >= tilesM * tilesN) break;
        if (tile >= tilesM * tilesN) continue;
        const int tm = tile / tilesN, tn = tile % tilesN;
        const int m0 = tm * 256, n0 = tn * 128;
        GAcc<2> acc; acc_zero(acc);
        gemm_kloop<2, 1>(ACCM, D, Wo, D, D, m0, n0, sm, acc);
        {
            const int wave = ltid() >> 6, wm = wave >> 1, wn = wave & 1;
            float* reg = (float*)sm + wave * (32 * EST);
#pragma unroll
            for (int mt = 0; mt < 2; ++mt) {
                epi_stage<2>(acc, mt, reg);
                epi_rows8<2>(reg, [&](int rl, int cl, float4 a, float4 b) {
                    const int row = m0 + wm * 64 + mt * 32 + rl, col = n0 + wn * 64 + cl;
                    const bool ic = row >= NL;
                    const int mi = ic ? 2 : (row >> 14);
                    const float4 g0 = *(const float4*)(MOD + mi * 3072 + 2048 + col), g1 = *(const float4*)(MOD + mi * 3072 + 2048 + col + 4);
                    const float* src; float* dst;
                    if (ic) { src = (l == 0 ? p.ctx : XC1) + (size_t)(row - NL) * D + col; dst = XC1 + (size_t)(row - NL) * D + col; }
                    else { src = (l == 0 ? p.x : p.out) + (size_t)row * D + col; dst = p.out + (size_t)row * D + col; }
                    const float4 x0 = *(const float4*)src, x1 = *(const float4*)(src + 4);
                    if (!p.dry) {
                        *(float4*)dst = make_float4(x0.x + g0.x * a.x, x0.y + g0.y * a.y, x0.z + g0.z * a.z, x0.w + g0.w * a.w);
                        *(float4*)(dst + 4) = make_float4(x1.x + g1.x * b.x, x1.y + g1.y * b.y, x1.z + g1.z * b.z, x1.w + g1.w * b.w);
                    }
                });
            }
        }
    }
}

DEVI void transpose_tile(const float* __restrict__ src, int K, int N, bf16_t* __restrict__ dst, int k0, int n0, float* sm) {
    const int tid = ltid();
    __syncthreads();
    {
        const int kr = tid >> 4, nc = (tid & 15) * 4;
#pragma unroll
        for (int i = 0; i < 2; ++i) {
            const int k = kr + 32 * i;
            float4 v = {0.f, 0.f, 0.f, 0.f};
            if (n0 + nc < N) v = *(const float4*)(src + (size_t)(k0 + k) * N + n0 + nc);
            sm[k * 65 + nc + 0] = v.x; sm[k * 65 + nc + 1] = v.y; sm[k * 65 + nc + 2] = v.z; sm[k * 65 + nc + 3] = v.w;
        }
    }
    __syncthreads();
    {
        const int n = tid >> 3, kc = (tid & 7) * 8;
        if (n0 + n < N) {
            uint4 w;
            w.x = pk2(sm[(kc + 0) * 65 + n], sm[(kc + 1) * 65 + n]); w.y = pk2(sm[(kc + 2) * 65 + n], sm[(kc + 3) * 65 + n]);
            w.z = pk2(sm[(kc + 4) * 65 + n], sm[(kc + 5) * 65 + n]); w.w = pk2(sm[(kc + 6) * 65 + n], sm[(kc + 7) * 65 + n]);
            *(uint4*)(dst + (size_t)(n0 + n) * K + k0 + kc) = w;
        }
    }
}

DEVI void hyena_mlp_task(const P& p, int l, int L, int p0, float* HT, float* sm) {
    const int tid = ltid();
    float* zb = sm;
    float* h1 = sm + 64 * 33;
    float* h2 = h1 + 64 * 65;
    const float* w1 = p.fw1 + (size_t)l * 33 * 64; const float* b1 = p.fb1 + l * 64;
    const float* w2 = p.fw2 + (size_t)l * 64 * 64; const float* b2 = p.fb2 + l * 64;
    const float* w3 = p.fw3 + (size_t)l * 64 * 64; const float* b3 = p.fb3 + l * 64;
    const float* fr = p.ffreq + l * 64;
    __syncthreads();
#pragma unroll 1
    for (int e = tid; e < 64 * 33; e += NTHR) {
        const int pos = e / 33, k = e % 33;
        const int pp = p0 + pos;
        float v;
        if (k == 0) v = (float)pp / (float)(L - 1);
        else {
            const int j = (k - 1) & 15;
            const float f = 1e-4f + (float)j * ((15.0f - 1e-4f) / 15.0f);
            const float wa = 6.283185307179586f * (float)pp / (float)L;
            v = (k <= 16) ? cosf(f * wa) : -sinf(f * wa);
        }
        zb[e] = v;
    }
    __syncthreads();
    const int pos = tid >> 3, fg = (tid & 7) * 8;
    {
        float a[8];
#pragma unroll
        for (int j = 0; j < 8; ++j) a[j] = b1[fg + j];
#pragma unroll 1
        for (int k = 0; k < 33; ++k) {
            const float zv = zb[pos * 33 + k];
#pragma unroll
            for (int j = 0; j < 8; ++j) a[j] += zv * w1[k * 64 + fg + j];
        }
#pragma unroll
        for (int j = 0; j < 8; ++j) h1[pos * 65 + fg + j] = sinf(fr[fg + j] * a[j]);
    }
    __syncthreads();
    {
        float a[8];
#pragma unroll
        for (int j = 0; j < 8; ++j) a[j] = b2[fg + j];
#pragma unroll 2
        for (int k = 0; k < 64; ++k) {
            const float zv = h1[pos * 65 + k];
#pragma unroll
            for (int j = 0; j < 8; ++j) a[j] += zv * w2[k * 64 + fg + j];
        }
#pragma unroll
        for (int j = 0; j < 8; ++j) h2[pos * 65 + fg + j] = sinf(fr[fg + j] * a[j]);
    }
    __syncthreads();
    {
        float a[8];
#pragma unroll
        for (int j = 0; j < 8; ++j) a[j] = b3[fg + j];
#pragma unroll 2
        for (int k = 0; k < 64; ++k) {
            const float zv = h2[pos * 65 + k];
#pragma unroll
            for (int j = 0; j < 8; ++j) a[j] += zv * w3[k * 64 + fg + j];
        }
#pragma unroll
        for (int j = 0; j < 8; ++j) HT[(size_t)(fg + j) * L + p0 + pos] = sinf(fr[fg + j] * a[j]);
    }
}

DEVI void phase_prep(const P& p, float* sm) {
    unsigned char* ws = p.ws;
    const int tid = ltid();
    constexpr int TN_IN = (IN_TOTAL + 63) / 64;
    constexpr int T_WIN = 2 * 16 * TN_IN;
    constexpr int T_WB = 2 * 4 * 8 * 16;
    constexpr int T_WO = 2 * 16 * 16;
    constexpr int T_MOD = 2 * 48;
    constexpr int T_ROPE = T * 32 / NTHR;
    constexpr int T_MLP = 2 * 256 + 4;
    constexpr int E0 = T_WIN, E1 = E0 + T_WB, E2 = E1 + T_WO, E3 = E2 + T_MOD, E4 = E3 + T_ROPE, E5 = E4 + T_MLP;
    for (int task = blockIdx.x; task < E5; task += gridDim.x) {
        if (task < E0) {
            const int l = task / (16 * TN_IN), r = task % (16 * TN_IN), kt = r / TN_IN, nt = r % TN_IN;
            transpose_tile(p.w_in + (size_t)l * D * IN_TOTAL, D, IN_TOTAL, (bf16_t*)(ws + OFF_WINT) + (size_t)l * IN_TOTAL * D, kt * 64, nt * 64, sm);
        } else if (task < E1) {
            const int q = task - E0, li = q / 128, r = q % 128, kt = r / 16, nt = r % 16;
            transpose_tile(p.w_branch + (size_t)li * 512 * D, 512, D, (bf16_t*)(ws + OFF_WBT) + (size_t)li * D * 512, kt * 64, nt * 64, sm);
        } else if (task < E2) {
            const int q = task - E1, l = q / 256, r = q % 256, kt = r / 16, nt = r % 16;
            transpose_tile(p.w_out + (size_t)l * D * D, D, D, (bf16_t*)(ws + OFF_WOT) + (size_t)l * D * D, kt * 64, nt * 64, sm);
        } else if (task < E3) {
            const int q = task - E2, l = q / 48, jb = q % 48;
            float* sc = sm;
            float* red = sm + 3072;
            __syncthreads();
#pragma unroll 1
            for (int e = tid; e < 3072; e += NTHR) {
                const int mi = e >> 10, k = e & 1023;
                const float v = (mi < 2) ? p.c[mi * D + k] : p.c_ctx[k];
                sc[e] = siluf(v);
            }
            __syncthreads();
            const int kg = tid >> 6, jj = tid & 63, j = jb * 64 + jj;
            const float* w = p.w_mod + (size_t)l * D * 3072 + j;
            float a0 = 0.f, a1 = 0.f, a2 = 0.f;
#pragma unroll 8
            for (int k = kg * 128; k < kg * 128 + 128; ++k) {
                const float wv = w[(size_t)k * 3072];
                a0 += sc[k] * wv; a1 += sc[1024 + k] * wv; a2 += sc[2048 + k] * wv;
            }
            red[(0 * 8 + kg) * 64 + jj] = a0; red[(1 * 8 + kg) * 64 + jj] = a1; red[(2 * 8 + kg) * 64 + jj] = a2;
            __syncthreads();
            if (tid < 192) {
                const int mi = tid >> 6, j2 = tid & 63;
                float s = p.b_mod[l * 3072 + jb * 64 + j2];
#pragma unroll
                for (int g = 0; g < 8; ++g) s += red[(mi * 8 + g) * 64 + j2];
                ((float*)(ws + OFF_MOD))[((size_t)l * 3 + mi) * 3072 + jb * 64 + j2] = s;
            }
        } else if (task < E4) {
            const int e = (task - E3) * NTHR + tid;
            const int t = e >> 5, c = e & 31;
            const float inv = powf(10000.0f, -(float)(c & 15) / 16.0f);
            const float pos = (c < 16) ? (float)(t >> 6) : (float)(t & 63);
            const float ang = pos * inv;
            float* rope = (float*)(ws + OFF_ROPE);
            rope[e] = cosf(ang); rope[(size_t)T * 32 + e] = sinf(ang);
        } else {
            const int q = task - E4;
            if (q < 512) { const int l = q >> 8; hyena_mlp_task(p, l, T, (q & 255) * 64, (float*)(ws + OFF_HH3T) + (size_t)l * 64 * T, sm); }
            else hyena_mlp_task(p, 0, CL, (q - 512) * 64, (float*)(ws + OFF_HH3C), sm);
        }
    }
}

DEVI void phase_hl(const P& p, int l) {
    unsigned char* ws = p.ws;
    const int lane = ltid() & 63, wave = ltid() >> 6;
    const float* MOD = (const float*)(ws + OFF_MOD) + (size_t)l * 3 * 3072;
    const float* nw = p.norm_w + l * D;
    bf16_t* HL = (bf16_t*)(ws + OFF_HL);
    const float* XC1 = (const float*)(ws + OFF_XC1);
    for (int row = blockIdx.x * 8 + wave; row < NR; row += gridDim.x * 8) {
        const float* src; int mi;
        if (row < NL) { src = (l == 0 ? p.x : p.out) + (size_t)row * D; mi = row >> 14; }
        else { src = (l == 0 ? p.ctx : XC1) + (size_t)(row - NL) * D; mi = 2; }
        float4 v[4]; float ss = 0.f;
#pragma unroll
        for (int i = 0; i < 4; ++i) { v[i] = *(const float4*)(src + lane * 4 + 256 * i); ss += v[i].x * v[i].x + v[i].y * v[i].y + v[i].z * v[i].z + v[i].w * v[i].w; }
        ss = wave_sum(ss);
        const float rs = rsqrtf(ss * (1.0f / D) + EPS);
        const float* sh = MOD + mi * 3072; const float* sc = sh + 1024;
#pragma unroll
        for (int i = 0; i < 4; ++i) {
            const int c = lane * 4 + 256 * i;
            const float4 w = *(const float4*)(nw + c), s1 = *(const float4*)(sc + c), s0 = *(const float4*)(sh + c);
            st4bf(HL + (size_t)row * D + c, v[i].x * rs * w.x * (1.f + s1.x) + s0.x, v[i].y * rs * w.y * (1.f + s1.y) + s0.y,
                  v[i].z * rs * w.z * (1.f + s1.z) + s0.z, v[i].w * rs * w.w * (1.f + s1.w) + s0.w);
        }
    }
}
DEVI void phase_final(const P& p) {
    const int lane = ltid() & 63, wave = ltid() >> 6;
    for (int row = blockIdx.x * 8 + wave; row < NL; row += gridDim.x * 8) {
        float* src = p.out + (size_t)row * D;
        float4 v[4]; float ss = 0.f;
#pragma unroll
        for (int i = 0; i < 4; ++i) { v[i] = *(const float4*)(src + lane * 4 + 256 * i); ss += v[i].x * v[i].x + v[i].y * v[i].y + v[i].z * v[i].z + v[i].w * v[i].w; }
        ss = wave_sum(ss);
        const float rs = rsqrtf(ss * (1.0f / D) + EPS);
#pragma unroll
        for (int i = 0; i < 4; ++i) {
            const int c = lane * 4 + 256 * i;
            const float4 w = *(const float4*)(p.final_norm_w + c);
            float4 r = {v[i].x * rs * w.x, v[i].y * rs * w.y, v[i].z * rs * w.z, v[i].w * rs * w.w};
            *(float4*)(src + c) = r;
        }
    }
}

union U8 { bf16x8 v; uint4 u; uint2 h[2]; unsigned w[4]; };
struct AttSt { float m, l; f32x4 o[4]; };
constexpr float L2E = 1.4426950408889634f;
constexpr float NEG_INF = -__builtin_huge_valf();

DEVI float rows_max(float x) {
    const unsigned u = __float_as_uint(x);
    auto r = __builtin_amdgcn_permlane16_swap(u, u, false, false);
    const float a = fmaxf(__uint_as_float(r[0]), __uint_as_float(r[1]));
    const unsigned v = __float_as_uint(a);
    auto t = __builtin_amdgcn_permlane32_swap(v, v, false, false);
    return fmaxf(__uint_as_float(t[0]), __uint_as_float(t[1]));
}
DEVI float rows_sum(float x) {
    const unsigned u = __float_as_uint(x);
    auto r = __builtin_amdgcn_permlane16_swap(u, u, false, false);
    const float a = __uint_as_float(r[0]) + __uint_as_float(r[1]);
    const unsigned v = __float_as_uint(a);
    auto t = __builtin_amdgcn_permlane32_swap(v, v, false, false);
    return __uint_as_float(t[0]) + __uint_as_float(t[1]);
}
struct KVF { bf16x8 ka, kb, kc, kd; U8 v0, v1, v2, v3; };
DEVI void att_load(KVF& f, const bf16_t* k0p, const bf16_t* k1p, const bf16_t* v0p, const bf16_t* v1p, size_t ldv) {
    f.ka = *(const bf16x8*)k0p; f.kb = *(const bf16x8*)(k0p + 32);
    f.kc = *(const bf16x8*)k1p; f.kd = *(const bf16x8*)(k1p + 32);
    f.v0.u = *(const uint4*)(v0p); f.v1.u = *(const uint4*)(v0p + 16 * ldv);
    f.v2.u = *(const uint4*)(v0p + 32 * ldv); f.v3.u = *(const uint4*)(v0p + 48 * ldv);
}
DEVI void att_load2(KVF& f, const char* kb, unsigned k0, unsigned k1, const char* vb, unsigned v0, unsigned vstep) {
    f.ka = *(const bf16x8*)(kb + k0); f.kb = *(const bf16x8*)(kb + (k0 + 64u));
    f.kc = *(const bf16x8*)(kb + k1); f.kd = *(const bf16x8*)(kb + (k1 + 64u));
    f.v0.u = *(const uint4*)(vb + v0); f.v1.u = *(const uint4*)(vb + (v0 + vstep));
    f.v2.u = *(const uint4*)(vb + (v0 + 2u * vstep)); f.v3.u = *(const uint4*)(vb + (v0 + 3u * vstep));
}
DEVI void att_compute(AttSt& st, const bf16x8& q0, const bf16x8& q1, const KVF& f, f32x4 b0, f32x4 b1, float scale2) {
    f32x4 s0 = {0.f, 0.f, 0.f, 0.f}, s1 = {0.f, 0.f, 0.f, 0.f};
    s0 = __builtin_amdgcn_mfma_f32_16x16x32_bf16(f.ka, q0, s0, 0, 0, 0);
    s0 = __builtin_amdgcn_mfma_f32_16x16x32_bf16(f.kb, q1, s0, 0, 0, 0);
    s1 = __builtin_amdgcn_mfma_f32_16x16x32_bf16(f.kc, q0, s1, 0, 0, 0);
    s1 = __builtin_amdgcn_mfma_f32_16x16x32_bf16(f.kd, q1, s1, 0, 0, 0);
    s0 = s0 * scale2 + b0; s1 = s1 * scale2 + b1;
    float mx = fmaxf(fmaxf(fmaxf(s0[0], s0[1]), fmaxf(s0[2], s0[3])), fmaxf(fmaxf(s1[0], s1[1]), fmaxf(s1[2], s1[3])));
    mx = rows_max(mx);
    const float mn = fmaxf(st.m, mx);
    const float alpha = __builtin_amdgcn_exp2f(st.m - mn);
    float pa[8];
#pragma unroll
    for (int i = 0; i < 4; ++i) { pa[i] = __builtin_amdgcn_exp2f(s0[i] - mn); pa[4 + i] = __builtin_amdgcn_exp2f(s1[i] - mn); }
    st.l = st.l * alpha + ((pa[0] + pa[1]) + (pa[2] + pa[3])) + ((pa[4] + pa[5]) + (pa[6] + pa[7]));
    st.m = mn;
    U8 pf; pf.w[0] = pk2(pa[0], pa[1]); pf.w[1] = pk2(pa[2], pa[3]); pf.w[2] = pk2(pa[4], pa[5]); pf.w[3] = pk2(pa[6], pa[7]);
    st.o[0] = st.o[0] * alpha; st.o[0] = __builtin_amdgcn_mfma_f32_16x16x32_bf16(f.v0.v, pf.v, st.o[0], 0, 0, 0);
    st.o[1] = st.o[1] * alpha; st.o[1] = __builtin_amdgcn_mfma_f32_16x16x32_bf16(f.v1.v, pf.v, st.o[1], 0, 0, 0);
    st.o[2] = st.o[2] * alpha; st.o[2] = __builtin_amdgcn_mfma_f32_16x16x32_bf16(f.v2.v, pf.v, st.o[2], 0, 0, 0);
    st.o[3] = st.o[3] * alpha; st.o[3] = __builtin_amdgcn_mfma_f32_16x16x32_bf16(f.v3.v, pf.v, st.o[3], 0, 0, 0);
}
#define ATT_PIPELINE(n_)                                              \
    { KVF fa_, fb_;                                                   \
      LOADS(fa_, 0);                                                  \
      int s_ = 0;                                                     \
      for (; s_ + 2 < (n_); s_ += 2) {        \
          LOADS(fb_, s_ + 1);                                         \
          COMPS(fa_, s_);                                             \
          LOADS(fa_, s_ + 2);                                         \
          COMPS(fb_, s_ + 1);                                         \
      }                                                               \
      if (s_ + 1 < (n_)) { LOADS(fb_, s_ + 1); COMPS(fa_, s_); COMPS(fb_, s_ + 1); } \
      else { COMPS(fa_, s_); } }
DEVI void att_finish(const AttSt& st, float extra_l, bf16_t* G  , int dry) {
    const int lane = ltid() & 63, g = lane >> 4;
    float lt = rows_sum(st.l);
    lt += extra_l;
    const float inv = 1.f / lt;
#pragma unroll
    for (int dt = 0; dt < 4; ++dt) {
        bf16_t* gp = G + dt * 16 + 4 * g;
        const uint2 gv = *(const uint2*)gp;
        if (!dry) st4bf(gp, st.o[dt][0] * inv * lo_bf(gv.x), st.o[dt][1] * inv * hi_bf(gv.x), st.o[dt][2] * inv * lo_bf(gv.y), st.o[dt][3] * inv * hi_bf(gv.y));
    }
}

DEVI void phase_att_a(const P& p, int l, float* smf) {
    unsigned char* ws = p.ws; unsigned char* scr = ws + OFF_SCR;
    const bf16_t* Q = (const bf16_t*)(scr + SA_Q); const bf16_t* K = (const bf16_t*)(scr + SA_K); const bf16_t* VT = (const bf16_t*)(scr + SA_VT);
    const bf16_t* VTC = VT + (size_t)NB * 8 * 64 * T;
    bf16_t* G = (bf16_t*)(ws + OFF_YS);
    const int tid = ltid(), lane = tid & 63, h = tid >> 6, q = lane & 15, g = lane >> 4;
    __syncthreads();
    for (int e = tid; e < 8 * 465; e += NTHR) smf[e] = p.rpb[(size_t)l * 8 * 465 + e] * L2E;
    __syncthreads();
    const float* tab = smf + h * 465;
    const float scale2 = 0.125f * L2E;
    const int ntask = 2048 + (l == 0 ? 32 : 0);
    for (int it = 0; it * (int)gridDim.x < ntask; ++it) {
        const int task = tile_of(it);
        if (task >= ntask) continue;
        AttSt st; st.m = -1e30f; st.l = 0.f;
#pragma unroll
        for (int dt = 0; dt < 4; ++dt) st.o[dt] = (f32x4){0.f, 0.f, 0.f, 0.f};
        int b, qrow;
        const bool lat = task < 2048;
        int r = 0, j = 0;
        if (lat) { b = task >> 10; r = (task >> 2) & 255; j = task & 3; qrow = b * T + r * 64 + j * 16 + q; }
        else { const int tt = task - 2048; b = tt >> 4; qrow = NL + b * CL + (tt & 15) * 16 + q; }
        const bf16_t* qp = Q + (size_t)qrow * 512 + h * 64 + g * 8;
        const bf16x8 q0 = *(const bf16x8*)qp, q1 = *(const bf16x8*)(qp + 32);
        {
            const int rs = min(max(r - 4, 0), 248), kc0 = min(max(j * 16 - 8, 0), 32);
            const int qc = j * 16 + q, cs = min(max(qc - 8, 0), 48);
            const int nloc = lat ? 8 : 0, nst = nloc + 8;
            const bf16_t* Kc = K + (size_t)(NL + b * CL) * 512 + h * 64 + g * 8;
            const bf16_t* Vc = VTC + ((size_t)(b * 8 + h) * 64 + (lane & 15)) * CL + 8 * g;
            const int kmap = 8 * ((lane & 15) >> 2) + (lane & 3);
            const char* KnB = (const char*)(K + (size_t)b * T * 512); const char* VnB = (const char*)(VT + (size_t)(b * 8) * 64 * T);
            const char* KcB = (const char*)(K + (size_t)(NL + b * CL) * 512); const char* VcB = (const char*)(VTC + (size_t)(b * 8) * 64 * CL);
            const unsigned kln = (unsigned)((kc0 + kmap) * 512 + h * 64 + g * 8) * 2u, vln = (unsigned)((h * 64 + (lane & 15)) * T + kc0 + 8 * g) * 2u;
            const unsigned klc = (unsigned)(kmap * 512 + h * 64 + g * 8) * 2u, vlc = (unsigned)((h * 64 + (lane & 15)) * CL + 8 * g) * 2u;
#define LOADS(F, S) { const int s2_ = (S); if (s2_ < nloc) { const unsigned k0_ = kln + (unsigned)(rs + s2_) * 65536u; \
                        att_load2(F, KnB, k0_, k0_ + 4096u, VnB, vln + (unsigned)(rs + s2_) * 128u, (unsigned)(16 * T * 2)); } \
                      else { const unsigned c_ = (unsigned)(s2_ - nloc); const unsigned k0_ = klc + c_ * 32768u; att_load2(F, KcB, k0_, k0_ + 4096u, VcB, vlc + c_ * 64u, (unsigned)(16 * CL * 2)); } }
            int ia[4], ib[4]; bool va_[4], vb_[4];
#pragma unroll
            for (int i = 0; i < 4; ++i) { const int kc_a = kc0 + 8 * g + i, kc_b = kc_a + 4;
                va_[i] = (kc_a >= cs && kc_a < cs + 16); vb_[i] = (kc_b >= cs && kc_b < cs + 16);
                ia[i] = min(max(kc_a - qc + 15, 0), 30); ib[i] = min(max(kc_b - qc + 15, 0), 30); }
#define COMPS(F, S) { const int s2_ = (S); f32x4 b0 = {0.f, 0.f, 0.f, 0.f}, b1 = {0.f, 0.f, 0.f, 0.f}; \
                      if (s2_ < nloc) { const float* trw = tab + (rs + s2_ - r + 7) * 31; \
                        _Pragma("unroll") for (int i = 0; i < 4; ++i) { b0[i] = va_[i] ? trw[ia[i]] : NEG_INF; b1[i] = vb_[i] ? trw[ib[i]] : NEG_INF; } } \
                      att_compute(st, q0, q1, F, b0, b1, scale2); }
            ATT_PIPELINE(nst)
#undef LOADS
#undef COMPS
        }
        att_finish(st, 0.f, G + (size_t)qrow * 512 + h * 64, p.dry);
    }
}

DEVI void phase_att_b(const P& p, int l) {
    unsigned char* ws = p.ws; unsigned char* scr = ws + OFF_SCR;
    const bf16_t* Q = (const bf16_t*)(scr + SB_Q); const bf16_t* K = (const bf16_t*)(scr + SB_K); const bf16_t* VT = (const bf16_t*)(scr + SB_VT);
    const bf16_t* VTC = VT + (size_t)NB * 2 * 64 * T;
    bf16_t* G = (bf16_t*)(ws + OFF_YS + SZ512);
    const int tid = ltid(), lane = tid & 63, h = tid >> 6, kvh = h >> 2, q = lane & 15, g = lane >> 4;
    const float scale2 = 0.125f * L2E;
    const float sink2 = p.sink[l * 8 + h] * L2E;
    const int ntask = 2048 + (l == 0 ? 32 : 0);
    for (int it = 0; it * (int)gridDim.x < ntask; ++it) {
        const int task = tile_of(it);
        if (task >= ntask) continue;
        AttSt st; st.m = -1e30f; st.l = 0.f;
#pragma unroll
        for (int dt = 0; dt < 4; ++dt) st.o[dt] = (f32x4){0.f, 0.f, 0.f, 0.f};
        int b, qrow;
        const bool lat = task < 2048;
        int q0t = 0;
        if (lat) { b = task >> 10; q0t = (task & 1023) * 16; qrow = b * T + q0t + q; }
        else { const int tt = task - 2048; b = tt >> 4; qrow = NL + b * CL + (tt & 15) * 16 + q; }
        const bf16_t* qp = Q + (size_t)qrow * 512 + h * 64 + g * 8;
        const bf16x8 q0 = *(const bf16x8*)qp, q1 = *(const bf16x8*)(qp + 32);
        {
            const int tq = q0t + q;
            const int nloc = lat ? 9 : 0, nst = nloc + 8;
            const bf16_t* Kc = K + (size_t)(NL + b * CL) * 128 + kvh * 64 + g * 8;
            const bf16_t* Vc = VTC + ((size_t)(b * 2 + kvh) * 64 + (lane & 15)) * CL + 8 * g;
            const int kmap = 8 * ((lane & 15) >> 2) + (lane & 3);
            const bf16_t* vbase = VT + ((size_t)(b * 2 + kvh) * 64 + (lane & 15)) * T;
            const char* KnB = (const char*)(K + (size_t)b * T * 128); const char* VnB = (const char*)(VT + (size_t)(b * 2) * 64 * T);
            const char* KcB = (const char*)(K + (size_t)(NL + b * CL) * 128); const char* VcB = (const char*)(VTC + (size_t)(b * 2) * 64 * CL);
            const unsigned kl2 = (unsigned)(kvh * 64 + g * 8) * 2u, vl2 = (unsigned)((kvh * 64 + (lane & 15)) * T) * 2u;
            const unsigned klc = (unsigned)(kmap * 128 + kvh * 64 + g * 8) * 2u, vlc = (unsigned)((kvh * 64 + (lane & 15)) * CL + 8 * g) * 2u;
#define LOADS(F, S) { const int s2_ = (S); if (s2_ < nloc) { const int tbase = q0t - 128 + 32 * s2_; \
                        const int ta = min(max(tbase + kmap, 0), T - 1), tb = min(max(tbase + kmap + 4, 0), T - 1); \
                        const int va = min(max(tbase + 8 * g, 0), T - 8); \
                        att_load2(F, KnB, kl2 + (unsigned)ta * 256u, kl2 + (unsigned)tb * 256u, VnB, vl2 + (unsigned)va * 2u, (unsigned)(16 * T * 2)); } \
                      else { const unsigned c_ = (unsigned)(s2_ - nloc); const unsigned k0_ = klc + c_ * 8192u; att_load2(F, KcB, k0_, k0_ + 1024u, VcB, vlc + c_ * 64u, (unsigned)(16 * CL * 2)); } }
#define COMPS(F, S) { const int s2_ = (S); f32x4 b0 = {0.f, 0.f, 0.f, 0.f}, b1 = {0.f, 0.f, 0.f, 0.f}; \
                      if (s2_ < nloc && (s2_ == 0 || s2_ == 8 || q0t < 128 || q0t + 160 > T)) { const int tbase = q0t - 128 + 32 * s2_; \
                        _Pragma("unroll") for (int i = 0; i < 4; ++i) { const int t0 = tbase + 8 * g + i, t1 = t0 + 4; \
                          b0[i] = (t0 >= 0 && t0 < T && abs(tq - t0) <= 128) ? 0.f : NEG_INF; \
                          b1[i] = (t1 >= 0 && t1 < T && abs(tq - t1) <= 128) ? 0.f : NEG_INF; } } \
                      att_compute(st, q0, q1, F, b0, b1, scale2); }
            ATT_PIPELINE(nst)
#undef LOADS
#undef COMPS
        }
        att_finish(st, __builtin_amdgcn_exp2f(sink2 - st.m), G + (size_t)qrow * 512 + h * 64, p.dry);
    }
}

constexpr int GL_CUM = 0;
constexpr int GL_LR = 32768;
constexpr int GL_T0 = GL_LR + 8192;
constexpr int GL_TSZ = 64 * LSTR * 2;
constexpr int GL_X = GL_T0 + 4 * GL_TSZ;

DEVI float logsigmoidf(float x) { return fminf(x, 0.f) - log1pf(expf(-fabsf(x))); }

DEVI void gla_cum(const P& p, int l, int h, int rowbase, unsigned char* sm) {
    const int tid = ltid();
    float* cum = (float*)(sm + GL_CUM); float* lrs = (float*)(sm + GL_LR);
    const float* LR = (const float*)(p.ws + OFF_SCR + SC_LR);
    __syncthreads();
    { const int t = tid >> 3, c4 = (tid & 7) * 4; *(float4*)(lrs + t * 32 + c4) = *(const float4*)(LR + (size_t)(rowbase + t) * 32 + c4); }
    __syncthreads();
    const int d = tid & 63, tg = tid >> 6;
    float* tot = lrs + 64 * 32;
    tot = (float*)(sm + GL_X);
    float la[2][8];
#pragma unroll
    for (int dir = 0; dir < 2; ++dir) {
        const float* W = p.w_alpha_up + ((size_t)(l * 2 + dir) * 16) * 256 + h * 64 + d;
        float w[16];
#pragma unroll
        for (int r = 0; r < 16; ++r) w[r] = W[r * 256];
        const float bia = p.b_alpha[(l * 2 + dir) * 256 + h * 64 + d];
#pragma unroll
        for (int tt = 0; tt < 8; ++tt) {
            const int t = tg * 8 + tt;
            float x = bia;
#pragma unroll
            for (int r = 0; r < 16; ++r) x += lrs[t * 32 + dir * 16 + r] * w[r];
            la[dir][tt] = logsigmoidf(x) * (1.0f / 16.0f);
        }
    }
#pragma unroll
    for (int tt = 1; tt < 8; ++tt) la[0][tt] += la[0][tt - 1];
#pragma unroll
    for (int tt = 6; tt >= 0; --tt) la[1][tt] += la[1][tt + 1];
    tot[(0 * 8 + tg) * 64 + d] = la[0][7];
    tot[(1 * 8 + tg) * 64 + d] = la[1][0];
    __syncthreads();
    float of = 0.f, ob = 0.f;
#pragma unroll
    for (int g2 = 0; g2 < 8; ++g2) {
        const float a = tot[(0 * 8 + g2) * 64 + d], b = tot[(1 * 8 + g2) * 64 + d];
        of += (g2 < tg) ? a : 0.f;
        ob += (g2 > tg) ? b : 0.f;
    }
#pragma unroll
    for (int tt = 0; tt < 8; ++tt) {
        const int t = tg * 8 + tt;
        cum[t * 64 + d] = la[0][tt] + of;
        cum[(64 + t) * 64 + d] = la[1][tt] + ob;
    }
    __syncthreads();
}
DEVI void gla_chunk_geom(int b, int c, int& rowbase, size_t& vt_off  , size_t& vld, int& ci_f, int& ci_b) {
    if (c < 4) { rowbase = NL + b * CL + c * 64; vld = CL; ci_f = c; ci_b = 3 - c; }
    else { rowbase = b * T + (c - 4) * 64; vld = T; ci_f = c; ci_b = 4 + 255 - (c - 4); }
}
DEVI const bf16_t* gla_vt_ptr(const bf16_t* VT, int b, int h, int c) {
    if (c < 4) return VT + (size_t)NB * 4 * 128 * T + ((size_t)(b * 4 + h) * 128) * CL + c * 64;
    return VT + ((size_t)(b * 4 + h) * 128) * T + (size_t)(c - 4) * 64;
}

DEVI void phase_gla1(const P& p, int l, unsigned char* sm) {
    unsigned char* scr = p.ws + OFF_SCR;
    const bf16_t* KG = (const bf16_t*)(scr + SC_K); const bf16_t* VT = (const bf16_t*)(scr + SC_VT);
    bf16_t* SB = (bf16_t*)(scr + SC_SB); float* GD = (float*)(scr + SC_GD);
    const int tid = ltid(), lane = tid & 63, wave = tid >> 6;
    const float* cum = (const float*)(sm + GL_CUM);
    bf16_t* kdT = (bf16_t*)(sm + GL_T0);
    for (int task = blockIdx.x; task < 8 * NCH; task += gridDim.x) {
        const int bh = task / NCH, c = task % NCH, b = bh >> 2, h = bh & 3;
        int rowbase, ci_f, ci_b; size_t vo, vld;
        gla_chunk_geom(b, c, rowbase, vo, vld, ci_f, ci_b);
        gla_cum(p, l, h, rowbase, sm);
        {
            const int d = tid & 63, tg = tid >> 6;
            const float ce_f = cum[63 * 64 + d], ce_b = cum[64 * 64 + d];
            float vf[8], vb[8];
#pragma unroll
            for (int j = 0; j < 8; ++j) {
                const int t = tg * 8 + j;
                const float kf = bf2f(KG[(size_t)(rowbase + t) * 256 + h * 64 + d]);
                vf[j] = kf * __expf(ce_f - cum[t * 64 + d]);
                vb[j] = kf * __expf(ce_b - cum[(64 + t) * 64 + d]);
            }
            uint4 wf, wb;
            wf.x = pk2(vf[0], vf[1]); wf.y = pk2(vf[2], vf[3]); wf.z = pk2(vf[4], vf[5]); wf.w = pk2(vf[6], vf[7]);
            wb.x = pk2(vb[0], vb[1]); wb.y = pk2(vb[2], vb[3]); wb.z = pk2(vb[4], vb[5]); wb.w = pk2(vb[6], vb[7]);
            *(uint4*)(kdT + d * LSTR + tg * 8) = wf;
            *(uint4*)(kdT + (64 + d) * LSTR + tg * 8) = wb;
        }
        __syncthreads();
        {
            const int dir = wave >> 2, dvt = wave & 3;
            const bf16_t* vp = gla_vt_ptr(VT, b, h, c) + (size_t)(dvt * 32 + (lane & 31)) * vld + (lane >> 5) * 8;
            const bf16_t* ap = kdT + (dir * 64 + (lane & 31)) * LSTR + (lane >> 5) * 8;
            f32x16 acc[2];
#pragma unroll
            for (int i = 0; i < 16; ++i) { acc[0][i] = 0.f; acc[1][i] = 0.f; }
#pragma unroll
            for (int ks = 0; ks < 4; ++ks) {
                const bf16x8 vb = *(const bf16x8*)(vp + ks * 16);
#pragma unroll
                for (int mt = 0; mt < 2; ++mt) {
                    const bf16x8 ka = *(const bf16x8*)(ap + mt * 32 * LSTR + ks * 16);
                    acc[mt] = __builtin_amdgcn_mfma_f32_32x32x16_bf16(ka, vb, acc[mt], 0, 0, 0);
                }
            }
            const int bhd = bh * 2 + dir, ci = dir ? ci_b : ci_f;
            bf16_t* out = SB + ((size_t)bhd * NCH + ci) * 8192 + (size_t)(dvt * 32 + (lane & 31)) * 64;
#ifdef EXP_C
            for (int mt = 0; mt < 2; ++mt) for (int i = 0; i < 16; ++i) { const int dk = mt * 32 + (i & 3) + 8 * (i >> 2) + 4 * (lane >> 5); acc[mt][i] = bf2f(kdT[(dir * 64 + dk) * LSTR + ((dvt * 32 + (lane & 31)) & 63)]); }
#endif
#pragma unroll
            for (int mt = 0; mt < 2; ++mt)
#pragma unroll
                for (int q4 = 0; q4 < 4; ++q4)
                    st4bf(out + mt * 32 + q4 * 8 + (lane >> 5) * 4, acc[mt][q4 * 4 + 0], acc[mt][q4 * 4 + 1], acc[mt][q4 * 4 + 2], acc[mt][q4 * 4 + 3]);
        }
        if (tid < 128) {
            const int dir = tid >> 6, d = tid & 63;
            const int bhd = bh * 2 + dir, ci = dir ? ci_b : ci_f;
            GD[((size_t)bhd * NCH + ci) * 64 + d] = __expf(dir ? cum[64 * 64 + d] : cum[63 * 64 + d]);
        }
    }
}

DEVI void phase_gla2(const P& p) {
    unsigned char* scr = p.ws + OFF_SCR;
    bf16_t* SB = (bf16_t*)(scr + SC_SB); const float* GD = (const float*)(scr + SC_GD);
    for (int idx = blockIdx.x * NTHR + ltid(); idx < 16 * 8192; idx += gridDim.x * NTHR) {
        const int bhd = idx >> 13, e = idx & 8191, dk = e & 63;
        bf16_t* base = SB + (size_t)bhd * NCH * 8192 + e;
        const float* gd = GD + (size_t)bhd * NCH * 64 + dk;
        float S = 0.f;
#pragma unroll 1
        for (int ci = 0; ci < NCH; ci += 13) {
            float kv[13], g[13];
#pragma unroll
            for (int u = 0; u < 13; ++u) { kv[u] = bf2f(base[(size_t)(ci + u) * 8192]); g[u] = gd[(ci + u) * 64]; }
#pragma unroll
            for (int u = 0; u < 13; ++u) { if (!p.dry) base[(size_t)(ci + u) * 8192] = f2bf(S); S = g[u] * S + kv[u]; }
        }
    }
}

DEVI void phase_gla3(const P& p, int l, unsigned char* sm) {
    unsigned char* scr = p.ws + OFF_SCR;
    const bf16_t* QG = (const bf16_t*)(scr + SC_Q); const bf16_t* KG = (const bf16_t*)(scr + SC_K); const bf16_t* VT = (const bf16_t*)(scr + SC_VT);
    const bf16_t* SB = (const bf16_t*)(scr + SC_SB);
    bf16_t* G = (bf16_t*)(p.ws + OFF_YS + 2 * SZ512);
    const float* gnw = p.gla_norm_w + l * 128;
    const int tid = ltid(), lane = tid & 63, wave = tid >> 6, q = lane & 15, g = lane >> 4;
    const float* cum = (const float*)(sm + GL_CUM);
    bf16_t* tiles = (bf16_t*)(sm + GL_T0);
    float* X = (float*)(sm + GL_X);
    const int c_lo = (l == 0) ? 0 : 4;
    const int nper = NCH - c_lo;
    for (int task = blockIdx.x; task < 8 * nper; task += gridDim.x) {
        const int bh = task / nper, c = c_lo + task % nper, b = bh >> 2, h = bh & 3;
        int rowbase, ci_f, ci_b; size_t vo, vld;
        gla_chunk_geom(b, c, rowbase, vo, vld, ci_f, ci_b);
        gla_cum(p, l, h, rowbase, sm);
        {
            const int t = tid >> 3, dg = (tid & 7) * 8;
            U8 qv, kv; qv.u = *(const uint4*)(QG + (size_t)(rowbase + t) * 256 + h * 64 + dg); kv.u = *(const uint4*)(KG + (size_t)(rowbase + t) * 256 + h * 64 + dg);
            float o[4][8];
#pragma unroll
            for (int j = 0; j < 8; ++j) {
                const int d = dg + j;
                const float qf = (j & 1) ? hi_bf(qv.w[j >> 1]) : lo_bf(qv.w[j >> 1]);
                const float kf = (j & 1) ? hi_bf(kv.w[j >> 1]) : lo_bf(kv.w[j >> 1]);
                const float cf = cum[t * 64 + d], cb = cum[(64 + t) * 64 + d];
                o[0][j] = qf * __expf(cf); o[1][j] = kf * __expf(-cf); o[2][j] = qf * __expf(cb); o[3][j] = kf * __expf(-cb);
            }
#pragma unroll
            for (int k = 0; k < 4; ++k) {
                uint4 w; w.x = pk2(o[k][0], o[k][1]); w.y = pk2(o[k][2], o[k][3]); w.z = pk2(o[k][4], o[k][5]); w.w = pk2(o[k][6], o[k][7]);
                *(uint4*)(tiles + k * 64 * LSTR + t * LSTR + dg) = w;
            }
        }
        __syncthreads();
        const int qi = wave & 3, dir = wave >> 2;
        f32x4 O[8];
#pragma unroll
        for (int i = 0; i < 8; ++i) O[i] = (f32x4){0.f, 0.f, 0.f, 0.f};
        {
            const bf16_t* Qd = tiles + (dir * 2) * 64 * LSTR; const bf16_t* Kd = tiles + (dir * 2 + 1) * 64 * LSTR;
            const bf16x8 qf0 = *(const bf16x8*)(Qd + (qi * 16 + q) * LSTR + g * 8), qf1 = *(const bf16x8*)(Qd + (qi * 16 + q) * LSTR + 32 + g * 8);
            const int iq = qi * 16 + q;
            U8 pf[2];
#pragma unroll
            for (int jt = 0; jt < 4; ++jt) {
                const bf16_t* kp = Kd + (jt * 16 + (lane & 15)) * LSTR + g * 8;
                f32x4 s = {0.f, 0.f, 0.f, 0.f};
                s = __builtin_amdgcn_mfma_f32_16x16x32_bf16(*(const bf16x8*)kp, qf0, s, 0, 0, 0);
                s = __builtin_amdgcn_mfma_f32_16x16x32_bf16(*(const bf16x8*)(kp + 32), qf1, s, 0, 0, 0);
#pragma unroll
                for (int i = 0; i < 4; ++i) { const int jk = jt * 16 + 4 * g + i; const bool ok = dir ? (jk >= iq) : (jk <= iq); s[i] = ok ? s[i] : 0.f; }
                pf[jt >> 1].w[(jt & 1) * 2 + 0] = pk2(s[0], s[1]); pf[jt >> 1].w[(jt & 1) * 2 + 1] = pk2(s[2], s[3]);
            }
            const bf16_t* vp = gla_vt_ptr(VT, b, h, c) + (size_t)(lane & 15) * vld + 4 * g;
            const int bhd = bh * 2 + dir, ci = dir ? ci_b : ci_f;
            const bf16_t* sp = SB + ((size_t)bhd * NCH + ci) * 8192 + (size_t)(lane & 15) * 64 + g * 8;
#pragma unroll
            for (int dvt = 0; dvt < 8; ++dvt) {
#pragma unroll
                for (int st = 0; st < 2; ++st) {
                    U8 vf; vf.h[0] = *(const uint2*)(vp + (size_t)dvt * 16 * vld + st * 32); vf.h[1] = *(const uint2*)(vp + (size_t)dvt * 16 * vld + st * 32 + 16);
                    O[dvt] = __builtin_amdgcn_mfma_f32_16x16x32_bf16(vf.v, pf[st].v, O[dvt], 0, 0, 0);
                }
                O[dvt] = __builtin_amdgcn_mfma_f32_16x16x32_bf16(*(const bf16x8*)(sp + dvt * 16 * 64), qf0, O[dvt], 0, 0, 0);
                O[dvt] = __builtin_amdgcn_mfma_f32_16x16x32_bf16(*(const bf16x8*)(sp + dvt * 16 * 64 + 32), qf1, O[dvt], 0, 0, 0);
            }
        }
        if (dir == 1) {
#pragma unroll
            for (int dvt = 0; dvt < 8; ++dvt)
#pragma unroll
                for (int i = 0; i < 4; ++i) X[(qi * 128 + dvt * 16 + 4 * g + i) * 16 + q] = O[dvt][i];
        }
        __syncthreads();
        if (dir == 0) {
            float ss = 0.f;
#pragma unroll
            for (int dvt = 0; dvt < 8; ++dvt)
#pragma unroll
                for (int i = 0; i < 4; ++i) { O[dvt][i] += X[(qi * 128 + dvt * 16 + 4 * g + i) * 16 + q]; ss += O[dvt][i] * O[dvt][i]; }
            ss = rows_sum(ss);
            const float rs = rsqrtf(ss * (1.0f / 128.0f) + EPS);
            bf16_t* gp = G + (size_t)(rowbase + qi * 16 + q) * 512 + h * 128;
#pragma unroll
            for (int dvt = 0; dvt < 8; ++dvt) {
                const int dv = dvt * 16 + 4 * g;
                const float4 w = *(const float4*)(gnw + dv);
                const uint2 gv = *(const uint2*)(gp + dv);
                if (!p.dry) st4bf(gp + dv, O[dvt][0] * rs * w.x * lo_bf(gv.x), O[dvt][1] * rs * w.y * hi_bf(gv.x), O[dvt][2] * rs * w.z * lo_bf(gv.y), O[dvt][3] * rs * w.w * hi_bf(gv.y));
            }
        }
    }
}

constexpr int LF = 16384;
DEVI int CIDX(int p) { return p + (p >> 4); }
DEVI int FIDX(int m) { return 2 * CIDX(m >> 1) + (m & 1); }
constexpr int LFP = LF + LF / 16;
DEVI float2 cmul(float2 a, float2 b) { return make_float2(a.x * b.x - a.y * b.y, a.x * b.y + a.y * b.x); }
DEVI float2 cadd(float2 a, float2 b) { return make_float2(a.x + b.x, a.y + b.y); }
DEVI float2 csub(float2 a, float2 b) { return make_float2(a.x - b.x, a.y - b.y); }
DEVI float2 twid(float frac) { return make_float2(__builtin_amdgcn_cosf(frac), __builtin_amdgcn_sinf(frac)); }

DEVI void fft_fwd(float2* F) {
    const int tid = ltid();
#pragma unroll 1
    for (int s = LF / 2; s >= 2; s >>= 2) {
        const int h = s >> 1;
        const int lh = 31 - __clz(h);
        const float inv2s = 1.0f / (float)(2 * s);
#pragma unroll 2
        for (int qq = tid; qq < LF / 4; qq += NTHR) {
            const int blk = qq >> lh, j = qq & (h - 1);
            const int i = blk * (2 * s) + j;
            const int i0 = CIDX(i), i1 = CIDX(i + h), i2 = CIDX(i + s), i3 = CIDX(i + s + h);
            const float2 x0 = F[i0], x1 = F[i1], x2 = F[i2], x3 = F[i3];
            float2 w1 = twid((float)j * inv2s); w1.y = -w1.y;
            const float2 w2 = cmul(w1, w1);
            const float2 y0 = cadd(x0, x2), y2 = cmul(csub(x0, x2), w1);
            const float2 y1 = cadd(x1, x3); const float2 tt = csub(x1, x3);
            const float2 y3 = cmul(make_float2(tt.y, -tt.x), w1);
            F[i0] = cadd(y0, y1); F[i1] = cmul(csub(y0, y1), w2);
            F[i2] = cadd(y2, y3); F[i3] = cmul(csub(y2, y3), w2);
        }
        __syncthreads();
    }
}
DEVI void fft_inv(float2* F) {
    const int tid = ltid();
#pragma unroll 1
    for (int h = 1; h <= LF / 4; h <<= 2) {
        const int s = 2 * h;
        const int lh = 31 - __clz(h);
        const float inv2s = 1.0f / (float)(2 * s);
#pragma unroll 2
        for (int qq = tid; qq < LF / 4; qq += NTHR) {
            const int blk = qq >> lh, j = qq & (h - 1);
            const int i = blk * (2 * s) + j;
            const int i0 = CIDX(i), i1 = CIDX(i + h), i2 = CIDX(i + s), i3 = CIDX(i + s + h);
            const float2 x0 = F[i0], x1 = F[i1], x2 = F[i2], x3 = F[i3];
            const float2 w1 = twid((float)j * inv2s);
            const float2 w2 = cmul(w1, w1);
            const float2 a1 = cmul(x1, w2), a3 = cmul(x3, w2);
            const float2 u0 = cadd(x0, a1), u1 = csub(x0, a1), u2 = cadd(x2, a3), u3 = csub(x2, a3);
            const float2 b2 = cmul(u2, w1); const float2 t3 = cmul(u3, w1); const float2 b3 = make_float2(-t3.y, t3.x);
            F[i0] = cadd(u0, b2); F[i2] = csub(u0, b2); F[i1] = cadd(u1, b3); F[i3] = csub(u1, b3);
        }
        __syncthreads();
    }
}
DEVI int rev14(int k) { return (int)(__brev((unsigned)k) >> 18); }
DEVI float hy_delta(int ch) {
    const float a = -3.0701134573253946f, b = -15.350567286626973f;
    return fabsf(a + (b - a) * ((float)ch / 511.0f));
}

DEVI void conv8(const bf16_t* U, const float* cw, const float* cb, int seq0, int Lseq, int t, int col0, float* out) {
    U8 r[3];
#pragma unroll
    for (int i = 0; i < 3; ++i) {
        const int tt = t - 1 + i;
        if (tt >= 0 && tt < Lseq) r[i].u = *(const uint4*)(U + (size_t)(seq0 + tt) * 1536 + col0);
        else r[i].u = make_uint4(0, 0, 0, 0);
    }
#pragma unroll
    for (int j = 0; j < 8; ++j) {
        float a = cb[col0 + j];
#pragma unroll
        for (int i = 0; i < 3; ++i) { const float uv = (j & 1) ? hi_bf(r[i].w[j >> 1]) : lo_bf(r[i].w[j >> 1]); a += uv * cw[i * 1536 + col0 + j]; }
        out[j] = a;
    }
}
DEVI void hy_task_geom(int task, int& b, int& t0, int& ch0, int& seq0, int& Lseq, float*& zt, unsigned char* scr) {
    if (task < 4096) { b = task >> 11; t0 = ((task >> 3) & 255) * 64; ch0 = (task & 7) * 64; seq0 = b * T; Lseq = T; zt = (float*)(scr + SD_ZT) + (size_t)b * 512 * T; }
    else { const int q = task - 4096; b = q >> 5; t0 = ((q >> 3) & 3) * 64; ch0 = (q & 7) * 64; seq0 = NL + b * CL; Lseq = CL; zt = (float*)(scr + SD_ZTC) + (size_t)b * 512 * CL; }
}
DEVI void phase_hy1(const P& p, int l, float* sm) {
    unsigned char* scr = p.ws + OFF_SCR;
    const bf16_t* U = (const bf16_t*)(scr + SD_U);
    const float* cw = p.conv_w + (size_t)l * 3 * 1536; const float* cb = p.conv_b + l * 1536;
    const int tid = ltid();
    const int ntask = 4096 + (l == 0 ? 64 : 0);
    for (int task = blockIdx.x; task < ntask; task += gridDim.x) {
        int b, t0, ch0, seq0, Lseq; float* zt;
        hy_task_geom(task, b, t0, ch0, seq0, Lseq, zt, scr);
        __syncthreads();
        {
            const int tt = tid >> 3, cg = (tid & 7) * 8;
            float a1[8], a2[8];
            conv8(U, cw, cb, seq0, Lseq, t0 + tt, 512 + ch0 + cg, a1);
            conv8(U, cw, cb, seq0, Lseq, t0 + tt, 1024 + ch0 + cg, a2);
#pragma unroll
            for (int j = 0; j < 8; ++j) sm[(cg + j) * 65 + tt] = a1[j] * a2[j];
        }
        __syncthreads();
        {
            const int ch = tid >> 3, t8 = (tid & 7) * 8;
            float4 w0 = {sm[ch * 65 + t8 + 0], sm[ch * 65 + t8 + 1], sm[ch * 65 + t8 + 2], sm[ch * 65 + t8 + 3]};
            float4 w1 = {sm[ch * 65 + t8 + 4], sm[ch * 65 + t8 + 5], sm[ch * 65 + t8 + 6], sm[ch * 65 + t8 + 7]};
            float* dst = zt + (size_t)(ch0 + ch) * Lseq + t0 + t8;
            *(float4*)dst = w0; *(float4*)(dst + 4) = w1;
        }
    }
}
DEVI void phase_hy3(const P& p, int l, float* sm) {
    unsigned char* scr = p.ws + OFF_SCR;
    const bf16_t* U = (const bf16_t*)(scr + SD_U);
    bf16_t* G = (bf16_t*)(p.ws + OFF_YS + 3 * SZ512);
    const float* cw = p.conv_w + (size_t)l * 3 * 1536; const float* cb = p.conv_b + l * 1536;
    const int tid = ltid();
    const int ntask = 4096 + (l == 0 ? 64 : 0);
    for (int task = blockIdx.x; task < ntask; task += gridDim.x) {
        int b, t0, ch0, seq0, Lseq; float* zt;
        hy_task_geom(task, b, t0, ch0, seq0, Lseq, zt, scr);
        __syncthreads();
        {
            const int ch = tid >> 3, t8 = (tid & 7) * 8;
            const float* src = zt + (size_t)(ch0 + ch) * Lseq + t0 + t8;
            const float4 w0 = *(const float4*)src, w1 = *(const float4*)(src + 4);
            float* d = sm + ch * 65 + t8;
            d[0] = w0.x; d[1] = w0.y; d[2] = w0.z; d[3] = w0.w; d[4] = w1.x; d[5] = w1.y; d[6] = w1.z; d[7] = w1.w;
        }
        __syncthreads();
        {
            const int tt = tid >> 3, cg = (tid & 7) * 8;
            float a0[8];
            conv8(U, cw, cb, seq0, Lseq, t0 + tt, ch0 + cg, a0);
            bf16_t* gp = G + (size_t)(seq0 + t0 + tt) * 512 + ch0 + cg;
            U8 gv; gv.u = *(const uint4*)gp;
            float o[8];
#pragma unroll
            for (int j = 0; j < 8; ++j) { const float gg = (j & 1) ? hi_bf(gv.w[j >> 1]) : lo_bf(gv.w[j >> 1]); o[j] = a0[j] * sm[(cg + j) * 65 + tt] * gg; }
            uint4 w; w.x = pk2(o[0], o[1]); w.y = pk2(o[2], o[3]); w.z = pk2(o[4], o[5]); w.w = pk2(o[6], o[7]);
            if (!p.dry) *(uint4*)gp = w;
        }
    }
}


constexpr int HYF_MT = 64;
DEVI void phase_hyf(const P& p, int l, float* sm) {
    const int tid = ltid();
    const float* HT = (const float*)(p.ws + OFF_HH3T) + (size_t)l * 64 * T;
    const float* wout = p.fwout + (size_t)l * 64 * 1024;
    bf16_t* K2 = (bf16_t*)(p.ws + OFF_K2);
    float* L1P = (float*)(p.ws + OFF_L1P);
    float* hs = sm;
    for (int task = blockIdx.x; task < T / HYF_MT; task += gridDim.x) {
        const int m0 = task * HYF_MT;
        __syncthreads();
        for (int e = tid; e < 64 * HYF_MT / 4; e += NTHR) { const int j = e / (HYF_MT / 4), c4 = (e % (HYF_MT / 4)) * 4; *(float4*)(hs + j * HYF_MT + c4) = *(const float4*)(HT + (size_t)j * T + m0 + c4); }
        __syncthreads();
        {
            const int ch = tid;
            const float delta = hy_delta(ch);
            float l1f = 0.f, l1b = 0.f;
#pragma unroll 1
            for (int mb = 0; mb < HYF_MT; mb += 16) {
                float af[16], ab[16];
#pragma unroll
                for (int u = 0; u < 16; ++u) { af[u] = 0.f; ab[u] = 0.f; }
#pragma unroll 2
                for (int j = 0; j < 64; ++j) {
                    const float wf = wout[j * 1024 + ch], wb = wout[j * 1024 + 512 + ch];
#pragma unroll
                    for (int u4 = 0; u4 < 4; ++u4) {
                        const float4 h = *(const float4*)(hs + j * HYF_MT + mb + u4 * 4);
                        af[u4 * 4 + 0] += h.x * wf; af[u4 * 4 + 1] += h.y * wf; af[u4 * 4 + 2] += h.z * wf; af[u4 * 4 + 3] += h.w * wf;
                        ab[u4 * 4 + 0] += h.x * wb; ab[u4 * 4 + 1] += h.y * wb; ab[u4 * 4 + 2] += h.z * wb; ab[u4 * 4 + 3] += h.w * wb;
                    }
                }
#pragma unroll
                for (int u = 0; u < 16; ++u) {
                    const int m = m0 + mb + u;
                    const float dec = expf(-((float)m / (float)(T - 1)) * delta);
                    af[u] *= dec; ab[u] *= dec;
                    l1f += fabsf(af[u]); l1b += (m == 0) ? 0.f : fabsf(ab[u]);
                }
                uint4 o;
                o.x = pk2(af[0], af[1]); o.y = pk2(af[2], af[3]); o.z = pk2(af[4], af[5]); o.w = pk2(af[6], af[7]);
                *(uint4*)(K2 + (size_t)ch * T + m0 + mb) = o;
                o.x = pk2(af[8], af[9]); o.y = pk2(af[10], af[11]); o.z = pk2(af[12], af[13]); o.w = pk2(af[14], af[15]);
                *(uint4*)(K2 + (size_t)ch * T + m0 + mb + 8) = o;
                o.x = pk2(ab[0], ab[1]); o.y = pk2(ab[2], ab[3]); o.z = pk2(ab[4], ab[5]); o.w = pk2(ab[6], ab[7]);
                *(uint4*)(K2 + (size_t)(512 + ch) * T + m0 + mb) = o;
                o.x = pk2(ab[8], ab[9]); o.y = pk2(ab[10], ab[11]); o.z = pk2(ab[12], ab[13]); o.w = pk2(ab[14], ab[15]);
                *(uint4*)(K2 + (size_t)(512 + ch) * T + m0 + mb + 8) = o;
            }
            L1P[(size_t)task * 1024 + ch] = l1f;
            L1P[(size_t)task * 1024 + 512 + ch] = l1b;
        }
    }
}
DEVI void phase_hy2(const P& p, int l, unsigned char* smem) {
    unsigned char* scr = p.ws + OFF_SCR;
    const int tid = ltid();
    float* Ff = (float*)smem; float2* F2 = (float2*)smem;
    float* red = (float*)(smem + (size_t)LFP * 8);
    float* spec = red + 16;
    const float* HT = (const float*)(p.ws + OFF_HH3T) + (size_t)l * 64 * T;
    const float* HC = (const float*)(p.ws + OFF_HH3C);
    const float* wout = p.fwout + (size_t)l * 64 * 1024;
    const int ntask = 512 + (l == 0 ? 512 : 0);
    for (int task = blockIdx.x; task < ntask; task += gridDim.x) {
        __syncthreads();
        if (task < 512) {
            const int ch = task;
            const float delta = hy_delta(ch);
            float l1 = 0.f;
            {
                const bf16_t* K2 = (const bf16_t*)(p.ws + OFF_K2);
                const float* L1P = (const float*)(p.ws + OFF_L1P);
                if (tid < 2 * (T / HYF_MT)) { const int side = tid / (T / HYF_MT), tk = tid % (T / HYF_MT); l1 = L1P[(size_t)tk * 1024 + side * 512 + ch]; }
#pragma unroll
                for (int i = 0; i < 4; ++i) {
                    const int m = (tid + NTHR * i) * 8;
                    U8 hf, hb; hf.u = *(const uint4*)(K2 + (size_t)ch * T + m); hb.u = *(const uint4*)(K2 + (size_t)(512 + ch) * T + m);
#pragma unroll
                    for (int u = 0; u < 8; ++u) {
                        const float af = (u & 1) ? hi_bf(hf.w[u >> 1]) : lo_bf(hf.w[u >> 1]);
                        const float ab = (u & 1) ? hi_bf(hb.w[u >> 1]) : lo_bf(hb.w[u >> 1]);
                        const int mm = m + u;
                        Ff[FIDX(mm)] = af;
                        if (mm >= 1) Ff[FIDX(2 * T - mm)] = ab; else Ff[FIDX(T)] = 0.f;
                    }
                }
            }
            l1 = block_sum(l1, red);
            __syncthreads();
            fft_fwd(F2);
            const float scale = 1.0f / ((float)LF * l1);
            float4* KF = (float4*)(p.ws + OFF_KF) + (size_t)blockIdx.x * 8192;
#pragma unroll 2
            for (int i = 0; i < 16; ++i) {
                const int k = tid + NTHR * i;
                const float2 ck = F2[CIDX(rev14(k))], cm = F2[CIDX(rev14((LF - k) & (LF - 1)))];
                KF[k] = make_float4((ck.x + cm.x) * 0.5f * scale, (ck.y - cm.y) * 0.5f * scale, (ck.y + cm.y) * 0.5f * scale, -(ck.x - cm.x) * 0.5f * scale);
            }
            if (tid == 0) { const float2 c = F2[CIDX(1)]; spec[0] = c.x * scale; spec[1] = c.y * scale; }
            const float fb = p.fbias[l * 512 + ch];
#pragma unroll 1
            for (int b = 0; b < NB; ++b) {
                float* zt = (float*)(scr + SD_ZT) + ((size_t)b * 512 + ch) * T;
                __syncthreads();
#pragma unroll
                for (int i = 0; i < 8; ++i) {
                    const int e = (tid + NTHR * i) * 4;
                    const float4 zv = *(const float4*)(zt + e);
                    const int c0 = CIDX(e >> 1), c1 = CIDX((T + e) >> 1);
                    F2[c0] = make_float2(zv.x, zv.y); F2[c0 + 1] = make_float2(zv.z, zv.w);
                    F2[c1] = make_float2(0.f, 0.f); F2[c1 + 1] = make_float2(0.f, 0.f);
                }
                __syncthreads();
                fft_fwd(F2);
#pragma unroll 2
                for (int i = 0; i < 16; ++i) {
                    const int k = tid + NTHR * i;
                    const int pk = CIDX(rev14(k)), pm = CIDX(rev14((LF - k) & (LF - 1)));
                    const float2 ck = F2[pk], cm = F2[pm];
                    const float4 kf = KF[k];
                    const float2 He = make_float2(kf.x, kf.y), Ho = make_float2(kf.z, kf.w);
                    const float2 E = make_float2((ck.x + cm.x) * 0.5f, (ck.y - cm.y) * 0.5f);
                    const float2 O = make_float2((ck.y + cm.y) * 0.5f, -(ck.x - cm.x) * 0.5f);
                    float2 w2 = twid((float)k * (1.0f / (float)LF)); w2.y = -w2.y;
                    const float2 Ye = cadd(cmul(E, He), cmul(w2, cmul(O, Ho)));
                    const float2 Yo = cadd(cmul(E, Ho), cmul(O, He));
                    F2[pk] = make_float2(Ye.x - Yo.y, Ye.y + Yo.x);
                    F2[pm] = make_float2(Ye.x + Yo.y, -Ye.y + Yo.x);
                }
                if (tid == 0) {
                    const float2 c = F2[CIDX(1)]; const float he = spec[0], ho = spec[1];
                    F2[CIDX(1)] = make_float2(c.x * he - c.y * ho, c.x * ho + c.y * he);
                }
                __syncthreads();
                fft_inv(F2);
#pragma unroll
                for (int i = 0; i < 8; ++i) {
                    const int e = (tid + NTHR * i) * 4;
                    const float4 zv = *(const float4*)(zt + e);
                    const int c0 = CIDX(e >> 1);
                    const float2 y0 = F2[c0], y1 = F2[c0 + 1];
                    const float4 yv = make_float4(y0.x, y0.y, y1.x, y1.y);
                    if (!p.dry) *(float4*)(zt + e) = make_float4(yv.x + zv.x * fb, yv.y + zv.y * fb, yv.z + zv.z * fb, yv.w + zv.w * fb);
                }
            }
        } else {
            const int ch = task - 512;
            const float delta = hy_delta(ch);
            float* hf = Ff; float* hb = Ff + 256; float* zs = Ff + 512;
            {
                const int m = tid & 255, side = tid >> 8;
                float a = 0.f;
#pragma unroll 4
                for (int j = 0; j < 64; ++j) a += HC[j * CL + m] * wout[j * 1024 + side * 512 + ch];
                a *= expf(-((float)m / (float)(CL - 1)) * delta);
                Ff[side * 256 + m] = a;
                float l1 = (side == 1 && m == 0) ? 0.f : fabsf(a);
                zs[tid] = ((const float*)(scr + SD_ZTC))[((size_t)(tid >> 8) * 512 + ch) * CL + (tid & 255)];
                l1 = block_sum(l1, red);
                const int b = tid >> 8, t = tid & 255;
                float y = 0.f;
#pragma unroll 4
                for (int s = 0; s <= t; ++s) y += zs[b * 256 + s] * hf[t - s];
#pragma unroll 4
                for (int s = t + 1; s < CL; ++s) y += zs[b * 256 + s] * hb[s - t];
                const float fb = p.fbias[l * 512 + ch];
                if (!p.dry) ((float*)(scr + SD_ZTC))[((size_t)b * 512 + ch) * CL + t] = y / l1 + zs[tid] * fb;
            }
        }
    }
}

constexpr int NPH = 32;
#ifndef ONLY
#define ONLY -1
#endif
#define CASE(n) case n: if (ONLY < 0 || ONLY == n)
DEVI void run_phase(const P& p, int ph, unsigned char* smem) {
    if (ph == 0) { if (ONLY < 0 || ONLY == 100) phase_prep(p, (float*)smem); return; }
    if (ph == NPH - 1) { if (ONLY < 0 || ONLY == 101) phase_final(p); return; }
    const int l = (ph - 1) / 15, k = (ph - 1) % 15;
    switch (k) {
        CASE(0) phase_hl(p, l); break;
        CASE(1) phase_inproj<0>(p, l, (bf16_t*)smem); break;
        CASE(2) phase_att_a(p, l, (float*)smem); break;
        CASE(3) phase_inproj<1>(p, l, (bf16_t*)smem); break;
        CASE(4) phase_att_b(p, l); break;
        CASE(5) phase_inproj<2>(p, l, (bf16_t*)smem); break;
        CASE(6) phase_gla1(p, l, smem); break;
        CASE(7) phase_gla2(p); break;
        CASE(8) phase_gla3(p, l, smem); break;
        CASE(9) phase_inproj<3>(p, l, (bf16_t*)smem); break;
        CASE(10) { phase_hyf(p, l, (float*)smem); phase_hy1(p, l, (float*)smem); } break;
        CASE(11) phase_hy2(p, l, smem); break;
        CASE(12) phase_hy3(p, l, (float*)smem); break;
        CASE(13) phase_merge(p, l, (bf16_t*)smem); break;
        CASE(14) phase_out(p, l, (bf16_t*)smem); break;
    }
}

#define XB_TMO      128
#define XB_XCNT(j)  (256  + 64 * (j))
#define XB_XSUB(j)  (1280 + 64 * (j))
#define XB_XGEN(j)  (2304 + 64 * (j))
#define XB_TOP      3328
#define XB_TOPGEN   3392
#define XCD_BAR_WORDS 3456
#define XB_SPIN_CAP (1u << 18)
#define LAS __attribute__((address_space(3)))
DEVI unsigned xb_ld(unsigned* p)              { return __hip_atomic_load(p, __ATOMIC_RELAXED, __HIP_MEMORY_SCOPE_AGENT); }
DEVI unsigned xb_add(unsigned* p, unsigned v) { return __hip_atomic_fetch_add(p, v, __ATOMIC_RELAXED, __HIP_MEMORY_SCOPE_AGENT); }
DEVI unsigned xb_xcc_id() { return (unsigned)__builtin_amdgcn_s_getreg((3 << 11) | 20) & 0xFu; }
#define XB_SPIN(cond, bar) do { unsigned _sp = 0; while (cond) { __builtin_amdgcn_s_sleep(1); \
    if ((++_sp & 255u) == 0u) { if (xb_ld(&(bar)[XB_TMO])) break; if (_sp > XB_SPIN_CAP) { atomicAdd(&(bar)[XB_TMO], 1u); break; } } } } while (0)
struct XcdBarrier { unsigned* bar; unsigned x; volatile LAS unsigned* st; };
DEVI XcdBarrier xcd_barrier_post(unsigned* bar, volatile LAS unsigned* st) {
    XcdBarrier b; b.bar = bar; b.x = xb_xcc_id(); b.st = st;
    if (threadIdx.x == 0) (void)xb_add(&bar[XB_XCNT(b.x)], 1u);
    return b;
}
DEVI void xcd_barrier_complete(unsigned* bar, unsigned x, unsigned& nloc, unsigned& nx) {
    const unsigned G = gridDim.x * gridDim.y * gridDim.z;
    unsigned sum, cnt, mine, sp = 0u;
    for (;;) {
        sum = 0u; cnt = 0u; mine = 0u;
#pragma unroll
        for (unsigned j = 0; j < 16; ++j) { const unsigned c = xb_ld(&bar[XB_XCNT(j)]); sum += c; cnt += (c > 0u) ? 1u : 0u; mine = (j == x) ? c : mine; }
        if (sum == G) break;
        __builtin_amdgcn_s_sleep(1);
        if ((++sp & 255u) == 0u) { if (xb_ld(&bar[XB_TMO])) break; if (sp > XB_SPIN_CAP) { atomicAdd(&bar[XB_TMO], 1u); break; } }
    }
    nloc = mine > 0u ? mine : 1u; nx = cnt > 0u ? cnt : 1u;
}
DEVI void xcd_barrier(const XcdBarrier& b) {
    asm volatile("s_waitcnt vmcnt(0)" ::: "memory");
    __syncthreads();
    if (threadIdx.x == 0) {
        unsigned* bar = b.bar;
        __builtin_amdgcn_s_waitcnt(0);
        unsigned nloc = b.st[0], nx = b.st[1];
        if (nloc == 0u) { xcd_barrier_complete(bar, b.x, nloc, nx); b.st[0] = nloc; b.st[1] = nx; }
        const unsigned old = xb_add(&bar[XB_XSUB(b.x)], 1u);
        const unsigned gen = old / nloc;
        if (old + 1u == (gen + 1u) * nloc) {
            __builtin_amdgcn_fence(__ATOMIC_RELEASE, "agent");
            asm volatile("s_waitcnt vmcnt(0)" ::: "memory");
            const unsigned og = xb_add(&bar[XB_TOP], 1u);
            const unsigned tg = og / nx;
            if (og + 1u == (tg + 1u) * nx) xb_add(&bar[XB_TOPGEN], 1u);
            else XB_SPIN(xb_ld(&bar[XB_TOPGEN]) == tg, bar);
            __builtin_amdgcn_fence(__ATOMIC_ACQUIRE, "agent");
            xb_add(&bar[XB_XGEN(b.x)], 1u);
            asm volatile("s_waitcnt vmcnt(0)" ::: "memory");
        } else {
            XB_SPIN(xb_ld(&bar[XB_XGEN(b.x)]) == gen, bar);
            __builtin_amdgcn_fence(__ATOMIC_ACQUIRE, "agent");
            asm volatile("s_waitcnt vmcnt(0)" ::: "memory");
        }
    }
    __syncthreads();
}
constexpr size_t OFF_BAR = WS_END + 1024;
constexpr size_t WS_TOTAL = OFF_BAR + XCD_BAR_WORDS * 4;

__global__ void __launch_bounds__(NTHR) mega(P p) {
    extern __shared__ __attribute__((aligned(16))) unsigned char smem[];
    cg::grid_group grid = cg::this_grid();
#ifndef DBL_MASK
#define DBL_MASK 0
#endif
#ifdef TIMING_A
    unsigned long long* ts = (unsigned long long*)(p.ws + WS_END);
    if (blockIdx.x == 0 && threadIdx.x == 0) ts[0] = __builtin_amdgcn_s_memrealtime();
#endif
    volatile LAS unsigned* xst = (volatile LAS unsigned*)(smem + LDS_BYTES - 16);
    if (threadIdx.x == 0) { xst[0] = 0u; xst[1] = 0u; }
    __syncthreads();
    XcdBarrier xb = xcd_barrier_post((unsigned*)(p.ws + OFF_BAR), xst);
#define GRID_SYNC(ph_) do { if ((ph_) == 0) grid.sync(); else xcd_barrier(xb); } while (0)
    for (int ph = p.ph_lo; ph < p.ph_hi; ++ph) {
        if (DBL_MASK != 0 && ph > 0 && ph < NPH - 1 && ((DBL_MASK >> ((ph - 1) % 15)) & 1)) { P pd = p; int one_ = 1; asm volatile("" : "+s"(one_)); pd.dry = one_; run_phase(pd, ph, smem); GRID_SYNC(1); }
        run_phase(p, ph, smem);
#ifdef TIMING_A
        GRID_SYNC(ph);
        if (blockIdx.x == 0 && threadIdx.x == 0) ts[ph + 1] = __builtin_amdgcn_s_memrealtime();
#else
        if (ph + 1 < p.ph_hi) GRID_SYNC(ph);
#endif
    }
}

#ifdef DIAG_OFF
__global__ void diag_dump(const unsigned char* src, float* out, size_t n) {
    for (size_t i = (size_t)blockIdx.x * blockDim.x + threadIdx.x; i < n; i += (size_t)gridDim.x * blockDim.x) {
#if DIAG_F32
        out[i] = ((const float*)src)[i % (size_t)(DIAG_N)];
#else
        { float v = bf2f(((const bf16_t*)src)[i % (size_t)(DIAG_N)]);
#ifdef EXP_FIN
          if (!(fabsf(v) < 1e30f)) v = 12345.f;
#endif
          out[i] = v; }
#endif
    }
}
#endif
#ifdef TIMING_A
__global__ void timing_tail(const unsigned long long* ts, float* out) {
    float grp[8] = {0, 0, 0, 0, 0, 0, 0, 0};
    const float total = (float)(ts[NPH] - ts[0]);
    for (int ph = 0; ph < NPH; ++ph) {
        const float dt = (float)(ts[ph + 1] - ts[ph]);
        int gi;
        if (ph == 0) gi = 5; else if (ph == NPH - 1) gi = 6;
        else { const int k = (ph - 1) % 15; gi = (k == 1 || k == 3 || k == 5 || k == 9) ? 0 : (k == 13) ? 1 : (k == 2 || k == 4) ? 2 : (k >= 6 && k <= 8) ? 3 : (k >= 10 && k <= 12) ? 4 : (k == 14) ? 7 : 6; }
#pragma unroll
        for (int q = 0; q < 8; ++q) grp[q] += (gi == q) ? dt : 0.f;
    }
    float fa = 0.f, fb = 0.f;
#pragma unroll
    for (int q = 0; q < 8; ++q) { fa += (q == TIMING_A) ? grp[q] : 0.f; fb += (q == TIMING_B) ? grp[q] : 0.f; }
    const float e1 = 1000.f * fa / total, e2 = 50.f * fb / total;
    if (blockIdx.x == 0 && threadIdx.x == 0) out[0] += e1;
    for (size_t i = (size_t)blockIdx.x * blockDim.x + threadIdx.x; i < (size_t)1048576; i += (size_t)gridDim.x * blockDim.x) out[D + i] += e2;
}
#endif
extern "C" void kernel_launch(void* const* d_in, const int* in_sizes, int n_in, void* d_out, int out_size, void* d_ws, size_t ws_size, hipStream_t stream) {
    static int grid = 0;
    if (grid == 0) {
        if (n_in != 27 || ws_size < WS_TOTAL) { fprintf(stderr, "kernel_launch: unexpected n_in %d or ws_size %zu (need %zu)\n", n_in, ws_size, (size_t)WS_TOTAL); grid = -1; return; }
        int dev = 0, cus = 0, per_cu = 0;
        hipGetDevice(&dev);
        hipDeviceGetAttribute(&cus, hipDeviceAttributeMultiprocessorCount, dev);
        if (hipFuncSetAttribute((const void*)mega, hipFuncAttributeMaxDynamicSharedMemorySize, LDS_BYTES) != hipSuccess) { fprintf(stderr, "kernel_launch: hipFuncSetAttribute failed\n"); grid = -1; return; }
        if (hipOccupancyMaxActiveBlocksPerMultiprocessor(&per_cu, (const void*)mega, NTHR, LDS_BYTES) != hipSuccess || per_cu < 1) { fprintf(stderr, "kernel_launch: occupancy query failed (%d)\n", per_cu); grid = -1; return; }
        grid = cus * per_cu; if (grid > MAXGRID) grid = MAXGRID;
        fprintf(stderr, "kernel_launch: grid %d (cus %d x %d)\n", grid, cus, per_cu);
    }
    if (grid < 0) return;
    P p{};
    const float** pp = (const float**)&p;
    for (int i = 0; i < 27; ++i) pp[i] = (const float*)d_in[i];
    p.out = (float*)d_out; p.ws = (unsigned char*)d_ws; p.dry = 0; p.pad_ = 0;
#if N_LAUNCH_MODE == 1
    p.ph_lo = 0; p.ph_hi = NPH;
    if (hipMemsetAsync((unsigned char*)d_ws + OFF_BAR, 0, XCD_BAR_WORDS * 4, stream) != hipSuccess) { fprintf(stderr, "kernel_launch: memset of barrier words failed\n"); return; }
    void* args[] = {&p};
    hipError_t e = hipLaunchCooperativeKernel((const void*)mega, dim3(grid), dim3(NTHR), args, LDS_BYTES, stream);
    if (e != hipSuccess) fprintf(stderr, "cooperative launch failed: %s (grid %d)\n", hipGetErrorString(e), grid);
#ifdef TIMING_A
    hipLaunchKernelGGL(timing_tail, dim3(256), dim3(256), 0, stream, (const unsigned long long*)((unsigned char*)d_ws + WS_END), (float*)d_out);
#endif
#else
#ifndef DIAG_STOP
#define DIAG_STOP NPH
#endif
    for (int ph = 0; ph < DIAG_STOP; ++ph) {
        p.ph_lo = ph; p.ph_hi = ph + 1;
        hipLaunchKernelGGL(mega, dim3(grid), dim3(NTHR), LDS_BYTES, stream, p);
    }
#ifdef DIAG_OFF
    hipLaunchKernelGGL(diag_dump, dim3(1024), dim3(256), 0, stream, (const unsigned char*)d_ws + (size_t)(DIAG_OFF), (float*)d_out, (size_t)out_size);
#endif
#endif
}
```

```cpp
#include <hip/hip_runtime.h>
#include <hip/hip_cooperative_groups.h>
#include <cstdio>
#include <cstdint>
namespace cg = cooperative_groups;

#ifndef N_LAUNCH_MODE
#define N_LAUNCH_MODE 1
#endif

#define DEVI __device__ __forceinline__
typedef unsigned short bf16_t;
typedef short bf16x8 __attribute__((ext_vector_type(8)));
typedef float f32x4 __attribute__((ext_vector_type(4)));
typedef float f32x16 __attribute__((ext_vector_type(16)));

constexpr int D = 1024, T = 16384, NB = 2, NL = NB * T, CL = 256, NC = NB * CL, NR = NL + NC;
constexpr int IN_TOTAL = 11040;
constexpr int COL_A = 0, COL_B = 2048, COL_C = 3328, COL_D = 4896, COL_GM = 6944;
constexpr float EPS = 1e-6f;
constexpr int NTHR = 512;
constexpr int LDS_BYTES = 140 * 1024;

constexpr size_t al256(size_t x) { return (x + 255) & ~(size_t)255; }
constexpr size_t OFF_MOD = 0;
constexpr size_t OFF_ROPE = al256(OFF_MOD + (size_t)2 * 3 * 3072 * 4);
constexpr size_t OFF_HH3T = al256(OFF_ROPE + (size_t)2 * T * 32 * 4);
constexpr size_t OFF_HH3C = al256(OFF_HH3T + (size_t)2 * 64 * T * 4);
constexpr size_t OFF_XC1 = al256(OFF_HH3C + (size_t)64 * CL * 4);
constexpr size_t OFF_WINT = al256(OFF_XC1 + (size_t)NC * D * 4);
constexpr size_t OFF_WBT = al256(OFF_WINT + (size_t)2 * IN_TOTAL * D * 2);
constexpr size_t OFF_WOT = al256(OFF_WBT + (size_t)2 * 4 * D * 512 * 2);
constexpr size_t OFF_HL = al256(OFF_WOT + (size_t)2 * D * D * 2);
constexpr size_t OFF_YS = al256(OFF_HL + (size_t)NR * D * 2);
constexpr size_t SZ512 = (size_t)NR * 512 * 2, SZ256 = (size_t)NR * 256 * 2, SZ128 = (size_t)NR * 128 * 2;
constexpr size_t OFF_SCR = al256(OFF_YS + 4 * SZ512);
constexpr size_t SA_Q = 0, SA_K = SZ512, SA_VT = 2 * SZ512;
constexpr size_t SB_Q = 0, SB_K = SZ512, SB_VT = SZ512 + SZ128;
constexpr size_t SC_Q = 0, SC_K = SZ256, SC_VT = 2 * SZ256, SC_LR = 2 * SZ256 + SZ512;
constexpr size_t SC_SB = al256(SC_LR + (size_t)NR * 32 * 4);
constexpr int NCH = 260;
constexpr size_t SC_GD = al256(SC_SB + (size_t)16 * NCH * 8192 * 2);
constexpr size_t SD_U = 0, SD_ZT = al256((size_t)NR * 1536 * 2), SD_ZTC = al256(SD_ZT + (size_t)NB * 512 * T * 4);
constexpr size_t SD_END = al256(SD_ZTC + (size_t)NB * 512 * CL * 4);
constexpr size_t OFF_KF = OFF_SCR + SD_END;
constexpr int MAXGRID = 256;
constexpr size_t OFF_K2 = al256(OFF_KF + (size_t)MAXGRID * 8192 * 16);
constexpr size_t OFF_L1P = al256(OFF_K2 + (size_t)1024 * T * 2);
constexpr size_t WS_END = al256(OFF_L1P + (size_t)(T / 64) * 1024 * 4);

struct P {
    const float *x, *c, *ctx, *c_ctx, *norm_w, *w_mod, *b_mod, *w_in, *rpb, *sink, *w_alpha_up, *b_alpha, *gla_norm_w,
        *conv_w, *conv_b, *fw1, *fb1, *fw2, *fb2, *fw3, *fb3, *ffreq, *fwout, *fbias, *w_branch, *w_out, *final_norm_w;
    float* out;
    unsigned char* ws;
    int ph_lo, ph_hi;
    int dry, pad_;
};

DEVI int ltid() { int t = threadIdx.x; asm volatile("" : "+v"(t)); return t; }
DEVI float bf2f(bf16_t v) { return __uint_as_float(((unsigned)v) << 16); }
typedef __bf16 bf16v2 __attribute__((ext_vector_type(2)));
typedef float f32v2 __attribute__((ext_vector_type(2)));
DEVI unsigned pk2(float lo, float hi) { f32v2 v = {lo, hi}; bf16v2 b = __builtin_convertvector(v, bf16v2); return __builtin_bit_cast(unsigned, b); }
DEVI bf16_t f2bf(float f) { return (bf16_t)(pk2(f, 0.f) & 0xffff); }
DEVI float lo_bf(unsigned u) { return __uint_as_float(u << 16); }
DEVI float hi_bf(unsigned u) { return __uint_as_float(u & 0xffff0000u); }
DEVI float siluf(float v) { return v / (1.f + __expf(-v)); }
DEVI float sigmf(float v) { return 1.f / (1.f + __expf(-v)); }
DEVI void row_decode(int row, int& b, int& t, bool& isctx) {
    if (row < NL) { b = row >> 14; t = row & (T - 1); isctx = false; }
    else { int r = row - NL; b = r >> 8; t = r & (CL - 1); isctx = true; }
}
DEVI float wave_sum(float v) {
#pragma unroll
    for (int o = 32; o >= 1; o >>= 1) v += __shfl_xor(v, o);
    return v;
}
DEVI float block_sum(float v, float* red  ) {
    v = wave_sum(v);
    __syncthreads();
    if ((ltid() & 63) == 0) red[ltid() >> 6] = v;
    __syncthreads();
    float s = 0.f;
#pragma unroll
    for (int i = 0; i < NTHR / 64; ++i) s += red[i];
    return s;
}

constexpr int LSTR = 72;
constexpr int GA_EL = 256 * LSTR, GB_EL = 128 * LSTR;
template <int NT> struct GAcc { f32x16 a[2][NT]; };

template <int NT, int DEPTH = 1>
DEVI void gemm_kloop(const bf16_t* __restrict__ A, int lda, const bf16_t* __restrict__ Bt, int ldb, int K, int m0, int n0,
                     bf16_t* sm, GAcc<NT>& acc) {
    const int tid = ltid(), lane = tid & 63, wave = tid >> 6, wm = wave >> 1, wn = wave & 1;
    const int lr = tid >> 3, lc = tid & 7;
    const char* Ab = (const char*)(A + (size_t)m0 * lda); const char* Bb = (const char*)(Bt + (size_t)n0 * ldb);
    const unsigned aoff = (unsigned)(lr * lda + lc * 8) * 2u, boff = (unsigned)(lr * ldb + lc * 8) * 2u;
    uint4 xa0, xa1, xa2, xa3, xb0, xb1 = {0, 0, 0, 0};
    uint4 ya0, ya1, ya2, ya3, yb0, yb1 = {0, 0, 0, 0};
    const int KT = K / 64;
    const int frow = lane & 31, fk = (lane >> 5) * 8;
    const unsigned sa64 = 128u * (unsigned)lda, sb64 = 128u * (unsigned)ldb;
#define GLOAD(P, KTI) { const unsigned ko_ = (unsigned)(KTI) * 128u; P##a0 = *(const uint4*)(Ab + (aoff + ko_)); P##a1 = *(const uint4*)(Ab + (aoff + sa64 + ko_)); P##a2 = *(const uint4*)(Ab + (aoff + 2 * sa64 + ko_)); \
                        P##a3 = *(const uint4*)(Ab + (aoff + 3 * sa64 + ko_)); P##b0 = *(const uint4*)(Bb + (boff + ko_)); if constexpr (NT > 1) P##b1 = *(const uint4*)(Bb + (boff + sb64 + ko_)); }
#define LWRITE(P, BUF) { bf16_t* wa_ = sm + (BUF) * (GA_EL + GB_EL) + lr * LSTR + lc * 8; bf16_t* wb_ = wa_ + GA_EL; \
                        *(uint4*)(wa_) = P##a0; *(uint4*)(wa_ + 64 * LSTR) = P##a1; *(uint4*)(wa_ + 128 * LSTR) = P##a2; *(uint4*)(wa_ + 192 * LSTR) = P##a3; \
                        *(uint4*)(wb_) = P##b0; if constexpr (NT > 1) *(uint4*)(wb_ + 64 * LSTR) = P##b1; }
    auto compute = [&](int buf) {
        const bf16_t* sa = sm + buf * (GA_EL + GB_EL) + (wm * 64 + frow) * LSTR + fk;
        const bf16_t* sb = sm + buf * (GA_EL + GB_EL) + GA_EL + (wn * 32 * NT + frow) * LSTR + fk;
#pragma unroll
        for (int ks = 0; ks < 4; ++ks) {
            bf16x8 tf[2], cf[NT];
#pragma unroll
            for (int mt = 0; mt < 2; ++mt) tf[mt] = *(const bf16x8*)(sa + mt * 32 * LSTR + ks * 16);
#pragma unroll
            for (int nt = 0; nt < NT; ++nt) cf[nt] = *(const bf16x8*)(sb + nt * 32 * LSTR + ks * 16);
#pragma unroll
            for (int mt = 0; mt < 2; ++mt)
#pragma unroll
                for (int nt = 0; nt < NT; ++nt)
                    acc.a[mt][nt] = __builtin_amdgcn_mfma_f32_32x32x16_bf16(cf[nt], tf[mt], acc.a[mt][nt], 0, 0, 0);
        }
    };
    __syncthreads();
    if constexpr (DEPTH == 1) {
        GLOAD(x, 0); LWRITE(x, 0); GLOAD(x, 1);
        __syncthreads();
        for (int kt = 0; kt < KT; ++kt) {
            if (kt + 1 < KT) LWRITE(x, (kt + 1) & 1);
            if (kt + 2 < KT) GLOAD(x, kt + 2);
            compute(kt & 1);
            __syncthreads();
        }
    } else {
        GLOAD(x, 0); LWRITE(x, 0); GLOAD(x, 1); GLOAD(y, 2);
        __syncthreads();
        for (int kt = 0; kt < KT; kt += 2) {
            LWRITE(x, 1);
            if (kt + 3 < KT) GLOAD(x, kt + 3);
            compute(0);
            __syncthreads();
            if (kt + 2 < KT) LWRITE(y, 0);
            if (kt + 4 < KT) GLOAD(y, kt + 4);
            compute(1);
            __syncthreads();
        }
    }
#undef GLOAD
#undef LWRITE
}
DEVI int tile_of(int it) {
    const int per = gridDim.x >> 3;
    if ((gridDim.x & 7) != 0 || per == 0) return it * gridDim.x + blockIdx.x;
    return it * gridDim.x + (blockIdx.x & 7) * per + (blockIdx.x >> 3);
}
template <int NT> DEVI void acc_zero(GAcc<NT>& acc) {
#pragma unroll
    for (int mt = 0; mt < 2; ++mt)
#pragma unroll
        for (int nt = 0; nt < NT; ++nt)
#pragma unroll
            for (int i = 0; i < 16; ++i) acc.a[mt][nt][i] = 0.f;
}
template <int NT, class F> DEVI void acc_foreach(const GAcc<NT>& acc, int m0, int n0, F f) {
    const int lane = ltid() & 63, wave = ltid() >> 6, wm = wave >> 1, wn = wave & 1;
#pragma unroll
    for (int mt = 0; mt < 2; ++mt) {
        const int row = m0 + wm * 64 + mt * 32 + (lane & 31);
#pragma unroll
        for (int nt = 0; nt < NT; ++nt)
#pragma unroll
            for (int q = 0; q < 4; ++q) {
                const int col = n0 + wn * 32 * NT + nt * 32 + q * 8 + (lane >> 5) * 4;
                f(row, col, acc.a[mt][nt][q * 4 + 0], acc.a[mt][nt][q * 4 + 1], acc.a[mt][nt][q * 4 + 2], acc.a[mt][nt][q * 4 + 3]);
            }
    }
}
constexpr int EST = 68;
template <int NT> DEVI void epi_stage(const GAcc<NT>& acc, int mt, float* reg) {
    const int lane = ltid() & 63;
    __syncthreads();
#pragma unroll
    for (int nt = 0; nt < NT; ++nt)
#pragma unroll
        for (int q = 0; q < 4; ++q) {
            float4 w = {acc.a[mt][nt][q * 4 + 0], acc.a[mt][nt][q * 4 + 1], acc.a[mt][nt][q * 4 + 2], acc.a[mt][nt][q * 4 + 3]};
            *(float4*)(reg + (lane & 31) * EST + nt * 32 + q * 8 + (lane >> 5) * 4) = w;
        }
    __syncthreads();
}
template <int NT, class F> DEVI void epi_rows8(const float* reg, F f) {
    const int lane = ltid() & 63;
#pragma unroll
    for (int it = 0; it < 2 * NT; ++it) {
        const int idx = it * 64 + lane, rl = idx / (NT * 4), ch = idx % (NT * 4);
        const float4 a = *(const float4*)(reg + rl * EST + ch * 8), b = *(const float4*)(reg + rl * EST + ch * 8 + 4);
        f(rl, ch * 8, a, b);
    }
}
DEVI void st8bf(bf16_t* p, float4 a, float4 b) { uint4 w; w.x = pk2(a.x, a.y); w.y = pk2(a.z, a.w); w.z = pk2(b.x, b.y); w.w = pk2(b.z, b.w); *(uint4*)p = w; }
DEVI float4 silu4(float4 a) { return make_float4(siluf(a.x), siluf(a.y), siluf(a.z), siluf(a.w)); }
template <int H, int DH> DEVI void epi_vt(const float* reg, bf16_t* VT, int row0  , int colv0) {
    const int lane = ltid() & 63;
    int b, t; bool ic; row_decode(row0, b, t, ic);
    const int tp = lane & 15, cg = lane >> 4;
#pragma unroll 4
    for (int it = 0; it < 16; ++it) {
        const int c = it * 4 + cg, colv = colv0 + c, h = colv / DH, d = colv % DH;
        const float v0 = reg[(2 * tp) * EST + c], v1 = reg[(2 * tp + 1) * EST + c];
        bf16_t* pp = ic ? (VT + (size_t)NB * H * DH * T + ((size_t)(b * H + h) * DH + d) * CL + t + 2 * tp) : (VT + ((size_t)(b * H + h) * DH + d) * T + t + 2 * tp);
        *(unsigned*)pp = pk2(v0, v1);
    }
}
DEVI void st4bf(bf16_t* p, float a, float b, float c, float d) { uint2 w; w.x = pk2(a, b); w.y = pk2(c, d); *(uint2*)p = w; }
template <int H, int DH> DEVI void store_vt(bf16_t* VT, int row, int colv, float v0, float v1, float v2, float v3) {
    int b, t; bool ic; row_decode(row, b, t, ic);
    const int h = colv / DH, d = colv % DH;
    bf16_t* p = ic ? (VT + (size_t)NB * H * DH * T + ((size_t)(b * H + h) * DH + d) * CL + t) : (VT + ((size_t)(b * H + h) * DH + d) * T + t);
    const size_t st = ic ? CL : T;
    p[0] = f2bf(v0); p[st] = f2bf(v1); p[2 * st] = f2bf(v2); p[3 * st] = f2bf(v3);
}

template <int BR>
DEVI void phase_inproj(const P& p, int l, bf16_t* sm) {
    unsigned char* ws = p.ws;
    const bf16_t* HL = (const bf16_t*)(ws + OFF_HL);
    constexpr int colbase = BR == 0 ? COL_A : BR == 1 ? COL_B : BR == 2 ? COL_C : COL_D;
    constexpr int N = BR == 0 ? 2048 : BR == 1 ? 1280 : BR == 2 ? 1568 : 2048;
    const bf16_t* Wt = (const bf16_t*)(ws + OFF_WINT) + ((size_t)l * IN_TOTAL + colbase) * D;
    unsigned char* scr = ws + OFF_SCR;
    bf16_t* YSb = (bf16_t*)(ws + OFF_YS + BR * SZ512);
    const float* rope = (const float*)(ws + OFF_ROPE);
    constexpr int tilesN = (N + 127) / 128, tilesM = NR / 256;
    for (int it = 0;; ++it) {
        const int tile = tile_of(it);
        if (it * (int)gridDim.x >= tilesM * tilesN) break;
        if (tile >= tilesM * tilesN) continue;
        const int tm = tile / tilesN, tn = tile % tilesN;
        const int m0 = tm * 256, n0 = tn * 128;
        GAcc<2> acc; acc_zero(acc);
        gemm_kloop<2, 1>(HL, D, Wt, D, D, m0, n0, sm, acc);
        const int lane = ltid() & 63, wave = ltid() >> 6, wm = wave >> 1, wn = wave & 1;
        float* reg = (float*)sm + wave * (32 * EST);
        const int cb = n0 + wn * 64;
#pragma unroll
        for (int mt = 0; mt < 2; ++mt) {
            epi_stage<2>(acc, mt, reg);
            const int rbase = m0 + wm * 64 + mt * 32;
            if constexpr (BR == 0) {
                bf16_t* Q = (bf16_t*)(scr + SA_Q); bf16_t* Kb = (bf16_t*)(scr + SA_K); bf16_t* VT = (bf16_t*)(scr + SA_VT);
                const int seg = cb >> 9, cc0 = cb & 511;
                if (seg == 2) epi_vt<8, 64>(reg, VT, rbase, cc0);
                else epi_rows8<2>(reg, [&](int rl, int cl, float4 a, float4 b) {
                    const size_t o = (size_t)(rbase + rl) * 512 + cc0 + cl;
                    if (seg == 0) st8bf(Q + o, a, b); else if (seg == 1) st8bf(Kb + o, a, b); else st8bf(YSb + o, silu4(a), silu4(b));
                });
            } else if constexpr (BR == 1) {
                bf16_t* Q = (bf16_t*)(scr + SB_Q); bf16_t* Kb = (bf16_t*)(scr + SB_K); bf16_t* VT = (bf16_t*)(scr + SB_VT);
                if (cb >= 640 && cb < 768) epi_vt<2, 64>(reg, VT, rbase, cb - 640);
                else epi_rows8<2>(reg, [&](int rl, int cl, float4 a, float4 b) {
                    const int row = rbase + rl;
                    if (cb < 640) {
                        if (row < NL) {
                            const float4 pa = *(const float4*)(reg + rl * EST + (cl ^ 32)), pb = *(const float4*)(reg + rl * EST + (cl ^ 32) + 4);
                            const int t = row & (T - 1), c = cl & 31;
                            const float4 c0 = *(const float4*)(rope + (size_t)t * 32 + c), c1 = *(const float4*)(rope + (size_t)t * 32 + c + 4);
                            const float4 s0 = *(const float4*)(rope + (size_t)T * 32 + (size_t)t * 32 + c), s1 = *(const float4*)(rope + (size_t)T * 32 + (size_t)t * 32 + c + 4);
                            if (cl < 32) {
                                a = make_float4(a.x * c0.x - pa.x * s0.x, a.y * c0.y - pa.y * s0.y, a.z * c0.z - pa.z * s0.z, a.w * c0.w - pa.w * s0.w);
                                b = make_float4(b.x * c1.x - pb.x * s1.x, b.y * c1.y - pb.y * s1.y, b.z * c1.z - pb.z * s1.z, b.w * c1.w - pb.w * s1.w);
                            } else {
                                a = make_float4(pa.x * s0.x + a.x * c0.x, pa.y * s0.y + a.y * c0.y, pa.z * s0.z + a.z * c0.z, pa.w * s0.w + a.w * c0.w);
                                b = make_float4(pb.x * s1.x + b.x * c1.x, pb.y * s1.y + b.y * c1.y, pb.z * s1.z + b.z * c1.z, pb.w * s1.w + b.w * c1.w);
                            }
                        }
                        if (cb < 512) st8bf(Q + (size_t)row * 512 + cb + cl, a, b);
                        else st8bf(Kb + (size_t)row * 128 + (cb - 512) + cl, a, b);
                    } else st8bf(YSb + (size_t)row * 512 + (cb - 768) + cl, silu4(a), silu4(b));
                });
            } else if constexpr (BR == 2) {
                bf16_t* Q = (bf16_t*)(scr + SC_Q); bf16_t* Kb = (bf16_t*)(scr + SC_K); bf16_t* VT = (bf16_t*)(scr + SC_VT);
                float* LR = (float*)(scr + SC_LR);
                if (cb >= 512 && cb < 1024) epi_vt<4, 128>(reg, VT, rbase, cb - 512);
                else epi_rows8<2>(reg, [&](int rl, int cl, float4 a, float4 b) {
                    const int row = rbase + rl, col = cb + cl;
                    if (col < 256) { const float sc = 0.125f; st8bf(Q + (size_t)row * 256 + col, make_float4(a.x * sc, a.y * sc, a.z * sc, a.w * sc), make_float4(b.x * sc, b.y * sc, b.z * sc, b.w * sc)); }
                    else if (col < 512) st8bf(Kb + (size_t)row * 256 + (col - 256), a, b);
                    else if (col < 1056) { *(float4*)(LR + (size_t)row * 32 + (col - 1024)) = a; *(float4*)(LR + (size_t)row * 32 + (col - 1024) + 4) = b; }
                    else if (col < 1568) st8bf(YSb + (size_t)row * 512 + (col - 1056), silu4(a), silu4(b));
                });
            } else {
                bf16_t* U = (bf16_t*)(scr + SD_U);
                epi_rows8<2>(reg, [&](int rl, int cl, float4 a, float4 b) {
                    const int row = rbase + rl, col = cb + cl;
                    if (col < 1536) st8bf(U + (size_t)row * 1536 + col, a, b);
                    else st8bf(YSb + (size_t)row * 512 + (col - 1536), silu4(a), silu4(b));
                });
            }
        }
    }
}

DEVI void phase_merge(const P& p, int l, bf16_t* sm) {
    unsigned char* ws = p.ws;
    const bf16_t* HL = (const bf16_t*)(ws + OFF_HL);
    const bf16_t* Wgm = (const bf16_t*)(ws + OFF_WINT) + ((size_t)l * IN_TOTAL + COL_GM) * D;
    const bf16_t* Wb = (const bf16_t*)(ws + OFF_WBT) + (size_t)l * 4 * D * 512;
    bf16_t* ACCM = (bf16_t*)(ws + OFF_SCR);
    const int M = (l == 0) ? NR : NL;
    const int tilesM = M / 256, tilesN = D / 128;
    for (int it = 0;; ++it) {
        const int tile = tile_of(it);
        if (it * (int)gridDim.x >= tilesM * tilesN) break;
        if (tile >= tilesM * tilesN) continue;
        const int tm = tile / tilesN, tn = tile % tilesN;
        const int m0 = tm * 256, n0 = tn * 128;
        GAcc<2> tot; acc_zero(tot);
        unsigned totp[2][2][8];
#pragma unroll
        for (int mt = 0; mt < 2; ++mt)
#pragma unroll
            for (int nt = 0; nt < 2; ++nt)
#pragma unroll
                for (int e = 0; e < 8; ++e) totp[mt][nt][e] = 0u;
#pragma unroll 1
        for (int i = 0; i < 4; ++i) {
#ifdef TIMING_A
            gemm_kloop<2>((const bf16_t*)(ws + OFF_YS + i * SZ512), 512, Wb + (size_t)i * D * 512, 512, 512, m0, n0, sm, tot);
            GAcc<2> g; acc_zero(g);
            gemm_kloop<2>(HL, D, Wgm + (size_t)i * D * D, D, D, m0, n0, sm, g);
#pragma unroll
            for (int mt = 0; mt < 2; ++mt)
#pragma unroll
                for (int nt = 0; nt < 2; ++nt)
#pragma unroll
                    for (int e = 0; e < 16; ++e) tot.a[mt][nt][e] += sigmf(g.a[mt][nt][e]);
        }
#else
            unsigned pp[2][2][8];
            {
                GAcc<2> pr; acc_zero(pr);
                gemm_kloop<2>((const bf16_t*)(ws + OFF_YS + i * SZ512), 512, Wb + (size_t)i * D * 512, 512, 512, m0, n0, sm, pr);
#pragma unroll
                for (int mt = 0; mt < 2; ++mt)
#pragma unroll
                    for (int nt = 0; nt < 2; ++nt)
#pragma unroll
                        for (int e = 0; e < 8; ++e) pp[mt][nt][e] = pk2(pr.a[mt][nt][2 * e], pr.a[mt][nt][2 * e + 1]);
            }
            GAcc<2> g; acc_zero(g);
            gemm_kloop<2>(HL, D, Wgm + (size_t)i * D * D, D, D, m0, n0, sm, g);
#pragma unroll
            for (int mt = 0; mt < 2; ++mt)
#pragma unroll
                for (int nt = 0; nt < 2; ++nt)
#pragma unroll
                    for (int e = 0; e < 8; ++e) {
                        const float t0 = lo_bf(totp[mt][nt][e]) + sigmf(g.a[mt][nt][2 * e]) * lo_bf(pp[mt][nt][e]);
                        const float t1 = hi_bf(totp[mt][nt][e]) + sigmf(g.a[mt][nt][2 * e + 1]) * hi_bf(pp[mt][nt][e]);
                        totp[mt][nt][e] = pk2(t0, t1);
                    }
        }
#pragma unroll
        for (int mt = 0; mt < 2; ++mt)
#pragma unroll
            for (int nt = 0; nt < 2; ++nt)
#pragma unroll
                for (int e = 0; e < 8; ++e) { tot.a[mt][nt][2 * e] = lo_bf(totp[mt][nt][e]); tot.a[mt][nt][2 * e + 1] = hi_bf(totp[mt][nt][e]); }
#endif
        {
            const int wave = ltid() >> 6, wm = wave >> 1, wn = wave & 1;
            float* reg = (float*)sm + wave * (32 * EST);
#pragma unroll
            for (int mt = 0; mt < 2; ++mt) {
                epi_stage<2>(tot, mt, reg);
                epi_rows8<2>(reg, [&](int rl, int cl, float4 a, float4 b) { st8bf(ACCM + (size_t)(m0 + wm * 64 + mt * 32 + rl) * D + n0 + wn * 64 + cl, a, b); });
            }
        }
    }
}

DEVI void phase_out(const P& p, int l, bf16_t* sm) {
    unsigned char* ws = p.ws;
    const bf16_t* ACCM = (const bf16_t*)(ws + OFF_SCR);
    const bf16_t* Wo = (const bf16_t*)(ws + OFF_WOT) + (size_t)l * D * D;
    const float* MOD = (const float*)(ws + OFF_MOD) + (size_t)l * 3 * 3072;
    float* XC1 = (float*)(ws + OFF_XC1);
    const int M = (l == 0) ? NR : NL;
    const int tilesM = M / 256, tilesN = D / 128;
    for (int it = 0;; ++it) {
        const int tile = tile_of(it);
        if (it * (int)gridDim.x >= tilesM * tilesN) break;
        if (tile >= tilesM * tilesN) continue;
        const int tm = tile / tilesN, tn = tile % tilesN;
        const int m0 = tm * 256, n0 = tn * 128;
        GAcc<2> acc; acc_zero(acc);
        gemm_kloop<2, 1>(ACCM, D, Wo, D, D, m0, n0, sm, acc);
        {
            const int wave = ltid() >> 6, wm = wave >> 1, wn = wave & 1;
            float* reg = (float*)sm + wave * (32 * EST);
#pragma unroll
            for (int mt = 0; mt < 2; ++mt) {
                epi_stage<2>(acc, mt, reg);
                epi_rows8<2>(reg, [&](int rl, int cl, float4 a, float4 b) {
                    const int row = m0 + wm * 64 + mt * 32 + rl, col = n0 + wn * 64 + cl;
                    const bool ic = row >= NL;
                    const int mi = ic ? 2 : (row >> 14);
                    const float4 g0 = *(const float4*)(MOD + mi * 3072 + 2048 + col), g1 = *(const float4*)(MOD + mi * 3072 + 2048 + col + 4);
                    const float* src; float* dst;
                    if (ic) { src = (l == 0 ? p.ctx : XC1) + (size_t)(row - NL) * D + col; dst = XC1 + (size_t)(row - NL) * D + col; }
                    else { src = (l == 0 ? p.x : p.out) + (size_t)row * D + col; dst = p.out + (size_t)row * D + col; }
                    const float4 x0 = *(const float4*)src, x1 = *(const float4*)(src + 4);
                    if (!p.dry) {
                        *(float4*)dst = make_float4(x0.x + g0.x * a.x, x0.y + g0.y * a.y, x0.z + g0.z * a.z, x0.w + g0.w * a.w);
                        *(float4*)(dst + 4) = make_float4(x1.x + g1.x * b.x, x1.y + g1.y * b.y, x1.z + g1.z * b.z, x1.w + g1.w * b.w);
                    }
                });
            }
        }
    }
}

DEVI void transpose_tile(const float* __restrict__ src, int K, int N, bf16_t* __restrict__ dst, int k0, int n0, float* sm) {
    const int tid = ltid();
    __syncthreads();
    {
        const int kr = tid >> 4, nc = (tid & 15) * 4;
#pragma unroll
        for (int i = 0; i < 2; ++i) {
            const int k = kr + 32 * i;
            float4 v = {0.f, 0.f, 0.f, 0.f};
            if (n0 + nc < N) v = *(const float4*)(src + (size_t)(k0 + k) * N + n0 + nc);
            sm[k * 65 + nc + 0] = v.x; sm[k * 65 + nc + 1] = v.y; sm[k * 65 + nc + 2] = v.z; sm[k * 65 + nc + 3] = v.w;
        }
    }
    __syncthreads();
    {
        const int n = tid >> 3, kc = (tid & 7) * 8;
        if (n0 + n < N) {
            uint4 w;
            w.x = pk2(sm[(kc + 0) * 65 + n], sm[(kc + 1) * 65 + n]); w.y = pk2(sm[(kc + 2) * 65 + n], sm[(kc + 3) * 65 + n]);
            w.z = pk2(sm[(kc + 4) * 65 + n], sm[(kc + 5) * 65 + n]); w.w = pk2(sm[(kc + 6) * 65 + n], sm[(kc + 7) * 65 + n]);
            *(uint4*)(dst + (size_t)(n0 + n) * K + k0 + kc) = w;
        }
    }
}

DEVI void hyena_mlp_task(const P& p, int l, int L, int p0, float* HT, float* sm) {
    const int tid = ltid();
    float* zb = sm;
    float* h1 = sm + 64 * 33;
    float* h2 = h1 + 64 * 65;
    const float* w1 = p.fw1 + (size_t)l * 33 * 64; const float* b1 = p.fb1 + l * 64;
    const float* w2 = p.fw2 + (size_t)l * 64 * 64; const float* b2 = p.fb2 + l * 64;
    const float* w3 = p.fw3 + (size_t)l * 64 * 64; const float* b3 = p.fb3 + l * 64;
    const float* fr = p.ffreq + l * 64;
    __syncthreads();
#pragma unroll 1
    for (int e = tid; e < 64 * 33; e += NTHR) {
        const int pos = e / 33, k = e % 33;
        const int pp = p0 + pos;
        float v;
        if (k == 0) v = (float)pp / (float)(L - 1);
        else {
            const int j = (k - 1) & 15;
            const float f = 1e-4f + (float)j * ((15.0f - 1e-4f) / 15.0f);
            const float wa = 6.283185307179586f * (float)pp / (float)L;
            v = (k <= 16) ? cosf(f * wa) : -sinf(f * wa);
        }
        zb[e] = v;
    }
    __syncthreads();
    const int pos = tid >> 3, fg = (tid & 7) * 8;
    {
        float a[8];
#pragma unroll
        for (int j = 0; j < 8; ++j) a[j] = b1[fg + j];
#pragma unroll 1
        for (int k = 0; k < 33; ++k) {
            const float zv = zb[pos * 33 + k];
#pragma unroll
            for (int j = 0; j < 8; ++j) a[j] += zv * w1[k * 64 + fg + j];
        }
#pragma unroll
        for (int j = 0; j < 8; ++j) h1[pos * 65 + fg + j] = sinf(fr[fg + j] * a[j]);
    }
    __syncthreads();
    {
        float a[8];
#pragma unroll
        for (int j = 0; j < 8; ++j) a[j] = b2[fg + j];
#pragma unroll 2
        for (int k = 0; k < 64; ++k) {
            const float zv = h1[pos * 65 + k];
#pragma unroll
            for (int j = 0; j < 8; ++j) a[j] += zv * w2[k * 64 + fg + j];
        }
#pragma unroll
        for (int j = 0; j < 8; ++j) h2[pos * 65 + fg + j] = sinf(fr[fg + j] * a[j]);
    }
    __syncthreads();
    {
        float a[8];
#pragma unroll
        for (int j = 0; j < 8; ++j) a[j] = b3[fg + j];
#pragma unroll 2
        for (int k = 0; k < 64; ++k) {
            const float zv = h2[pos * 65 + k];
#pragma unroll
            for (int j = 0; j < 8; ++j) a[j] += zv * w3[k * 64 + fg + j];
        }
#pragma unroll
        for (int j = 0; j < 8; ++j) HT[(size_t)(fg + j) * L + p0 + pos] = sinf(fr[fg + j] * a[j]);
    }
}

DEVI void phase_prep(const P& p, float* sm) {
    unsigned char* ws = p.ws;
    const int tid = ltid();
    constexpr int TN_IN = (IN_TOTAL + 63) / 64;
    constexpr int T_WIN = 2 * 16 * TN_IN;
    constexpr int T_WB = 2 * 4 * 8 * 16;
    constexpr int T_WO = 2 * 16 * 16;
    constexpr int T_MOD = 2 * 48;
    constexpr int T_ROPE = T * 32 / NTHR;
    constexpr int T_MLP = 2 * 256 + 4;
    constexpr int E0 = T_WIN, E1 = E0 + T_WB, E2 = E1 + T_WO, E3 = E2 + T_MOD, E4 = E3 + T_ROPE, E5 = E4 + T_MLP;
    for (int task = blockIdx.x; task < E5; task += gridDim.x) {
        if (task < E0) {
            const int l = task / (16 * TN_IN), r = task % (16 * TN_IN), kt = r / TN_IN, nt = r % TN_IN;
            transpose_tile(p.w_in + (size_t)l * D * IN_TOTAL, D, IN_TOTAL, (bf16_t*)(ws + OFF_WINT) + (size_t)l * IN_TOTAL * D, kt * 64, nt * 64, sm);
        } else if (task < E1) {
            const int q = task - E0, li = q / 128, r = q % 128, kt = r / 16, nt = r % 16;
            transpose_tile(p.w_branch + (size_t)li * 512 * D, 512, D, (bf16_t*)(ws + OFF_WBT) + (size_t)li * D * 512, kt * 64, nt * 64, sm);
        } else if (task < E2) {
            const int q = task - E1, l = q / 256, r = q % 256, kt = r / 16, nt = r % 16;
            transpose_tile(p.w_out + (size_t)l * D * D, D, D, (bf16_t*)(ws + OFF_WOT) + (size_t)l * D * D, kt * 64, nt * 64, sm);
        } else if (task < E3) {
            const int q = task - E2, l = q / 48, jb = q % 48;
            float* sc = sm;
            float* red = sm + 3072;
            __syncthreads();
#pragma unroll 1
            for (int e = tid; e < 3072; e += NTHR) {
                const int mi = e >> 10, k = e & 1023;
                const float v = (mi < 2) ? p.c[mi * D + k] : p.c_ctx[k];
                sc[e] = siluf(v);
            }
            __syncthreads();
            const int kg = tid >> 6, jj = tid & 63, j = jb * 64 + jj;
            const float* w = p.w_mod + (size_t)l * D * 3072 + j;
            float a0 = 0.f, a1 = 0.f, a2 = 0.f;
#pragma unroll 8
            for (int k = kg * 128; k < kg * 128 + 128; ++k) {
                const float wv = w[(size_t)k * 3072];
                a0 += sc[k] * wv; a1 += sc[1024 + k] * wv; a2 += sc[2048 + k] * wv;
            }
            red[(0 * 8 + kg) * 64 + jj] = a0; red[(1 * 8 + kg) * 64 + jj] = a1; red[(2 * 8 + kg) * 64 + jj] = a2;
            __syncthreads();
            if (tid < 192) {
                const int mi = tid >> 6, j2 = tid & 63;
                float s = p.b_mod[l * 3072 + jb * 64 + j2];
#pragma unroll
                for (int g = 0; g < 8; ++g) s += red[(mi * 8 + g) * 64 + j2];
                ((float*)(ws + OFF_MOD))[((size_t)l * 3 + mi) * 3072 + jb * 64 + j2] = s;
            }
        } else if (task < E4) {
            const int e = (task - E3) * NTHR + tid;
            const int t = e >> 5, c = e & 31;
            const float inv = powf(10000.0f, -(float)(c & 15) / 16.0f);
            const float pos = (c < 16) ? (float)(t >> 6) : (float)(t & 63);
            const float ang = pos * inv;
            float* rope = (float*)(ws + OFF_ROPE);
            rope[e] = cosf(ang); rope[(size_t)T * 32 + e] = sinf(ang);
        } else {
            const int q = task - E4;
            if (q < 512) { const int l = q >> 8; hyena_mlp_task(p, l, T, (q & 255) * 64, (float*)(ws + OFF_HH3T) + (size_t)l * 64 * T, sm); }
            else hyena_mlp_task(p, 0, CL, (q - 512) * 64, (float*)(ws + OFF_HH3C), sm);
        }
    }
}

DEVI void phase_hl(const P& p, int l) {
    unsigned char* ws = p.ws;
    const int lane = ltid() & 63, wave = ltid() >> 6;
    const float* MOD = (const float*)(ws + OFF_MOD) + (size_t)l * 3 * 3072;
    const float* nw = p.norm_w + l * D;
    bf16_t* HL = (bf16_t*)(ws + OFF_HL);
    const float* XC1 = (const float*)(ws + OFF_XC1);
    for (int row = blockIdx.x * 8 + wave; row < NR; row += gridDim.x * 8) {
        const float* src; int mi;
        if (row < NL) { src = (l == 0 ? p.x : p.out) + (size_t)row * D; mi = row >> 14; }
        else { src = (l == 0 ? p.ctx : XC1) + (size_t)(row - NL) * D; mi = 2; }
        float4 v[4]; float ss = 0.f;
#pragma unroll
        for (int i = 0; i < 4; ++i) { v[i] = *(const float4*)(src + lane * 4 + 256 * i); ss += v[i].x * v[i].x + v[i].y * v[i].y + v[i].z * v[i].z + v[i].w * v[i].w; }
        ss = wave_sum(ss);
        const float rs = rsqrtf(ss * (1.0f / D) + EPS);
        const float* sh = MOD + mi * 3072; const float* sc = sh + 1024;
#pragma unroll
        for (int i = 0; i < 4; ++i) {
            const int c = lane * 4 + 256 * i;
            const float4 w = *(const float4*)(nw + c), s1 = *(const float4*)(sc + c), s0 = *(const float4*)(sh + c);
            st4bf(HL + (size_t)row * D + c, v[i].x * rs * w.x * (1.f + s1.x) + s0.x, v[i].y * rs * w.y * (1.f + s1.y) + s0.y,
                  v[i].z * rs * w.z * (1.f + s1.z) + s0.z, v[i].w * rs * w.w * (1.f + s1.w) + s0.w);
        }
    }
}
DEVI void phase_final(const P& p) {
    const int lane = ltid() & 63, wave = ltid() >> 6;
    for (int row = blockIdx.x * 8 + wave; row < NL; row += gridDim.x * 8) {
        float* src = p.out + (size_t)row * D;
        float4 v[4]; float ss = 0.f;
#pragma unroll
        for (int i = 0; i < 4; ++i) { v[i] = *(const float4*)(src + lane * 4 + 256 * i); ss += v[i].x * v[i].x + v[i].y * v[i].y + v[i].z * v[i].z + v[i].w * v[i].w; }
        ss = wave_sum(ss);
        const float rs = rsqrtf(ss * (1.0f / D) + EPS);
#pragma unroll
        for (int i = 0; i < 4; ++i) {
            const int c = lane * 4 + 256 * i;
            const float4 w = *(const float4*)(p.final_norm_w + c);
            float4 r = {v[i].x * rs * w.x, v[i].y * rs * w.y, v[i].z * rs * w.z, v[i].w * rs * w.w};
            *(float4*)(src + c) = r;
        }
    }
}

union U8 { bf16x8 v; uint4 u; uint2 h[2]; unsigned w[4]; };
struct AttSt { float m, l; f32x4 o[4]; };
constexpr float L2E = 1.4426950408889634f;
constexpr float NEG_INF = -__builtin_huge_valf();

DEVI float rows_max(float x) {
    const unsigned u = __float_as_uint(x);
    auto r = __builtin_amdgcn_permlane16_swap(u, u, false, false);
    const float a = fmaxf(__uint_as_float(r[0]), __uint_as_float(r[1]));
    const unsigned v = __float_as_uint(a);
    auto t = __builtin_amdgcn_permlane32_swap(v, v, false, false);
    return fmaxf(__uint_as_float(t[0]), __uint_as_float(t[1]));
}
DEVI float rows_sum(float x) {
    const unsigned u = __float_as_uint(x);
    auto r = __builtin_amdgcn_permlane16_swap(u, u, false, false);
    const float a = __uint_as_float(r[0]) + __uint_as_float(r[1]);
    const unsigned v = __float_as_uint(a);
    auto t = __builtin_amdgcn_permlane32_swap(v, v, false, false);
    return __uint_as_float(t[0]) + __uint_as_float(t[1]);
}
struct KVF { bf16x8 ka, kb, kc, kd; U8 v0, v1, v2, v3; };
DEVI void att_load(KVF& f, const bf16_t* k0p, const bf16_t* k1p, const bf16_t* v0p, const bf16_t* v1p, size_t ldv) {
    f.ka = *(const bf16x8*)k0p; f.kb = *(const bf16x8*)(k0p + 32);
    f.kc = *(const bf16x8*)k1p; f.kd = *(const bf16x8*)(k1p + 32);
    f.v0.u = *(const uint4*)(v0p); f.v1.u = *(const uint4*)(v0p + 16 * ldv);
    f.v2.u = *(const uint4*)(v0p + 32 * ldv); f.v3.u = *(const uint4*)(v0p + 48 * ldv);
}
DEVI void att_load2(KVF& f, const char* kb, unsigned k0, unsigned k1, const char* vb, unsigned v0, unsigned vstep) {
    f.ka = *(const bf16x8*)(kb + k0); f.kb = *(const bf16x8*)(kb + (k0 + 64u));
    f.kc = *(const bf16x8*)(kb + k1); f.kd = *(const bf16x8*)(kb + (k1 + 64u));
    f.v0.u = *(const uint4*)(vb + v0); f.v1.u = *(const uint4*)(vb + (v0 + vstep));
    f.v2.u = *(const uint4*)(vb + (v0 + 2u * vstep)); f.v3.u = *(const uint4*)(vb + (v0 + 3u * vstep));
}
DEVI void att_compute(AttSt& st, const bf16x8& q0, const bf16x8& q1, const KVF& f, f32x4 b0, f32x4 b1, float scale2) {
    f32x4 s0 = {0.f, 0.f, 0.f, 0.f}, s1 = {0.f, 0.f, 0.f, 0.f};
    s0 = __builtin_amdgcn_mfma_f32_16x16x32_bf16(f.ka, q0, s0, 0, 0, 0);
    s0 = __builtin_amdgcn_mfma_f32_16x16x32_bf16(f.kb, q1, s0, 0, 0, 0);
    s1 = __builtin_amdgcn_mfma_f32_16x16x32_bf16(f.kc, q0, s1, 0, 0, 0);
    s1 = __builtin_amdgcn_mfma_f32_16x16x32_bf16(f.kd, q1, s1, 0, 0, 0);
    s0 = s0 * scale2 + b0; s1 = s1 * scale2 + b1;
    float mx = fmaxf(fmaxf(fmaxf(s0[0], s0[1]), fmaxf(s0[2], s0[3])), fmaxf(fmaxf(s1[0], s1[1]), fmaxf(s1[2], s1[3])));
    mx = rows_max(mx);
    if (__any(mx > st.m + 8.0f)) {
        const float mn = fmaxf(st.m, mx);
        const float alpha = __builtin_amdgcn_exp2f(st.m - mn);
        st.l *= alpha; st.m = mn;
        st.o[0] = st.o[0] * alpha; st.o[1] = st.o[1] * alpha; st.o[2] = st.o[2] * alpha; st.o[3] = st.o[3] * alpha;
    }
    const float mref = st.m;
    float pa[8];
#pragma unroll
    for (int i = 0; i < 4; ++i) { pa[i] = __builtin_amdgcn_exp2f(s0[i] - mref); pa[4 + i] = __builtin_amdgcn_exp2f(s1[i] - mref); }
    st.l += ((pa[0] + pa[1]) + (pa[2] + pa[3])) + ((pa[4] + pa[5]) + (pa[6] + pa[7]));
    U8 pf; pf.w[0] = pk2(pa[0], pa[1]); pf.w[1] = pk2(pa[2], pa[3]); pf.w[2] = pk2(pa[4], pa[5]); pf.w[3] = pk2(pa[6], pa[7]);
    st.o[0] = __builtin_amdgcn_mfma_f32_16x16x32_bf16(f.v0.v, pf.v, st.o[0], 0, 0, 0);
    st.o[1] = __builtin_amdgcn_mfma_f32_16x16x32_bf16(f.v1.v, pf.v, st.o[1], 0, 0, 0);
    st.o[2] = __builtin_amdgcn_mfma_f32_16x16x32_bf16(f.v2.v, pf.v, st.o[2], 0, 0, 0);
    st.o[3] = __builtin_amdgcn_mfma_f32_16x16x32_bf16(f.v3.v, pf.v, st.o[3], 0, 0, 0);
}
#define ATT_PIPELINE(n_)                                              \
    { KVF fa_, fb_;                                                   \
      LOADS(fa_, 0);                                                  \
      int s_ = 0;                                                     \
      for (; s_ + 2 < (n_); s_ += 2) {        \
          LOADS(fb_, s_ + 1);                                         \
          COMPS(fa_, s_);                                             \
          LOADS(fa_, s_ + 2);                                         \
          COMPS(fb_, s_ + 1);                                         \
      }                                                               \
      if (s_ + 1 < (n_)) { LOADS(fb_, s_ + 1); COMPS(fa_, s_); COMPS(fb_, s_ + 1); } \
      else { COMPS(fa_, s_); } }
DEVI void att_finish(const AttSt& st, float extra_l, bf16_t* G  , int dry) {
    const int lane = ltid() & 63, g = lane >> 4;
    float lt = rows_sum(st.l);
    lt += extra_l;
    const float inv = 1.f / lt;
#pragma unroll
    for (int dt = 0; dt < 4; ++dt) {
        bf16_t* gp = G + dt * 16 + 4 * g;
        const uint2 gv = *(const uint2*)gp;
        if (!dry) st4bf(gp, st.o[dt][0] * inv * lo_bf(gv.x), st.o[dt][1] * inv * hi_bf(gv.x), st.o[dt][2] * inv * lo_bf(gv.y), st.o[dt][3] * inv * hi_bf(gv.y));
    }
}

DEVI void phase_att_a(const P& p, int l, float* smf) {
    unsigned char* ws = p.ws; unsigned char* scr = ws + OFF_SCR;
    const bf16_t* Q = (const bf16_t*)(scr + SA_Q); const bf16_t* K = (const bf16_t*)(scr + SA_K); const bf16_t* VT = (const bf16_t*)(scr + SA_VT);
    const bf16_t* VTC = VT + (size_t)NB * 8 * 64 * T;
    bf16_t* G = (bf16_t*)(ws + OFF_YS);
    const int tid = ltid(), lane = tid & 63, h = tid >> 6, q = lane & 15, g = lane >> 4;
    __syncthreads();
    for (int e = tid; e < 8 * 465; e += NTHR) smf[e] = p.rpb[(size_t)l * 8 * 465 + e] * L2E;
    __syncthreads();
    const float* tab = smf + h * 465;
    const float scale2 = 0.125f * L2E;
    const int ntask = 2048 + (l == 0 ? 32 : 0);
    for (int it = 0; it * (int)gridDim.x < ntask; ++it) {
        const int task = tile_of(it);
        if (task >= ntask) continue;
        AttSt st; st.m = -1e30f; st.l = 0.f;
#pragma unroll
        for (int dt = 0; dt < 4; ++dt) st.o[dt] = (f32x4){0.f, 0.f, 0.f, 0.f};
        int b, qrow;
        const bool lat = task < 2048;
        int r = 0, j = 0;
        if (lat) { b = task >> 10; r = (task >> 2) & 255; j = task & 3; qrow = b * T + r * 64 + j * 16 + q; }
        else { const int tt = task - 2048; b = tt >> 4; qrow = NL + b * CL + (tt & 15) * 16 + q; }
        const bf16_t* qp = Q + (size_t)qrow * 512 + h * 64 + g * 8;
        const bf16x8 q0 = *(const bf16x8*)qp, q1 = *(const bf16x8*)(qp + 32);
        {
            const int rs = min(max(r - 4, 0), 248), kc0 = min(max(j * 16 - 8, 0), 32);
            const int qc = j * 16 + q, cs = min(max(qc - 8, 0), 48);
            const int nloc = lat ? 8 : 0, nst = nloc + 8;
            const bf16_t* Kc = K + (size_t)(NL + b * CL) * 512 + h * 64 + g * 8;
            const bf16_t* Vc = VTC + ((size_t)(b * 8 + h) * 64 + (lane & 15)) * CL + 8 * g;
            const int kmap = 8 * ((lane & 15) >> 2) + (lane & 3);
            const char* KnB = (const char*)(K + (size_t)b * T * 512); const char* VnB = (const char*)(VT + (size_t)(b * 8) * 64 * T);
            const char* KcB = (const char*)(K + (size_t)(NL + b * CL) * 512); const char* VcB = (const char*)(VTC + (size_t)(b * 8) * 64 * CL);
            const unsigned kln = (unsigned)((kc0 + kmap) * 512 + h * 64 + g * 8) * 2u, vln = (unsigned)((h * 64 + (lane & 15)) * T + kc0 + 8 * g) * 2u;
            const unsigned klc = (unsigned)(kmap * 512 + h * 64 + g * 8) * 2u, vlc = (unsigned)((h * 64 + (lane & 15)) * CL + 8 * g) * 2u;
#define LOADS(F, S) { const int s2_ = (S); if (s2_ < nloc) { const unsigned k0_ = kln + (unsigned)(rs + s2_) * 65536u; \
                        att_load2(F, KnB, k0_, k0_ + 4096u, VnB, vln + (unsigned)(rs + s2_) * 128u, (unsigned)(16 * T * 2)); } \
                      else { const unsigned c_ = (unsigned)(s2_ - nloc); const unsigned k0_ = klc + c_ * 32768u; att_load2(F, KcB, k0_, k0_ + 4096u, VcB, vlc + c_ * 64u, (unsigned)(16 * CL * 2)); } }
            int ia[4], ib[4]; bool va_[4], vb_[4];
#pragma unroll
            for (int i = 0; i < 4; ++i) { const int kc_a = kc0 + 8 * g + i, kc_b = kc_a + 4;
                va_[i] = (kc_a >= cs && kc_a < cs + 16); vb_[i] = (kc_b >= cs && kc_b < cs + 16);
                ia[i] = min(max(kc_a - qc + 15, 0), 30); ib[i] = min(max(kc_b - qc + 15, 0), 30); }
#define COMPS(F, S) { const int s2_ = (S); f32x4 b0 = {0.f, 0.f, 0.f, 0.f}, b1 = {0.f, 0.f, 0.f, 0.f}; \
                      if (s2_ < nloc) { const float* trw = tab + (rs + s2_ - r + 7) * 31; \
                        _Pragma("unroll") for (int i = 0; i < 4; ++i) { b0[i] = va_[i] ? trw[ia[i]] : NEG_INF; b1[i] = vb_[i] ? trw[ib[i]] : NEG_INF; } } \
                      att_compute(st, q0, q1, F, b0, b1, scale2); }
            ATT_PIPELINE(nst)
#undef LOADS
#undef COMPS
        }
        att_finish(st, 0.f, G + (size_t)qrow * 512 + h * 64, p.dry);
    }
}

DEVI void phase_att_b(const P& p, int l) {
    unsigned char* ws = p.ws; unsigned char* scr = ws + OFF_SCR;
    const bf16_t* Q = (const bf16_t*)(scr + SB_Q); const bf16_t* K = (const bf16_t*)(scr + SB_K); const bf16_t* VT = (const bf16_t*)(scr + SB_VT);
    const bf16_t* VTC = VT + (size_t)NB * 2 * 64 * T;
    bf16_t* G = (bf16_t*)(ws + OFF_YS + SZ512);
    const int tid = ltid(), lane = tid & 63, h = tid >> 6, kvh = h >> 2, q = lane & 15, g = lane >> 4;
    const float scale2 = 0.125f * L2E;
    const float sink2 = p.sink[l * 8 + h] * L2E;
    const int ntask = 2048 + (l == 0 ? 32 : 0);
    for (int it = 0; it * (int)gridDim.x < ntask; ++it) {
        const int task = tile_of(it);
        if (task >= ntask) continue;
        AttSt st; st.m = -1e30f; st.l = 0.f;
#pragma unroll
        for (int dt = 0; dt < 4; ++dt) st.o[dt] = (f32x4){0.f, 0.f, 0.f, 0.f};
        int b, qrow;
        const bool lat = task < 2048;
        int q0t = 0;
        if (lat) { b = task >> 10; q0t = (task & 1023) * 16; qrow = b * T + q0t + q; }
        else { const int tt = task - 2048; b = tt >> 4; qrow = NL + b * CL + (tt & 15) * 16 + q; }
        const bf16_t* qp = Q + (size_t)qrow * 512 + h * 64 + g * 8;
        const bf16x8 q0 = *(const bf16x8*)qp, q1 = *(const bf16x8*)(qp + 32);
        {
            const int tq = q0t + q;
            const int nloc = lat ? 9 : 0, nst = nloc + 8;
            const bf16_t* Kc = K + (size_t)(NL + b * CL) * 128 + kvh * 64 + g * 8;
            const bf16_t* Vc = VTC + ((size_t)(b * 2 + kvh) * 64 + (lane & 15)) * CL + 8 * g;
            const int kmap = 8 * ((lane & 15) >> 2) + (lane & 3);
            const bf16_t* vbase = VT + ((size_t)(b * 2 + kvh) * 64 + (lane & 15)) * T;
            const char* KnB = (const char*)(K + (size_t)b * T * 128); const char* VnB = (const char*)(VT + (size_t)(b * 2) * 64 * T);
            const char* KcB = (const char*)(K + (size_t)(NL + b * CL) * 128); const char* VcB = (const char*)(VTC + (size_t)(b * 2) * 64 * CL);
            const unsigned kl2 = (unsigned)(kvh * 64 + g * 8) * 2u, vl2 = (unsigned)((kvh * 64 + (lane & 15)) * T) * 2u;
            const unsigned klc = (unsigned)(kmap * 128 + kvh * 64 + g * 8) * 2u, vlc = (unsigned)((kvh * 64 + (lane & 15)) * CL + 8 * g) * 2u;
#define LOADS(F, S) { const int s2_ = (S); if (s2_ < nloc) { const int tbase = q0t - 128 + 32 * s2_; \
                        const int ta = min(max(tbase + kmap, 0), T - 1), tb = min(max(tbase + kmap + 4, 0), T - 1); \
                        const int va = min(max(tbase + 8 * g, 0), T - 8); \
                        att_load2(F, KnB, kl2 + (unsigned)ta * 256u, kl2 + (unsigned)tb * 256u, VnB, vl2 + (unsigned)va * 2u, (unsigned)(16 * T * 2)); } \
                      else { const unsigned c_ = (unsigned)(s2_ - nloc); const unsigned k0_ = klc + c_ * 8192u; att_load2(F, KcB, k0_, k0_ + 1024u, VcB, vlc + c_ * 64u, (unsigned)(16 * CL * 2)); } }
#define COMPS(F, S) { const int s2_ = (S); f32x4 b0 = {0.f, 0.f, 0.f, 0.f}, b1 = {0.f, 0.f, 0.f, 0.f}; \
                      if (s2_ < nloc && (s2_ == 0 || s2_ == 8 || q0t < 128 || q0t + 160 > T)) { const int tbase = q0t - 128 + 32 * s2_; \
                        _Pragma("unroll") for (int i = 0; i < 4; ++i) { const int t0 = tbase + 8 * g + i, t1 = t0 + 4; \
                          b0[i] = (t0 >= 0 && t0 < T && abs(tq - t0) <= 128) ? 0.f : NEG_INF; \
                          b1[i] = (t1 >= 0 && t1 < T && abs(tq - t1) <= 128) ? 0.f : NEG_INF; } } \
                      att_compute(st, q0, q1, F, b0, b1, scale2); }
            ATT_PIPELINE(nst)
#undef LOADS
#undef COMPS
        }
        att_finish(st, __builtin_amdgcn_exp2f(sink2 - st.m), G + (size_t)qrow * 512 + h * 64, p.dry);
    }
}

constexpr int GL_CUM = 0;
constexpr int GL_LR = 32768;
constexpr int GL_T0 = GL_LR + 8192;
constexpr int GL_TSZ = 64 * LSTR * 2;
constexpr int GL_X = GL_T0 + 4 * GL_TSZ;

DEVI float logsigmoidf(float x) { return fminf(x, 0.f) - log1pf(expf(-fabsf(x))); }

DEVI void gla_cum(const P& p, int l, int h, int rowbase, unsigned char* sm) {
    const int tid = ltid();
    float* cum = (float*)(sm + GL_CUM); float* lrs = (float*)(sm + GL_LR);
    const float* LR = (const float*)(p.ws + OFF_SCR + SC_LR);
    __syncthreads();
    { const int t = tid >> 3, c4 = (tid & 7) * 4; *(float4*)(lrs + t * 32 + c4) = *(const float4*)(LR + (size_t)(rowbase + t) * 32 + c4); }
    __syncthreads();
    const int d = tid & 63, tg = tid >> 6;
    float* tot = lrs + 64 * 32;
    tot = (float*)(sm + GL_X);
    float la[2][8];
#pragma unroll
    for (int dir = 0; dir < 2; ++dir) {
        const float* W = p.w_alpha_up + ((size_t)(l * 2 + dir) * 16) * 256 + h * 64 + d;
        float w[16];
#pragma unroll
        for (int r = 0; r < 16; ++r) w[r] = W[r * 256];
        const float bia = p.b_alpha[(l * 2 + dir) * 256 + h * 64 + d];
#pragma unroll
        for (int tt = 0; tt < 8; ++tt) {
            const int t = tg * 8 + tt;
            float x = bia;
#pragma unroll
            for (int r = 0; r < 16; ++r) x += lrs[t * 32 + dir * 16 + r] * w[r];
            la[dir][tt] = logsigmoidf(x) * (1.0f / 16.0f);
        }
    }
#pragma unroll
    for (int tt = 1; tt < 8; ++tt) la[0][tt] += la[0][tt - 1];
#pragma unroll
    for (int tt = 6; tt >= 0; --tt) la[1][tt] += la[1][tt + 1];
    tot[(0 * 8 + tg) * 64 + d] = la[0][7];
    tot[(1 * 8 + tg) * 64 + d] = la[1][0];
    __syncthreads();
    float of = 0.f, ob = 0.f;
#pragma unroll
    for (int g2 = 0; g2 < 8; ++g2) {
        const float a = tot[(0 * 8 + g2) * 64 + d], b = tot[(1 * 8 + g2) * 64 + d];
        of += (g2 < tg) ? a : 0.f;
        ob += (g2 > tg) ? b : 0.f;
    }
#pragma unroll
    for (int tt = 0; tt < 8; ++tt) {
        const int t = tg * 8 + tt;
        cum[t * 64 + d] = la[0][tt] + of;
        cum[(64 + t) * 64 + d] = la[1][tt] + ob;
    }
    __syncthreads();
}
DEVI void gla_chunk_geom(int b, int c, int& rowbase, size_t& vt_off  , size_t& vld, int& ci_f, int& ci_b) {
    if (c < 4) { rowbase = NL + b * CL + c * 64; vld = CL; ci_f = c; ci_b = 3 - c; }
    else { rowbase = b * T + (c - 4) * 64; vld = T; ci_f = c; ci_b = 4 + 255 - (c - 4); }
}
DEVI const bf16_t* gla_vt_ptr(const bf16_t* VT, int b, int h, int c) {
    if (c < 4) return VT + (size_t)NB * 4 * 128 * T + ((size_t)(b * 4 + h) * 128) * CL + c * 64;
    return VT + ((size_t)(b * 4 + h) * 128) * T + (size_t)(c - 4) * 64;
}

DEVI void phase_gla1(const P& p, int l, unsigned char* sm) {
    unsigned char* scr = p.ws + OFF_SCR;
    const bf16_t* KG = (const bf16_t*)(scr + SC_K); const bf16_t* VT = (const bf16_t*)(scr + SC_VT);
    bf16_t* SB = (bf16_t*)(scr + SC_SB); float* GD = (float*)(scr + SC_GD);
    const int tid = ltid(), lane = tid & 63, wave = tid >> 6;
    const float* cum = (const float*)(sm + GL_CUM);
    bf16_t* kdT = (bf16_t*)(sm + GL_T0);
    for (int task = blockIdx.x; task < 8 * NCH; task += gridDim.x) {
        const int bh = task / NCH, c = task % NCH, b = bh >> 2, h = bh & 3;
        int rowbase, ci_f, ci_b; size_t vo, vld;
        gla_chunk_geom(b, c, rowbase, vo, vld, ci_f, ci_b);
        gla_cum(p, l, h, rowbase, sm);
        {
            const int d = tid & 63, tg = tid >> 6;
            const float ce_f = cum[63 * 64 + d], ce_b = cum[64 * 64 + d];
            float vf[8], vb[8];
#pragma unroll
            for (int j = 0; j < 8; ++j) {
                const int t = tg * 8 + j;
                const float kf = bf2f(KG[(size_t)(rowbase + t) * 256 + h * 64 + d]);
                vf[j] = kf * __expf(ce_f - cum[t * 64 + d]);
                vb[j] = kf * __expf(ce_b - cum[(64 + t) * 64 + d]);
            }
            uint4 wf, wb;
            wf.x = pk2(vf[0], vf[1]); wf.y = pk2(vf[2], vf[3]); wf.z = pk2(vf[4], vf[5]); wf.w = pk2(vf[6], vf[7]);
            wb.x = pk2(vb[0], vb[1]); wb.y = pk2(vb[2], vb[3]); wb.z = pk2(vb[4], vb[5]); wb.w = pk2(vb[6], vb[7]);
            *(uint4*)(kdT + d * LSTR + tg * 8) = wf;
            *(uint4*)(kdT + (64 + d) * LSTR + tg * 8) = wb;
        }
        __syncthreads();
        {
            const int dir = wave >> 2, dvt = wave & 3;
            const bf16_t* vp = gla_vt_ptr(VT, b, h, c) + (size_t)(dvt * 32 + (lane & 31)) * vld + (lane >> 5) * 8;
            const bf16_t* ap = kdT + (dir * 64 + (lane & 31)) * LSTR + (lane >> 5) * 8;
            f32x16 acc[2];
#pragma unroll
            for (int i = 0; i < 16; ++i) { acc[0][i] = 0.f; acc[1][i] = 0.f; }
#pragma unroll
            for (int ks = 0; ks < 4; ++ks) {
                const bf16x8 vb = *(const bf16x8*)(vp + ks * 16);
#pragma unroll
                for (int mt = 0; mt < 2; ++mt) {
                    const bf16x8 ka = *(const bf16x8*)(ap + mt * 32 * LSTR + ks * 16);
                    acc[mt] = __builtin_amdgcn_mfma_f32_32x32x16_bf16(ka, vb, acc[mt], 0, 0, 0);
                }
            }
            const int bhd = bh * 2 + dir, ci = dir ? ci_b : ci_f;
            bf16_t* out = SB + ((size_t)bhd * NCH + ci) * 8192 + (size_t)(dvt * 32 + (lane & 31)) * 64;
#ifdef EXP_C
            for (int mt = 0; mt < 2; ++mt) for (int i = 0; i < 16; ++i) { const int dk = mt * 32 + (i & 3) + 8 * (i >> 2) + 4 * (lane >> 5); acc[mt][i] = bf2f(kdT[(dir * 64 + dk) * LSTR + ((dvt * 32 + (lane & 31)) & 63)]); }
#endif
#pragma unroll
            for (int mt = 0; mt < 2; ++mt)
#pragma unroll
                for (int q4 = 0; q4 < 4; ++q4)
                    st4bf(out + mt * 32 + q4 * 8 + (lane >> 5) * 4, acc[mt][q4 * 4 + 0], acc[mt][q4 * 4 + 1], acc[mt][q4 * 4 + 2], acc[mt][q4 * 4 + 3]);
        }
        if (tid < 128) {
            const int dir = tid >> 6, d = tid & 63;
            const int bhd = bh * 2 + dir, ci = dir ? ci_b : ci_f;
            GD[((size_t)bhd * NCH + ci) * 64 + d] = __expf(dir ? cum[64 * 64 + d] : cum[63 * 64 + d]);
        }
    }
}

DEVI void phase_gla2(const P& p) {
    unsigned char* scr = p.ws + OFF_SCR;
    bf16_t* SB = (bf16_t*)(scr + SC_SB); const float* GD = (const float*)(scr + SC_GD);
    for (int idx = blockIdx.x * NTHR + ltid(); idx < 16 * 8192; idx += gridDim.x * NTHR) {
        const int bhd = idx >> 13, e = idx & 8191, dk = e & 63;
        bf16_t* base = SB + (size_t)bhd * NCH * 8192 + e;
        const float* gd = GD + (size_t)bhd * NCH * 64 + dk;
        float S = 0.f;
#pragma unroll 1
        for (int ci = 0; ci < NCH; ci += 13) {
            float kv[13], g[13];
#pragma unroll
            for (int u = 0; u < 13; ++u) { kv[u] = bf2f(base[(size_t)(ci + u) * 8192]); g[u] = gd[(ci + u) * 64]; }
#pragma unroll
            for (int u = 0; u < 13; ++u) { if (!p.dry) base[(size_t)(ci + u) * 8192] = f2bf(S); S = g[u] * S + kv[u]; }
        }
    }
}

DEVI void phase_gla3(const P& p, int l, unsigned char* sm) {
    unsigned char* scr = p.ws + OFF_SCR;
    const bf16_t* QG = (const bf16_t*)(scr + SC_Q); const bf16_t* KG = (const bf16_t*)(scr + SC_K); const bf16_t* VT = (const bf16_t*)(scr + SC_VT);
    const bf16_t* SB = (const bf16_t*)(scr + SC_SB);
    bf16_t* G = (bf16_t*)(p.ws + OFF_YS + 2 * SZ512);
    const float* gnw = p.gla_norm_w + l * 128;
    const int tid = ltid(), lane = tid & 63, wave = tid >> 6, q = lane & 15, g = lane >> 4;
    const float* cum = (const float*)(sm + GL_CUM);
    bf16_t* tiles = (bf16_t*)(sm + GL_T0);
    float* X = (float*)(sm + GL_X);
    const int c_lo = (l == 0) ? 0 : 4;
    const int nper = NCH - c_lo;
    for (int task = blockIdx.x; task < 8 * nper; task += gridDim.x) {
        const int bh = task / nper, c = c_lo + task % nper, b = bh >> 2, h = bh & 3;
        int rowbase, ci_f, ci_b; size_t vo, vld;
        gla_chunk_geom(b, c, rowbase, vo, vld, ci_f, ci_b);
        gla_cum(p, l, h, rowbase, sm);
        {
            const int t = tid >> 3, dg = (tid & 7) * 8;
            U8 qv, kv; qv.u = *(const uint4*)(QG + (size_t)(rowbase + t) * 256 + h * 64 + dg); kv.u = *(const uint4*)(KG + (size_t)(rowbase + t) * 256 + h * 64 + dg);
            float o[4][8];
#pragma unroll
            for (int j = 0; j < 8; ++j) {
                const int d = dg + j;
                const float qf = (j & 1) ? hi_bf(qv.w[j >> 1]) : lo_bf(qv.w[j >> 1]);
                const float kf = (j & 1) ? hi_bf(kv.w[j >> 1]) : lo_bf(kv.w[j >> 1]);
                const float cf = cum[t * 64 + d], cb = cum[(64 + t) * 64 + d];
                o[0][j] = qf * __expf(cf); o[1][j] = kf * __expf(-cf); o[2][j] = qf * __expf(cb); o[3][j] = kf * __expf(-cb);
            }
#pragma unroll
            for (int k = 0; k < 4; ++k) {
                uint4 w; w.x = pk2(o[k][0], o[k][1]); w.y = pk2(o[k][2], o[k][3]); w.z = pk2(o[k][4], o[k][5]); w.w = pk2(o[k][6], o[k][7]);
                *(uint4*)(tiles + k * 64 * LSTR + t * LSTR + dg) = w;
            }
        }
        __syncthreads();
        const int qi = wave & 3, dir = wave >> 2;
        f32x4 O[8];
#pragma unroll
        for (int i = 0; i < 8; ++i) O[i] = (f32x4){0.f, 0.f, 0.f, 0.f};
        {
            const bf16_t* Qd = tiles + (dir * 2) * 64 * LSTR; const bf16_t* Kd = tiles + (dir * 2 + 1) * 64 * LSTR;
            const bf16x8 qf0 = *(const bf16x8*)(Qd + (qi * 16 + q) * LSTR + g * 8), qf1 = *(const bf16x8*)(Qd + (qi * 16 + q) * LSTR + 32 + g * 8);
            const int iq = qi * 16 + q;
            U8 pf[2];
#pragma unroll
            for (int jt = 0; jt < 4; ++jt) {
                const bf16_t* kp = Kd + (jt * 16 + (lane & 15)) * LSTR + g * 8;
                f32x4 s = {0.f, 0.f, 0.f, 0.f};
                s = __builtin_amdgcn_mfma_f32_16x16x32_bf16(*(const bf16x8*)kp, qf0, s, 0, 0, 0);
                s = __builtin_amdgcn_mfma_f32_16x16x32_bf16(*(const bf16x8*)(kp + 32), qf1, s, 0, 0, 0);
#pragma unroll
                for (int i = 0; i < 4; ++i) { const int jk = jt * 16 + 4 * g + i; const bool ok = dir ? (jk >= iq) : (jk <= iq); s[i] = ok ? s[i] : 0.f; }
                pf[jt >> 1].w[(jt & 1) * 2 + 0] = pk2(s[0], s[1]); pf[jt >> 1].w[(jt & 1) * 2 + 1] = pk2(s[2], s[3]);
            }
            const bf16_t* vp = gla_vt_ptr(VT, b, h, c) + (size_t)(lane & 15) * vld + 4 * g;
            const int bhd = bh * 2 + dir, ci = dir ? ci_b : ci_f;
            const bf16_t* sp = SB + ((size_t)bhd * NCH + ci) * 8192 + (size_t)(lane & 15) * 64 + g * 8;
#pragma unroll
            for (int dvt = 0; dvt < 8; ++dvt) {
#pragma unroll
                for (int st = 0; st < 2; ++st) {
                    U8 vf; vf.h[0] = *(const uint2*)(vp + (size_t)dvt * 16 * vld + st * 32); vf.h[1] = *(const uint2*)(vp + (size_t)dvt * 16 * vld + st * 32 + 16);
                    O[dvt] = __builtin_amdgcn_mfma_f32_16x16x32_bf16(vf.v, pf[st].v, O[dvt], 0, 0, 0);
                }
                O[dvt] = __builtin_amdgcn_mfma_f32_16x16x32_bf16(*(const bf16x8*)(sp + dvt * 16 * 64), qf0, O[dvt], 0, 0, 0);
                O[dvt] = __builtin_amdgcn_mfma_f32_16x16x32_bf16(*(const bf16x8*)(sp + dvt * 16 * 64 + 32), qf1, O[dvt], 0, 0, 0);
            }
        }
        if (dir == 1) {
#pragma unroll
            for (int dvt = 0; dvt < 8; ++dvt)
#pragma unroll
                for (int i = 0; i < 4; ++i) X[(qi * 128 + dvt * 16 + 4 * g + i) * 16 + q] = O[dvt][i];
        }
        __syncthreads();
        if (dir == 0) {
            float ss = 0.f;
#pragma unroll
            for (int dvt = 0; dvt < 8; ++dvt)
#pragma unroll
                for (int i = 0; i < 4; ++i) { O[dvt][i] += X[(qi * 128 + dvt * 16 + 4 * g + i) * 16 + q]; ss += O[dvt][i] * O[dvt][i]; }
            ss = rows_sum(ss);
            const float rs = rsqrtf(ss * (1.0f / 128.0f) + EPS);
            bf16_t* gp = G + (size_t)(rowbase + qi * 16 + q) * 512 + h * 128;
#pragma unroll
            for (int dvt = 0; dvt < 8; ++dvt) {
                const int dv = dvt * 16 + 4 * g;
                const float4 w = *(const float4*)(gnw + dv);
                const uint2 gv = *(const uint2*)(gp + dv);
                if (!p.dry) st4bf(gp + dv, O[dvt][0] * rs * w.x * lo_bf(gv.x), O[dvt][1] * rs * w.y * hi_bf(gv.x), O[dvt][2] * rs * w.z * lo_bf(gv.y), O[dvt][3] * rs * w.w * hi_bf(gv.y));
            }
        }
    }
}

constexpr int LF = 16384;
DEVI int CIDX(int p) { return p + (p >> 4); }
DEVI int FIDX(int m) { return 2 * CIDX(m >> 1) + (m & 1); }
constexpr int LFP = LF + LF / 16;
DEVI float2 cmul(float2 a, float2 b) { return make_float2(a.x * b.x - a.y * b.y, a.x * b.y + a.y * b.x); }
DEVI float2 cadd(float2 a, float2 b) { return make_float2(a.x + b.x, a.y + b.y); }
DEVI float2 csub(float2 a, float2 b) { return make_float2(a.x - b.x, a.y - b.y); }
DEVI float2 twid(float frac) { return make_float2(__builtin_amdgcn_cosf(frac), __builtin_amdgcn_sinf(frac)); }

DEVI void fft_fwd(float2* F) {
    const int tid = ltid();
#pragma unroll 1
    for (int s = LF / 2; s >= 2; s >>= 2) {
        const int h = s >> 1;
        const int lh = 31 - __clz(h);
        const float inv2s = 1.0f / (float)(2 * s);
#pragma unroll 2
        for (int qq = tid; qq < LF / 4; qq += NTHR) {
            const int blk = qq >> lh, j = qq & (h - 1);
            const int i = blk * (2 * s) + j;
            const int i0 = CIDX(i), i1 = CIDX(i + h), i2 = CIDX(i + s), i3 = CIDX(i + s + h);
            const float2 x0 = F[i0], x1 = F[i1], x2 = F[i2], x3 = F[i3];
            float2 w1 = twid((float)j * inv2s); w1.y = -w1.y;
            const float2 w2 = cmul(w1, w1);
            const float2 y0 = cadd(x0, x2), y2 = cmul(csub(x0, x2), w1);
            const float2 y1 = cadd(x1, x3); const float2 tt = csub(x1, x3);
            const float2 y3 = cmul(make_float2(tt.y, -tt.x), w1);
            F[i0] = cadd(y0, y1); F[i1] = cmul(csub(y0, y1), w2);
            F[i2] = cadd(y2, y3); F[i3] = cmul(csub(y2, y3), w2);
        }
        __syncthreads();
    }
}
DEVI void fft_inv(float2* F) {
    const int tid = ltid();
#pragma unroll 1
    for (int h = 1; h <= LF / 4; h <<= 2) {
        const int s = 2 * h;
        const int lh = 31 - __clz(h);
        const float inv2s = 1.0f / (float)(2 * s);
#pragma unroll 2
        for (int qq = tid; qq < LF / 4; qq += NTHR) {
            const int blk = qq >> lh, j = qq & (h - 1);
            const int i = blk * (2 * s) + j;
            const int i0 = CIDX(i), i1 = CIDX(i + h), i2 = CIDX(i + s), i3 = CIDX(i + s + h);
            const float2 x0 = F[i0], x1 = F[i1], x2 = F[i2], x3 = F[i3];
            const float2 w1 = twid((float)j * inv2s);
            const float2 w2 = cmul(w1, w1);
            const float2 a1 = cmul(x1, w2), a3 = cmul(x3, w2);
            const float2 u0 = cadd(x0, a1), u1 = csub(x0, a1), u2 = cadd(x2, a3), u3 = csub(x2, a3);
            const float2 b2 = cmul(u2, w1); const float2 t3 = cmul(u3, w1); const float2 b3 = make_float2(-t3.y, t3.x);
            F[i0] = cadd(u0, b2); F[i2] = csub(u0, b2); F[i1] = cadd(u1, b3); F[i3] = csub(u1, b3);
        }
        __syncthreads();
    }
}
DEVI int rev14(int k) { return (int)(__brev((unsigned)k) >> 18); }
DEVI float hy_delta(int ch) {
    const float a = -3.0701134573253946f, b = -15.350567286626973f;
    return fabsf(a + (b - a) * ((float)ch / 511.0f));
}

DEVI void conv8(const bf16_t* U, const float* cw, const float* cb, int seq0, int Lseq, int t, int col0, float* out) {
    U8 r[3];
#pragma unroll
    for (int i = 0; i < 3; ++i) {
        const int tt = t - 1 + i;
        if (tt >= 0 && tt < Lseq) r[i].u = *(const uint4*)(U + (size_t)(seq0 + tt) * 1536 + col0);
        else r[i].u = make_uint4(0, 0, 0, 0);
    }
#pragma unroll
    for (int j = 0; j < 8; ++j) {
        float a = cb[col0 + j];
#pragma unroll
        for (int i = 0; i < 3; ++i) { const float uv = (j & 1) ? hi_bf(r[i].w[j >> 1]) : lo_bf(r[i].w[j >> 1]); a += uv * cw[i * 1536 + col0 + j]; }
        out[j] = a;
    }
}
DEVI void hy_task_geom(int task, int& b, int& t0, int& ch0, int& seq0, int& Lseq, float*& zt, unsigned char* scr) {
    if (task < 4096) { b = task >> 11; t0 = ((task >> 3) & 255) * 64; ch0 = (task & 7) * 64; seq0 = b * T; Lseq = T; zt = (float*)(scr + SD_ZT) + (size_t)b * 512 * T; }
    else { const int q = task - 4096; b = q >> 5; t0 = ((q >> 3) & 3) * 64; ch0 = (q & 7) * 64; seq0 = NL + b * CL; Lseq = CL; zt = (float*)(scr + SD_ZTC) + (size_t)b * 512 * CL; }
}
DEVI void phase_hy1(const P& p, int l, float* sm) {
    unsigned char* scr = p.ws + OFF_SCR;
    const bf16_t* U = (const bf16_t*)(scr + SD_U);
    const float* cw = p.conv_w + (size_t)l * 3 * 1536; const float* cb = p.conv_b + l * 1536;
    const int tid = ltid();
    const int ntask = 4096 + (l == 0 ? 64 : 0);
    for (int task = blockIdx.x; task < ntask; task += gridDim.x) {
        int b, t0, ch0, seq0, Lseq; float* zt;
        hy_task_geom(task, b, t0, ch0, seq0, Lseq, zt, scr);
        __syncthreads();
        {
            const int tt = tid >> 3, cg = (tid & 7) * 8;
            float a1[8], a2[8];
            conv8(U, cw, cb, seq0, Lseq, t0 + tt, 512 + ch0 + cg, a1);
            conv8(U, cw, cb, seq0, Lseq, t0 + tt, 1024 + ch0 + cg, a2);
#pragma unroll
            for (int j = 0; j < 8; ++j) sm[(cg + j) * 65 + tt] = a1[j] * a2[j];
        }
        __syncthreads();
        {
            const int ch = tid >> 3, t8 = (tid & 7) * 8;
            float4 w0 = {sm[ch * 65 + t8 + 0], sm[ch * 65 + t8 + 1], sm[ch * 65 + t8 + 2], sm[ch * 65 + t8 + 3]};
            float4 w1 = {sm[ch * 65 + t8 + 4], sm[ch * 65 + t8 + 5], sm[ch * 65 + t8 + 6], sm[ch * 65 + t8 + 7]};
            float* dst = zt + (size_t)(ch0 + ch) * Lseq + t0 + t8;
            *(float4*)dst = w0; *(float4*)(dst + 4) = w1;
        }
    }
}
DEVI void phase_hy3(const P& p, int l, float* sm) {
    unsigned char* scr = p.ws + OFF_SCR;
    const bf16_t* U = (const bf16_t*)(scr + SD_U);
    bf16_t* G = (bf16_t*)(p.ws + OFF_YS + 3 * SZ512);
    const float* cw = p.conv_w + (size_t)l * 3 * 1536; const float* cb = p.conv_b + l * 1536;
    const int tid = ltid();
    const int ntask = 4096 + (l == 0 ? 64 : 0);
    for (int task = blockIdx.x; task < ntask; task += gridDim.x) {
        int b, t0, ch0, seq0, Lseq; float* zt;
        hy_task_geom(task, b, t0, ch0, seq0, Lseq, zt, scr);
        __syncthreads();
        {
            const int ch = tid >> 3, t8 = (tid & 7) * 8;
            const float* src = zt + (size_t)(ch0 + ch) * Lseq + t0 + t8;
            const float4 w0 = *(const float4*)src, w1 = *(const float4*)(src + 4);
            float* d = sm + ch * 65 + t8;
            d[0] = w0.x; d[1] = w0.y; d[2] = w0.z; d[3] = w0.w; d[4] = w1.x; d[5] = w1.y; d[6] = w1.z; d[7] = w1.w;
        }
        __syncthreads();
        {
            const int tt = tid >> 3, cg = (tid & 7) * 8;
            float a0[8];
            conv8(U, cw, cb, seq0, Lseq, t0 + tt, ch0 + cg, a0);
            bf16_t* gp = G + (size_t)(seq0 + t0 + tt) * 512 + ch0 + cg;
            U8 gv; gv.u = *(const uint4*)gp;
            float o[8];
#pragma unroll
            for (int j = 0; j < 8; ++j) { const float gg = (j & 1) ? hi_bf(gv.w[j >> 1]) : lo_bf(gv.w[j >> 1]); o[j] = a0[j] * sm[(cg + j) * 65 + tt] * gg; }
            uint4 w; w.x = pk2(o[0], o[1]); w.y = pk2(o[2], o[3]); w.z = pk2(o[4], o[5]); w.w = pk2(o[6], o[7]);
            if (!p.dry) *(uint4*)gp = w;
        }
    }
}


constexpr int HYF_MT = 64;
DEVI void phase_hyf(const P& p, int l, float* sm) {
    const int tid = ltid();
    const float* HT = (const float*)(p.ws + OFF_HH3T) + (size_t)l * 64 * T;
    const float* wout = p.fwout + (size_t)l * 64 * 1024;
    bf16_t* K2 = (bf16_t*)(p.ws + OFF_K2);
    float* L1P = (float*)(p.ws + OFF_L1P);
    float* hs = sm;
    for (int task = blockIdx.x; task < T / HYF_MT; task += gridDim.x) {
        const int m0 = task * HYF_MT;
        __syncthreads();
        for (int e = tid; e < 64 * HYF_MT / 4; e += NTHR) { const int j = e / (HYF_MT / 4), c4 = (e % (HYF_MT / 4)) * 4; *(float4*)(hs + j * HYF_MT + c4) = *(const float4*)(HT + (size_t)j * T + m0 + c4); }
        __syncthreads();
        {
            const int ch = tid;
            const float delta = hy_delta(ch);
            float l1f = 0.f, l1b = 0.f;
#pragma unroll 1
            for (int mb = 0; mb < HYF_MT; mb += 16) {
                float af[16], ab[16];
#pragma unroll
                for (int u = 0; u < 16; ++u) { af[u] = 0.f; ab[u] = 0.f; }
#pragma unroll 2
                for (int j = 0; j < 64; ++j) {
                    const float wf = wout[j * 1024 + ch], wb = wout[j * 1024 + 512 + ch];
#pragma unroll
                    for (int u4 = 0; u4 < 4; ++u4) {
                        const float4 h = *(const float4*)(hs + j * HYF_MT + mb + u4 * 4);
                        af[u4 * 4 + 0] += h.x * wf; af[u4 * 4 + 1] += h.y * wf; af[u4 * 4 + 2] += h.z * wf; af[u4 * 4 + 3] += h.w * wf;
                        ab[u4 * 4 + 0] += h.x * wb; ab[u4 * 4 + 1] += h.y * wb; ab[u4 * 4 + 2] += h.z * wb; ab[u4 * 4 + 3] += h.w * wb;
                    }
                }
#pragma unroll
                for (int u = 0; u < 16; ++u) {
                    const int m = m0 + mb + u;
                    const float dec = expf(-((float)m / (float)(T - 1)) * delta);
                    af[u] *= dec; ab[u] *= dec;
                    l1f += fabsf(af[u]); l1b += (m == 0) ? 0.f : fabsf(ab[u]);
                }
                uint4 o;
                o.x = pk2(af[0], af[1]); o.y = pk2(af[2], af[3]); o.z = pk2(af[4], af[5]); o.w = pk2(af[6], af[7]);
                *(uint4*)(K2 + (size_t)ch * T + m0 + mb) = o;
                o.x = pk2(af[8], af[9]); o.y = pk2(af[10], af[11]); o.z = pk2(af[12], af[13]); o.w = pk2(af[14], af[15]);
                *(uint4*)(K2 + (size_t)ch * T + m0 + mb + 8) = o;
                o.x = pk2(ab[0], ab[1]); o.y = pk2(ab[2], ab[3]); o.z = pk2(ab[4], ab[5]); o.w = pk2(ab[6], ab[7]);
                *(uint4*)(K2 + (size_t)(512 + ch) * T + m0 + mb) = o;
                o.x = pk2(ab[8], ab[9]); o.y = pk2(ab[10], ab[11]); o.z = pk2(ab[12], ab[13]); o.w = pk2(ab[14], ab[15]);
                *(uint4*)(K2 + (size_t)(512 + ch) * T + m0 + mb + 8) = o;
            }
            L1P[(size_t)task * 1024 + ch] = l1f;
            L1P[(size_t)task * 1024 + 512 + ch] = l1b;
        }
    }
}
DEVI void phase_hy2(const P& p, int l, unsigned char* smem) {
    unsigned char* scr = p.ws + OFF_SCR;
    const int tid = ltid();
    float* Ff = (float*)smem; float2* F2 = (float2*)smem;
    float* red = (float*)(smem + (size_t)LFP * 8);
    float* spec = red + 16;
    const float* HT = (const float*)(p.ws + OFF_HH3T) + (size_t)l * 64 * T;
    const float* HC = (const float*)(p.ws + OFF_HH3C);
    const float* wout = p.fwout + (size_t)l * 64 * 1024;
    const int ntask = 512 + (l == 0 ? 512 : 0);
    for (int task = blockIdx.x; task < ntask; task += gridDim.x) {
        __syncthreads();
        if (task < 512) {
            const int ch = task;
            const float delta = hy_delta(ch);
            float l1 = 0.f;
            {
                const bf16_t* K2 = (const bf16_t*)(p.ws + OFF_K2);
                const float* L1P = (const float*)(p.ws + OFF_L1P);
                if (tid < 2 * (T / HYF_MT)) { const int side = tid / (T / HYF_MT), tk = tid % (T / HYF_MT); l1 = L1P[(size_t)tk * 1024 + side * 512 + ch]; }
#pragma unroll
                for (int i = 0; i < 4; ++i) {
                    const int m = (tid + NTHR * i) * 8;
                    U8 hf, hb; hf.u = *(const uint4*)(K2 + (size_t)ch * T + m); hb.u = *(const uint4*)(K2 + (size_t)(512 + ch) * T + m);
#pragma unroll
                    for (int u = 0; u < 8; ++u) {
                        const float af = (u & 1) ? hi_bf(hf.w[u >> 1]) : lo_bf(hf.w[u >> 1]);
                        const float ab = (u & 1) ? hi_bf(hb.w[u >> 1]) : lo_bf(hb.w[u >> 1]);
                        const int mm = m + u;
                        Ff[FIDX(mm)] = af;
                        if (mm >= 1) Ff[FIDX(2 * T - mm)] = ab; else Ff[FIDX(T)] = 0.f;
                    }
                }
            }
            l1 = block_sum(l1, red);
            __syncthreads();
            fft_fwd(F2);
            const float scale = 1.0f / ((float)LF * l1);
            float4* KF = (float4*)(p.ws + OFF_KF) + (size_t)blockIdx.x * 8192;
#pragma unroll 2
            for (int i = 0; i < 16; ++i) {
                const int k = tid + NTHR * i;
                const float2 ck = F2[CIDX(rev14(k))], cm = F2[CIDX(rev14((LF - k) & (LF - 1)))];
                KF[k] = make_float4((ck.x + cm.x) * 0.5f * scale, (ck.y - cm.y) * 0.5f * scale, (ck.y + cm.y) * 0.5f * scale, -(ck.x - cm.x) * 0.5f * scale);
            }
            if (tid == 0) { const float2 c = F2[CIDX(1)]; spec[0] = c.x * scale; spec[1] = c.y * scale; }
            const float fb = p.fbias[l * 512 + ch];
#pragma unroll 1
            for (int b = 0; b < NB; ++b) {
                float* zt = (float*)(scr + SD_ZT) + ((size_t)b * 512 + ch) * T;
                __syncthreads();
#pragma unroll
                for (int i = 0; i < 8; ++i) {
                    const int e = (tid + NTHR * i) * 4;
                    const float4 zv = *(const float4*)(zt + e);
                    const int c0 = CIDX(e >> 1), c1 = CIDX((T + e) >> 1);
                    F2[c0] = make_float2(zv.x, zv.y); F2[c0 + 1] = make_float2(zv.z, zv.w);
                    F2[c1] = make_float2(0.f, 0.f); F2[c1 + 1] = make_float2(0.f, 0.f);
                }
                __syncthreads();
                fft_fwd(F2);
#pragma unroll 2
                for (int i = 0; i < 16; ++i) {
                    const int k = tid + NTHR * i;
                    const int pk = CIDX(rev14(k)), pm = CIDX(rev14((LF - k) & (LF - 1)));
                    const float2 ck = F2[pk], cm = F2[pm];
                    const float4 kf = KF[k];
                    const float2 He = make_float2(kf.x, kf.y), Ho = make_float2(kf.z, kf.w);
                    const float2 E = make_float2((ck.x + cm.x) * 0.5f, (ck.y - cm.y) * 0.5f);
                    const float2 O = make_float2((ck.y + cm.y) * 0.5f, -(ck.x - cm.x) * 0.5f);
                    float2 w2 = twid((float)k * (1.0f / (float)LF)); w2.y = -w2.y;
                    const float2 Ye = cadd(cmul(E, He), cmul(w2, cmul(O, Ho)));
                    const float2 Yo = cadd(cmul(E, Ho), cmul(O, He));
                    F2[pk] = make_float2(Ye.x - Yo.y, Ye.y + Yo.x);
                    F2[pm] = make_float2(Ye.x + Yo.y, -Ye.y + Yo.x);
                }
                if (tid == 0) {
                    const float2 c = F2[CIDX(1)]; const float he = spec[0], ho = spec[1];
                    F2[CIDX(1)] = make_float2(c.x * he - c.y * ho, c.x * ho + c.y * he);
                }
                __syncthreads();
                fft_inv(F2);
#pragma unroll
                for (int i = 0; i < 8; ++i) {
                    const int e = (tid + NTHR * i) * 4;
                    const float4 zv = *(const float4*)(zt + e);
                    const int c0 = CIDX(e >> 1);
                    const float2 y0 = F2[c0], y1 = F2[c0 + 1];
                    const float4 yv = make_float4(y0.x, y0.y, y1.x, y1.y);
                    if (!p.dry) *(float4*)(zt + e) = make_float4(yv.x + zv.x * fb, yv.y + zv.y * fb, yv.z + zv.z * fb, yv.w + zv.w * fb);
                }
            }
        } else {
            const int ch = task - 512;
            const float delta = hy_delta(ch);
            float* hf = Ff; float* hb = Ff + 256; float* zs = Ff + 512;
            {
                const int m = tid & 255, side = tid >> 8;
                float a = 0.f;
#pragma unroll 4
                for (int j = 0; j < 64; ++j) a += HC[j * CL + m] * wout[j * 1024 + side * 512 + ch];
                a *= expf(-((float)m / (float)(CL - 1)) * delta);
                Ff[side * 256 + m] = a;
                float l1 = (side == 1 && m == 0) ? 0.f : fabsf(a);
                zs[tid] = ((const float*)(scr + SD_ZTC))[((size_t)(tid >> 8) * 512 + ch) * CL + (tid & 255)];
                l1 = block_sum(l1, red);
                const int b = tid >> 8, t = tid & 255;
                float y = 0.f;
#pragma unroll 4
                for (int s = 0; s <= t; ++s) y += zs[b * 256 + s] * hf[t - s];
#pragma unroll 4
                for (int s = t + 1; s < CL; ++s) y += zs[b * 256 + s] * hb[s - t];
                const float fb = p.fbias[l * 512 + ch];
                if (!p.dry) ((float*)(scr + SD_ZTC))[((size_t)b * 512 + ch) * CL + t] = y / l1 + zs[tid] * fb;
            }
        }
    }
}

constexpr int NPH = 32;
#ifndef ONLY
#define ONLY -1
#endif
#define CASE(n) case n: if (ONLY < 0 || ONLY == n)
DEVI void run_phase(const P& p, int ph, unsigned char* smem) {
    if (ph == 0) { if (ONLY < 0 || ONLY == 100) phase_prep(p, (float*)smem); return; }
    if (ph == NPH - 1) { if (ONLY < 0 || ONLY == 101) phase_final(p); return; }
    const int l = (ph - 1) / 15, k = (ph - 1) % 15;
    switch (k) {
        CASE(0) phase_hl(p, l); break;
        CASE(1) phase_inproj<0>(p, l, (bf16_t*)smem); break;
        CASE(2) phase_att_a(p, l, (float*)smem); break;
        CASE(3) phase_inproj<1>(p, l, (bf16_t*)smem); break;
        CASE(4) phase_att_b(p, l); break;
        CASE(5) phase_inproj<2>(p, l, (bf16_t*)smem); break;
        CASE(6) phase_gla1(p, l, smem); break;
        CASE(7) phase_gla2(p); break;
        CASE(8) phase_gla3(p, l, smem); break;
        CASE(9) phase_inproj<3>(p, l, (bf16_t*)smem); break;
        CASE(10) { phase_hyf(p, l, (float*)smem); phase_hy1(p, l, (float*)smem); } break;
        CASE(11) phase_hy2(p, l, smem); break;
        CASE(12) phase_hy3(p, l, (float*)smem); break;
        CASE(13) phase_merge(p, l, (bf16_t*)smem); break;
        CASE(14) phase_out(p, l, (bf16_t*)smem); break;
    }
}

#define XB_TMO      128
#define XB_XCNT(j)  (256  + 64 * (j))
#define XB_XSUB(j)  (1280 + 64 * (j))
#define XB_XGEN(j)  (2304 + 64 * (j))
#define XB_TOP      3328
#define XB_TOPGEN   3392
#define XCD_BAR_WORDS 3456
#define XB_SPIN_CAP (1u << 18)
#define LAS __attribute__((address_space(3)))
DEVI unsigned xb_ld(unsigned* p)              { return __hip_atomic_load(p, __ATOMIC_RELAXED, __HIP_MEMORY_SCOPE_AGENT); }
DEVI unsigned xb_add(unsigned* p, unsigned v) { return __hip_atomic_fetch_add(p, v, __ATOMIC_RELAXED, __HIP_MEMORY_SCOPE_AGENT); }
DEVI unsigned xb_xcc_id() { return (unsigned)__builtin_amdgcn_s_getreg((3 << 11) | 20) & 0xFu; }
#define XB_SPIN(cond, bar) do { unsigned _sp = 0; while (cond) { __builtin_amdgcn_s_sleep(1); \
    if ((++_sp & 255u) == 0u) { if (xb_ld(&(bar)[XB_TMO])) break; if (_sp > XB_SPIN_CAP) { atomicAdd(&(bar)[XB_TMO], 1u); break; } } } } while (0)
struct XcdBarrier { unsigned* bar; unsigned x; volatile LAS unsigned* st; };
DEVI XcdBarrier xcd_barrier_post(unsigned* bar, volatile LAS unsigned* st) {
    XcdBarrier b; b.bar = bar; b.x = xb_xcc_id(); b.st = st;
    if (threadIdx.x == 0) (void)xb_add(&bar[XB_XCNT(b.x)], 1u);
    return b;
}
DEVI void xcd_barrier_complete(unsigned* bar, unsigned x, unsigned& nloc, unsigned& nx) {
    const unsigned G = gridDim.x * gridDim.y * gridDim.z;
    unsigned sum, cnt, mine, sp = 0u;
    for (;;) {
        sum = 0u; cnt = 0u; mine = 0u;
#pragma unroll
        for (unsigned j = 0; j < 16; ++j) { const unsigned c = xb_ld(&bar[XB_XCNT(j)]); sum += c; cnt += (c > 0u) ? 1u : 0u; mine = (j == x) ? c : mine; }
        if (sum == G) break;
        __builtin_amdgcn_s_sleep(1);
        if ((++sp & 255u) == 0u) { if (xb_ld(&bar[XB_TMO])) break; if (sp > XB_SPIN_CAP) { atomicAdd(&bar[XB_TMO], 1u); break; } }
    }
    nloc = mine > 0u ? mine : 1u; nx = cnt > 0u ? cnt : 1u;
}
DEVI void xcd_barrier(const XcdBarrier& b) {
    asm volatile("s_waitcnt vmcnt(0)" ::: "memory");
    __syncthreads();
    if (threadIdx.x == 0) {
        unsigned* bar = b.bar;
        __builtin_amdgcn_s_waitcnt(0);
        unsigned nloc = b.st[0], nx = b.st[1];
        if (nloc == 0u) { xcd_barrier_complete(bar, b.x, nloc, nx); b.st[0] = nloc; b.st[1] = nx; }
        const unsigned old = xb_add(&bar[XB_XSUB(b.x)], 1u);
        const unsigned gen = old / nloc;
        if (old + 1u == (gen + 1u) * nloc) {
            __builtin_amdgcn_fence(__ATOMIC_RELEASE, "agent");
            asm volatile("s_waitcnt vmcnt(0)" ::: "memory");
            const unsigned og = xb_add(&bar[XB_TOP], 1u);
            const unsigned tg = og / nx;
            if (og + 1u == (tg + 1u) * nx) xb_add(&bar[XB_TOPGEN], 1u);
            else XB_SPIN(xb_ld(&bar[XB_TOPGEN]) == tg, bar);
            __builtin_amdgcn_fence(__ATOMIC_ACQUIRE, "agent");
            xb_add(&bar[XB_XGEN(b.x)], 1u);
            asm volatile("s_waitcnt vmcnt(0)" ::: "memory");
        } else {
            XB_SPIN(xb_ld(&bar[XB_XGEN(b.x)]) == gen, bar);
            __builtin_amdgcn_fence(__ATOMIC_ACQUIRE, "agent");
            asm volatile("s_waitcnt vmcnt(0)" ::: "memory");
        }
    }
    __syncthreads();
}
constexpr size_t OFF_BAR = WS_END + 1024;
constexpr size_t WS_TOTAL = OFF_BAR + XCD_BAR_WORDS * 4;

__global__ void __launch_bounds__(NTHR) mega(P p) {
    extern __shared__ __attribute__((aligned(16))) unsigned char smem[];
    cg::grid_group grid = cg::this_grid();
#ifndef DBL_MASK
#define DBL_MASK 0
#endif
#ifdef TIMING_A
    unsigned long long* ts = (unsigned long long*)(p.ws + WS_END);
    if (blockIdx.x == 0 && threadIdx.x == 0) ts[0] = __builtin_amdgcn_s_memrealtime();
#endif
    volatile LAS unsigned* xst = (volatile LAS unsigned*)(smem + LDS_BYTES - 16);
    if (threadIdx.x == 0) { xst[0] = 0u; xst[1] = 0u; }
    __syncthreads();
    XcdBarrier xb = xcd_barrier_post((unsigned*)(p.ws + OFF_BAR), xst);
#define GRID_SYNC(ph_) do { if ((ph_) == 0) grid.sync(); else xcd_barrier(xb); } while (0)
    for (int ph = p.ph_lo; ph < p.ph_hi; ++ph) {
        if (DBL_MASK != 0 && ph > 0 && ph < NPH - 1 && ((DBL_MASK >> ((ph - 1) % 15)) & 1)) { P pd = p; int one_ = 1; asm volatile("" : "+s"(one_)); pd.dry = one_; run_phase(pd, ph, smem); GRID_SYNC(1); }
        run_phase(p, ph, smem);
#ifdef TIMING_A
        GRID_SYNC(ph);
        if (blockIdx.x == 0 && threadIdx.x == 0) ts[ph + 1] = __builtin_amdgcn_s_memrealtime();
#else
        if (ph + 1 < p.ph_hi) GRID_SYNC(ph);
#endif
    }
}

#ifdef DIAG_OFF
__global__ void diag_dump(const unsigned char* src, float* out, size_t n) {
    for (size_t i = (size_t)blockIdx.x * blockDim.x + threadIdx.x; i < n; i += (size_t)gridDim.x * blockDim.x) {
#if DIAG_F32
        out[i] = ((const float*)src)[i % (size_t)(DIAG_N)];
#else
        { float v = bf2f(((const bf16_t*)src)[i % (size_t)(DIAG_N)]);
#ifdef EXP_FIN
          if (!(fabsf(v) < 1e30f)) v = 12345.f;
#endif
          out[i] = v; }
#endif
    }
}
#endif
#ifdef TIMING_A
__global__ void timing_tail(const unsigned long long* ts, float* out) {
    float grp[8] = {0, 0, 0, 0, 0, 0, 0, 0};
    const float total = (float)(ts[NPH] - ts[0]);
    for (int ph = 0; ph < NPH; ++ph) {
        const float dt = (float)(ts[ph + 1] - ts[ph]);
        int gi;
        if (ph == 0) gi = 5; else if (ph == NPH - 1) gi = 6;
        else { const int k = (ph - 1) % 15; gi = (k == 1 || k == 3 || k == 5 || k == 9) ? 0 : (k == 13) ? 1 : (k == 2 || k == 4) ? 2 : (k >= 6 && k <= 8) ? 3 : (k >= 10 && k <= 12) ? 4 : (k == 14) ? 7 : 6; }
#pragma unroll
        for (int q = 0; q < 8; ++q) grp[q] += (gi == q) ? dt : 0.f;
    }
    float fa = 0.f, fb = 0.f;
#pragma unroll
    for (int q = 0; q < 8; ++q) { fa += (q == TIMING_A) ? grp[q] : 0.f; fb += (q == TIMING_B) ? grp[q] : 0.f; }
    const float e1 = 1000.f * fa / total, e2 = 50.f * fb / total;
    if (blockIdx.x == 0 && threadIdx.x == 0) out[0] += e1;
    for (size_t i = (size_t)blockIdx.x * blockDim.x + threadIdx.x; i < (size_t)1048576; i += (size_t)gridDim.x * blockDim.x) out[D + i] += e2;
}
#endif
extern "C" void kernel_launch(void* const* d_in, const int* in_sizes, int n_in, void* d_out, int out_size, void* d_ws, size_t ws_size, hipStream_t stream) {
    static int grid = 0;
    if (grid == 0) {
        if (n_in != 27 || ws_size < WS_TOTAL) { fprintf(stderr, "kernel_launch: unexpected n_in %d or ws_size %zu (need %zu)\n", n_in, ws_size, (size_t)WS_TOTAL); grid = -1; return; }
        int dev = 0, cus = 0, per_cu = 0;
        hipGetDevice(&dev);
        hipDeviceGetAttribute(&cus, hipDeviceAttributeMultiprocessorCount, dev);
        if (hipFuncSetAttribute((const void*)mega, hipFuncAttributeMaxDynamicSharedMemorySize, LDS_BYTES) != hipSuccess) { fprintf(stderr, "kernel_launch: hipFuncSetAttribute failed\n"); grid = -1; return; }
        if (hipOccupancyMaxActiveBlocksPerMultiprocessor(&per_cu, (const void*)mega, NTHR, LDS_BYTES) != hipSuccess || per_cu < 1) { fprintf(stderr, "kernel_launch: occupancy query failed (%d)\n", per_cu); grid = -1; return; }
        grid = cus * per_cu; if (grid > MAXGRID) grid = MAXGRID;
        fprintf(stderr, "kernel_launch: grid %d (cus %d x %d)\n", grid, cus, per_cu);
    }
    if (grid < 0) return;
    P p{};
    const float** pp = (const float**)&p;
    for (int i = 0; i < 27; ++i) pp[i] = (const float*)d_in[i];
    p.out = (float*)d_out; p.ws = (unsigned char*)d_ws; p.dry = 0; p.pad_ = 0;
#if N_LAUNCH_MODE == 1
    p.ph_lo = 0; p.ph_hi = NPH;
    if (hipMemsetAsync((unsigned char*)d_ws + OFF_BAR, 0, XCD_BAR_WORDS * 4, stream) != hipSuccess) { fprintf(stderr, "kernel_launch: memset of barrier words failed\n"); return; }
    void* args[] = {&p};
    hipError_t e = hipLaunchCooperativeKernel((const void*)mega, dim3(grid), dim3(NTHR), args, LDS_BYTES, stream);
    if (e != hipSuccess) fprintf(stderr, "cooperative launch failed: %s (grid %d)\n", hipGetErrorString(e), grid);
#ifdef TIMING_A
    hipLaunchKernelGGL(timing_tail, dim3(256), dim3(256), 0, stream, (const unsigned long long*)((unsigned char*)d_ws + WS_END), (float*)d_out);
#endif
#else
#ifndef DIAG_STOP
#define DIAG_STOP NPH
#endif
    for (int ph = 0; ph < DIAG_STOP; ++ph) {
        p.ph_lo = ph; p.ph_hi = ph + 1;
        hipLaunchKernelGGL(mega, dim3(grid), dim3(NTHR), LDS_BYTES, stream, p);
    }
#ifdef DIAG_OFF
    hipLaunchKernelGGL(diag_dump, dim3(1024), dim3(256), 0, stream, (const unsigned char*)d_ws + (size_t)(DIAG_OFF), (float*)d_out, (size_t)out_size);
#endif
#endif
}
```

```cpp
#include <hip/hip_runtime.h>
#include <hip/hip_cooperative_groups.h>
#include <cstdio>
#include <cstdint>
namespace cg = cooperative_groups;

#ifndef N_LAUNCH_MODE
#define N_LAUNCH_MODE 1
#endif

#define DEVI __device__ __forceinline__
typedef unsigned short bf16_t;
typedef short bf16x8 __attribute__((ext_vector_type(8)));
typedef float f32x4 __attribute__((ext_vector_type(4)));
typedef float f32x16 __attribute__((ext_vector_type(16)));

constexpr int D = 1024, T = 16384, NB = 2, NL = NB * T, CL = 256, NC = NB * CL, NR = NL + NC;
constexpr int IN_TOTAL = 11040;
constexpr int COL_A = 0, COL_B = 2048, COL_C = 3328, COL_D = 4896, COL_GM = 6944;
constexpr float EPS = 1e-6f;
constexpr int NTHR = 512;
constexpr int LDS_BYTES = 140 * 1024;

constexpr size_t al256(size_t x) { return (x + 255) & ~(size_t)255; }
constexpr size_t OFF_MOD = 0;
constexpr size_t OFF_ROPE = al256(OFF_MOD + (size_t)2 * 3 * 3072 * 4);
constexpr size_t OFF_HH3T = al256(OFF_ROPE + (size_t)2 * T * 32 * 4);
constexpr size_t OFF_HH3C = al256(OFF_HH3T + (size_t)2 * 64 * T * 4);
constexpr size_t OFF_XC1 = al256(OFF_HH3C + (size_t)64 * CL * 4);
constexpr size_t OFF_WINT = al256(OFF_XC1 + (size_t)NC * D * 4);
constexpr size_t OFF_WBT = al256(OFF_WINT + (size_t)2 * IN_TOTAL * D * 2);
constexpr size_t OFF_WOT = al256(OFF_WBT + (size_t)2 * 4 * D * 512 * 2);
constexpr size_t OFF_HL = al256(OFF_WOT + (size_t)2 * D * D * 2);
constexpr size_t OFF_YS = al256(OFF_HL + (size_t)NR * D * 2);
constexpr size_t SZ512 = (size_t)NR * 512 * 2, SZ256 = (size_t)NR * 256 * 2, SZ128 = (size_t)NR * 128 * 2;
constexpr size_t OFF_SCR = al256(OFF_YS + 4 * SZ512);
constexpr size_t SA_Q = 0, SA_K = SZ512, SA_VT = 2 * SZ512;
constexpr size_t SB_Q = 0, SB_K = SZ512, SB_VT = SZ512 + SZ128;
constexpr size_t SC_Q = 0, SC_K = SZ256, SC_VT = 2 * SZ256, SC_LR = 2 * SZ256 + SZ512;
constexpr size_t SC_SB = al256(SC_LR + (size_t)NR * 32 * 4);
constexpr int NCH = 260;
constexpr size_t SC_GD = al256(SC_SB + (size_t)16 * NCH * 8192 * 2);
constexpr size_t SD_U = 0, SD_ZT = al256((size_t)NR * 1536 * 2), SD_ZTC = al256(SD_ZT + (size_t)NB * 512 * T * 4);
constexpr size_t SD_END = al256(SD_ZTC + (size_t)NB * 512 * CL * 4);
constexpr size_t OFF_KF = OFF_SCR + SD_END;
constexpr int MAXGRID = 256;
constexpr size_t OFF_K2 = al256(OFF_KF + (size_t)MAXGRID * 8192 * 16);
constexpr size_t OFF_L1P = al256(OFF_K2 + (size_t)1024 * T * 2);
constexpr size_t WS_END = al256(OFF_L1P + (size_t)(T / 64) * 1024 * 4);

struct P {
    const float *x, *c, *ctx, *c_ctx, *norm_w, *w_mod, *b_mod, *w_in, *rpb, *sink, *w_alpha_up, *b_alpha, *gla_norm_w,
        *conv_w, *conv_b, *fw1, *fb1, *fw2, *fb2, *fw3, *fb3, *ffreq, *fwout, *fbias, *w_branch, *w_out, *final_norm_w;
    float* out;
    unsigned char* ws;
    int ph_lo, ph_hi;
    int dry, pad_;
};

DEVI int ltid() { int t = threadIdx.x; asm volatile("" : "+v"(t)); return t; }
DEVI float bf2f(bf16_t v) { return __uint_as_float(((unsigned)v) << 16); }
typedef __bf16 bf16v2 __attribute__((ext_vector_type(2)));
typedef float f32v2 __attribute__((ext_vector_type(2)));
DEVI unsigned pk2(float lo, float hi) { f32v2 v = {lo, hi}; bf16v2 b = __builtin_convertvector(v, bf16v2); return __builtin_bit_cast(unsigned, b); }
DEVI bf16_t f2bf(float f) { return (bf16_t)(pk2(f, 0.f) & 0xffff); }
DEVI float lo_bf(unsigned u) { return __uint_as_float(u << 16); }
DEVI float hi_bf(unsigned u) { return __uint_as_float(u & 0xffff0000u); }
DEVI float siluf(float v) { return v / (1.f + __expf(-v)); }
DEVI float sigmf(float v) { return 1.f / (1.f + __expf(-v)); }
DEVI void row_decode(int row, int& b, int& t, bool& isctx) {
    if (row < NL) { b = row >> 14; t = row & (T - 1); isctx = false; }
    else { int r = row - NL; b = r >> 8; t = r & (CL - 1); isctx = true; }
}
DEVI float wave_sum(float v) {
#pragma unroll
    for (int o = 32; o >= 1; o >>= 1) v += __shfl_xor(v, o);
    return v;
}
DEVI float block_sum(float v, float* red  ) {
    v = wave_sum(v);
    __syncthreads();
    if ((ltid() & 63) == 0) red[ltid() >> 6] = v;
    __syncthreads();
    float s = 0.f;
#pragma unroll
    for (int i = 0; i < NTHR / 64; ++i) s += red[i];
    return s;
}

constexpr int LSTR = 72;
constexpr int GA_EL = 256 * LSTR, GB_EL = 128 * LSTR;
template <int NT> struct GAcc { f32x16 a[2][NT]; };

template <int NT, int DEPTH = 1>
DEVI void gemm_kloop(const bf16_t* __restrict__ A, int lda, const bf16_t* __restrict__ Bt, int ldb, int K, int m0, int n0,
                     bf16_t* sm, GAcc<NT>& acc) {
    const int tid = ltid(), lane = tid & 63, wave = tid >> 6, wm = wave >> 1, wn = wave & 1;
    const int lr = tid >> 3, lc = tid & 7;
    const char* Ab = (const char*)(A + (size_t)m0 * lda); const char* Bb = (const char*)(Bt + (size_t)n0 * ldb);
    const unsigned aoff = (unsigned)(lr * lda + lc * 8) * 2u, boff = (unsigned)(lr * ldb + lc * 8) * 2u;
    uint4 xa0, xa1, xa2, xa3, xb0, xb1 = {0, 0, 0, 0};
    uint4 ya0, ya1, ya2, ya3, yb0, yb1 = {0, 0, 0, 0};
    const int KT = K / 64;
    const int frow = lane & 31, fk = (lane >> 5) * 8;
    const unsigned sa64 = 128u * (unsigned)lda, sb64 = 128u * (unsigned)ldb;
#define GLOAD(P, KTI) { const unsigned ko_ = (unsigned)(KTI) * 128u; P##a0 = *(const uint4*)(Ab + (aoff + ko_)); P##a1 = *(const uint4*)(Ab + (aoff + sa64 + ko_)); P##a2 = *(const uint4*)(Ab + (aoff + 2 * sa64 + ko_)); \
                        P##a3 = *(const uint4*)(Ab + (aoff + 3 * sa64 + ko_)); P##b0 = *(const uint4*)(Bb + (boff + ko_)); if constexpr (NT > 1) P##b1 = *(const uint4*)(Bb + (boff + sb64 + ko_)); }
#define LWRITE(P, BUF) { bf16_t* wa_ = sm + (BUF) * (GA_EL + GB_EL) + lr * LSTR + lc * 8; bf16_t* wb_ = wa_ + GA_EL; \
                        *(uint4*)(wa_) = P##a0; *(uint4*)(wa_ + 64 * LSTR) = P##a1; *(uint4*)(wa_ + 128 * LSTR) = P##a2; *(uint4*)(wa_ + 192 * LSTR) = P##a3; \
                        *(uint4*)(wb_) = P##b0; if constexpr (NT > 1) *(uint4*)(wb_ + 64 * LSTR) = P##b1; }
    auto compute = [&](int buf) {
        const bf16_t* sa = sm + buf * (GA_EL + GB_EL) + (wm * 64 + frow) * LSTR + fk;
        const bf16_t* sb = sm + buf * (GA_EL + GB_EL) + GA_EL + (wn * 32 * NT + frow) * LSTR + fk;
#pragma unroll
        for (int ks = 0; ks < 4; ++ks) {
            bf16x8 tf[2], cf[NT];
#pragma unroll
            for (int mt = 0; mt < 2; ++mt) tf[mt] = *(const bf16x8*)(sa + mt * 32 * LSTR + ks * 16);
#pragma unroll
            for (int nt = 0; nt < NT; ++nt) cf[nt] = *(const bf16x8*)(sb + nt * 32 * LSTR + ks * 16);
#pragma unroll
            for (int mt = 0; mt < 2; ++mt)
#pragma unroll
                for (int nt = 0; nt < NT; ++nt)
                    acc.a[mt][nt] = __builtin_amdgcn_mfma_f32_32x32x16_bf16(cf[nt], tf[mt], acc.a[mt][nt], 0, 0, 0);
        }
    };
    __syncthreads();
    if constexpr (DEPTH == 1) {
        GLOAD(x, 0); LWRITE(x, 0); GLOAD(x, 1);
        __syncthreads();
        for (int kt = 0; kt < KT; ++kt) {
            if (kt + 1 < KT) LWRITE(x, (kt + 1) & 1);
            if (kt + 2 < KT) GLOAD(x, kt + 2);
            compute(kt & 1);
            __syncthreads();
        }
    } else {
        GLOAD(x, 0); LWRITE(x, 0); GLOAD(x, 1); GLOAD(y, 2);
        __syncthreads();
        for (int kt = 0; kt < KT; kt += 2) {
            LWRITE(x, 1);
            if (kt + 3 < KT) GLOAD(x, kt + 3);
            compute(0);
            __syncthreads();
            if (kt + 2 < KT) LWRITE(y, 0);
            if (kt + 4 < KT) GLOAD(y, kt + 4);
            compute(1);
            __syncthreads();
        }
    }
#undef GLOAD
#undef LWRITE
}
DEVI int tile_of(int it) {
    const int per = gridDim.x >> 3;
    if ((gridDim.x & 7) != 0 || per == 0) return it * gridDim.x + blockIdx.x;
    return it * gridDim.x + (blockIdx.x & 7) * per + (blockIdx.x >> 3);
}
template <int NT> DEVI void acc_zero(GAcc<NT>& acc) {
#pragma unroll
    for (int mt = 0; mt < 2; ++mt)
#pragma unroll
        for (int nt = 0; nt < NT; ++nt)
#pragma unroll
            for (int i = 0; i < 16; ++i) acc.a[mt][nt][i] = 0.f;
}
template <int NT, class F> DEVI void acc_foreach(const GAcc<NT>& acc, int m0, int n0, F f) {
    const int lane = ltid() & 63, wave = ltid() >> 6, wm = wave >> 1, wn = wave & 1;
#pragma unroll
    for (int mt = 0; mt < 2; ++mt) {
        const int row = m0 + wm * 64 + mt * 32 + (lane & 31);
#pragma unroll
        for (int nt = 0; nt < NT; ++nt)
#pragma unroll
            for (int q = 0; q < 4; ++q) {
                const int col = n0 + wn * 32 * NT + nt * 32 + q * 8 + (lane >> 5) * 4;
                f(row, col, acc.a[mt][nt][q * 4 + 0], acc.a[mt][nt][q * 4 + 1], acc.a[mt][nt][q * 4 + 2], acc.a[mt][nt][q * 4 + 3]);
            }
    }
}
constexpr int EST = 68;
template <int NT> DEVI void epi_stage(const GAcc<NT>& acc, int mt, float* reg) {
    const int lane = ltid() & 63;
    __syncthreads();
#pragma unroll
    for (int nt = 0; nt < NT; ++nt)
#pragma unroll
        for (int q = 0; q < 4; ++q) {
            float4 w = {acc.a[mt][nt][q * 4 + 0], acc.a[mt][nt][q * 4 + 1], acc.a[mt][nt][q * 4 + 2], acc.a[mt][nt][q * 4 + 3]};
            *(float4*)(reg + (lane & 31) * EST + nt * 32 + q * 8 + (lane >> 5) * 4) = w;
        }
    __syncthreads();
}
template <int NT, class F> DEVI void epi_rows8(const float* reg, F f) {
    const int lane = ltid() & 63;
#pragma unroll
    for (int it = 0; it < 2 * NT; ++it) {
        const int idx = it * 64 + lane, rl = idx / (NT * 4), ch = idx % (NT * 4);
        const float4 a = *(const float4*)(reg + rl * EST + ch * 8), b = *(const float4*)(reg + rl * EST + ch * 8 + 4);
        f(rl, ch * 8, a, b);
    }
}
DEVI void st8bf(bf16_t* p, float4 a, float4 b) { uint4 w; w.x = pk2(a.x, a.y); w.y = pk2(a.z, a.w); w.z = pk2(b.x, b.y); w.w = pk2(b.z, b.w); *(uint4*)p = w; }
DEVI float4 silu4(float4 a) { return make_float4(siluf(a.x), siluf(a.y), siluf(a.z), siluf(a.w)); }
template <int H, int DH> DEVI void epi_vt(const float* reg, bf16_t* VT, int row0  , int colv0) {
    const int lane = ltid() & 63;
    int b, t; bool ic; row_decode(row0, b, t, ic);
    const int tp = lane & 15, cg = lane >> 4;
#pragma unroll 4
    for (int it = 0; it < 16; ++it) {
        const int c = it * 4 + cg, colv = colv0 + c, h = colv / DH, d = colv % DH;
        const float v0 = reg[(2 * tp) * EST + c], v1 = reg[(2 * tp + 1) * EST + c];
        bf16_t* pp = ic ? (VT + (size_t)NB * H * DH * T + ((size_t)(b * H + h) * DH + d) * CL + t + 2 * tp) : (VT + ((size_t)(b * H + h) * DH + d) * T + t + 2 * tp);
        *(unsigned*)pp = pk2(v0, v1);
    }
}
DEVI void st4bf(bf16_t* p, float a, float b, float c, float d) { uint2 w; w.x = pk2(a, b); w.y = pk2(c, d); *(uint2*)p = w; }
template <int H, int DH> DEVI void store_vt(bf16_t* VT, int row, int colv, float v0, float v1, float v2, float v3) {
    int b, t; bool ic; row_decode(row, b, t, ic);
    const int h = colv / DH, d = colv % DH;
    bf16_t* p = ic ? (VT + (size_t)NB * H * DH * T + ((size_t)(b * H + h) * DH + d) * CL + t) : (VT + ((size_t)(b * H + h) * DH + d) * T + t);
    const size_t st = ic ? CL : T;
    p[0] = f2bf(v0); p[st] = f2bf(v1); p[2 * st] = f2bf(v2); p[3 * st] = f2bf(v3);
}

template <int BR>
DEVI void phase_inproj(const P& p, int l, bf16_t* sm) {
    unsigned char* ws = p.ws;
    const bf16_t* HL = (const bf16_t*)(ws + OFF_HL);
    constexpr int colbase = BR == 0 ? COL_A : BR == 1 ? COL_B : BR == 2 ? COL_C : COL_D;
    constexpr int N = BR == 0 ? 2048 : BR == 1 ? 1280 : BR == 2 ? 1568 : 2048;
    const bf16_t* Wt = (const bf16_t*)(ws + OFF_WINT) + ((size_t)l * IN_TOTAL + colbase) * D;
    unsigned char* scr = ws + OFF_SCR;
    bf16_t* YSb = (bf16_t*)(ws + OFF_YS + BR * SZ512);
    const float* rope = (const float*)(ws + OFF_ROPE);
    constexpr int tilesN = (N + 127) / 128;
    const int tilesM = (BR == 3 && l == 1) ? NL / 256 : NR / 256;
    for (int it = 0;; ++it) {
        const int tile = tile_of(it);
        if (it * (int)gridDim.x >= tilesM * tilesN) break;
        if (tile >= tilesM * tilesN) continue;
        const int tm = tile / tilesN, tn = tile % tilesN;
        const int m0 = tm * 256, n0 = tn * 128;
        GAcc<2> acc; acc_zero(acc);
        gemm_kloop<2, 1>(HL, D, Wt, D, D, m0, n0, sm, acc);
        const int lane = ltid() & 63, wave = ltid() >> 6, wm = wave >> 1, wn = wave & 1;
        float* reg = (float*)sm + wave * (32 * EST);
        const int cb = n0 + wn * 64;
#pragma unroll
        for (int mt = 0; mt < 2; ++mt) {
            epi_stage<2>(acc, mt, reg);
            const int rbase = m0 + wm * 64 + mt * 32;
            if constexpr (BR == 0) {
                bf16_t* Q = (bf16_t*)(scr + SA_Q); bf16_t* Kb = (bf16_t*)(scr + SA_K); bf16_t* VT = (bf16_t*)(scr + SA_VT);
                const int seg = cb >> 9, cc0 = cb & 511;
                if (seg == 2) epi_vt<8, 64>(reg, VT, rbase, cc0);
                else epi_rows8<2>(reg, [&](int rl, int cl, float4 a, float4 b) {
                    const size_t o = (size_t)(rbase + rl) * 512 + cc0 + cl;
                    if (seg == 0) st8bf(Q + o, a, b); else if (seg == 1) st8bf(Kb + o, a, b); else st8bf(YSb + o, silu4(a), silu4(b));
                });
            } else if constexpr (BR == 1) {
                bf16_t* Q = (bf16_t*)(scr + SB_Q); bf16_t* Kb = (bf16_t*)(scr + SB_K); bf16_t* VT = (bf16_t*)(scr + SB_VT);
                if (cb >= 640 && cb < 768) epi_vt<2, 64>(reg, VT, rbase, cb - 640);
                else epi_rows8<2>(reg, [&](int rl, int cl, float4 a, float4 b) {
                    const int row = rbase + rl;
                    if (cb < 640) {
                        if (row < NL) {
                            const float4 pa = *(const float4*)(reg + rl * EST + (cl ^ 32)), pb = *(const float4*)(reg + rl * EST + (cl ^ 32) + 4);
                            const int t = row & (T - 1), c = cl & 31;
                            const float4 c0 = *(const float4*)(rope + (size_t)t * 32 + c), c1 = *(const float4*)(rope + (size_t)t * 32 + c + 4);
                            const float4 s0 = *(const float4*)(rope + (size_t)T * 32 + (size_t)t * 32 + c), s1 = *(const float4*)(rope + (size_t)T * 32 + (size_t)t * 32 + c + 4);
                            if (cl < 32) {
                                a = make_float4(a.x * c0.x - pa.x * s0.x, a.y * c0.y - pa.y * s0.y, a.z * c0.z - pa.z * s0.z, a.w * c0.w - pa.w * s0.w);
                                b = make_float4(b.x * c1.x - pb.x * s1.x, b.y * c1.y - pb.y * s1.y, b.z * c1.z - pb.z * s1.z, b.w * c1.w - pb.w * s1.w);
                            } else {
                                a = make_float4(pa.x * s0.x + a.x * c0.x, pa.y * s0.y + a.y * c0.y, pa.z * s0.z + a.z * c0.z, pa.w * s0.w + a.w * c0.w);
                                b = make_float4(pb.x * s1.x + b.x * c1.x, pb.y * s1.y + b.y * c1.y, pb.z * s1.z + b.z * c1.z, pb.w * s1.w + b.w * c1.w);
                            }
                        }
                        if (cb < 512) st8bf(Q + (size_t)row * 512 + cb + cl, a, b);
                        else st8bf(Kb + (size_t)row * 128 + (cb - 512) + cl, a, b);
                    } else st8bf(YSb + (size_t)row * 512 + (cb - 768) + cl, silu4(a), silu4(b));
                });
            } else if constexpr (BR == 2) {
                bf16_t* Q = (bf16_t*)(scr + SC_Q); bf16_t* Kb = (bf16_t*)(scr + SC_K); bf16_t* VT = (bf16_t*)(scr + SC_VT);
                float* LR = (float*)(scr + SC_LR);
                if (cb >= 512 && cb < 1024) epi_vt<4, 128>(reg, VT, rbase, cb - 512);
                else epi_rows8<2>(reg, [&](int rl, int cl, float4 a, float4 b) {
                    const int row = rbase + rl, col = cb + cl;
                    if (col < 256) { const float sc = 0.125f; st8bf(Q + (size_t)row * 256 + col, make_float4(a.x * sc, a.y * sc, a.z * sc, a.w * sc), make_float4(b.x * sc, b.y * sc, b.z * sc, b.w * sc)); }
                    else if (col < 512) st8bf(Kb + (size_t)row * 256 + (col - 256), a, b);
                    else if (col < 1056) { *(float4*)(LR + (size_t)row * 32 + (col - 1024)) = a; *(float4*)(LR + (size_t)row * 32 + (col - 1024) + 4) = b; }
                    else if (col < 1568) st8bf(YSb + (size_t)row * 512 + (col - 1056), silu4(a), silu4(b));
                });
            } else {
                bf16_t* U = (bf16_t*)(scr + SD_U);
                epi_rows8<2>(reg, [&](int rl, int cl, float4 a, float4 b) {
                    const int row = rbase + rl, col = cb + cl;
                    if (col < 1536) st8bf(U + (size_t)row * 1536 + col, a, b);
                    else st8bf(YSb + (size_t)row * 512 + (col - 1536), silu4(a), silu4(b));
                });
            }
        }
    }
}

DEVI void phase_merge(const P& p, int l, bf16_t* sm) {
    unsigned char* ws = p.ws;
    const bf16_t* HL = (const bf16_t*)(ws + OFF_HL);
    const bf16_t* Wgm = (const bf16_t*)(ws + OFF_WINT) + ((size_t)l * IN_TOTAL + COL_GM) * D;
    const bf16_t* Wb = (const bf16_t*)(ws + OFF_WBT) + (size_t)l * 4 * D * 512;
    bf16_t* ACCM = (bf16_t*)(ws + OFF_SCR);
    const int M = (l == 0) ? NR : NL;
    const int tilesM = M / 256, tilesN = D / 128;
    for (int it = 0;; ++it) {
        const int tile = tile_of(it);
        if (it * (int)gridDim.x >= tilesM * tilesN) break;
        if (tile >= tilesM * tilesN) continue;
        const int tm = tile / tilesN, tn = tile % tilesN;
        const int m0 = tm * 256, n0 = tn * 128;
        GAcc<2> tot; acc_zero(tot);
        unsigned totp[2][2][8];
#pragma unroll
        for (int mt = 0; mt < 2; ++mt)
#pragma unroll
            for (int nt = 0; nt < 2; ++nt)
#pragma unroll
                for (int e = 0; e < 8; ++e) totp[mt][nt][e] = 0u;
#pragma unroll 1
        for (int i = 0; i < 4; ++i) {
#ifdef TIMING_A
            gemm_kloop<2>((const bf16_t*)(ws + OFF_YS + i * SZ512), 512, Wb + (size_t)i * D * 512, 512, 512, m0, n0, sm, tot);
            GAcc<2> g; acc_zero(g);
            gemm_kloop<2>(HL, D, Wgm + (size_t)i * D * D, D, D, m0, n0, sm, g);
#pragma unroll
            for (int mt = 0; mt < 2; ++mt)
#pragma unroll
                for (int nt = 0; nt < 2; ++nt)
#pragma unroll
                    for (int e = 0; e < 16; ++e) tot.a[mt][nt][e] += sigmf(g.a[mt][nt][e]);
        }
#else
            unsigned pp[2][2][8];
            {
                GAcc<2> pr; acc_zero(pr);
                gemm_kloop<2>((const bf16_t*)(ws + OFF_YS + i * SZ512), 512, Wb + (size_t)i * D * 512, 512, 512, m0, n0, sm, pr);
#pragma unroll
                for (int mt = 0; mt < 2; ++mt)
#pragma unroll
                    for (int nt = 0; nt < 2; ++nt)
#pragma unroll
                        for (int e = 0; e < 8; ++e) pp[mt][nt][e] = pk2(pr.a[mt][nt][2 * e], pr.a[mt][nt][2 * e + 1]);
            }
            GAcc<2> g; acc_zero(g);
            gemm_kloop<2>(HL, D, Wgm + (size_t)i * D * D, D, D, m0, n0, sm, g);
#pragma unroll
            for (int mt = 0; mt < 2; ++mt)
#pragma unroll
                for (int nt = 0; nt < 2; ++nt)
#pragma unroll
                    for (int e = 0; e < 8; ++e) {
                        const float t0 = lo_bf(totp[mt][nt][e]) + sigmf(g.a[mt][nt][2 * e]) * lo_bf(pp[mt][nt][e]);
                        const float t1 = hi_bf(totp[mt][nt][e]) + sigmf(g.a[mt][nt][2 * e + 1]) * hi_bf(pp[mt][nt][e]);
                        totp[mt][nt][e] = pk2(t0, t1);
                    }
        }
#pragma unroll
        for (int mt = 0; mt < 2; ++mt)
#pragma unroll
            for (int nt = 0; nt < 2; ++nt)
#pragma unroll
                for (int e = 0; e < 8; ++e) { tot.a[mt][nt][2 * e] = lo_bf(totp[mt][nt][e]); tot.a[mt][nt][2 * e + 1] = hi_bf(totp[mt][nt][e]); }
#endif
        {
            const int wave = ltid() >> 6, wm = wave >> 1, wn = wave & 1;
            float* reg = (float*)sm + wave * (32 * EST);
#pragma unroll
            for (int mt = 0; mt < 2; ++mt) {
                epi_stage<2>(tot, mt, reg);
                epi_rows8<2>(reg, [&](int rl, int cl, float4 a, float4 b) { st8bf(ACCM + (size_t)(m0 + wm * 64 + mt * 32 + rl) * D + n0 + wn * 64 + cl, a, b); });
            }
        }
    }
}

DEVI void phase_out(const P& p, int l, bf16_t* sm) {
    unsigned char* ws = p.ws;
    const bf16_t* ACCM = (const bf16_t*)(ws + OFF_SCR);
    const bf16_t* Wo = (const bf16_t*)(ws + OFF_WOT) + (size_t)l * D * D;
    const float* MOD = (const float*)(ws + OFF_MOD) + (size_t)l * 3 * 3072;
    float* XC1 = (float*)(ws + OFF_XC1);
    const int M = (l == 0) ? NR : NL;
    const int tilesM = M / 256, tilesN = D / 128;
    for (int it = 0;; ++it) {
        const int tile = tile_of(it);
        if (it * (int)gridDim.x >= tilesM * tilesN) break;
        if (tile >= tilesM * tilesN) continue;
        const int tm = tile / tilesN, tn = tile % tilesN;
        const int m0 = tm * 256, n0 = tn * 128;
        GAcc<2> acc; acc_zero(acc);
        gemm_kloop<2, 1>(ACCM, D, Wo, D, D, m0, n0, sm, acc);
        {
            const int wave = ltid() >> 6, wm = wave >> 1, wn = wave & 1;
            float* reg = (float*)sm + wave * (32 * EST);
#pragma unroll
            for (int mt = 0; mt < 2; ++mt) {
                epi_stage<2>(acc, mt, reg);
                epi_rows8<2>(reg, [&](int rl, int cl, float4 a, float4 b) {
                    const int row = m0 + wm * 64 + mt * 32 + rl, col = n0 + wn * 64 + cl;
                    const bool ic = row >= NL;
                    const int mi = ic ? 2 : (row >> 14);
                    const float4 g0 = *(const float4*)(MOD + mi * 3072 + 2048 + col), g1 = *(const float4*)(MOD + mi * 3072 + 2048 + col + 4);
                    const float* src; float* dst;
                    if (ic) { src = (l == 0 ? p.ctx : XC1) + (size_t)(row - NL) * D + col; dst = XC1 + (size_t)(row - NL) * D + col; }
                    else { src = (l == 0 ? p.x : p.out) + (size_t)row * D + col; dst = p.out + (size_t)row * D + col; }
                    const float4 x0 = *(const float4*)src, x1 = *(const float4*)(src + 4);
                    if (!p.dry) {
                        *(float4*)dst = make_float4(x0.x + g0.x * a.x, x0.y + g0.y * a.y, x0.z + g0.z * a.z, x0.w + g0.w * a.w);
                        *(float4*)(dst + 4) = make_float4(x1.x + g1.x * b.x, x1.y + g1.y * b.y, x1.z + g1.z * b.z, x1.w + g1.w * b.w);
                    }
                });
            }
        }
    }
}

DEVI void transpose_tile(const float* __restrict__ src, int K, int N, bf16_t* __restrict__ dst, int k0, int n0, float* sm) {
    const int tid = ltid();
    __syncthreads();
    {
        const int kr = tid >> 4, nc = (tid & 15) * 4;
#pragma unroll
        for (int i = 0; i < 2; ++i) {
            const int k = kr + 32 * i;
            float4 v = {0.f, 0.f, 0.f, 0.f};
            if (n0 + nc < N) v = *(const float4*)(src + (size_t)(k0 + k) * N + n0 + nc);
            sm[k * 65 + nc + 0] = v.x; sm[k * 65 + nc + 1] = v.y; sm[k * 65 + nc + 2] = v.z; sm[k * 65 + nc + 3] = v.w;
        }
    }
    __syncthreads();
    {
        const int n = tid >> 3, kc = (tid & 7) * 8;
        if (n0 + n < N) {
            uint4 w;
            w.x = pk2(sm[(kc + 0) * 65 + n], sm[(kc + 1) * 65 + n]); w.y = pk2(sm[(kc + 2) * 65 + n], sm[(kc + 3) * 65 + n]);
            w.z = pk2(sm[(kc + 4) * 65 + n], sm[(kc + 5) * 65 + n]); w.w = pk2(sm[(kc + 6) * 65 + n], sm[(kc + 7) * 65 + n]);
            *(uint4*)(dst + (size_t)(n0 + n) * K + k0 + kc) = w;
        }
    }
}

DEVI void hyena_mlp_task(const P& p, int l, int L, int p0, float* HT, float* sm) {
    const int tid = ltid();
    float* zb = sm;
    float* h1 = sm + 64 * 33;
    float* h2 = h1 + 64 * 65;
    const float* w1 = p.fw1 + (size_t)l * 33 * 64; const float* b1 = p.fb1 + l * 64;
    const float* w2 = p.fw2 + (size_t)l * 64 * 64; const float* b2 = p.fb2 + l * 64;
    const float* w3 = p.fw3 + (size_t)l * 64 * 64; const float* b3 = p.fb3 + l * 64;
    const float* fr = p.ffreq + l * 64;
    __syncthreads();
#pragma unroll 1
    for (int e = tid; e < 64 * 33; e += NTHR) {
        const int pos = e / 33, k = e % 33;
        const int pp = p0 + pos;
        float v;
        if (k == 0) v = (float)pp / (float)(L - 1);
        else {
            const int j = (k - 1) & 15;
            const float f = 1e-4f + (float)j * ((15.0f - 1e-4f) / 15.0f);
            const float wa = 6.283185307179586f * (float)pp / (float)L;
            v = (k <= 16) ? cosf(f * wa) : -sinf(f * wa);
        }
        zb[e] = v;
    }
    __syncthreads();
    const int pos = tid >> 3, fg = (tid & 7) * 8;
    {
        float a[8];
#pragma unroll
        for (int j = 0; j < 8; ++j) a[j] = b1[fg + j];
#pragma unroll 1
        for (int k = 0; k < 33; ++k) {
            const float zv = zb[pos * 33 + k];
#pragma unroll
            for (int j = 0; j < 8; ++j) a[j] += zv * w1[k * 64 + fg + j];
        }
#pragma unroll
        for (int j = 0; j < 8; ++j) h1[pos * 65 + fg + j] = sinf(fr[fg + j] * a[j]);
    }
    __syncthreads();
    {
        float a[8];
#pragma unroll
        for (int j = 0; j < 8; ++j) a[j] = b2[fg + j];
#pragma unroll 2
        for (int k = 0; k < 64; ++k) {
            const float zv = h1[pos * 65 + k];
#pragma unroll
            for (int j = 0; j < 8; ++j) a[j] += zv * w2[k * 64 + fg + j];
        }
#pragma unroll
        for (int j = 0; j < 8; ++j) h2[pos * 65 + fg + j] = sinf(fr[fg + j] * a[j]);
    }
    __syncthreads();
    {
        float a[8];
#pragma unroll
        for (int j = 0; j < 8; ++j) a[j] = b3[fg + j];
#pragma unroll 2
        for (int k = 0; k < 64; ++k) {
            const float zv = h2[pos * 65 + k];
#pragma unroll
            for (int j = 0; j < 8; ++j) a[j] += zv * w3[k * 64 + fg + j];
        }
#pragma unroll
        for (int j = 0; j < 8; ++j) HT[(size_t)(fg + j) * L + p0 + pos] = sinf(fr[fg + j] * a[j]);
    }
}

DEVI void phase_prep(const P& p, float* sm) {
    unsigned char* ws = p.ws;
    const int tid = ltid();
    constexpr int TN_IN = (IN_TOTAL + 63) / 64;
    constexpr int T_WIN = 2 * 16 * TN_IN;
    constexpr int T_WB = 2 * 4 * 8 * 16;
    constexpr int T_WO = 2 * 16 * 16;
    constexpr int T_MOD = 2 * 48;
    constexpr int T_ROPE = T * 32 / NTHR;
    constexpr int T_MLP = 2 * 256 + 4;
    constexpr int E0 = T_WIN, E1 = E0 + T_WB, E2 = E1 + T_WO, E3 = E2 + T_MOD, E4 = E3 + T_ROPE, E5 = E4 + T_MLP;
    for (int task = blockIdx.x; task < E5; task += gridDim.x) {
        if (task < E0) {
            const int l = task / (16 * TN_IN), r = task % (16 * TN_IN), kt = r / TN_IN, nt = r % TN_IN;
            transpose_tile(p.w_in + (size_t)l * D * IN_TOTAL, D, IN_TOTAL, (bf16_t*)(ws + OFF_WINT) + (size_t)l * IN_TOTAL * D, kt * 64, nt * 64, sm);
        } else if (task < E1) {
            const int q = task - E0, li = q / 128, r = q % 128, kt = r / 16, nt = r % 16;
            transpose_tile(p.w_branch + (size_t)li * 512 * D, 512, D, (bf16_t*)(ws + OFF_WBT) + (size_t)li * D * 512, kt * 64, nt * 64, sm);
        } else if (task < E2) {
            const int q = task - E1, l = q / 256, r = q % 256, kt = r / 16, nt = r % 16;
            transpose_tile(p.w_out + (size_t)l * D * D, D, D, (bf16_t*)(ws + OFF_WOT) + (size_t)l * D * D, kt * 64, nt * 64, sm);
        } else if (task < E3) {
            const int q = task - E2, l = q / 48, jb = q % 48;
            float* sc = sm;
            float* red = sm + 3072;
            __syncthreads();
#pragma unroll 1
            for (int e = tid; e < 3072; e += NTHR) {
                const int mi = e >> 10, k = e & 1023;
                const float v = (mi < 2) ? p.c[mi * D + k] : p.c_ctx[k];
                sc[e] = siluf(v);
            }
            __syncthreads();
            const int kg = tid >> 6, jj = tid & 63, j = jb * 64 + jj;
            const float* w = p.w_mod + (size_t)l * D * 3072 + j;
            float a0 = 0.f, a1 = 0.f, a2 = 0.f;
#pragma unroll 8
            for (int k = kg * 128; k < kg * 128 + 128; ++k) {
                const float wv = w[(size_t)k * 3072];
                a0 += sc[k] * wv; a1 += sc[1024 + k] * wv; a2 += sc[2048 + k] * wv;
            }
            red[(0 * 8 + kg) * 64 + jj] = a0; red[(1 * 8 + kg) * 64 + jj] = a1; red[(2 * 8 + kg) * 64 + jj] = a2;
            __syncthreads();
            if (tid < 192) {
                const int mi = tid >> 6, j2 = tid & 63;
                float s = p.b_mod[l * 3072 + jb * 64 + j2];
#pragma unroll
                for (int g = 0; g < 8; ++g) s += red[(mi * 8 + g) * 64 + j2];
                ((float*)(ws + OFF_MOD))[((size_t)l * 3 + mi) * 3072 + jb * 64 + j2] = s;
            }
        } else if (task < E4) {
            const int e = (task - E3) * NTHR + tid;
            const int t = e >> 5, c = e & 31;
            const float inv = powf(10000.0f, -(float)(c & 15) / 16.0f);
            const float pos = (c < 16) ? (float)(t >> 6) : (float)(t & 63);
            const float ang = pos * inv;
            float* rope = (float*)(ws + OFF_ROPE);
            rope[e] = cosf(ang); rope[(size_t)T * 32 + e] = sinf(ang);
        } else {
            const int q = task - E4;
            if (q < 512) { const int l = q >> 8; hyena_mlp_task(p, l, T, (q & 255) * 64, (float*)(ws + OFF_HH3T) + (size_t)l * 64 * T, sm); }
            else hyena_mlp_task(p, 0, CL, (q - 512) * 64, (float*)(ws + OFF_HH3C), sm);
        }
    }
}

DEVI void phase_hl(const P& p, int l) {
    unsigned char* ws = p.ws;
    const int lane = ltid() & 63, wave = ltid() >> 6;
    const float* MOD = (const float*)(ws + OFF_MOD) + (size_t)l * 3 * 3072;
    const float* nw = p.norm_w + l * D;
    bf16_t* HL = (bf16_t*)(ws + OFF_HL);
    const float* XC1 = (const float*)(ws + OFF_XC1);
    for (int row = blockIdx.x * 8 + wave; row < NR; row += gridDim.x * 8) {
        const float* src; int mi;
        if (row < NL) { src = (l == 0 ? p.x : p.out) + (size_t)row * D; mi = row >> 14; }
        else { src = (l == 0 ? p.ctx : XC1) + (size_t)(row - NL) * D; mi = 2; }
        float4 v[4]; float ss = 0.f;
#pragma unroll
        for (int i = 0; i < 4; ++i) { v[i] = *(const float4*)(src + lane * 4 + 256 * i); ss += v[i].x * v[i].x + v[i].y * v[i].y + v[i].z * v[i].z + v[i].w * v[i].w; }
        ss = wave_sum(ss);
        const float rs = rsqrtf(ss * (1.0f / D) + EPS);
        const float* sh = MOD + mi * 3072; const float* sc = sh + 1024;
#pragma unroll
        for (int i = 0; i < 4; ++i) {
            const int c = lane * 4 + 256 * i;
            const float4 w = *(const float4*)(nw + c), s1 = *(const float4*)(sc + c), s0 = *(const float4*)(sh + c);
            st4bf(HL + (size_t)row * D + c, v[i].x * rs * w.x * (1.f + s1.x) + s0.x, v[i].y * rs * w.y * (1.f + s1.y) + s0.y,
                  v[i].z * rs * w.z * (1.f + s1.z) + s0.z, v[i].w * rs * w.w * (1.f + s1.w) + s0.w);
        }
    }
}
DEVI void phase_final(const P& p) {
    const int lane = ltid() & 63, wave = ltid() >> 6;
    for (int row = blockIdx.x * 8 + wave; row < NL; row += gridDim.x * 8) {
        float* src = p.out + (size_t)row * D;
        float4 v[4]; float ss = 0.f;
#pragma unroll
        for (int i = 0; i < 4; ++i) { v[i] = *(const float4*)(src + lane * 4 + 256 * i); ss += v[i].x * v[i].x + v[i].y * v[i].y + v[i].z * v[i].z + v[i].w * v[i].w; }
        ss = wave_sum(ss);
        const float rs = rsqrtf(ss * (1.0f / D) + EPS);
#pragma unroll
        for (int i = 0; i < 4; ++i) {
            const int c = lane * 4 + 256 * i;
            const float4 w = *(const float4*)(p.final_norm_w + c);
            float4 r = {v[i].x * rs * w.x, v[i].y * rs * w.y, v[i].z * rs * w.z, v[i].w * rs * w.w};
            *(float4*)(src + c) = r;
        }
    }
}

union U8 { bf16x8 v; uint4 u; uint2 h[2]; unsigned w[4]; };
struct AttSt { float m, l; f32x4 o[4]; };
constexpr float L2E = 1.4426950408889634f;
constexpr float NEG_INF = -__builtin_huge_valf();

DEVI float rows_max(float x) {
    const unsigned u = __float_as_uint(x);
    auto r = __builtin_amdgcn_permlane16_swap(u, u, false, false);
    const float a = fmaxf(__uint_as_float(r[0]), __uint_as_float(r[1]));
    const unsigned v = __float_as_uint(a);
    auto t = __builtin_amdgcn_permlane32_swap(v, v, false, false);
    return fmaxf(__uint_as_float(t[0]), __uint_as_float(t[1]));
}
DEVI float rows_sum(float x) {
    const unsigned u = __float_as_uint(x);
    auto r = __builtin_amdgcn_permlane16_swap(u, u, false, false);
    const float a = __uint_as_float(r[0]) + __uint_as_float(r[1]);
    const unsigned v = __float_as_uint(a);
    auto t = __builtin_amdgcn_permlane32_swap(v, v, false, false);
    return __uint_as_float(t[0]) + __uint_as_float(t[1]);
}
struct KVF { bf16x8 ka, kb, kc, kd; U8 v0, v1, v2, v3; };
DEVI void att_load(KVF& f, const bf16_t* k0p, const bf16_t* k1p, const bf16_t* v0p, const bf16_t* v1p, size_t ldv) {
    f.ka = *(const bf16x8*)k0p; f.kb = *(const bf16x8*)(k0p + 32);
    f.kc = *(const bf16x8*)k1p; f.kd = *(const bf16x8*)(k1p + 32);
    f.v0.u = *(const uint4*)(v0p); f.v1.u = *(const uint4*)(v0p + 16 * ldv);
    f.v2.u = *(const uint4*)(v0p + 32 * ldv); f.v3.u = *(const uint4*)(v0p + 48 * ldv);
}
DEVI void att_load2(KVF& f, const char* kb, unsigned k0, unsigned k1, const char* vb, unsigned v0, unsigned vstep) {
    f.ka = *(const bf16x8*)(kb + k0); f.kb = *(const bf16x8*)(kb + (k0 + 64u));
    f.kc = *(const bf16x8*)(kb + k1); f.kd = *(const bf16x8*)(kb + (k1 + 64u));
    f.v0.u = *(const uint4*)(vb + v0); f.v1.u = *(const uint4*)(vb + (v0 + vstep));
    f.v2.u = *(const uint4*)(vb + (v0 + 2u * vstep)); f.v3.u = *(const uint4*)(vb + (v0 + 3u * vstep));
}
DEVI void att_compute(AttSt& st, const bf16x8& q0, const bf16x8& q1, const KVF& f, f32x4 b0, f32x4 b1, float scale2) {
    f32x4 s0 = {0.f, 0.f, 0.f, 0.f}, s1 = {0.f, 0.f, 0.f, 0.f};
    s0 = __builtin_amdgcn_mfma_f32_16x16x32_bf16(f.ka, q0, s0, 0, 0, 0);
    s0 = __builtin_amdgcn_mfma_f32_16x16x32_bf16(f.kb, q1, s0, 0, 0, 0);
    s1 = __builtin_amdgcn_mfma_f32_16x16x32_bf16(f.kc, q0, s1, 0, 0, 0);
    s1 = __builtin_amdgcn_mfma_f32_16x16x32_bf16(f.kd, q1, s1, 0, 0, 0);
    s0 = s0 * scale2 + b0; s1 = s1 * scale2 + b1;
    float mx = fmaxf(fmaxf(fmaxf(s0[0], s0[1]), fmaxf(s0[2], s0[3])), fmaxf(fmaxf(s1[0], s1[1]), fmaxf(s1[2], s1[3])));
    mx = rows_max(mx);
    if (__any(mx > st.m + 8.0f)) {
        const float mn = fmaxf(st.m, mx);
        const float alpha = __builtin_amdgcn_exp2f(st.m - mn);
        st.l *= alpha; st.m = mn;
        st.o[0] = st.o[0] * alpha; st.o[1] = st.o[1] * alpha; st.o[2] = st.o[2] * alpha; st.o[3] = st.o[3] * alpha;
    }
    const float mref = st.m;
    float pa[8];
#pragma unroll
    for (int i = 0; i < 4; ++i) { pa[i] = __builtin_amdgcn_exp2f(s0[i] - mref); pa[4 + i] = __builtin_amdgcn_exp2f(s1[i] - mref); }
    st.l += ((pa[0] + pa[1]) + (pa[2] + pa[3])) + ((pa[4] + pa[5]) + (pa[6] + pa[7]));
    U8 pf; pf.w[0] = pk2(pa[0], pa[1]); pf.w[1] = pk2(pa[2], pa[3]); pf.w[2] = pk2(pa[4], pa[5]); pf.w[3] = pk2(pa[6], pa[7]);
    st.o[0] = __builtin_amdgcn_mfma_f32_16x16x32_bf16(f.v0.v, pf.v, st.o[0], 0, 0, 0);
    st.o[1] = __builtin_amdgcn_mfma_f32_16x16x32_bf16(f.v1.v, pf.v, st.o[1], 0, 0, 0);
    st.o[2] = __builtin_amdgcn_mfma_f32_16x16x32_bf16(f.v2.v, pf.v, st.o[2], 0, 0, 0);
    st.o[3] = __builtin_amdgcn_mfma_f32_16x16x32_bf16(f.v3.v, pf.v, st.o[3], 0, 0, 0);
}
#define ATT_PIPELINE(n_)                                              \
    { KVF fa_, fb_;                                                   \
      LOADS(fa_, 0);                                                  \
      int s_ = 0;                                                     \
      for (; s_ + 2 < (n_); s_ += 2) {        \
          LOADS(fb_, s_ + 1);                                         \
          COMPS(fa_, s_);                                             \
          LOADS(fa_, s_ + 2);                                         \
          COMPS(fb_, s_ + 1);                                         \
      }                                                               \
      if (s_ + 1 < (n_)) { LOADS(fb_, s_ + 1); COMPS(fa_, s_); COMPS(fb_, s_ + 1); } \
      else { COMPS(fa_, s_); } }
DEVI void att_finish(const AttSt& st, float extra_l, bf16_t* G  , int dry) {
    const int lane = ltid() & 63, g = lane >> 4;
    float lt = rows_sum(st.l);
    lt += extra_l;
    const float inv = 1.f / lt;
#pragma unroll
    for (int dt = 0; dt < 4; ++dt) {
        bf16_t* gp = G + dt * 16 + 4 * g;
        const uint2 gv = *(const uint2*)gp;
        if (!dry) st4bf(gp, st.o[dt][0] * inv * lo_bf(gv.x), st.o[dt][1] * inv * hi_bf(gv.x), st.o[dt][2] * inv * lo_bf(gv.y), st.o[dt][3] * inv * hi_bf(gv.y));
    }
}

DEVI void phase_att_a(const P& p, int l, float* smf) {
    unsigned char* ws = p.ws; unsigned char* scr = ws + OFF_SCR;
    const bf16_t* Q = (const bf16_t*)(scr + SA_Q); const bf16_t* K = (const bf16_t*)(scr + SA_K); const bf16_t* VT = (const bf16_t*)(scr + SA_VT);
    const bf16_t* VTC = VT + (size_t)NB * 8 * 64 * T;
    bf16_t* G = (bf16_t*)(ws + OFF_YS);
    const int tid = ltid(), lane = tid & 63, h = tid >> 6, q = lane & 15, g = lane >> 4;
    __syncthreads();
    for (int e = tid; e < 8 * 465; e += NTHR) smf[e] = p.rpb[(size_t)l * 8 * 465 + e] * L2E;
    __syncthreads();
    const float* tab = smf + h * 465;
    const float scale2 = 0.125f * L2E;
    const int ntask = 2048 + (l == 0 ? 32 : 0);
    for (int it = 0; it * (int)gridDim.x < ntask; ++it) {
        const int task = tile_of(it);
        if (task >= ntask) continue;
        AttSt st; st.m = -1e30f; st.l = 0.f;
#pragma unroll
        for (int dt = 0; dt < 4; ++dt) st.o[dt] = (f32x4){0.f, 0.f, 0.f, 0.f};
        int b, qrow;
        const bool lat = task < 2048;
        int r = 0, j = 0;
        if (lat) { b = task >> 10; r = (task >> 2) & 255; j = task & 3; qrow = b * T + r * 64 + j * 16 + q; }
        else { const int tt = task - 2048; b = tt >> 4; qrow = NL + b * CL + (tt & 15) * 16 + q; }
        const bf16_t* qp = Q + (size_t)qrow * 512 + h * 64 + g * 8;
        const bf16x8 q0 = *(const bf16x8*)qp, q1 = *(const bf16x8*)(qp + 32);
        {
            const int rs = min(max(r - 4, 0), 248), kc0 = min(max(j * 16 - 8, 0), 32);
            const int qc = j * 16 + q, cs = min(max(qc - 8, 0), 48);
            const int nloc = lat ? 8 : 0, nst = nloc + 8;
            const bf16_t* Kc = K + (size_t)(NL + b * CL) * 512 + h * 64 + g * 8;
            const bf16_t* Vc = VTC + ((size_t)(b * 8 + h) * 64 + (lane & 15)) * CL + 8 * g;
            const int kmap = 8 * ((lane & 15) >> 2) + (lane & 3);
            const char* KnB = (const char*)(K + (size_t)b * T * 512); const char* VnB = (const char*)(VT + (size_t)(b * 8) * 64 * T);
            const char* KcB = (const char*)(K + (size_t)(NL + b * CL) * 512); const char* VcB = (const char*)(VTC + (size_t)(b * 8) * 64 * CL);
            const unsigned kln = (unsigned)((kc0 + kmap) * 512 + h * 64 + g * 8) * 2u, vln = (unsigned)((h * 64 + (lane & 15)) * T + kc0 + 8 * g) * 2u;
            const unsigned klc = (unsigned)(kmap * 512 + h * 64 + g * 8) * 2u, vlc = (unsigned)((h * 64 + (lane & 15)) * CL + 8 * g) * 2u;
#define LOADS(F, S) { const int s2_ = (S); if (s2_ < nloc) { const unsigned k0_ = kln + (unsigned)(rs + s2_) * 65536u; \
                        att_load2(F, KnB, k0_, k0_ + 4096u, VnB, vln + (unsigned)(rs + s2_) * 128u, (unsigned)(16 * T * 2)); } \
                      else { const unsigned c_ = (unsigned)(s2_ - nloc); const unsigned k0_ = klc + c_ * 32768u; att_load2(F, KcB, k0_, k0_ + 4096u, VcB, vlc + c_ * 64u, (unsigned)(16 * CL * 2)); } }
            int ia[4], ib[4]; bool va_[4], vb_[4];
#pragma unroll
            for (int i = 0; i < 4; ++i) { const int kc_a = kc0 + 8 * g + i, kc_b = kc_a + 4;
                va_[i] = (kc_a >= cs && kc_a < cs + 16); vb_[i] = (kc_b >= cs && kc_b < cs + 16);
                ia[i] = min(max(kc_a - qc + 15, 0), 30); ib[i] = min(max(kc_b - qc + 15, 0), 30); }
#define COMPS(F, S) { const int s2_ = (S); f32x4 b0 = {0.f, 0.f, 0.f, 0.f}, b1 = {0.f, 0.f, 0.f, 0.f}; \
                      if (s2_ < nloc) { const float* trw = tab + (rs + s2_ - r + 7) * 31; \
                        _Pragma("unroll") for (int i = 0; i < 4; ++i) { b0[i] = va_[i] ? trw[ia[i]] : NEG_INF; b1[i] = vb_[i] ? trw[ib[i]] : NEG_INF; } } \
                      att_compute(st, q0, q1, F, b0, b1, scale2); }
            ATT_PIPELINE(nst)
#undef LOADS
#undef COMPS
        }
        att_finish(st, 0.f, G + (size_t)qrow * 512 + h * 64, p.dry);
    }
}

DEVI void phase_att_b(const P& p, int l) {
    unsigned char* ws = p.ws; unsigned char* scr = ws + OFF_SCR;
    const bf16_t* Q = (const bf16_t*)(scr + SB_Q); const bf16_t* K = (const bf16_t*)(scr + SB_K); const bf16_t* VT = (const bf16_t*)(scr + SB_VT);
    const bf16_t* VTC = VT + (size_t)NB * 2 * 64 * T;
    bf16_t* G = (bf16_t*)(ws + OFF_YS + SZ512);
    const int tid = ltid(), lane = tid & 63, h = tid >> 6, kvh = h >> 2, q = lane & 15, g = lane >> 4;
    const float scale2 = 0.125f * L2E;
    const float sink2 = p.sink[l * 8 + h] * L2E;
    const int ntask = 2048 + (l == 0 ? 32 : 0);
    for (int it = 0; it * (int)gridDim.x < ntask; ++it) {
        const int task = tile_of(it);
        if (task >= ntask) continue;
        AttSt st; st.m = -1e30f; st.l = 0.f;
#pragma unroll
        for (int dt = 0; dt < 4; ++dt) st.o[dt] = (f32x4){0.f, 0.f, 0.f, 0.f};
        int b, qrow;
        const bool lat = task < 2048;
        int q0t = 0;
        if (lat) { b = task >> 10; q0t = (task & 1023) * 16; qrow = b * T + q0t + q; }
        else { const int tt = task - 2048; b = tt >> 4; qrow = NL + b * CL + (tt & 15) * 16 + q; }
        const bf16_t* qp = Q + (size_t)qrow * 512 + h * 64 + g * 8;
        const bf16x8 q0 = *(const bf16x8*)qp, q1 = *(const bf16x8*)(qp + 32);
        {
            const int tq = q0t + q;
            const int nloc = lat ? 9 : 0, nst = nloc + 8;
            const bf16_t* Kc = K + (size_t)(NL + b * CL) * 128 + kvh * 64 + g * 8;
            const bf16_t* Vc = VTC + ((size_t)(b * 2 + kvh) * 64 + (lane & 15)) * CL + 8 * g;
            const int kmap = 8 * ((lane & 15) >> 2) + (lane & 3);
            const bf16_t* vbase = VT + ((size_t)(b * 2 + kvh) * 64 + (lane & 15)) * T;
            const char* KnB = (const char*)(K + (size_t)b * T * 128); const char* VnB = (const char*)(VT + (size_t)(b * 2) * 64 * T);
            const char* KcB = (const char*)(K + (size_t)(NL + b * CL) * 128); const char* VcB = (const char*)(VTC + (size_t)(b * 2) * 64 * CL);
            const unsigned kl2 = (unsigned)(kvh * 64 + g * 8) * 2u, vl2 = (unsigned)((kvh * 64 + (lane & 15)) * T) * 2u;
            const unsigned klc = (unsigned)(kmap * 128 + kvh * 64 + g * 8) * 2u, vlc = (unsigned)((kvh * 64 + (lane & 15)) * CL + 8 * g) * 2u;
#define LOADS(F, S) { const int s2_ = (S); if (s2_ < nloc) { const int tbase = q0t - 128 + 32 * s2_; \
                        const int ta = min(max(tbase + kmap, 0), T - 1), tb = min(max(tbase + kmap + 4, 0), T - 1); \
                        const int va = min(max(tbase + 8 * g, 0), T - 8); \
                        att_load2(F, KnB, kl2 + (unsigned)ta * 256u, kl2 + (unsigned)tb * 256u, VnB, vl2 + (unsigned)va * 2u, (unsigned)(16 * T * 2)); } \
                      else { const unsigned c_ = (unsigned)(s2_ - nloc); const unsigned k0_ = klc + c_ * 8192u; att_load2(F, KcB, k0_, k0_ + 1024u, VcB, vlc + c_ * 64u, (unsigned)(16 * CL * 2)); } }
#define COMPS(F, S) { const int s2_ = (S); f32x4 b0 = {0.f, 0.f, 0.f, 0.f}, b1 = {0.f, 0.f, 0.f, 0.f}; \
                      if (s2_ < nloc && (s2_ == 0 || s2_ == 8 || q0t < 128 || q0t + 160 > T)) { const int tbase = q0t - 128 + 32 * s2_; \
                        _Pragma("unroll") for (int i = 0; i < 4; ++i) { const int t0 = tbase + 8 * g + i, t1 = t0 + 4; \
                          b0[i] = (t0 >= 0 && t0 < T && abs(tq - t0) <= 128) ? 0.f : NEG_INF; \
                          b1[i] = (t1 >= 0 && t1 < T && abs(tq - t1) <= 128) ? 0.f : NEG_INF; } } \
                      att_compute(st, q0, q1, F, b0, b1, scale2); }
            ATT_PIPELINE(nst)
#undef LOADS
#undef COMPS
        }
        att_finish(st, __builtin_amdgcn_exp2f(sink2 - st.m), G + (size_t)qrow * 512 + h * 64, p.dry);
    }
}

constexpr int GL_CUM = 0;
constexpr int GL_LR = 32768;
constexpr int GL_T0 = GL_LR + 8192;
constexpr int GL_TSZ = 64 * LSTR * 2;
constexpr int GL_X = GL_T0 + 4 * GL_TSZ;

DEVI float logsigmoidf(float x) { return fminf(x, 0.f) - log1pf(expf(-fabsf(x))); }

DEVI void gla_cum(const P& p, int l, int h, int rowbase, unsigned char* sm) {
    const int tid = ltid();
    float* cum = (float*)(sm + GL_CUM); float* lrs = (float*)(sm + GL_LR);
    const float* LR = (const float*)(p.ws + OFF_SCR + SC_LR);
    __syncthreads();
    { const int t = tid >> 3, c4 = (tid & 7) * 4; *(float4*)(lrs + t * 32 + c4) = *(const float4*)(LR + (size_t)(rowbase + t) * 32 + c4); }
    __syncthreads();
    const int d = tid & 63, tg = tid >> 6;
    float* tot = lrs + 64 * 32;
    tot = (float*)(sm + GL_X);
    float la[2][8];
#pragma unroll
    for (int dir = 0; dir < 2; ++dir) {
        const float* W = p.w_alpha_up + ((size_t)(l * 2 + dir) * 16) * 256 + h * 64 + d;
        float w[16];
#pragma unroll
        for (int r = 0; r < 16; ++r) w[r] = W[r * 256];
        const float bia = p.b_alpha[(l * 2 + dir) * 256 + h * 64 + d];
#pragma unroll
        for (int tt = 0; tt < 8; ++tt) {
            const int t = tg * 8 + tt;
            float x = bia;
#pragma unroll
            for (int r = 0; r < 16; ++r) x += lrs[t * 32 + dir * 16 + r] * w[r];
            la[dir][tt] = logsigmoidf(x) * (1.0f / 16.0f);
        }
    }
#pragma unroll
    for (int tt = 1; tt < 8; ++tt) la[0][tt] += la[0][tt - 1];
#pragma unroll
    for (int tt = 6; tt >= 0; --tt) la[1][tt] += la[1][tt + 1];
    tot[(0 * 8 + tg) * 64 + d] = la[0][7];
    tot[(1 * 8 + tg) * 64 + d] = la[1][0];
    __syncthreads();
    float of = 0.f, ob = 0.f;
#pragma unroll
    for (int g2 = 0; g2 < 8; ++g2) {
        const float a = tot[(0 * 8 + g2) * 64 + d], b = tot[(1 * 8 + g2) * 64 + d];
        of += (g2 < tg) ? a : 0.f;
        ob += (g2 > tg) ? b : 0.f;
    }
#pragma unroll
    for (int tt = 0; tt < 8; ++tt) {
        const int t = tg * 8 + tt;
        cum[t * 64 + d] = la[0][tt] + of;
        cum[(64 + t) * 64 + d] = la[1][tt] + ob;
    }
    __syncthreads();
}
DEVI void gla_chunk_geom(int b, int c, int& rowbase, size_t& vt_off  , size_t& vld, int& ci_f, int& ci_b) {
    if (c < 4) { rowbase = NL + b * CL + c * 64; vld = CL; ci_f = c; ci_b = 3 - c; }
    else { rowbase = b * T + (c - 4) * 64; vld = T; ci_f = c; ci_b = 4 + 255 - (c - 4); }
}
DEVI const bf16_t* gla_vt_ptr(const bf16_t* VT, int b, int h, int c) {
    if (c < 4) return VT + (size_t)NB * 4 * 128 * T + ((size_t)(b * 4 + h) * 128) * CL + c * 64;
    return VT + ((size_t)(b * 4 + h) * 128) * T + (size_t)(c - 4) * 64;
}

DEVI void phase_gla1(const P& p, int l, unsigned char* sm) {
    unsigned char* scr = p.ws + OFF_SCR;
    const bf16_t* KG = (const bf16_t*)(scr + SC_K); const bf16_t* VT = (const bf16_t*)(scr + SC_VT);
    bf16_t* SB = (bf16_t*)(scr + SC_SB); float* GD = (float*)(scr + SC_GD);
    const int tid = ltid(), lane = tid & 63, wave = tid >> 6;
    const float* cum = (const float*)(sm + GL_CUM);
    bf16_t* kdT = (bf16_t*)(sm + GL_T0);
    for (int task = blockIdx.x; task < 8 * NCH; task += gridDim.x) {
        const int bh = task / NCH, c = task % NCH, b = bh >> 2, h = bh & 3;
        int rowbase, ci_f, ci_b; size_t vo, vld;
        gla_chunk_geom(b, c, rowbase, vo, vld, ci_f, ci_b);
        gla_cum(p, l, h, rowbase, sm);
        {
            const int d = tid & 63, tg = tid >> 6;
            const float ce_f = cum[63 * 64 + d], ce_b = cum[64 * 64 + d];
            float vf[8], vb[8];
#pragma unroll
            for (int j = 0; j < 8; ++j) {
                const int t = tg * 8 + j;
                const float kf = bf2f(KG[(size_t)(rowbase + t) * 256 + h * 64 + d]);
                vf[j] = kf * __expf(ce_f - cum[t * 64 + d]);
                vb[j] = kf * __expf(ce_b - cum[(64 + t) * 64 + d]);
            }
            uint4 wf, wb;
            wf.x = pk2(vf[0], vf[1]); wf.y = pk2(vf[2], vf[3]); wf.z = pk2(vf[4], vf[5]); wf.w = pk2(vf[6], vf[7]);
            wb.x = pk2(vb[0], vb[1]); wb.y = pk2(vb[2], vb[3]); wb.z = pk2(vb[4], vb[5]); wb.w = pk2(vb[6], vb[7]);
            *(uint4*)(kdT + d * LSTR + tg * 8) = wf;
            *(uint4*)(kdT + (64 + d) * LSTR + tg * 8) = wb;
        }
        __syncthreads();
        {
            const int dir = wave >> 2, dvt = wave & 3;
            const bf16_t* vp = gla_vt_ptr(VT, b, h, c) + (size_t)(dvt * 32 + (lane & 31)) * vld + (lane >> 5) * 8;
            const bf16_t* ap = kdT + (dir * 64 + (lane & 31)) * LSTR + (lane >> 5) * 8;
            f32x16 acc[2];
#pragma unroll
            for (int i = 0; i < 16; ++i) { acc[0][i] = 0.f; acc[1][i] = 0.f; }
#pragma unroll
            for (int ks = 0; ks < 4; ++ks) {
                const bf16x8 vb = *(const bf16x8*)(vp + ks * 16);
#pragma unroll
                for (int mt = 0; mt < 2; ++mt) {
                    const bf16x8 ka = *(const bf16x8*)(ap + mt * 32 * LSTR + ks * 16);
                    acc[mt] = __builtin_amdgcn_mfma_f32_32x32x16_bf16(ka, vb, acc[mt], 0, 0, 0);
                }
            }
            const int bhd = bh * 2 + dir, ci = dir ? ci_b : ci_f;
            bf16_t* out = SB + ((size_t)bhd * NCH + ci) * 8192 + (size_t)(dvt * 32 + (lane & 31)) * 64;
#ifdef EXP_C
            for (int mt = 0; mt < 2; ++mt) for (int i = 0; i < 16; ++i) { const int dk = mt * 32 + (i & 3) + 8 * (i >> 2) + 4 * (lane >> 5); acc[mt][i] = bf2f(kdT[(dir * 64 + dk) * LSTR + ((dvt * 32 + (lane & 31)) & 63)]); }
#endif
#pragma unroll
            for (int mt = 0; mt < 2; ++mt)
#pragma unroll
                for (int q4 = 0; q4 < 4; ++q4)
                    st4bf(out + mt * 32 + q4 * 8 + (lane >> 5) * 4, acc[mt][q4 * 4 + 0], acc[mt][q4 * 4 + 1], acc[mt][q4 * 4 + 2], acc[mt][q4 * 4 + 3]);
        }
        if (tid < 128) {
            const int dir = tid >> 6, d = tid & 63;
            const int bhd = bh * 2 + dir, ci = dir ? ci_b : ci_f;
            GD[((size_t)bhd * NCH + ci) * 64 + d] = __expf(dir ? cum[64 * 64 + d] : cum[63 * 64 + d]);
        }
    }
}

DEVI void phase_gla2(const P& p) {
    unsigned char* scr = p.ws + OFF_SCR;
    bf16_t* SB = (bf16_t*)(scr + SC_SB); const float* GD = (const float*)(scr + SC_GD);
    for (int idx = blockIdx.x * NTHR + ltid(); idx < 16 * 8192; idx += gridDim.x * NTHR) {
        const int bhd = idx >> 13, e = idx & 8191, dk = e & 63;
        bf16_t* base = SB + (size_t)bhd * NCH * 8192 + e;
        const float* gd = GD + (size_t)bhd * NCH * 64 + dk;
        float S = 0.f;
#pragma unroll 1
        for (int ci = 0; ci < NCH; ci += 13) {
            float kv[13], g[13];
#pragma unroll
            for (int u = 0; u < 13; ++u) { kv[u] = bf2f(base[(size_t)(ci + u) * 8192]); g[u] = gd[(ci + u) * 64]; }
#pragma unroll
            for (int u = 0; u < 13; ++u) { if (!p.dry) base[(size_t)(ci + u) * 8192] = f2bf(S); S = g[u] * S + kv[u]; }
        }
    }
}

DEVI void phase_gla3(const P& p, int l, unsigned char* sm) {
    unsigned char* scr = p.ws + OFF_SCR;
    const bf16_t* QG = (const bf16_t*)(scr + SC_Q); const bf16_t* KG = (const bf16_t*)(scr + SC_K); const bf16_t* VT = (const bf16_t*)(scr + SC_VT);
    const bf16_t* SB = (const bf16_t*)(scr + SC_SB);
    bf16_t* G = (bf16_t*)(p.ws + OFF_YS + 2 * SZ512);
    const float* gnw = p.gla_norm_w + l * 128;
    const int tid = ltid(), lane = tid & 63, wave = tid >> 6, q = lane & 15, g = lane >> 4;
    const float* cum = (const float*)(sm + GL_CUM);
    bf16_t* tiles = (bf16_t*)(sm + GL_T0);
    float* X = (float*)(sm + GL_X);
    const int c_lo = (l == 0) ? 0 : 4;
    const int nper = NCH - c_lo;
    for (int task = blockIdx.x; task < 8 * nper; task += gridDim.x) {
        const int bh = task / nper, c = c_lo + task % nper, b = bh >> 2, h = bh & 3;
        int rowbase, ci_f, ci_b; size_t vo, vld;
        gla_chunk_geom(b, c, rowbase, vo, vld, ci_f, ci_b);
        gla_cum(p, l, h, rowbase, sm);
        {
            const int t = tid >> 3, dg = (tid & 7) * 8;
            U8 qv, kv; qv.u = *(const uint4*)(QG + (size_t)(rowbase + t) * 256 + h * 64 + dg); kv.u = *(const uint4*)(KG + (size_t)(rowbase + t) * 256 + h * 64 + dg);
            float o[4][8];
#pragma unroll
            for (int j = 0; j < 8; ++j) {
                const int d = dg + j;
                const float qf = (j & 1) ? hi_bf(qv.w[j >> 1]) : lo_bf(qv.w[j >> 1]);
                const float kf = (j & 1) ? hi_bf(kv.w[j >> 1]) : lo_bf(kv.w[j >> 1]);
                const float cf = cum[t * 64 + d], cb = cum[(64 + t) * 64 + d];
                o[0][j] = qf * __expf(cf); o[1][j] = kf * __expf(-cf); o[2][j] = qf * __expf(cb); o[3][j] = kf * __expf(-cb);
            }
#pragma unroll
            for (int k = 0; k < 4; ++k) {
                uint4 w; w.x = pk2(o[k][0], o[k][1]); w.y = pk2(o[k][2], o[k][3]); w.z = pk2(o[k][4], o[k][5]); w.w = pk2(o[k][6], o[k][7]);
                *(uint4*)(tiles + k * 64 * LSTR + t * LSTR + dg) = w;
            }
        }
        __syncthreads();
        const int qi = wave & 3, dir = wave >> 2;
        f32x4 O[8];
#pragma unroll
        for (int i = 0; i < 8; ++i) O[i] = (f32x4){0.f, 0.f, 0.f, 0.f};
        {
            const bf16_t* Qd = tiles + (dir * 2) * 64 * LSTR; const bf16_t* Kd = tiles + (dir * 2 + 1) * 64 * LSTR;
            const bf16x8 qf0 = *(const bf16x8*)(Qd + (qi * 16 + q) * LSTR + g * 8), qf1 = *(const bf16x8*)(Qd + (qi * 16 + q) * LSTR + 32 + g * 8);
            const int iq = qi * 16 + q;
            U8 pf[2];
#pragma unroll
            for (int jt = 0; jt < 4; ++jt) {
                const bf16_t* kp = Kd + (jt * 16 + (lane & 15)) * LSTR + g * 8;
                f32x4 s = {0.f, 0.f, 0.f, 0.f};
                s = __builtin_amdgcn_mfma_f32_16x16x32_bf16(*(const bf16x8*)kp, qf0, s, 0, 0, 0);
                s = __builtin_amdgcn_mfma_f32_16x16x32_bf16(*(const bf16x8*)(kp + 32), qf1, s, 0, 0, 0);
#pragma unroll
                for (int i = 0; i < 4; ++i) { const int jk = jt * 16 + 4 * g + i; const bool ok = dir ? (jk >= iq) : (jk <= iq); s[i] = ok ? s[i] : 0.f; }
                pf[jt >> 1].w[(jt & 1) * 2 + 0] = pk2(s[0], s[1]); pf[jt >> 1].w[(jt & 1) * 2 + 1] = pk2(s[2], s[3]);
            }
            const bf16_t* vp = gla_vt_ptr(VT, b, h, c) + (size_t)(lane & 15) * vld + 4 * g;
            const int bhd = bh * 2 + dir, ci = dir ? ci_b : ci_f;
            const bf16_t* sp = SB + ((size_t)bhd * NCH + ci) * 8192 + (size_t)(lane & 15) * 64 + g * 8;
#pragma unroll
            for (int dvt = 0; dvt < 8; ++dvt) {
#pragma unroll
                for (int st = 0; st < 2; ++st) {
                    U8 vf; vf.h[0] = *(const uint2*)(vp + (size_t)dvt * 16 * vld + st * 32); vf.h[1] = *(const uint2*)(vp + (size_t)dvt * 16 * vld + st * 32 + 16);
                    O[dvt] = __builtin_amdgcn_mfma_f32_16x16x32_bf16(vf.v, pf[st].v, O[dvt], 0, 0, 0);
                }
                O[dvt] = __builtin_amdgcn_mfma_f32_16x16x32_bf16(*(const bf16x8*)(sp + dvt * 16 * 64), qf0, O[dvt], 0, 0, 0);
                O[dvt] = __builtin_amdgcn_mfma_f32_16x16x32_bf16(*(const bf16x8*)(sp + dvt * 16 * 64 + 32), qf1, O[dvt], 0, 0, 0);
            }
        }
        if (dir == 1) {
#pragma unroll
            for (int dvt = 0; dvt < 8; ++dvt)
#pragma unroll
                for (int i = 0; i < 4; ++i) X[(qi * 128 + dvt * 16 + 4 * g + i) * 16 + q] = O[dvt][i];
        }
        __syncthreads();
        if (dir == 0) {
            float ss = 0.f;
#pragma unroll
            for (int dvt = 0; dvt < 8; ++dvt)
#pragma unroll
                for (int i = 0; i < 4; ++i) { O[dvt][i] += X[(qi * 128 + dvt * 16 + 4 * g + i) * 16 + q]; ss += O[dvt][i] * O[dvt][i]; }
            ss = rows_sum(ss);
            const float rs = rsqrtf(ss * (1.0f / 128.0f) + EPS);
            bf16_t* gp = G + (size_t)(rowbase + qi * 16 + q) * 512 + h * 128;
#pragma unroll
            for (int dvt = 0; dvt < 8; ++dvt) {
                const int dv = dvt * 16 + 4 * g;
                const float4 w = *(const float4*)(gnw + dv);
                const uint2 gv = *(const uint2*)(gp + dv);
                if (!p.dry) st4bf(gp + dv, O[dvt][0] * rs * w.x * lo_bf(gv.x), O[dvt][1] * rs * w.y * hi_bf(gv.x), O[dvt][2] * rs * w.z * lo_bf(gv.y), O[dvt][3] * rs * w.w * hi_bf(gv.y));
            }
        }
    }
}

constexpr int LF = 16384;
DEVI int CIDX(int p) { return p + (p >> 4); }
DEVI int FIDX(int m) { return 2 * CIDX(m >> 1) + (m & 1); }
constexpr int LFP = LF + LF / 16;
DEVI float2 cmul(float2 a, float2 b) { return make_float2(a.x * b.x - a.y * b.y, a.x * b.y + a.y * b.x); }
DEVI float2 cadd(float2 a, float2 b) { return make_float2(a.x + b.x, a.y + b.y); }
DEVI float2 csub(float2 a, float2 b) { return make_float2(a.x - b.x, a.y - b.y); }
DEVI float2 twid(float frac) { return make_float2(__builtin_amdgcn_cosf(frac), __builtin_amdgcn_sinf(frac)); }

DEVI void fft_fwd(float2* F) {
    const int tid = ltid();
#pragma unroll 1
    for (int s = LF / 2; s >= 2; s >>= 2) {
        const int h = s >> 1;
        const int lh = 31 - __clz(h);
        const float inv2s = 1.0f / (float)(2 * s);
#pragma unroll 2
        for (int qq = tid; qq < LF / 4; qq += NTHR) {
            const int blk = qq >> lh, j = qq & (h - 1);
            const int i = blk * (2 * s) + j;
            const int i0 = CIDX(i), i1 = CIDX(i + h), i2 = CIDX(i + s), i3 = CIDX(i + s + h);
            const float2 x0 = F[i0], x1 = F[i1], x2 = F[i2], x3 = F[i3];
            float2 w1 = twid((float)j * inv2s); w1.y = -w1.y;
            const float2 w2 = cmul(w1, w1);
            const float2 y0 = cadd(x0, x2), y2 = cmul(csub(x0, x2), w1);
            const float2 y1 = cadd(x1, x3); const float2 tt = csub(x1, x3);
            const float2 y3 = cmul(make_float2(tt.y, -tt.x), w1);
            F[i0] = cadd(y0, y1); F[i1] = cmul(csub(y0, y1), w2);
            F[i2] = cadd(y2, y3); F[i3] = cmul(csub(y2, y3), w2);
        }
        __syncthreads();
    }
}
DEVI void fft_inv(float2* F) {
    const int tid = ltid();
#pragma unroll 1
    for (int h = 1; h <= LF / 4; h <<= 2) {
        const int s = 2 * h;
        const int lh = 31 - __clz(h);
        const float inv2s = 1.0f / (float)(2 * s);
#pragma unroll 2
        for (int qq = tid; qq < LF / 4; qq += NTHR) {
            const int blk = qq >> lh, j = qq & (h - 1);
            const int i = blk * (2 * s) + j;
            const int i0 = CIDX(i), i1 = CIDX(i + h), i2 = CIDX(i + s), i3 = CIDX(i + s + h);
            const float2 x0 = F[i0], x1 = F[i1], x2 = F[i2], x3 = F[i3];
            const float2 w1 = twid((float)j * inv2s);
            const float2 w2 = cmul(w1, w1);
            const float2 a1 = cmul(x1, w2), a3 = cmul(x3, w2);
            const float2 u0 = cadd(x0, a1), u1 = csub(x0, a1), u2 = cadd(x2, a3), u3 = csub(x2, a3);
            const float2 b2 = cmul(u2, w1); const float2 t3 = cmul(u3, w1); const float2 b3 = make_float2(-t3.y, t3.x);
            F[i0] = cadd(u0, b2); F[i2] = csub(u0, b2); F[i1] = cadd(u1, b3); F[i3] = csub(u1, b3);
        }
        __syncthreads();
    }
}
DEVI int rev14(int k) { return (int)(__brev((unsigned)k) >> 18); }
DEVI float hy_delta(int ch) {
    const float a = -3.0701134573253946f, b = -15.350567286626973f;
    return fabsf(a + (b - a) * ((float)ch / 511.0f));
}

DEVI void conv8(const bf16_t* U, const float* cw, const float* cb, int seq0, int Lseq, int t, int col0, float* out) {
    U8 r[3];
#pragma unroll
    for (int i = 0; i < 3; ++i) {
        const int tt = t - 1 + i;
        if (tt >= 0 && tt < Lseq) r[i].u = *(const uint4*)(U + (size_t)(seq0 + tt) * 1536 + col0);
        else r[i].u = make_uint4(0, 0, 0, 0);
    }
#pragma unroll
    for (int j = 0; j < 8; ++j) {
        float a = cb[col0 + j];
#pragma unroll
        for (int i = 0; i < 3; ++i) { const float uv = (j & 1) ? hi_bf(r[i].w[j >> 1]) : lo_bf(r[i].w[j >> 1]); a += uv * cw[i * 1536 + col0 + j]; }
        out[j] = a;
    }
}
DEVI void hy_task_geom(int task, int& b, int& t0, int& ch0, int& seq0, int& Lseq, float*& zt, unsigned char* scr) {
    if (task < 4096) { b = task >> 11; t0 = ((task >> 3) & 255) * 64; ch0 = (task & 7) * 64; seq0 = b * T; Lseq = T; zt = (float*)(scr + SD_ZT) + (size_t)b * 512 * T; }
    else { const int q = task - 4096; b = q >> 5; t0 = ((q >> 3) & 3) * 64; ch0 = (q & 7) * 64; seq0 = NL + b * CL; Lseq = CL; zt = (float*)(scr + SD_ZTC) + (size_t)b * 512 * CL; }
}
DEVI void phase_hy1(const P& p, int l, float* sm) {
    unsigned char* scr = p.ws + OFF_SCR;
    const bf16_t* U = (const bf16_t*)(scr + SD_U);
    const float* cw = p.conv_w + (size_t)l * 3 * 1536; const float* cb = p.conv_b + l * 1536;
    const int tid = ltid();
    const int ntask = 4096 + (l == 0 ? 64 : 0);
    for (int task = blockIdx.x; task < ntask; task += gridDim.x) {
        int b, t0, ch0, seq0, Lseq; float* zt;
        hy_task_geom(task, b, t0, ch0, seq0, Lseq, zt, scr);
        __syncthreads();
        {
            const int tt = tid >> 3, cg = (tid & 7) * 8;
            float a1[8], a2[8];
            conv8(U, cw, cb, seq0, Lseq, t0 + tt, 512 + ch0 + cg, a1);
            conv8(U, cw, cb, seq0, Lseq, t0 + tt, 1024 + ch0 + cg, a2);
#pragma unroll
            for (int j = 0; j < 8; ++j) sm[(cg + j) * 65 + tt] = a1[j] * a2[j];
        }
        __syncthreads();
        {
            const int ch = tid >> 3, t8 = (tid & 7) * 8;
            float4 w0 = {sm[ch * 65 + t8 + 0], sm[ch * 65 + t8 + 1], sm[ch * 65 + t8 + 2], sm[ch * 65 + t8 + 3]};
            float4 w1 = {sm[ch * 65 + t8 + 4], sm[ch * 65 + t8 + 5], sm[ch * 65 + t8 + 6], sm[ch * 65 + t8 + 7]};
            float* dst = zt + (size_t)(ch0 + ch) * Lseq + t0 + t8;
            *(float4*)dst = w0; *(float4*)(dst + 4) = w1;
        }
    }
}
DEVI void phase_hy3(const P& p, int l, float* sm) {
    unsigned char* scr = p.ws + OFF_SCR;
    const bf16_t* U = (const bf16_t*)(scr + SD_U);
    bf16_t* G = (bf16_t*)(p.ws + OFF_YS + 3 * SZ512);
    const float* cw = p.conv_w + (size_t)l * 3 * 1536; const float* cb = p.conv_b + l * 1536;
    const int tid = ltid();
    const int ntask = 4096 + (l == 0 ? 64 : 0);
    for (int task = blockIdx.x; task < ntask; task += gridDim.x) {
        int b, t0, ch0, seq0, Lseq; float* zt;
        hy_task_geom(task, b, t0, ch0, seq0, Lseq, zt, scr);
        __syncthreads();
        {
            const int ch = tid >> 3, t8 = (tid & 7) * 8;
            const float* src = zt + (size_t)(ch0 + ch) * Lseq + t0 + t8;
            const float4 w0 = *(const float4*)src, w1 = *(const float4*)(src + 4);
            float* d = sm + ch * 65 + t8;
            d[0] = w0.x; d[1] = w0.y; d[2] = w0.z; d[3] = w0.w; d[4] = w1.x; d[5] = w1.y; d[6] = w1.z; d[7] = w1.w;
        }
        __syncthreads();
        {
            const int tt = tid >> 3, cg = (tid & 7) * 8;
            float a0[8];
            conv8(U, cw, cb, seq0, Lseq, t0 + tt, ch0 + cg, a0);
            bf16_t* gp = G + (size_t)(seq0 + t0 + tt) * 512 + ch0 + cg;
            U8 gv; gv.u = *(const uint4*)gp;
            float o[8];
#pragma unroll
            for (int j = 0; j < 8; ++j) { const float gg = (j & 1) ? hi_bf(gv.w[j >> 1]) : lo_bf(gv.w[j >> 1]); o[j] = a0[j] * sm[(cg + j) * 65 + tt] * gg; }
            uint4 w; w.x = pk2(o[0], o[1]); w.y = pk2(o[2], o[3]); w.z = pk2(o[4], o[5]); w.w = pk2(o[6], o[7]);
            if (!p.dry) *(uint4*)gp = w;
        }
    }
}


constexpr int HYF_MT = 64;
DEVI void phase_hyf(const P& p, int l, float* sm) {
    const int tid = ltid();
    const float* HT = (const float*)(p.ws + OFF_HH3T) + (size_t)l * 64 * T;
    const float* wout = p.fwout + (size_t)l * 64 * 1024;
    bf16_t* K2 = (bf16_t*)(p.ws + OFF_K2);
    float* L1P = (float*)(p.ws + OFF_L1P);
    float* hs = sm;
    for (int task = blockIdx.x; task < T / HYF_MT; task += gridDim.x) {
        const int m0 = task * HYF_MT;
        __syncthreads();
        for (int e = tid; e < 64 * HYF_MT / 4; e += NTHR) { const int j = e / (HYF_MT / 4), c4 = (e % (HYF_MT / 4)) * 4; *(float4*)(hs + j * HYF_MT + c4) = *(const float4*)(HT + (size_t)j * T + m0 + c4); }
        __syncthreads();
        {
            const int ch = tid;
            const float delta = hy_delta(ch);
            float l1f = 0.f, l1b = 0.f;
#pragma unroll 1
            for (int mb = 0; mb < HYF_MT; mb += 16) {
                float af[16], ab[16];
#pragma unroll
                for (int u = 0; u < 16; ++u) { af[u] = 0.f; ab[u] = 0.f; }
#pragma unroll 2
                for (int j = 0; j < 64; ++j) {
                    const float wf = wout[j * 1024 + ch], wb = wout[j * 1024 + 512 + ch];
#pragma unroll
                    for (int u4 = 0; u4 < 4; ++u4) {
                        const float4 h = *(const float4*)(hs + j * HYF_MT + mb + u4 * 4);
                        af[u4 * 4 + 0] += h.x * wf; af[u4 * 4 + 1] += h.y * wf; af[u4 * 4 + 2] += h.z * wf; af[u4 * 4 + 3] += h.w * wf;
                        ab[u4 * 4 + 0] += h.x * wb; ab[u4 * 4 + 1] += h.y * wb; ab[u4 * 4 + 2] += h.z * wb; ab[u4 * 4 + 3] += h.w * wb;
                    }
                }
#pragma unroll
                for (int u = 0; u < 16; ++u) {
                    const int m = m0 + mb + u;
                    const float dec = expf(-((float)m / (float)(T - 1)) * delta);
                    af[u] *= dec; ab[u] *= dec;
                    l1f += fabsf(af[u]); l1b += (m == 0) ? 0.f : fabsf(ab[u]);
                }
                uint4 o;
                o.x = pk2(af[0], af[1]); o.y = pk2(af[2], af[3]); o.z = pk2(af[4], af[5]); o.w = pk2(af[6], af[7]);
                *(uint4*)(K2 + (size_t)ch * T + m0 + mb) = o;
                o.x = pk2(af[8], af[9]); o.y = pk2(af[10], af[11]); o.z = pk2(af[12], af[13]); o.w = pk2(af[14], af[15]);
                *(uint4*)(K2 + (size_t)ch * T + m0 + mb + 8) = o;
                o.x = pk2(ab[0], ab[1]); o.y = pk2(ab[2], ab[3]); o.z = pk2(ab[4], ab[5]); o.w = pk2(ab[6], ab[7]);
                *(uint4*)(K2 + (size_t)(512 + ch) * T + m0 + mb) = o;
                o.x = pk2(ab[8], ab[9]); o.y = pk2(ab[10], ab[11]); o.z = pk2(ab[12], ab[13]); o.w = pk2(ab[14], ab[15]);
                *(uint4*)(K2 + (size_t)(512 + ch) * T + m0 + mb + 8) = o;
            }
            L1P[(size_t)task * 1024 + ch] = l1f;
            L1P[(size_t)task * 1024 + 512 + ch] = l1b;
        }
    }
}
DEVI void phase_hy2(const P& p, int l, unsigned char* smem) {
    unsigned char* scr = p.ws + OFF_SCR;
    const int tid = ltid();
    float* Ff = (float*)smem; float2* F2 = (float2*)smem;
    float* red = (float*)(smem + (size_t)LFP * 8);
    float* spec = red + 16;
    const float* HT = (const float*)(p.ws + OFF_HH3T) + (size_t)l * 64 * T;
    const float* HC = (const float*)(p.ws + OFF_HH3C);
    const float* wout = p.fwout + (size_t)l * 64 * 1024;
    const int ntask = 512 + (l == 0 ? 512 : 0);
    for (int task = blockIdx.x; task < ntask; task += gridDim.x) {
        __syncthreads();
        if (task < 512) {
            const int ch = task;
            const float delta = hy_delta(ch);
            float l1 = 0.f;
            {
                const bf16_t* K2 = (const bf16_t*)(p.ws + OFF_K2);
                const float* L1P = (const float*)(p.ws + OFF_L1P);
                if (tid < 2 * (T / HYF_MT)) { const int side = tid / (T / HYF_MT), tk = tid % (T / HYF_MT); l1 = L1P[(size_t)tk * 1024 + side * 512 + ch]; }
#pragma unroll
                for (int i = 0; i < 4; ++i) {
                    const int m = (tid + NTHR * i) * 8;
                    U8 hf, hb; hf.u = *(const uint4*)(K2 + (size_t)ch * T + m); hb.u = *(const uint4*)(K2 + (size_t)(512 + ch) * T + m);
#pragma unroll
                    for (int u = 0; u < 8; ++u) {
                        const float af = (u & 1) ? hi_bf(hf.w[u >> 1]) : lo_bf(hf.w[u >> 1]);
                        const float ab = (u & 1) ? hi_bf(hb.w[u >> 1]) : lo_bf(hb.w[u >> 1]);
                        const int mm = m + u;
                        Ff[FIDX(mm)] = af;
                        if (mm >= 1) Ff[FIDX(2 * T - mm)] = ab; else Ff[FIDX(T)] = 0.f;
                    }
                }
            }
            l1 = block_sum(l1, red);
            __syncthreads();
            fft_fwd(F2);
            const float scale = 1.0f / ((float)LF * l1);
            float4* KF = (float4*)(p.ws + OFF_KF) + (size_t)blockIdx.x * 8192;
#pragma unroll 2
            for (int i = 0; i < 16; ++i) {
                const int k = tid + NTHR * i;
                const float2 ck = F2[CIDX(rev14(k))], cm = F2[CIDX(rev14((LF - k) & (LF - 1)))];
                KF[k] = make_float4((ck.x + cm.x) * 0.5f * scale, (ck.y - cm.y) * 0.5f * scale, (ck.y + cm.y) * 0.5f * scale, -(ck.x - cm.x) * 0.5f * scale);
            }
            if (tid == 0) { const float2 c = F2[CIDX(1)]; spec[0] = c.x * scale; spec[1] = c.y * scale; }
            const float fb = p.fbias[l * 512 + ch];
#pragma unroll 1
            for (int b = 0; b < NB; ++b) {
                float* zt = (float*)(scr + SD_ZT) + ((size_t)b * 512 + ch) * T;
                __syncthreads();
#pragma unroll
                for (int i = 0; i < 8; ++i) {
                    const int e = (tid + NTHR * i) * 4;
                    const float4 zv = *(const float4*)(zt + e);
                    const int c0 = CIDX(e >> 1), c1 = CIDX((T + e) >> 1);
                    F2[c0] = make_float2(zv.x, zv.y); F2[c0 + 1] = make_float2(zv.z, zv.w);
                    F2[c1] = make_float2(0.f, 0.f); F2[c1 + 1] = make_float2(0.f, 0.f);
                }
                __syncthreads();
                fft_fwd(F2);
#pragma unroll 2
                for (int i = 0; i < 16; ++i) {
                    const int k = tid + NTHR * i;
                    const int pk = CIDX(rev14(k)), pm = CIDX(rev14((LF - k) & (LF - 1)));
                    const float2 ck = F2[pk], cm = F2[pm];
                    const float4 kf = KF[k];
                    const float2 He = make_float2(kf.x, kf.y), Ho = make_float2(kf.z, kf.w);
                    const float2 E = make_float2((ck.x + cm.x) * 0.5f, (ck.y - cm.y) * 0.5f);
                    const float2 O = make_float2((ck.y + cm.y) * 0.5f, -(ck.x - cm.x) * 0.5f);
                    float2 w2 = twid((float)k * (1.0f / (float)LF)); w2.y = -w2.y;
                    const float2 Ye = cadd(cmul(E, He), cmul(w2, cmul(O, Ho)));
                    const float2 Yo = cadd(cmul(E, Ho), cmul(O, He));
                    F2[pk] = make_float2(Ye.x - Yo.y, Ye.y + Yo.x);
                    F2[pm] = make_float2(Ye.x + Yo.y, -Ye.y + Yo.x);
                }
                if (tid == 0) {
                    const float2 c = F2[CIDX(1)]; const float he = spec[0], ho = spec[1];
                    F2[CIDX(1)] = make_float2(c.x * he - c.y * ho, c.x * ho + c.y * he);
                }
                __syncthreads();
                fft_inv(F2);
#pragma unroll
                for (int i = 0; i < 8; ++i) {
                    const int e = (tid + NTHR * i) * 4;
                    const float4 zv = *(const float4*)(zt + e);
                    const int c0 = CIDX(e >> 1);
                    const float2 y0 = F2[c0], y1 = F2[c0 + 1];
                    const float4 yv = make_float4(y0.x, y0.y, y1.x, y1.y);
                    if (!p.dry) *(float4*)(zt + e) = make_float4(yv.x + zv.x * fb, yv.y + zv.y * fb, yv.z + zv.z * fb, yv.w + zv.w * fb);
                }
            }
        } else {
            const int ch = task - 512;
            const float delta = hy_delta(ch);
            float* hf = Ff; float* hb = Ff + 256; float* zs = Ff + 512;
            {
                const int m = tid & 255, side = tid >> 8;
                float a = 0.f;
#pragma unroll 4
                for (int j = 0; j < 64; ++j) a += HC[j * CL + m] * wout[j * 1024 + side * 512 + ch];
                a *= expf(-((float)m / (float)(CL - 1)) * delta);
                Ff[side * 256 + m] = a;
                float l1 = (side == 1 && m == 0) ? 0.f : fabsf(a);
                zs[tid] = ((const float*)(scr + SD_ZTC))[((size_t)(tid >> 8) * 512 + ch) * CL + (tid & 255)];
                l1 = block_sum(l1, red);
                const int b = tid >> 8, t = tid & 255;
                float y = 0.f;
#pragma unroll 4
                for (int s = 0; s <= t; ++s) y += zs[b * 256 + s] * hf[t - s];
#pragma unroll 4
                for (int s = t + 1; s < CL; ++s) y += zs[b * 256 + s] * hb[s - t];
                const float fb = p.fbias[l * 512 + ch];
                if (!p.dry) ((float*)(scr + SD_ZTC))[((size_t)b * 512 + ch) * CL + t] = y / l1 + zs[tid] * fb;
            }
        }
    }
}

constexpr int NPH = 32;
#ifndef ONLY
#define ONLY -1
#endif
#define CASE(n) case n: if (ONLY < 0 || ONLY == n)
DEVI void run_phase(const P& p, int ph, unsigned char* smem) {
    if (ph == 0) { if (ONLY < 0 || ONLY == 100) phase_prep(p, (float*)smem); return; }
    if (ph == NPH - 1) { if (ONLY < 0 || ONLY == 101) phase_final(p); return; }
    const int l = (ph - 1) / 15, k = (ph - 1) % 15;
    switch (k) {
        CASE(0) phase_hl(p, l); break;
        CASE(1) phase_inproj<0>(p, l, (bf16_t*)smem); break;
        CASE(2) phase_att_a(p, l, (float*)smem); break;
        CASE(3) phase_inproj<1>(p, l, (bf16_t*)smem); break;
        CASE(4) phase_att_b(p, l); break;
        CASE(5) phase_inproj<2>(p, l, (bf16_t*)smem); break;
        CASE(6) phase_gla1(p, l, smem); break;
        CASE(7) phase_gla2(p); break;
        CASE(8) phase_gla3(p, l, smem); break;
        CASE(9) phase_inproj<3>(p, l, (bf16_t*)smem); break;
        CASE(10) { phase_hyf(p, l, (float*)smem); phase_hy1(p, l, (float*)smem); } break;
        CASE(11) phase_hy2(p, l, smem); break;
        CASE(12) phase_hy3(p, l, (float*)smem); break;
        CASE(13) phase_merge(p, l, (bf16_t*)smem); break;
        CASE(14) phase_out(p, l, (bf16_t*)smem); break;
    }
}

#define XB_TMO      128
#define XB_XCNT(j)  (256  + 64 * (j))
#define XB_XSUB(j)  (1280 + 64 * (j))
#define XB_XGEN(j)  (2304 + 64 * (j))
#define XB_TOP      3328
#define XB_TOPGEN   3392
#define XCD_BAR_WORDS 3456
#define XB_SPIN_CAP (1u << 18)
#define LAS __attribute__((address_space(3)))
DEVI unsigned xb_ld(unsigned* p)              { return __hip_atomic_load(p, __ATOMIC_RELAXED, __HIP_MEMORY_SCOPE_AGENT); }
DEVI unsigned xb_add(unsigned* p, unsigned v) { return __hip_atomic_fetch_add(p, v, __ATOMIC_RELAXED, __HIP_MEMORY_SCOPE_AGENT); }
DEVI unsigned xb_xcc_id() { return (unsigned)__builtin_amdgcn_s_getreg((3 << 11) | 20) & 0xFu; }
#define XB_SPIN(cond, bar) do { unsigned _sp = 0; while (cond) { __builtin_amdgcn_s_sleep(1); \
    if ((++_sp & 255u) == 0u) { if (xb_ld(&(bar)[XB_TMO])) break; if (_sp > XB_SPIN_CAP) { atomicAdd(&(bar)[XB_TMO], 1u); break; } } } } while (0)
struct XcdBarrier { unsigned* bar; unsigned x; volatile LAS unsigned* st; };
DEVI XcdBarrier xcd_barrier_post(unsigned* bar, volatile LAS unsigned* st) {
    XcdBarrier b; b.bar = bar; b.x = xb_xcc_id(); b.st = st;
    if (threadIdx.x == 0) (void)xb_add(&bar[XB_XCNT(b.x)], 1u);
    return b;
}
DEVI void xcd_barrier_complete(unsigned* bar, unsigned x, unsigned& nloc, unsigned& nx) {
    const unsigned G = gridDim.x * gridDim.y * gridDim.z;
    unsigned sum, cnt, mine, sp = 0u;
    for (;;) {
        sum = 0u; cnt = 0u; mine = 0u;
#pragma unroll
        for (unsigned j = 0; j < 16; ++j) { const unsigned c = xb_ld(&bar[XB_XCNT(j)]); sum += c; cnt += (c > 0u) ? 1u : 0u; mine = (j == x) ? c : mine; }
        if (sum == G) break;
        __builtin_amdgcn_s_sleep(1);
        if ((++sp & 255u) == 0u) { if (xb_ld(&bar[XB_TMO])) break; if (sp > XB_SPIN_CAP) { atomicAdd(&bar[XB_TMO], 1u); break; } }
    }
    nloc = mine > 0u ? mine : 1u; nx = cnt > 0u ? cnt : 1u;
}
DEVI void xcd_barrier(const XcdBarrier& b) {
    asm volatile("s_waitcnt vmcnt(0)" ::: "memory");
    __syncthreads();
    if (threadIdx.x == 0) {
        unsigned* bar = b.bar;
        __builtin_amdgcn_s_waitcnt(0);
        unsigned nloc = b.st[0], nx = b.st[1];
        if (nloc == 0u) { xcd_barrier_complete(bar, b.x, nloc, nx); b.st[0] = nloc; b.st[1] = nx; }
        const unsigned old = xb_add(&bar[XB_XSUB(b.x)], 1u);
        const unsigned gen = old / nloc;
        if (old + 1u == (gen + 1u) * nloc) {
            __builtin_amdgcn_fence(__ATOMIC_RELEASE, "agent");
            asm volatile("s_waitcnt vmcnt(0)" ::: "memory");
            const unsigned og = xb_add(&bar[XB_TOP], 1u);
            const unsigned tg = og / nx;
            if (og + 1u == (tg + 1u) * nx) xb_add(&bar[XB_TOPGEN], 1u);
            else XB_SPIN(xb_ld(&bar[XB_TOPGEN]) == tg, bar);
            __builtin_amdgcn_fence(__ATOMIC_ACQUIRE, "agent");
            xb_add(&bar[XB_XGEN(b.x)], 1u);
            asm volatile("s_waitcnt vmcnt(0)" ::: "memory");
        } else {
            XB_SPIN(xb_ld(&bar[XB_XGEN(b.x)]) == gen, bar);
            __builtin_amdgcn_fence(__ATOMIC_ACQUIRE, "agent");
            asm volatile("s_waitcnt vmcnt(0)" ::: "memory");
        }
    }
    __syncthreads();
}
constexpr size_t OFF_BAR = WS_END + 1024;
constexpr size_t WS_TOTAL = OFF_BAR + XCD_BAR_WORDS * 4;

__global__ void __launch_bounds__(NTHR) mega(P p) {
    extern __shared__ __attribute__((aligned(16))) unsigned char smem[];
    cg::grid_group grid = cg::this_grid();
#ifndef DBL_MASK
#define DBL_MASK 0
#endif
#ifdef TIMING_A
    unsigned long long* ts = (unsigned long long*)(p.ws + WS_END);
    if (blockIdx.x == 0 && threadIdx.x == 0) ts[0] = __builtin_amdgcn_s_memrealtime();
#endif
    volatile LAS unsigned* xst = (volatile LAS unsigned*)(smem + LDS_BYTES - 16);
    if (threadIdx.x == 0) { xst[0] = 0u; xst[1] = 0u; }
    __syncthreads();
    XcdBarrier xb = xcd_barrier_post((unsigned*)(p.ws + OFF_BAR), xst);
#define GRID_SYNC(ph_) do { if ((ph_) == 0) grid.sync(); else xcd_barrier(xb); } while (0)
    for (int ph = p.ph_lo; ph < p.ph_hi; ++ph) {
        if (DBL_MASK != 0 && ph > 0 && ph < NPH - 1 && ((DBL_MASK >> ((ph - 1) % 15)) & 1)) { P pd = p; int one_ = 1; asm volatile("" : "+s"(one_)); pd.dry = one_; run_phase(pd, ph, smem); GRID_SYNC(1); }
        run_phase(p, ph, smem);
#ifdef TIMING_A
        GRID_SYNC(ph);
        if (blockIdx.x == 0 && threadIdx.x == 0) ts[ph + 1] = __builtin_amdgcn_s_memrealtime();
#else
        if (ph + 1 < p.ph_hi) GRID_SYNC(ph);
#endif
    }
}

#ifdef DIAG_OFF
__global__ void diag_dump(const unsigned char* src, float* out, size_t n) {
    for (size_t i = (size_t)blockIdx.x * blockDim.x + threadIdx.x; i < n; i += (size_t)gridDim.x * blockDim.x) {
#if DIAG_F32
        out[i] = ((const float*)src)[i % (size_t)(DIAG_N)];
#else
        { float v = bf2f(((const bf16_t*)src)[i % (size_t)(DIAG_N)]);
#ifdef EXP_FIN
          if (!(fabsf(v) < 1e30f)) v = 12345.f;
#endif
          out[i] = v; }
#endif
    }
}
#endif
#ifdef TIMING_A
__global__ void timing_tail(const unsigned long long* ts, float* out) {
    float grp[8] = {0, 0, 0, 0, 0, 0, 0, 0};
    const float total = (float)(ts[NPH] - ts[0]);
    for (int ph = 0; ph < NPH; ++ph) {
        const float dt = (float)(ts[ph + 1] - ts[ph]);
        int gi;
        if (ph == 0) gi = 5; else if (ph == NPH - 1) gi = 6;
        else { const int k = (ph - 1) % 15; gi = (k == 1 || k == 3 || k == 5 || k == 9) ? 0 : (k == 13) ? 1 : (k == 2 || k == 4) ? 2 : (k >= 6 && k <= 8) ? 3 : (k >= 10 && k <= 12) ? 4 : (k == 14) ? 7 : 6; }
#pragma unroll
        for (int q = 0; q < 8; ++q) grp[q] += (gi == q) ? dt : 0.f;
    }
    float fa = 0.f, fb = 0.f;
#pragma unroll
    for (int q = 0; q < 8; ++q) { fa += (q == TIMING_A) ? grp[q] : 0.f; fb += (q == TIMING_B) ? grp[q] : 0.f; }
    const float e1 = 1000.f * fa / total, e2 = 50.f * fb / total;
    if (blockIdx.x == 0 && threadIdx.x == 0) out[0] += e1;
    for (size_t i = (size_t)blockIdx.x * blockDim.x + threadIdx.x; i < (size_t)1048576; i += (size_t)gridDim.x * blockDim.x) out[D + i] += e2;
}
#endif
extern "C" void kernel_launch(void* const* d_in, const int* in_sizes, int n_in, void* d_out, int out_size, void* d_ws, size_t ws_size, hipStream_t stream) {
    static int grid = 0;
    if (grid == 0) {
        if (n_in != 27 || ws_size < WS_TOTAL) { fprintf(stderr, "kernel_launch: unexpected n_in %d or ws_size %zu (need %zu)\n", n_in, ws_size, (size_t)WS_TOTAL); grid = -1; return; }
        int dev = 0, cus = 0, per_cu = 0;
        hipGetDevice(&dev);
        hipDeviceGetAttribute(&cus, hipDeviceAttributeMultiprocessorCount, dev);
        if (hipFuncSetAttribute((const void*)mega, hipFuncAttributeMaxDynamicSharedMemorySize, LDS_BYTES) != hipSuccess) { fprintf(stderr, "kernel_launch: hipFuncSetAttribute failed\n"); grid = -1; return; }
        if (hipOccupancyMaxActiveBlocksPerMultiprocessor(&per_cu, (const void*)mega, NTHR, LDS_BYTES) != hipSuccess || per_cu < 1) { fprintf(stderr, "kernel_launch: occupancy query failed (%d)\n", per_cu); grid = -1; return; }
        grid = cus * per_cu; if (grid > MAXGRID) grid = MAXGRID;
        fprintf(stderr, "kernel_launch: grid %d (cus %d x %d)\n", grid, cus, per_cu);
    }
    if (grid < 0) return;
    P p{};
    const float** pp = (const float**)&p;
    for (int i = 0; i < 27; ++i) pp[i] = (const float*)d_in[i];
    p.out = (float*)d_out; p.ws = (unsigned char*)d_ws; p.dry = 0; p.pad_ = 0;
#if N_LAUNCH_MODE == 1
    p.ph_lo = 0; p.ph_hi = NPH;
    if (hipMemsetAsync((unsigned char*)d_ws + OFF_BAR, 0, XCD_BAR_WORDS * 4, stream) != hipSuccess) { fprintf(stderr, "kernel_launch: memset of barrier words failed\n"); return; }
    void* args[] = {&p};
    hipError_t e = hipLaunchCooperativeKernel((const void*)mega, dim3(grid), dim3(NTHR), args, LDS_BYTES, stream);
    if (e != hipSuccess) fprintf(stderr, "cooperative launch failed: %s (grid %d)\n", hipGetErrorString(e), grid);
#ifdef TIMING_A
    hipLaunchKernelGGL(timing_tail, dim3(256), dim3(256), 0, stream, (const unsigned long long*)((unsigned char*)d_ws + WS_END), (float*)d_out);
#endif
#else
#ifndef DIAG_STOP
#define DIAG_STOP NPH
#endif
    for (int ph = 0; ph < DIAG_STOP; ++ph) {
        p.ph_lo = ph; p.ph_hi = ph + 1;
        hipLaunchKernelGGL(mega, dim3(grid), dim3(NTHR), LDS_BYTES, stream, p);
    }
#ifdef DIAG_OFF
    hipLaunchKernelGGL(diag_dump, dim3(1024), dim3(256), 0, stream, (const unsigned char*)d_ws + (size_t)(DIAG_OFF), (float*)d_out, (size_t)out_size);
#endif
#endif
}
```

```cpp
#include <hip/hip_runtime.h>
#include <hip/hip_cooperative_groups.h>
#include <cstdio>
#include <cstdint>
namespace cg = cooperative_groups;

#ifndef N_LAUNCH_MODE
#define N_LAUNCH_MODE 1
#endif

#define DEVI __device__ __forceinline__
typedef unsigned short bf16_t;
typedef short bf16x8 __attribute__((ext_vector_type(8)));
typedef float f32x4 __attribute__((ext_vector_type(4)));
typedef float f32x16 __attribute__((ext_vector_type(16)));

constexpr int D = 1024, T = 16384, NB = 2, NL = NB * T, CL = 256, NC = NB * CL, NR = NL + NC;
constexpr int IN_TOTAL = 11040;
constexpr int COL_A = 0, COL_B = 2048, COL_C = 3328, COL_D = 4896, COL_GM = 6944;
constexpr float EPS = 1e-6f;
constexpr int NTHR = 512;
constexpr int LDS_BYTES = 140 * 1024;

constexpr size_t al256(size_t x) { return (x + 255) & ~(size_t)255; }
constexpr size_t OFF_MOD = 0;
constexpr size_t OFF_ROPE = al256(OFF_MOD + (size_t)2 * 3 * 3072 * 4);
constexpr size_t OFF_HH3T = al256(OFF_ROPE + (size_t)2 * T * 32 * 4);
constexpr size_t OFF_HH3C = al256(OFF_HH3T + (size_t)2 * 64 * T * 4);
constexpr size_t OFF_XC1 = al256(OFF_HH3C + (size_t)64 * CL * 4);
constexpr size_t OFF_WINT = al256(OFF_XC1 + (size_t)NC * D * 4);
constexpr size_t OFF_WBT = al256(OFF_WINT + (size_t)2 * IN_TOTAL * D * 2);
constexpr size_t OFF_WOT = al256(OFF_WBT + (size_t)2 * 4 * D * 512 * 2);
constexpr size_t OFF_HL = al256(OFF_WOT + (size_t)2 * D * D * 2);
constexpr size_t OFF_YS = al256(OFF_HL + (size_t)NR * D * 2);
constexpr size_t SZ512 = (size_t)NR * 512 * 2, SZ256 = (size_t)NR * 256 * 2, SZ128 = (size_t)NR * 128 * 2;
constexpr size_t OFF_SCR = al256(OFF_YS + 4 * SZ512);
constexpr size_t SA_Q = 0, SA_K = SZ512, SA_VT = 2 * SZ512;
constexpr size_t SB_Q = 0, SB_K = SZ512, SB_VT = SZ512 + SZ128;
constexpr size_t SC_Q = 0, SC_K = SZ256, SC_VT = 2 * SZ256, SC_LR = 2 * SZ256 + SZ512;
constexpr size_t SC_SB = al256(SC_LR + (size_t)NR * 32 * 4);
constexpr int NCH = 260;
constexpr size_t SC_GD = al256(SC_SB + (size_t)16 * NCH * 8192 * 2);
constexpr size_t SD_U = 0, SD_ZT = al256((size_t)NR * 1536 * 2), SD_ZTC = al256(SD_ZT + (size_t)NB * 512 * T * 4);
constexpr size_t SD_END = al256(SD_ZTC + (size_t)NB * 512 * CL * 4);
constexpr size_t OFF_KF = OFF_SCR + SD_END;
constexpr int MAXGRID = 256;
constexpr size_t OFF_K2 = al256(OFF_KF + (size_t)MAXGRID * 8192 * 16);
constexpr size_t OFF_L1P = al256(OFF_K2 + (size_t)1024 * T * 2);
constexpr size_t WS_END = al256(OFF_L1P + (size_t)(T / 64) * 1024 * 4);

struct P {
    const float *x, *c, *ctx, *c_ctx, *norm_w, *w_mod, *b_mod, *w_in, *rpb, *sink, *w_alpha_up, *b_alpha, *gla_norm_w,
        *conv_w, *conv_b, *fw1, *fb1, *fw2, *fb2, *fw3, *fb3, *ffreq, *fwout, *fbias, *w_branch, *w_out, *final_norm_w;
    float* out;
    unsigned char* ws;
    int ph_lo, ph_hi;
    int dry, pad_;
};

DEVI int ltid() { int t = threadIdx.x; asm volatile("" : "+v"(t)); return t; }
DEVI float bf2f(bf16_t v) { return __uint_as_float(((unsigned)v) << 16); }
typedef __bf16 bf16v2 __attribute__((ext_vector_type(2)));
typedef float f32v2 __attribute__((ext_vector_type(2)));
DEVI unsigned pk2(float lo, float hi) { f32v2 v = {lo, hi}; bf16v2 b = __builtin_convertvector(v, bf16v2); return __builtin_bit_cast(unsigned, b); }
DEVI bf16_t f2bf(float f) { return (bf16_t)(pk2(f, 0.f) & 0xffff); }
DEVI float lo_bf(unsigned u) { return __uint_as_float(u << 16); }
DEVI float hi_bf(unsigned u) { return __uint_as_float(u & 0xffff0000u); }
DEVI float siluf(float v) { return v * __builtin_amdgcn_rcpf(1.f + __expf(-v)); }
DEVI float sigmf(float v) { return __builtin_amdgcn_rcpf(1.f + __expf(-v)); }
DEVI void row_decode(int row, int& b, int& t, bool& isctx) {
    if (row < NL) { b = row >> 14; t = row & (T - 1); isctx = false; }
    else { int r = row - NL; b = r >> 8; t = r & (CL - 1); isctx = true; }
}
DEVI float wave_sum(float v) {
#pragma unroll
    for (int o = 32; o >= 1; o >>= 1) v += __shfl_xor(v, o);
    return v;
}
DEVI float block_sum(float v, float* red  ) {
    v = wave_sum(v);
    __syncthreads();
    if ((ltid() & 63) == 0) red[ltid() >> 6] = v;
    __syncthreads();
    float s = 0.f;
#pragma unroll
    for (int i = 0; i < NTHR / 64; ++i) s += red[i];
    return s;
}

constexpr int LSTR = 72;
constexpr int GA_EL = 256 * LSTR, GB_EL = 128 * LSTR;
template <int NT> struct GAcc { f32x16 a[2][NT]; };

template <int NT, int DEPTH = 1>
DEVI void gemm_kloop(const bf16_t* __restrict__ A, int lda, const bf16_t* __restrict__ Bt, int ldb, int K, int m0, int n0,
                     bf16_t* sm, GAcc<NT>& acc) {
    const int tid = ltid(), lane = tid & 63, wave = tid >> 6, wm = wave >> 1, wn = wave & 1;
    const int lr = tid >> 3, lc = tid & 7;
    const char* Ab = (const char*)(A + (size_t)m0 * lda); const char* Bb = (const char*)(Bt + (size_t)n0 * ldb);
    const unsigned aoff = (unsigned)(lr * lda + lc * 8) * 2u, boff = (unsigned)(lr * ldb + lc * 8) * 2u;
    uint4 xa0, xa1, xa2, xa3, xb0, xb1 = {0, 0, 0, 0};
    uint4 ya0, ya1, ya2, ya3, yb0, yb1 = {0, 0, 0, 0};
    const int KT = K / 64;
    const int frow = lane & 31, fk = (lane >> 5) * 8;
    const unsigned sa64 = 128u * (unsigned)lda, sb64 = 128u * (unsigned)ldb;
#define GLOAD(P, KTI) { const unsigned ko_ = (unsigned)(KTI) * 128u; P##a0 = *(const uint4*)(Ab + (aoff + ko_)); P##a1 = *(const uint4*)(Ab + (aoff + sa64 + ko_)); P##a2 = *(const uint4*)(Ab + (aoff + 2 * sa64 + ko_)); \
                        P##a3 = *(const uint4*)(Ab + (aoff + 3 * sa64 + ko_)); P##b0 = *(const uint4*)(Bb + (boff + ko_)); if constexpr (NT > 1) P##b1 = *(const uint4*)(Bb + (boff + sb64 + ko_)); }
#define LWRITE(P, BUF) { bf16_t* wa_ = sm + (BUF) * (GA_EL + GB_EL) + lr * LSTR + lc * 8; bf16_t* wb_ = wa_ + GA_EL; \
                        *(uint4*)(wa_) = P##a0; *(uint4*)(wa_ + 64 * LSTR) = P##a1; *(uint4*)(wa_ + 128 * LSTR) = P##a2; *(uint4*)(wa_ + 192 * LSTR) = P##a3; \
                        *(uint4*)(wb_) = P##b0; if constexpr (NT > 1) *(uint4*)(wb_ + 64 * LSTR) = P##b1; }
    auto compute = [&](int buf) {
        const bf16_t* sa = sm + buf * (GA_EL + GB_EL) + (wm * 64 + frow) * LSTR + fk;
        const bf16_t* sb = sm + buf * (GA_EL + GB_EL) + GA_EL + (wn * 32 * NT + frow) * LSTR + fk;
#pragma unroll
        for (int ks = 0; ks < 4; ++ks) {
            bf16x8 tf[2], cf[NT];
#pragma unroll
            for (int mt = 0; mt < 2; ++mt) tf[mt] = *(const bf16x8*)(sa + mt * 32 * LSTR + ks * 16);
#pragma unroll
            for (int nt = 0; nt < NT; ++nt) cf[nt] = *(const bf16x8*)(sb + nt * 32 * LSTR + ks * 16);
#pragma unroll
            for (int mt = 0; mt < 2; ++mt)
#pragma unroll
                for (int nt = 0; nt < NT; ++nt)
                    acc.a[mt][nt] = __builtin_amdgcn_mfma_f32_32x32x16_bf16(cf[nt], tf[mt], acc.a[mt][nt], 0, 0, 0);
        }
    };
    __syncthreads();
    if constexpr (DEPTH == 1) {
        GLOAD(x, 0); LWRITE(x, 0); GLOAD(x, 1);
        __syncthreads();
        for (int kt = 0; kt < KT; ++kt) {
            if (kt + 1 < KT) LWRITE(x, (kt + 1) & 1);
            if (kt + 2 < KT) GLOAD(x, kt + 2);
            compute(kt & 1);
            __syncthreads();
        }
    } else {
        GLOAD(x, 0); LWRITE(x, 0); GLOAD(x, 1); GLOAD(y, 2);
        __syncthreads();
        for (int kt = 0; kt < KT; kt += 2) {
            LWRITE(x, 1);
            if (kt + 3 < KT) GLOAD(x, kt + 3);
            compute(0);
            __syncthreads();
            if (kt + 2 < KT) LWRITE(y, 0);
            if (kt + 4 < KT) GLOAD(y, kt + 4);
            compute(1);
            __syncthreads();
        }
    }
#undef GLOAD
#undef LWRITE
}
DEVI int tile_of(int it) {
    const int per = gridDim.x >> 3;
    if ((gridDim.x & 7) != 0 || per == 0) return it * gridDim.x + blockIdx.x;
    return it * gridDim.x + (blockIdx.x & 7) * per + (blockIdx.x >> 3);
}
template <int NT> DEVI void acc_zero(GAcc<NT>& acc) {
#pragma unroll
    for (int mt = 0; mt < 2; ++mt)
#pragma unroll
        for (int nt = 0; nt < NT; ++nt)
#pragma unroll
            for (int i = 0; i < 16; ++i) acc.a[mt][nt][i] = 0.f;
}
template <int NT, class F> DEVI void acc_foreach(const GAcc<NT>& acc, int m0, int n0, F f) {
    const int lane = ltid() & 63, wave = ltid() >> 6, wm = wave >> 1, wn = wave & 1;
#pragma unroll
    for (int mt = 0; mt < 2; ++mt) {
        const int row = m0 + wm * 64 + mt * 32 + (lane & 31);
#pragma unroll
        for (int nt = 0; nt < NT; ++nt)
#pragma unroll
            for (int q = 0; q < 4; ++q) {
                const int col = n0 + wn * 32 * NT + nt * 32 + q * 8 + (lane >> 5) * 4;
                f(row, col, acc.a[mt][nt][q * 4 + 0], acc.a[mt][nt][q * 4 + 1], acc.a[mt][nt][q * 4 + 2], acc.a[mt][nt][q * 4 + 3]);
            }
    }
}
constexpr int EST = 68;
template <int NT> DEVI void epi_stage(const GAcc<NT>& acc, int mt, float* reg) {
    const int lane = ltid() & 63;
    __syncthreads();
#pragma unroll
    for (int nt = 0; nt < NT; ++nt)
#pragma unroll
        for (int q = 0; q < 4; ++q) {
            float4 w = {acc.a[mt][nt][q * 4 + 0], acc.a[mt][nt][q * 4 + 1], acc.a[mt][nt][q * 4 + 2], acc.a[mt][nt][q * 4 + 3]};
            *(float4*)(reg + (lane & 31) * EST + nt * 32 + q * 8 + (lane >> 5) * 4) = w;
        }
    __syncthreads();
}
template <int NT, class F> DEVI void epi_rows8(const float* reg, F f) {
    const int lane = ltid() & 63;
#pragma unroll
    for (int it = 0; it < 2 * NT; ++it) {
        const int idx = it * 64 + lane, rl = idx / (NT * 4), ch = idx % (NT * 4);
        const float4 a = *(const float4*)(reg + rl * EST + ch * 8), b = *(const float4*)(reg + rl * EST + ch * 8 + 4);
        f(rl, ch * 8, a, b);
    }
}
DEVI void st8bf(bf16_t* p, float4 a, float4 b) { uint4 w; w.x = pk2(a.x, a.y); w.y = pk2(a.z, a.w); w.z = pk2(b.x, b.y); w.w = pk2(b.z, b.w); *(uint4*)p = w; }
DEVI float4 silu4(float4 a) { return make_float4(siluf(a.x), siluf(a.y), siluf(a.z), siluf(a.w)); }
template <int H, int DH> DEVI void epi_vt(const float* reg, bf16_t* VT, int row0  , int colv0) {
    const int lane = ltid() & 63;
    int b, t; bool ic; row_decode(row0, b, t, ic);
    const int tp = lane & 15, cg = lane >> 4;
#pragma unroll 4
    for (int it = 0; it < 16; ++it) {
        const int c = it * 4 + cg, colv = colv0 + c, h = colv / DH, d = colv % DH;
        const float v0 = reg[(2 * tp) * EST + c], v1 = reg[(2 * tp + 1) * EST + c];
        bf16_t* pp = ic ? (VT + (size_t)NB * H * DH * T + ((size_t)(b * H + h) * DH + d) * CL + t + 2 * tp) : (VT + ((size_t)(b * H + h) * DH + d) * T + t + 2 * tp);
        *(unsigned*)pp = pk2(v0, v1);
    }
}
DEVI void st4bf(bf16_t* p, float a, float b, float c, float d) { uint2 w; w.x = pk2(a, b); w.y = pk2(c, d); *(uint2*)p = w; }
template <int H, int DH> DEVI void store_vt(bf16_t* VT, int row, int colv, float v0, float v1, float v2, float v3) {
    int b, t; bool ic; row_decode(row, b, t, ic);
    const int h = colv / DH, d = colv % DH;
    bf16_t* p = ic ? (VT + (size_t)NB * H * DH * T + ((size_t)(b * H + h) * DH + d) * CL + t) : (VT + ((size_t)(b * H + h) * DH + d) * T + t);
    const size_t st = ic ? CL : T;
    p[0] = f2bf(v0); p[st] = f2bf(v1); p[2 * st] = f2bf(v2); p[3 * st] = f2bf(v3);
}

template <int BR>
DEVI void phase_inproj(const P& p, int l, bf16_t* sm) {
    unsigned char* ws = p.ws;
    const bf16_t* HL = (const bf16_t*)(ws + OFF_HL);
    constexpr int colbase = BR == 0 ? COL_A : BR == 1 ? COL_B : BR == 2 ? COL_C : COL_D;
    constexpr int N = BR == 0 ? 2048 : BR == 1 ? 1280 : BR == 2 ? 1568 : 2048;
    const bf16_t* Wt = (const bf16_t*)(ws + OFF_WINT) + ((size_t)l * IN_TOTAL + colbase) * D;
    unsigned char* scr = ws + OFF_SCR;
    bf16_t* YSb = (bf16_t*)(ws + OFF_YS + BR * SZ512);
    const float* rope = (const float*)(ws + OFF_ROPE);
    constexpr int tilesN = (N + 127) / 128;
    const int tilesM = (BR == 3 && l == 1) ? NL / 256 : NR / 256;
    for (int it = 0;; ++it) {
        const int tile = tile_of(it);
        if (it * (int)gridDim.x >= tilesM * tilesN) break;
        if (tile >= tilesM * tilesN) continue;
        const int tm = tile / tilesN, tn = tile % tilesN;
        const int m0 = tm * 256, n0 = tn * 128;
        GAcc<2> acc; acc_zero(acc);
        gemm_kloop<2, 1>(HL, D, Wt, D, D, m0, n0, sm, acc);
        const int lane = ltid() & 63, wave = ltid() >> 6, wm = wave >> 1, wn = wave & 1;
        float* reg = (float*)sm + wave * (32 * EST);
        const int cb = n0 + wn * 64;
#pragma unroll
        for (int mt = 0; mt < 2; ++mt) {
            epi_stage<2>(acc, mt, reg);
            const int rbase = m0 + wm * 64 + mt * 32;
            if constexpr (BR == 0) {
                bf16_t* Q = (bf16_t*)(scr + SA_Q); bf16_t* Kb = (bf16_t*)(scr + SA_K); bf16_t* VT = (bf16_t*)(scr + SA_VT);
                const int seg = cb >> 9, cc0 = cb & 511;
                if (seg == 2) epi_vt<8, 64>(reg, VT, rbase, cc0);
                else epi_rows8<2>(reg, [&](int rl, int cl, float4 a, float4 b) {
                    const size_t o = (size_t)(rbase + rl) * 512 + cc0 + cl;
                    if (seg == 0) st8bf(Q + o, a, b); else if (seg == 1) st8bf(Kb + o, a, b); else st8bf(YSb + o, silu4(a), silu4(b));
                });
            } else if constexpr (BR == 1) {
                bf16_t* Q = (bf16_t*)(scr + SB_Q); bf16_t* Kb = (bf16_t*)(scr + SB_K); bf16_t* VT = (bf16_t*)(scr + SB_VT);
                if (cb >= 640 && cb < 768) epi_vt<2, 64>(reg, VT, rbase, cb - 640);
                else epi_rows8<2>(reg, [&](int rl, int cl, float4 a, float4 b) {
                    const int row = rbase + rl;
                    if (cb < 640) {
                        if (row < NL) {
                            const float4 pa = *(const float4*)(reg + rl * EST + (cl ^ 32)), pb = *(const float4*)(reg + rl * EST + (cl ^ 32) + 4);
                            const int t = row & (T - 1), c = cl & 31;
                            const float4 c0 = *(const float4*)(rope + (size_t)t * 32 + c), c1 = *(const float4*)(rope + (size_t)t * 32 + c + 4);
                            const float4 s0 = *(const float4*)(rope + (size_t)T * 32 + (size_t)t * 32 + c), s1 = *(const float4*)(rope + (size_t)T * 32 + (size_t)t * 32 + c + 4);
                            if (cl < 32) {
                                a = make_float4(a.x * c0.x - pa.x * s0.x, a.y * c0.y - pa.y * s0.y, a.z * c0.z - pa.z * s0.z, a.w * c0.w - pa.w * s0.w);
                                b = make_float4(b.x * c1.x - pb.x * s1.x, b.y * c1.y - pb.y * s1.y, b.z * c1.z - pb.z * s1.z, b.w * c1.w - pb.w * s1.w);
                            } else {
                                a = make_float4(pa.x * s0.x + a.x * c0.x, pa.y * s0.y + a.y * c0.y, pa.z * s0.z + a.z * c0.z, pa.w * s0.w + a.w * c0.w);
                                b = make_float4(pb.x * s1.x + b.x * c1.x, pb.y * s1.y + b.y * c1.y, pb.z * s1.z + b.z * c1.z, pb.w * s1.w + b.w * c1.w);
                            }
                        }
                        if (cb < 512) st8bf(Q + (size_t)row * 512 + cb + cl, a, b);
                        else st8bf(Kb + (size_t)row * 128 + (cb - 512) + cl, a, b);
                    } else st8bf(YSb + (size_t)row * 512 + (cb - 768) + cl, silu4(a), silu4(b));
                });
            } else if constexpr (BR == 2) {
                bf16_t* Q = (bf16_t*)(scr + SC_Q); bf16_t* Kb = (bf16_t*)(scr + SC_K); bf16_t* VT = (bf16_t*)(scr + SC_VT);
                float* LR = (float*)(scr + SC_LR);
                if (cb >= 512 && cb < 1024) epi_vt<4, 128>(reg, VT, rbase, cb - 512);
                else epi_rows8<2>(reg, [&](int rl, int cl, float4 a, float4 b) {
                    const int row = rbase + rl, col = cb + cl;
                    if (col < 256) { const float sc = 0.125f; st8bf(Q + (size_t)row * 256 + col, make_float4(a.x * sc, a.y * sc, a.z * sc, a.w * sc), make_float4(b.x * sc, b.y * sc, b.z * sc, b.w * sc)); }
                    else if (col < 512) st8bf(Kb + (size_t)row * 256 + (col - 256), a, b);
                    else if (col < 1056) { *(float4*)(LR + (size_t)row * 32 + (col - 1024)) = a; *(float4*)(LR + (size_t)row * 32 + (col - 1024) + 4) = b; }
                    else if (col < 1568) st8bf(YSb + (size_t)row * 512 + (col - 1056), silu4(a), silu4(b));
                });
            } else {
                bf16_t* U = (bf16_t*)(scr + SD_U);
                epi_rows8<2>(reg, [&](int rl, int cl, float4 a, float4 b) {
                    const int row = rbase + rl, col = cb + cl;
                    if (col < 1536) st8bf(U + (size_t)row * 1536 + col, a, b);
                    else st8bf(YSb + (size_t)row * 512 + (col - 1536), silu4(a), silu4(b));
                });
            }
        }
    }
}

DEVI void phase_merge(const P& p, int l, bf16_t* sm) {
    unsigned char* ws = p.ws;
    const bf16_t* HL = (const bf16_t*)(ws + OFF_HL);
    const bf16_t* Wgm = (const bf16_t*)(ws + OFF_WINT) + ((size_t)l * IN_TOTAL + COL_GM) * D;
    const bf16_t* Wb = (const bf16_t*)(ws + OFF_WBT) + (size_t)l * 4 * D * 512;
    bf16_t* ACCM = (bf16_t*)(ws + OFF_SCR);
    const int M = (l == 0) ? NR : NL;
    const int tilesM = M / 256, tilesN = D / 128;
    for (int it = 0;; ++it) {
        const int tile = tile_of(it);
        if (it * (int)gridDim.x >= tilesM * tilesN) break;
        if (tile >= tilesM * tilesN) continue;
        const int tm = tile / tilesN, tn = tile % tilesN;
        const int m0 = tm * 256, n0 = tn * 128;
        GAcc<2> tot; acc_zero(tot);
        unsigned totp[2][2][8];
#pragma unroll
        for (int mt = 0; mt < 2; ++mt)
#pragma unroll
            for (int nt = 0; nt < 2; ++nt)
#pragma unroll
                for (int e = 0; e < 8; ++e) totp[mt][nt][e] = 0u;
#pragma unroll 1
        for (int i = 0; i < 4; ++i) {
#ifdef TIMING_A
            gemm_kloop<2>((const bf16_t*)(ws + OFF_YS + i * SZ512), 512, Wb + (size_t)i * D * 512, 512, 512, m0, n0, sm, tot);
            GAcc<2> g; acc_zero(g);
            gemm_kloop<2>(HL, D, Wgm + (size_t)i * D * D, D, D, m0, n0, sm, g);
#pragma unroll
            for (int mt = 0; mt < 2; ++mt)
#pragma unroll
                for (int nt = 0; nt < 2; ++nt)
#pragma unroll
                    for (int e = 0; e < 16; ++e) tot.a[mt][nt][e] += sigmf(g.a[mt][nt][e]);
        }
#else
            unsigned pp[2][2][8];
            {
                GAcc<2> pr; acc_zero(pr);
                gemm_kloop<2>((const bf16_t*)(ws + OFF_YS + i * SZ512), 512, Wb + (size_t)i * D * 512, 512, 512, m0, n0, sm, pr);
#pragma unroll
                for (int mt = 0; mt < 2; ++mt)
#pragma unroll
                    for (int nt = 0; nt < 2; ++nt)
#pragma unroll
                        for (int e = 0; e < 8; ++e) pp[mt][nt][e] = pk2(pr.a[mt][nt][2 * e], pr.a[mt][nt][2 * e + 1]);
            }
            GAcc<2> g; acc_zero(g);
            gemm_kloop<2>(HL, D, Wgm + (size_t)i * D * D, D, D, m0, n0, sm, g);
#pragma unroll
            for (int mt = 0; mt < 2; ++mt)
#pragma unroll
                for (int nt = 0; nt < 2; ++nt)
#pragma unroll
                    for (int e = 0; e < 8; ++e) {
                        const float t0 = lo_bf(totp[mt][nt][e]) + sigmf(g.a[mt][nt][2 * e]) * lo_bf(pp[mt][nt][e]);
                        const float t1 = hi_bf(totp[mt][nt][e]) + sigmf(g.a[mt][nt][2 * e + 1]) * hi_bf(pp[mt][nt][e]);
                        totp[mt][nt][e] = pk2(t0, t1);
                    }
        }
#pragma unroll
        for (int mt = 0; mt < 2; ++mt)
#pragma unroll
            for (int nt = 0; nt < 2; ++nt)
#pragma unroll
                for (int e = 0; e < 8; ++e) { tot.a[mt][nt][2 * e] = lo_bf(totp[mt][nt][e]); tot.a[mt][nt][2 * e + 1] = hi_bf(totp[mt][nt][e]); }
#endif
        {
            const int wave = ltid() >> 6, wm = wave >> 1, wn = wave & 1;
            float* reg = (float*)sm + wave * (32 * EST);
#pragma unroll
            for (int mt = 0; mt < 2; ++mt) {
                epi_stage<2>(tot, mt, reg);
                epi_rows8<2>(reg, [&](int rl, int cl, float4 a, float4 b) { st8bf(ACCM + (size_t)(m0 + wm * 64 + mt * 32 + rl) * D + n0 + wn * 64 + cl, a, b); });
            }
        }
    }
}

DEVI void phase_out(const P& p, int l, bf16_t* sm) {
    unsigned char* ws = p.ws;
    const bf16_t* ACCM = (const bf16_t*)(ws + OFF_SCR);
    const bf16_t* Wo = (const bf16_t*)(ws + OFF_WOT) + (size_t)l * D * D;
    const float* MOD = (const float*)(ws + OFF_MOD) + (size_t)l * 3 * 3072;
    float* XC1 = (float*)(ws + OFF_XC1);
    const int M = (l == 0) ? NR : NL;
    const int tilesM = M / 256, tilesN = D / 128;
    for (int it = 0;; ++it) {
        const int tile = tile_of(it);
        if (it * (int)gridDim.x >= tilesM * tilesN) break;
        if (tile >= tilesM * tilesN) continue;
        const int tm = tile / tilesN, tn = tile % tilesN;
        const int m0 = tm * 256, n0 = tn * 128;
        GAcc<2> acc; acc_zero(acc);
        gemm_kloop<2, 1>(ACCM, D, Wo, D, D, m0, n0, sm, acc);
        {
            const int wave = ltid() >> 6, wm = wave >> 1, wn = wave & 1;
            float* reg = (float*)sm + wave * (32 * EST);
#pragma unroll
            for (int mt = 0; mt < 2; ++mt) {
                epi_stage<2>(acc, mt, reg);
                epi_rows8<2>(reg, [&](int rl, int cl, float4 a, float4 b) {
                    const int row = m0 + wm * 64 + mt * 32 + rl, col = n0 + wn * 64 + cl;
                    const bool ic = row >= NL;
                    const int mi = ic ? 2 : (row >> 14);
                    const float4 g0 = *(const float4*)(MOD + mi * 3072 + 2048 + col), g1 = *(const float4*)(MOD + mi * 3072 + 2048 + col + 4);
                    const float* src; float* dst;
                    if (ic) { src = (l == 0 ? p.ctx : XC1) + (size_t)(row - NL) * D + col; dst = XC1 + (size_t)(row - NL) * D + col; }
                    else { src = (l == 0 ? p.x : p.out) + (size_t)row * D + col; dst = p.out + (size_t)row * D + col; }
                    const float4 x0 = *(const float4*)src, x1 = *(const float4*)(src + 4);
                    if (!p.dry) {
                        *(float4*)dst = make_float4(x0.x + g0.x * a.x, x0.y + g0.y * a.y, x0.z + g0.z * a.z, x0.w + g0.w * a.w);
                        *(float4*)(dst + 4) = make_float4(x1.x + g1.x * b.x, x1.y + g1.y * b.y, x1.z + g1.z * b.z, x1.w + g1.w * b.w);
                    }
                });
            }
        }
    }
}

DEVI void transpose_tile(const float* __restrict__ src, int K, int N, bf16_t* __restrict__ dst, int k0, int n0, float* sm) {
    const int tid = ltid();
    __syncthreads();
    {
        const int kr = tid >> 4, nc = (tid & 15) * 4;
#pragma unroll
        for (int i = 0; i < 2; ++i) {
            const int k = kr + 32 * i;
            float4 v = {0.f, 0.f, 0.f, 0.f};
            if (n0 + nc < N) v = *(const float4*)(src + (size_t)(k0 + k) * N + n0 + nc);
            sm[k * 65 + nc + 0] = v.x; sm[k * 65 + nc + 1] = v.y; sm[k * 65 + nc + 2] = v.z; sm[k * 65 + nc + 3] = v.w;
        }
    }
    __syncthreads();
    {
        const int n = tid >> 3, kc = (tid & 7) * 8;
        if (n0 + n < N) {
            uint4 w;
            w.x = pk2(sm[(kc + 0) * 65 + n], sm[(kc + 1) * 65 + n]); w.y = pk2(sm[(kc + 2) * 65 + n], sm[(kc + 3) * 65 + n]);
            w.z = pk2(sm[(kc + 4) * 65 + n], sm[(kc + 5) * 65 + n]); w.w = pk2(sm[(kc + 6) * 65 + n], sm[(kc + 7) * 65 + n]);
            *(uint4*)(dst + (size_t)(n0 + n) * K + k0 + kc) = w;
        }
    }
}

DEVI void hyena_mlp_task(const P& p, int l, int L, int p0, float* HT, float* sm) {
    const int tid = ltid();
    float* zb = sm;
    float* h1 = sm + 64 * 33;
    float* h2 = h1 + 64 * 65;
    const float* w1 = p.fw1 + (size_t)l * 33 * 64; const float* b1 = p.fb1 + l * 64;
    const float* w2 = p.fw2 + (size_t)l * 64 * 64; const float* b2 = p.fb2 + l * 64;
    const float* w3 = p.fw3 + (size_t)l * 64 * 64; const float* b3 = p.fb3 + l * 64;
    const float* fr = p.ffreq + l * 64;
    __syncthreads();
#pragma unroll 1
    for (int e = tid; e < 64 * 33; e += NTHR) {
        const int pos = e / 33, k = e % 33;
        const int pp = p0 + pos;
        float v;
        if (k == 0) v = (float)pp / (float)(L - 1);
        else {
            const int j = (k - 1) & 15;
            const float f = 1e-4f + (float)j * ((15.0f - 1e-4f) / 15.0f);
            const float wa = 6.283185307179586f * (float)pp / (float)L;
            v = (k <= 16) ? cosf(f * wa) : -sinf(f * wa);
        }
        zb[e] = v;
    }
    __syncthreads();
    const int pos = tid >> 3, fg = (tid & 7) * 8;
    {
        float a[8];
#pragma unroll
        for (int j = 0; j < 8; ++j) a[j] = b1[fg + j];
#pragma unroll 1
        for (int k = 0; k < 33; ++k) {
            const float zv = zb[pos * 33 + k];
#pragma unroll
            for (int j = 0; j < 8; ++j) a[j] += zv * w1[k * 64 + fg + j];
        }
#pragma unroll
        for (int j = 0; j < 8; ++j) h1[pos * 65 + fg + j] = sinf(fr[fg + j] * a[j]);
    }
    __syncthreads();
    {
        float a[8];
#pragma unroll
        for (int j = 0; j < 8; ++j) a[j] = b2[fg + j];
#pragma unroll 2
        for (int k = 0; k < 64; ++k) {
            const float zv = h1[pos * 65 + k];
#pragma unroll
            for (int j = 0; j < 8; ++j) a[j] += zv * w2[k * 64 + fg + j];
        }
#pragma unroll
        for (int j = 0; j < 8; ++j) h2[pos * 65 + fg + j] = sinf(fr[fg + j] * a[j]);
    }
    __syncthreads();
    {
        float a[8];
#pragma unroll
        for (int j = 0; j < 8; ++j) a[j] = b3[fg + j];
#pragma unroll 2
        for (int k = 0; k < 64; ++k) {
            const float zv = h2[pos * 65 + k];
#pragma unroll
            for (int j = 0; j < 8; ++j) a[j] += zv * w3[k * 64 + fg + j];
        }
#pragma unroll
        for (int j = 0; j < 8; ++j) HT[(size_t)(fg + j) * L + p0 + pos] = sinf(fr[fg + j] * a[j]);
    }
}

DEVI void phase_prep(const P& p, float* sm) {
    unsigned char* ws = p.ws;
    const int tid = ltid();
    constexpr int TN_IN = (IN_TOTAL + 63) / 64;
    constexpr int T_WIN = 2 * 16 * TN_IN;
    constexpr int T_WB = 2 * 4 * 8 * 16;
    constexpr int T_WO = 2 * 16 * 16;
    constexpr int T_MOD = 2 * 48;
    constexpr int T_ROPE = T * 32 / NTHR;
    constexpr int T_MLP = 2 * 256 + 4;
    constexpr int E0 = T_WIN, E1 = E0 + T_WB, E2 = E1 + T_WO, E3 = E2 + T_MOD, E4 = E3 + T_ROPE, E5 = E4 + T_MLP;
    for (int task = blockIdx.x; task < E5; task += gridDim.x) {
        if (task < E0) {
            const int l = task / (16 * TN_IN), r = task % (16 * TN_IN), kt = r / TN_IN, nt = r % TN_IN;
            transpose_tile(p.w_in + (size_t)l * D * IN_TOTAL, D, IN_TOTAL, (bf16_t*)(ws + OFF_WINT) + (size_t)l * IN_TOTAL * D, kt * 64, nt * 64, sm);
        } else if (task < E1) {
            const int q = task - E0, li = q / 128, r = q % 128, kt = r / 16, nt = r % 16;
            transpose_tile(p.w_branch + (size_t)li * 512 * D, 512, D, (bf16_t*)(ws + OFF_WBT) + (size_t)li * D * 512, kt * 64, nt * 64, sm);
        } else if (task < E2) {
            const int q = task - E1, l = q / 256, r = q % 256, kt = r / 16, nt = r % 16;
            transpose_tile(p.w_out + (size_t)l * D * D, D, D, (bf16_t*)(ws + OFF_WOT) + (size_t)l * D * D, kt * 64, nt * 64, sm);
        } else if (task < E3) {
            const int q = task - E2, l = q / 48, jb = q % 48;
            float* sc = sm;
            float* red = sm + 3072;
            __syncthreads();
#pragma unroll 1
            for (int e = tid; e < 3072; e += NTHR) {
                const int mi = e >> 10, k = e & 1023;
                const float v = (mi < 2) ? p.c[mi * D + k] : p.c_ctx[k];
                sc[e] = siluf(v);
            }
            __syncthreads();
            const int kg = tid >> 6, jj = tid & 63, j = jb * 64 + jj;
            const float* w = p.w_mod + (size_t)l * D * 3072 + j;
            float a0 = 0.f, a1 = 0.f, a2 = 0.f;
#pragma unroll 8
            for (int k = kg * 128; k < kg * 128 + 128; ++k) {
                const float wv = w[(size_t)k * 3072];
                a0 += sc[k] * wv; a1 += sc[1024 + k] * wv; a2 += sc[2048 + k] * wv;
            }
            red[(0 * 8 + kg) * 64 + jj] = a0; red[(1 * 8 + kg) * 64 + jj] = a1; red[(2 * 8 + kg) * 64 + jj] = a2;
            __syncthreads();
            if (tid < 192) {
                const int mi = tid >> 6, j2 = tid & 63;
                float s = p.b_mod[l * 3072 + jb * 64 + j2];
#pragma unroll
                for (int g = 0; g < 8; ++g) s += red[(mi * 8 + g) * 64 + j2];
                ((float*)(ws + OFF_MOD))[((size_t)l * 3 + mi) * 3072 + jb * 64 + j2] = s;
            }
        } else if (task < E4) {
            const int e = (task - E3) * NTHR + tid;
            const int t = e >> 5, c = e & 31;
            const float inv = powf(10000.0f, -(float)(c & 15) / 16.0f);
            const float pos = (c < 16) ? (float)(t >> 6) : (float)(t & 63);
            const float ang = pos * inv;
            float* rope = (float*)(ws + OFF_ROPE);
            rope[e] = cosf(ang); rope[(size_t)T * 32 + e] = sinf(ang);
        } else {
            const int q = task - E4;
            if (q < 512) { const int l = q >> 8; hyena_mlp_task(p, l, T, (q & 255) * 64, (float*)(ws + OFF_HH3T) + (size_t)l * 64 * T, sm); }
            else hyena_mlp_task(p, 0, CL, (q - 512) * 64, (float*)(ws + OFF_HH3C), sm);
        }
    }
}

DEVI void phase_hl(const P& p, int l) {
    unsigned char* ws = p.ws;
    const int lane = ltid() & 63, wave = ltid() >> 6;
    const float* MOD = (const float*)(ws + OFF_MOD) + (size_t)l * 3 * 3072;
    const float* nw = p.norm_w + l * D;
    bf16_t* HL = (bf16_t*)(ws + OFF_HL);
    const float* XC1 = (const float*)(ws + OFF_XC1);
    for (int row = blockIdx.x * 8 + wave; row < NR; row += gridDim.x * 8) {
        const float* src; int mi;
        if (row < NL) { src = (l == 0 ? p.x : p.out) + (size_t)row * D; mi = row >> 14; }
        else { src = (l == 0 ? p.ctx : XC1) + (size_t)(row - NL) * D; mi = 2; }
        float4 v[4]; float ss = 0.f;
#pragma unroll
        for (int i = 0; i < 4; ++i) { v[i] = *(const float4*)(src + lane * 4 + 256 * i); ss += v[i].x * v[i].x + v[i].y * v[i].y + v[i].z * v[i].z + v[i].w * v[i].w; }
        ss = wave_sum(ss);
        const float rs = rsqrtf(ss * (1.0f / D) + EPS);
        const float* sh = MOD + mi * 3072; const float* sc = sh + 1024;
#pragma unroll
        for (int i = 0; i < 4; ++i) {
            const int c = lane * 4 + 256 * i;
            const float4 w = *(const float4*)(nw + c), s1 = *(const float4*)(sc + c), s0 = *(const float4*)(sh + c);
            st4bf(HL + (size_t)row * D + c, v[i].x * rs * w.x * (1.f + s1.x) + s0.x, v[i].y * rs * w.y * (1.f + s1.y) + s0.y,
                  v[i].z * rs * w.z * (1.f + s1.z) + s0.z, v[i].w * rs * w.w * (1.f + s1.w) + s0.w);
        }
    }
}
DEVI void phase_final(const P& p) {
    const int lane = ltid() & 63, wave = ltid() >> 6;
    for (int row = blockIdx.x * 8 + wave; row < NL; row += gridDim.x * 8) {
        float* src = p.out + (size_t)row * D;
        float4 v[4]; float ss = 0.f;
#pragma unroll
        for (int i = 0; i < 4; ++i) { v[i] = *(const float4*)(src + lane * 4 + 256 * i); ss += v[i].x * v[i].x + v[i].y * v[i].y + v[i].z * v[i].z + v[i].w * v[i].w; }
        ss = wave_sum(ss);
        const float rs = rsqrtf(ss * (1.0f / D) + EPS);
#pragma unroll
        for (int i = 0; i < 4; ++i) {
            const int c = lane * 4 + 256 * i;
            const float4 w = *(const float4*)(p.final_norm_w + c);
            float4 r = {v[i].x * rs * w.x, v[i].y * rs * w.y, v[i].z * rs * w.z, v[i].w * rs * w.w};
            *(float4*)(src + c) = r;
        }
    }
}

union U8 { bf16x8 v; uint4 u; uint2 h[2]; unsigned w[4]; };
struct AttSt { float m, l; f32x4 o[4]; };
constexpr float L2E = 1.4426950408889634f;
constexpr float NEG_INF = -__builtin_huge_valf();

DEVI float rows_max(float x) {
    const unsigned u = __float_as_uint(x);
    auto r = __builtin_amdgcn_permlane16_swap(u, u, false, false);
    const float a = fmaxf(__uint_as_float(r[0]), __uint_as_float(r[1]));
    const unsigned v = __float_as_uint(a);
    auto t = __builtin_amdgcn_permlane32_swap(v, v, false, false);
    return fmaxf(__uint_as_float(t[0]), __uint_as_float(t[1]));
}
DEVI float rows_sum(float x) {
    const unsigned u = __float_as_uint(x);
    auto r = __builtin_amdgcn_permlane16_swap(u, u, false, false);
    const float a = __uint_as_float(r[0]) + __uint_as_float(r[1]);
    const unsigned v = __float_as_uint(a);
    auto t = __builtin_amdgcn_permlane32_swap(v, v, false, false);
    return __uint_as_float(t[0]) + __uint_as_float(t[1]);
}
struct KVF { bf16x8 ka, kb, kc, kd; U8 v0, v1, v2, v3; };
DEVI void att_load(KVF& f, const bf16_t* k0p, const bf16_t* k1p, const bf16_t* v0p, const bf16_t* v1p, size_t ldv) {
    f.ka = *(const bf16x8*)k0p; f.kb = *(const bf16x8*)(k0p + 32);
    f.kc = *(const bf16x8*)k1p; f.kd = *(const bf16x8*)(k1p + 32);
    f.v0.u = *(const uint4*)(v0p); f.v1.u = *(const uint4*)(v0p + 16 * ldv);
    f.v2.u = *(const uint4*)(v0p + 32 * ldv); f.v3.u = *(const uint4*)(v0p + 48 * ldv);
}
DEVI void att_load2(KVF& f, const char* kb, unsigned k0, unsigned k1, const char* vb, unsigned v0, unsigned vstep) {
    f.ka = *(const bf16x8*)(kb + k0); f.kb = *(const bf16x8*)(kb + (k0 + 64u));
    f.kc = *(const bf16x8*)(kb + k1); f.kd = *(const bf16x8*)(kb + (k1 + 64u));
    f.v0.u = *(const uint4*)(vb + v0); f.v1.u = *(const uint4*)(vb + (v0 + vstep));
    f.v2.u = *(const uint4*)(vb + (v0 + 2u * vstep)); f.v3.u = *(const uint4*)(vb + (v0 + 3u * vstep));
}
DEVI void att_compute(AttSt& st, const bf16x8& q0, const bf16x8& q1, const KVF& f, f32x4 b0, f32x4 b1, float scale2) {
    f32x4 s0 = {0.f, 0.f, 0.f, 0.f}, s1 = {0.f, 0.f, 0.f, 0.f};
    s0 = __builtin_amdgcn_mfma_f32_16x16x32_bf16(f.ka, q0, s0, 0, 0, 0);
    s0 = __builtin_amdgcn_mfma_f32_16x16x32_bf16(f.kb, q1, s0, 0, 0, 0);
    s1 = __builtin_amdgcn_mfma_f32_16x16x32_bf16(f.kc, q0, s1, 0, 0, 0);
    s1 = __builtin_amdgcn_mfma_f32_16x16x32_bf16(f.kd, q1, s1, 0, 0, 0);
    s0 = s0 * scale2 + b0; s1 = s1 * scale2 + b1;
    float mx = fmaxf(fmaxf(fmaxf(s0[0], s0[1]), fmaxf(s0[2], s0[3])), fmaxf(fmaxf(s1[0], s1[1]), fmaxf(s1[2], s1[3])));
    mx = rows_max(mx);
    if (__any(mx > st.m + 8.0f)) {
        const float mn = fmaxf(st.m, mx);
        const float alpha = __builtin_amdgcn_exp2f(st.m - mn);
        st.l *= alpha; st.m = mn;
        st.o[0] = st.o[0] * alpha; st.o[1] = st.o[1] * alpha; st.o[2] = st.o[2] * alpha; st.o[3] = st.o[3] * alpha;
    }
    const float mref = st.m;
    float pa[8];
#pragma unroll
    for (int i = 0; i < 4; ++i) { pa[i] = __builtin_amdgcn_exp2f(s0[i] - mref); pa[4 + i] = __builtin_amdgcn_exp2f(s1[i] - mref); }
    st.l += ((pa[0] + pa[1]) + (pa[2] + pa[3])) + ((pa[4] + pa[5]) + (pa[6] + pa[7]));
    U8 pf; pf.w[0] = pk2(pa[0], pa[1]); pf.w[1] = pk2(pa[2], pa[3]); pf.w[2] = pk2(pa[4], pa[5]); pf.w[3] = pk2(pa[6], pa[7]);
    st.o[0] = __builtin_amdgcn_mfma_f32_16x16x32_bf16(f.v0.v, pf.v, st.o[0], 0, 0, 0);
    st.o[1] = __builtin_amdgcn_mfma_f32_16x16x32_bf16(f.v1.v, pf.v, st.o[1], 0, 0, 0);
    st.o[2] = __builtin_amdgcn_mfma_f32_16x16x32_bf16(f.v2.v, pf.v, st.o[2], 0, 0, 0);
    st.o[3] = __builtin_amdgcn_mfma_f32_16x16x32_bf16(f.v3.v, pf.v, st.o[3], 0, 0, 0);
}
#define ATT_PIPELINE(n_)                                              \
    { KVF fa_, fb_;                                                   \
      LOADS(fa_, 0);                                                  \
      int s_ = 0;                                                     \
      for (; s_ + 2 < (n_); s_ += 2) {        \
          LOADS(fb_, s_ + 1);                                         \
          COMPS(fa_, s_);                                             \
          LOADS(fa_, s_ + 2);                                         \
          COMPS(fb_, s_ + 1);                                         \
      }                                                               \
      if (s_ + 1 < (n_)) { LOADS(fb_, s_ + 1); COMPS(fa_, s_); COMPS(fb_, s_ + 1); } \
      else { COMPS(fa_, s_); } }
DEVI void att_finish(const AttSt& st, float extra_l, bf16_t* G  , int dry) {
    const int lane = ltid() & 63, g = lane >> 4;
    float lt = rows_sum(st.l);
    lt += extra_l;
    const float inv = 1.f / lt;
#pragma unroll
    for (int dt = 0; dt < 4; ++dt) {
        bf16_t* gp = G + dt * 16 + 4 * g;
        const uint2 gv = *(const uint2*)gp;
        if (!dry) st4bf(gp, st.o[dt][0] * inv * lo_bf(gv.x), st.o[dt][1] * inv * hi_bf(gv.x), st.o[dt][2] * inv * lo_bf(gv.y), st.o[dt][3] * inv * hi_bf(gv.y));
    }
}

DEVI void phase_att_a(const P& p, int l, float* smf) {
    unsigned char* ws = p.ws; unsigned char* scr = ws + OFF_SCR;
    const bf16_t* Q = (const bf16_t*)(scr + SA_Q); const bf16_t* K = (const bf16_t*)(scr + SA_K); const bf16_t* VT = (const bf16_t*)(scr + SA_VT);
    const bf16_t* VTC = VT + (size_t)NB * 8 * 64 * T;
    bf16_t* G = (bf16_t*)(ws + OFF_YS);
    const int tid = ltid(), lane = tid & 63, h = tid >> 6, q = lane & 15, g = lane >> 4;
    __syncthreads();
    for (int e = tid; e < 8 * 465; e += NTHR) smf[e] = p.rpb[(size_t)l * 8 * 465 + e] * L2E;
    __syncthreads();
    const float* tab = smf + h * 465;
    const float scale2 = 0.125f * L2E;
    const int ntask = 2048 + (l == 0 ? 32 : 0);
    for (int it = 0; it * (int)gridDim.x < ntask; ++it) {
        const int task = tile_of(it);
        if (task >= ntask) continue;
        AttSt st; st.m = -1e30f; st.l = 0.f;
#pragma unroll
        for (int dt = 0; dt < 4; ++dt) st.o[dt] = (f32x4){0.f, 0.f, 0.f, 0.f};
        int b, qrow;
        const bool lat = task < 2048;
        int r = 0, j = 0;
        if (lat) { b = task >> 10; r = (task >> 2) & 255; j = task & 3; qrow = b * T + r * 64 + j * 16 + q; }
        else { const int tt = task - 2048; b = tt >> 4; qrow = NL + b * CL + (tt & 15) * 16 + q; }
        const bf16_t* qp = Q + (size_t)qrow * 512 + h * 64 + g * 8;
        const bf16x8 q0 = *(const bf16x8*)qp, q1 = *(const bf16x8*)(qp + 32);
        {
            const int rs = min(max(r - 4, 0), 248), kc0 = min(max(j * 16 - 8, 0), 32);
            const int qc = j * 16 + q, cs = min(max(qc - 8, 0), 48);
            const int nloc = lat ? 8 : 0, nst = nloc + 8;
            const bf16_t* Kc = K + (size_t)(NL + b * CL) * 512 + h * 64 + g * 8;
            const bf16_t* Vc = VTC + ((size_t)(b * 8 + h) * 64 + (lane & 15)) * CL + 8 * g;
            const int kmap = 8 * ((lane & 15) >> 2) + (lane & 3);
            const char* KnB = (const char*)(K + (size_t)b * T * 512); const char* VnB = (const char*)(VT + (size_t)(b * 8) * 64 * T);
            const char* KcB = (const char*)(K + (size_t)(NL + b * CL) * 512); const char* VcB = (const char*)(VTC + (size_t)(b * 8) * 64 * CL);
            const unsigned kln = (unsigned)((kc0 + kmap) * 512 + h * 64 + g * 8) * 2u, vln = (unsigned)((h * 64 + (lane & 15)) * T + kc0 + 8 * g) * 2u;
            const unsigned klc = (unsigned)(kmap * 512 + h * 64 + g * 8) * 2u, vlc = (unsigned)((h * 64 + (lane & 15)) * CL + 8 * g) * 2u;
#define LOADS(F, S) { const int s2_ = (S); if (s2_ < nloc) { const unsigned k0_ = kln + (unsigned)(rs + s2_) * 65536u; \
                        att_load2(F, KnB, k0_, k0_ + 4096u, VnB, vln + (unsigned)(rs + s2_) * 128u, (unsigned)(16 * T * 2)); } \
                      else { const unsigned c_ = (unsigned)(s2_ - nloc); const unsigned k0_ = klc + c_ * 32768u; att_load2(F, KcB, k0_, k0_ + 4096u, VcB, vlc + c_ * 64u, (unsigned)(16 * CL * 2)); } }
            int ia[4], ib[4]; bool va_[4], vb_[4];
#pragma unroll
            for (int i = 0; i < 4; ++i) { const int kc_a = kc0 + 8 * g + i, kc_b = kc_a + 4;
                va_[i] = (kc_a >= cs && kc_a < cs + 16); vb_[i] = (kc_b >= cs && kc_b < cs + 16);
                ia[i] = min(max(kc_a - qc + 15, 0), 30); ib[i] = min(max(kc_b - qc + 15, 0), 30); }
#define COMPS(F, S) { const int s2_ = (S); f32x4 b0 = {0.f, 0.f, 0.f, 0.f}, b1 = {0.f, 0.f, 0.f, 0.f}; \
                      if (s2_ < nloc) { const float* trw = tab + (rs + s2_ - r + 7) * 31; \
                        _Pragma("unroll") for (int i = 0; i < 4; ++i) { b0[i] = va_[i] ? trw[ia[i]] : NEG_INF; b1[i] = vb_[i] ? trw[ib[i]] : NEG_INF; } } \
                      att_compute(st, q0, q1, F, b0, b1, scale2); }
            ATT_PIPELINE(nst)
#undef LOADS
#undef COMPS
        }
        att_finish(st, 0.f, G + (size_t)qrow * 512 + h * 64, p.dry);
    }
}

DEVI void phase_att_b(const P& p, int l) {
    unsigned char* ws = p.ws; unsigned char* scr = ws + OFF_SCR;
    const bf16_t* Q = (const bf16_t*)(scr + SB_Q); const bf16_t* K = (const bf16_t*)(scr + SB_K); const bf16_t* VT = (const bf16_t*)(scr + SB_VT);
    const bf16_t* VTC = VT + (size_t)NB * 2 * 64 * T;
    bf16_t* G = (bf16_t*)(ws + OFF_YS + SZ512);
    const int tid = ltid(), lane = tid & 63, h = tid >> 6, kvh = h >> 2, q = lane & 15, g = lane >> 4;
    const float scale2 = 0.125f * L2E;
    const float sink2 = p.sink[l * 8 + h] * L2E;
    const int ntask = 2048 + (l == 0 ? 32 : 0);
    for (int it = 0; it * (int)gridDim.x < ntask; ++it) {
        const int task = tile_of(it);
        if (task >= ntask) continue;
        AttSt st; st.m = -1e30f; st.l = 0.f;
#pragma unroll
        for (int dt = 0; dt < 4; ++dt) st.o[dt] = (f32x4){0.f, 0.f, 0.f, 0.f};
        int b, qrow;
        const bool lat = task < 2048;
        int q0t = 0;
        if (lat) { b = task >> 10; q0t = (task & 1023) * 16; qrow = b * T + q0t + q; }
        else { const int tt = task - 2048; b = tt >> 4; qrow = NL + b * CL + (tt & 15) * 16 + q; }
        const bf16_t* qp = Q + (size_t)qrow * 512 + h * 64 + g * 8;
        const bf16x8 q0 = *(const bf16x8*)qp, q1 = *(const bf16x8*)(qp + 32);
        {
            const int tq = q0t + q;
            const int nloc = lat ? 9 : 0, nst = nloc + 8;
            const bf16_t* Kc = K + (size_t)(NL + b * CL) * 128 + kvh * 64 + g * 8;
            const bf16_t* Vc = VTC + ((size_t)(b * 2 + kvh) * 64 + (lane & 15)) * CL + 8 * g;
            const int kmap = 8 * ((lane & 15) >> 2) + (lane & 3);
            const bf16_t* vbase = VT + ((size_t)(b * 2 + kvh) * 64 + (lane & 15)) * T;
            const char* KnB = (const char*)(K + (size_t)b * T * 128); const char* VnB = (const char*)(VT + (size_t)(b * 2) * 64 * T);
            const char* KcB = (const char*)(K + (size_t)(NL + b * CL) * 128); const char* VcB = (const char*)(VTC + (size_t)(b * 2) * 64 * CL);
            const unsigned kl2 = (unsigned)(kvh * 64 + g * 8) * 2u, vl2 = (unsigned)((kvh * 64 + (lane & 15)) * T) * 2u;
            const unsigned klc = (unsigned)(kmap * 128 + kvh * 64 + g * 8) * 2u, vlc = (unsigned)((kvh * 64 + (lane & 15)) * CL + 8 * g) * 2u;
#define LOADS(F, S) { const int s2_ = (S); if (s2_ < nloc) { const int tbase = q0t - 128 + 32 * s2_; \
                        const int ta = min(max(tbase + kmap, 0), T - 1), tb = min(max(tbase + kmap + 4, 0), T - 1); \
                        const int va = min(max(tbase + 8 * g, 0), T - 8); \
                        att_load2(F, KnB, kl2 + (unsigned)ta * 256u, kl2 + (unsigned)tb * 256u, VnB, vl2 + (unsigned)va * 2u, (unsigned)(16 * T * 2)); } \
                      else { const unsigned c_ = (unsigned)(s2_ - nloc); const unsigned k0_ = klc + c_ * 8192u; att_load2(F, KcB, k0_, k0_ + 1024u, VcB, vlc + c_ * 64u, (unsigned)(16 * CL * 2)); } }
#define COMPS(F, S) { const int s2_ = (S); f32x4 b0 = {0.f, 0.f, 0.f, 0.f}, b1 = {0.f, 0.f, 0.f, 0.f}; \
                      if (s2_ < nloc && (s2_ == 0 || s2_ == 8 || q0t < 128 || q0t + 160 > T)) { const int tbase = q0t - 128 + 32 * s2_; \
                        _Pragma("unroll") for (int i = 0; i < 4; ++i) { const int t0 = tbase + 8 * g + i, t1 = t0 + 4; \
                          b0[i] = (t0 >= 0 && t0 < T && abs(tq - t0) <= 128) ? 0.f : NEG_INF; \
                          b1[i] = (t1 >= 0 && t1 < T && abs(tq - t1) <= 128) ? 0.f : NEG_INF; } } \
                      att_compute(st, q0, q1, F, b0, b1, scale2); }
            ATT_PIPELINE(nst)
#undef LOADS
#undef COMPS
        }
        att_finish(st, __builtin_amdgcn_exp2f(sink2 - st.m), G + (size_t)qrow * 512 + h * 64, p.dry);
    }
}

constexpr int GL_CUM = 0;
constexpr int GL_LR = 32768;
constexpr int GL_T0 = GL_LR + 8192;
constexpr int GL_TSZ = 64 * LSTR * 2;
constexpr int GL_X = GL_T0 + 4 * GL_TSZ;

DEVI float logsigmoidf(float x) { return fminf(x, 0.f) - __logf(1.0f + __expf(-fabsf(x))); }

DEVI void gla_cum(const P& p, int l, int h, int rowbase, unsigned char* sm) {
    const int tid = ltid();
    float* cum = (float*)(sm + GL_CUM); float* lrs = (float*)(sm + GL_LR);
    const float* LR = (const float*)(p.ws + OFF_SCR + SC_LR);
    __syncthreads();
    { const int t = tid >> 3, c4 = (tid & 7) * 4; *(float4*)(lrs + t * 32 + c4) = *(const float4*)(LR + (size_t)(rowbase + t) * 32 + c4); }
    __syncthreads();
    const int d = tid & 63, tg = tid >> 6;
    float* tot = lrs + 64 * 32;
    tot = (float*)(sm + GL_X);
    float la[2][8];
#pragma unroll
    for (int dir = 0; dir < 2; ++dir) {
        const float* W = p.w_alpha_up + ((size_t)(l * 2 + dir) * 16) * 256 + h * 64 + d;
        float w[16];
#pragma unroll
        for (int r = 0; r < 16; ++r) w[r] = W[r * 256];
        const float bia = p.b_alpha[(l * 2 + dir) * 256 + h * 64 + d];
#pragma unroll
        for (int tt = 0; tt < 8; ++tt) {
            const int t = tg * 8 + tt;
            float x = bia;
#pragma unroll
            for (int r = 0; r < 16; ++r) x += lrs[t * 32 + dir * 16 + r] * w[r];
            la[dir][tt] = logsigmoidf(x) * (1.0f / 16.0f);
        }
    }
#pragma unroll
    for (int tt = 1; tt < 8; ++tt) la[0][tt] += la[0][tt - 1];
#pragma unroll
    for (int tt = 6; tt >= 0; --tt) la[1][tt] += la[1][tt + 1];
    tot[(0 * 8 + tg) * 64 + d] = la[0][7];
    tot[(1 * 8 + tg) * 64 + d] = la[1][0];
    __syncthreads();
    float of = 0.f, ob = 0.f;
#pragma unroll
    for (int g2 = 0; g2 < 8; ++g2) {
        const float a = tot[(0 * 8 + g2) * 64 + d], b = tot[(1 * 8 + g2) * 64 + d];
        of += (g2 < tg) ? a : 0.f;
        ob += (g2 > tg) ? b : 0.f;
    }
#pragma unroll
    for (int tt = 0; tt < 8; ++tt) {
        const int t = tg * 8 + tt;
        cum[t * 64 + d] = la[0][tt] + of;
        cum[(64 + t) * 64 + d] = la[1][tt] + ob;
    }
    __syncthreads();
}
DEVI void gla_chunk_geom(int b, int c, int& rowbase, size_t& vt_off  , size_t& vld, int& ci_f, int& ci_b) {
    if (c < 4) { rowbase = NL + b * CL + c * 64; vld = CL; ci_f = c; ci_b = 3 - c; }
    else { rowbase = b * T + (c - 4) * 64; vld = T; ci_f = c; ci_b = 4 + 255 - (c - 4); }
}
DEVI const bf16_t* gla_vt_ptr(const bf16_t* VT, int b, int h, int c) {
    if (c < 4) return VT + (size_t)NB * 4 * 128 * T + ((size_t)(b * 4 + h) * 128) * CL + c * 64;
    return VT + ((size_t)(b * 4 + h) * 128) * T + (size_t)(c - 4) * 64;
}

DEVI void phase_gla1(const P& p, int l, unsigned char* sm) {
    unsigned char* scr = p.ws + OFF_SCR;
    const bf16_t* KG = (const bf16_t*)(scr + SC_K); const bf16_t* VT = (const bf16_t*)(scr + SC_VT);
    bf16_t* SB = (bf16_t*)(scr + SC_SB); float* GD = (float*)(scr + SC_GD);
    const int tid = ltid(), lane = tid & 63, wave = tid >> 6;
    const float* cum = (const float*)(sm + GL_CUM);
    bf16_t* kdT = (bf16_t*)(sm + GL_T0);
    for (int task = blockIdx.x; task < 8 * NCH; task += gridDim.x) {
        const int bh = task / NCH, c = task % NCH, b = bh >> 2, h = bh & 3;
        int rowbase, ci_f, ci_b; size_t vo, vld;
        gla_chunk_geom(b, c, rowbase, vo, vld, ci_f, ci_b);
        gla_cum(p, l, h, rowbase, sm);
        {
            const int d = tid & 63, tg = tid >> 6;
            const float ce_f = cum[63 * 64 + d], ce_b = cum[64 * 64 + d];
            float vf[8], vb[8];
#pragma unroll
            for (int j = 0; j < 8; ++j) {
                const int t = tg * 8 + j;
                const float kf = bf2f(KG[(size_t)(rowbase + t) * 256 + h * 64 + d]);
                vf[j] = kf * __expf(ce_f - cum[t * 64 + d]);
                vb[j] = kf * __expf(ce_b - cum[(64 + t) * 64 + d]);
            }
            uint4 wf, wb;
            wf.x = pk2(vf[0], vf[1]); wf.y = pk2(vf[2], vf[3]); wf.z = pk2(vf[4], vf[5]); wf.w = pk2(vf[6], vf[7]);
            wb.x = pk2(vb[0], vb[1]); wb.y = pk2(vb[2], vb[3]); wb.z = pk2(vb[4], vb[5]); wb.w = pk2(vb[6], vb[7]);
            *(uint4*)(kdT + d * LSTR + tg * 8) = wf;
            *(uint4*)(kdT + (64 + d) * LSTR + tg * 8) = wb;
        }
        __syncthreads();
        {
            const int dir = wave >> 2, dvt = wave & 3;
            const bf16_t* vp = gla_vt_ptr(VT, b, h, c) + (size_t)(dvt * 32 + (lane & 31)) * vld + (lane >> 5) * 8;
            const bf16_t* ap = kdT + (dir * 64 + (lane & 31)) * LSTR + (lane >> 5) * 8;
            f32x16 acc[2];
#pragma unroll
            for (int i = 0; i < 16; ++i) { acc[0][i] = 0.f; acc[1][i] = 0.f; }
#pragma unroll
            for (int ks = 0; ks < 4; ++ks) {
                const bf16x8 vb = *(const bf16x8*)(vp + ks * 16);
#pragma unroll
                for (int mt = 0; mt < 2; ++mt) {
                    const bf16x8 ka = *(const bf16x8*)(ap + mt * 32 * LSTR + ks * 16);
                    acc[mt] = __builtin_amdgcn_mfma_f32_32x32x16_bf16(ka, vb, acc[mt], 0, 0, 0);
                }
            }
            const int bhd = bh * 2 + dir, ci = dir ? ci_b : ci_f;
            bf16_t* out = SB + ((size_t)bhd * NCH + ci) * 8192 + (size_t)(dvt * 32 + (lane & 31)) * 64;
#ifdef EXP_C
            for (int mt = 0; mt < 2; ++mt) for (int i = 0; i < 16; ++i) { const int dk = mt * 32 + (i & 3) + 8 * (i >> 2) + 4 * (lane >> 5); acc[mt][i] = bf2f(kdT[(dir * 64 + dk) * LSTR + ((dvt * 32 + (lane & 31)) & 63)]); }
#endif
#pragma unroll
            for (int mt = 0; mt < 2; ++mt)
#pragma unroll
                for (int q4 = 0; q4 < 4; ++q4)
                    st4bf(out + mt * 32 + q4 * 8 + (lane >> 5) * 4, acc[mt][q4 * 4 + 0], acc[mt][q4 * 4 + 1], acc[mt][q4 * 4 + 2], acc[mt][q4 * 4 + 3]);
        }
        if (tid < 128) {
            const int dir = tid >> 6, d = tid & 63;
            const int bhd = bh * 2 + dir, ci = dir ? ci_b : ci_f;
            GD[((size_t)bhd * NCH + ci) * 64 + d] = __expf(dir ? cum[64 * 64 + d] : cum[63 * 64 + d]);
        }
    }
}

DEVI void phase_gla2(const P& p) {
    unsigned char* scr = p.ws + OFF_SCR;
    bf16_t* SB = (bf16_t*)(scr + SC_SB); const float* GD = (const float*)(scr + SC_GD);
    for (int idx = blockIdx.x * NTHR + ltid(); idx < 16 * 8192; idx += gridDim.x * NTHR) {
        const int bhd = idx >> 13, e = idx & 8191, dk = e & 63;
        bf16_t* base = SB + (size_t)bhd * NCH * 8192 + e;
        const float* gd = GD + (size_t)bhd * NCH * 64 + dk;
        float S = 0.f;
#pragma unroll 1
        for (int ci = 0; ci < NCH; ci += 13) {
            float kv[13], g[13];
#pragma unroll
            for (int u = 0; u < 13; ++u) { kv[u] = bf2f(base[(size_t)(ci + u) * 8192]); g[u] = gd[(ci + u) * 64]; }
#pragma unroll
            for (int u = 0; u < 13; ++u) { if (!p.dry) base[(size_t)(ci + u) * 8192] = f2bf(S); S = g[u] * S + kv[u]; }
        }
    }
}

DEVI void phase_gla3(const P& p, int l, unsigned char* sm) {
    unsigned char* scr = p.ws + OFF_SCR;
    const bf16_t* QG = (const bf16_t*)(scr + SC_Q); const bf16_t* KG = (const bf16_t*)(scr + SC_K); const bf16_t* VT = (const bf16_t*)(scr + SC_VT);
    const bf16_t* SB = (const bf16_t*)(scr + SC_SB);
    bf16_t* G = (bf16_t*)(p.ws + OFF_YS + 2 * SZ512);
    const float* gnw = p.gla_norm_w + l * 128;
    const int tid = ltid(), lane = tid & 63, wave = tid >> 6, q = lane & 15, g = lane >> 4;
    const float* cum = (const float*)(sm + GL_CUM);
    bf16_t* tiles = (bf16_t*)(sm + GL_T0);
    float* X = (float*)(sm + GL_X);
    const int c_lo = (l == 0) ? 0 : 4;
    const int nper = NCH - c_lo;
    for (int task = blockIdx.x; task < 8 * nper; task += gridDim.x) {
        const int bh = task / nper, c = c_lo + task % nper, b = bh >> 2, h = bh & 3;
        int rowbase, ci_f, ci_b; size_t vo, vld;
        gla_chunk_geom(b, c, rowbase, vo, vld, ci_f, ci_b);
        gla_cum(p, l, h, rowbase, sm);
        {
            const int t = tid >> 3, dg = (tid & 7) * 8;
            U8 qv, kv; qv.u = *(const uint4*)(QG + (size_t)(rowbase + t) * 256 + h * 64 + dg); kv.u = *(const uint4*)(KG + (size_t)(rowbase + t) * 256 + h * 64 + dg);
            float o[4][8];
#pragma unroll
            for (int j = 0; j < 8; ++j) {
                const int d = dg + j;
                const float qf = (j & 1) ? hi_bf(qv.w[j >> 1]) : lo_bf(qv.w[j >> 1]);
                const float kf = (j & 1) ? hi_bf(kv.w[j >> 1]) : lo_bf(kv.w[j >> 1]);
                const float cf = cum[t * 64 + d], cb = cum[(64 + t) * 64 + d];
                o[0][j] = qf * __expf(cf); o[1][j] = kf * __expf(-cf); o[2][j] = qf * __expf(cb); o[3][j] = kf * __expf(-cb);
            }
#pragma unroll
            for (int k = 0; k < 4; ++k) {
                uint4 w; w.x = pk2(o[k][0], o[k][1]); w.y = pk2(o[k][2], o[k][3]); w.z = pk2(o[k][4], o[k][5]); w.w = pk2(o[k][6], o[k][7]);
                *(uint4*)(tiles + k * 64 * LSTR + t * LSTR + dg) = w;
            }
        }
        __syncthreads();
        const int qi = wave & 3, dir = wave >> 2;
        f32x4 O[8];
#pragma unroll
        for (int i = 0; i < 8; ++i) O[i] = (f32x4){0.f, 0.f, 0.f, 0.f};
        {
            const bf16_t* Qd = tiles + (dir * 2) * 64 * LSTR; const bf16_t* Kd = tiles + (dir * 2 + 1) * 64 * LSTR;
            const bf16x8 qf0 = *(const bf16x8*)(Qd + (qi * 16 + q) * LSTR + g * 8), qf1 = *(const bf16x8*)(Qd + (qi * 16 + q) * LSTR + 32 + g * 8);
            const int iq = qi * 16 + q;
            U8 pf[2];
#pragma unroll
            for (int jt = 0; jt < 4; ++jt) {
                const bf16_t* kp = Kd + (jt * 16 + (lane & 15)) * LSTR + g * 8;
                f32x4 s = {0.f, 0.f, 0.f, 0.f};
                s = __builtin_amdgcn_mfma_f32_16x16x32_bf16(*(const bf16x8*)kp, qf0, s, 0, 0, 0);
                s = __builtin_amdgcn_mfma_f32_16x16x32_bf16(*(const bf16x8*)(kp + 32), qf1, s, 0, 0, 0);
#pragma unroll
                for (int i = 0; i < 4; ++i) { const int jk = jt * 16 + 4 * g + i; const bool ok = dir ? (jk >= iq) : (jk <= iq); s[i] = ok ? s[i] : 0.f; }
                pf[jt >> 1].w[(jt & 1) * 2 + 0] = pk2(s[0], s[1]); pf[jt >> 1].w[(jt & 1) * 2 + 1] = pk2(s[2], s[3]);
            }
            const bf16_t* vp = gla_vt_ptr(VT, b, h, c) + (size_t)(lane & 15) * vld + 4 * g;
            const int bhd = bh * 2 + dir, ci = dir ? ci_b : ci_f;
            const bf16_t* sp = SB + ((size_t)bhd * NCH + ci) * 8192 + (size_t)(lane & 15) * 64 + g * 8;
#pragma unroll
            for (int dvt = 0; dvt < 8; ++dvt) {
#pragma unroll
                for (int st = 0; st < 2; ++st) {
                    U8 vf; vf.h[0] = *(const uint2*)(vp + (size_t)dvt * 16 * vld + st * 32); vf.h[1] = *(const uint2*)(vp + (size_t)dvt * 16 * vld + st * 32 + 16);
                    O[dvt] = __builtin_amdgcn_mfma_f32_16x16x32_bf16(vf.v, pf[st].v, O[dvt], 0, 0, 0);
                }
                O[dvt] = __builtin_amdgcn_mfma_f32_16x16x32_bf16(*(const bf16x8*)(sp + dvt * 16 * 64), qf0, O[dvt], 0, 0, 0);
                O[dvt] = __builtin_amdgcn_mfma_f32_16x16x32_bf16(*(const bf16x8*)(sp + dvt * 16 * 64 + 32), qf1, O[dvt], 0, 0, 0);
            }
        }
        if (dir == 1) {
#pragma unroll
            for (int dvt = 0; dvt < 8; ++dvt)
#pragma unroll
                for (int i = 0; i < 4; ++i) X[(qi * 128 + dvt * 16 + 4 * g + i) * 16 + q] = O[dvt][i];
        }
        __syncthreads();
        if (dir == 0) {
            float ss = 0.f;
#pragma unroll
            for (int dvt = 0; dvt < 8; ++dvt)
#pragma unroll
                for (int i = 0; i < 4; ++i) { O[dvt][i] += X[(qi * 128 + dvt * 16 + 4 * g + i) * 16 + q]; ss += O[dvt][i] * O[dvt][i]; }
            ss = rows_sum(ss);
            const float rs = rsqrtf(ss * (1.0f / 128.0f) + EPS);
            bf16_t* gp = G + (size_t)(rowbase + qi * 16 + q) * 512 + h * 128;
#pragma unroll
            for (int dvt = 0; dvt < 8; ++dvt) {
                const int dv = dvt * 16 + 4 * g;
                const float4 w = *(const float4*)(gnw + dv);
                const uint2 gv = *(const uint2*)(gp + dv);
                if (!p.dry) st4bf(gp + dv, O[dvt][0] * rs * w.x * lo_bf(gv.x), O[dvt][1] * rs * w.y * hi_bf(gv.x), O[dvt][2] * rs * w.z * lo_bf(gv.y), O[dvt][3] * rs * w.w * hi_bf(gv.y));
            }
        }
    }
}

constexpr int LF = 16384;
DEVI int CIDX(int p) { return p + (p >> 4); }
DEVI int FIDX(int m) { return 2 * CIDX(m >> 1) + (m & 1); }
constexpr int LFP = LF + LF / 16;
DEVI float2 cmul(float2 a, float2 b) { return make_float2(a.x * b.x - a.y * b.y, a.x * b.y + a.y * b.x); }
DEVI float2 cadd(float2 a, float2 b) { return make_float2(a.x + b.x, a.y + b.y); }
DEVI float2 csub(float2 a, float2 b) { return make_float2(a.x - b.x, a.y - b.y); }
DEVI float2 twid(float frac) { return make_float2(__builtin_amdgcn_cosf(frac), __builtin_amdgcn_sinf(frac)); }

DEVI void fft_fwd(float2* F) {
    const int tid = ltid();
#pragma unroll 1
    for (int s = LF / 2; s >= 2; s >>= 2) {
        const int h = s >> 1;
        const int lh = 31 - __clz(h);
        const float inv2s = 1.0f / (float)(2 * s);
#pragma unroll 2
        for (int qq = tid; qq < LF / 4; qq += NTHR) {
            const int blk = qq >> lh, j = qq & (h - 1);
            const int i = blk * (2 * s) + j;
            const int i0 = CIDX(i), i1 = CIDX(i + h), i2 = CIDX(i + s), i3 = CIDX(i + s + h);
            const float2 x0 = F[i0], x1 = F[i1], x2 = F[i2], x3 = F[i3];
            float2 w1 = twid((float)j * inv2s); w1.y = -w1.y;
            const float2 w2 = cmul(w1, w1);
            const float2 y0 = cadd(x0, x2), y2 = cmul(csub(x0, x2), w1);
            const float2 y1 = cadd(x1, x3); const float2 tt = csub(x1, x3);
            const float2 y3 = cmul(make_float2(tt.y, -tt.x), w1);
            F[i0] = cadd(y0, y1); F[i1] = cmul(csub(y0, y1), w2);
            F[i2] = cadd(y2, y3); F[i3] = cmul(csub(y2, y3), w2);
        }
        __syncthreads();
    }
}
DEVI void fft_inv(float2* F) {
    const int tid = ltid();
#pragma unroll 1
    for (int h = 1; h <= LF / 4; h <<= 2) {
        const int s = 2 * h;
        const int lh = 31 - __clz(h);
        const float inv2s = 1.0f / (float)(2 * s);
#pragma unroll 2
        for (int qq = tid; qq < LF / 4; qq += NTHR) {
            const int blk = qq >> lh, j = qq & (h - 1);
            const int i = blk * (2 * s) + j;
            const int i0 = CIDX(i), i1 = CIDX(i + h), i2 = CIDX(i + s), i3 = CIDX(i + s + h);
            const float2 x0 = F[i0], x1 = F[i1], x2 = F[i2], x3 = F[i3];
            const float2 w1 = twid((float)j * inv2s);
            const float2 w2 = cmul(w1, w1);
            const float2 a1 = cmul(x1, w2), a3 = cmul(x3, w2);
            const float2 u0 = cadd(x0, a1), u1 = csub(x0, a1), u2 = cadd(x2, a3), u3 = csub(x2, a3);
            const float2 b2 = cmul(u2, w1); const float2 t3 = cmul(u3, w1); const float2 b3 = make_float2(-t3.y, t3.x);
            F[i0] = cadd(u0, b2); F[i2] = csub(u0, b2); F[i1] = cadd(u1, b3); F[i3] = csub(u1, b3);
        }
        __syncthreads();
    }
}
DEVI int rev14(int k) { return (int)(__brev((unsigned)k) >> 18); }
DEVI float hy_delta(int ch) {
    const float a = -3.0701134573253946f, b = -15.350567286626973f;
    return fabsf(a + (b - a) * ((float)ch / 511.0f));
}

DEVI void conv8(const bf16_t* U, const float* cw, const float* cb, int seq0, int Lseq, int t, int col0, float* out) {
    U8 r[3];
#pragma unroll
    for (int i = 0; i < 3; ++i) {
        const int tt = t - 1 + i;
        if (tt >= 0 && tt < Lseq) r[i].u = *(const uint4*)(U + (size_t)(seq0 + tt) * 1536 + col0);
        else r[i].u = make_uint4(0, 0, 0, 0);
    }
#pragma unroll
    for (int j = 0; j < 8; ++j) {
        float a = cb[col0 + j];
#pragma unroll
        for (int i = 0; i < 3; ++i) { const float uv = (j & 1) ? hi_bf(r[i].w[j >> 1]) : lo_bf(r[i].w[j >> 1]); a += uv * cw[i * 1536 + col0 + j]; }
        out[j] = a;
    }
}
DEVI void hy_task_geom(int task, int& b, int& t0, int& ch0, int& seq0, int& Lseq, float*& zt, unsigned char* scr) {
    if (task < 4096) { b = task >> 11; t0 = ((task >> 3) & 255) * 64; ch0 = (task & 7) * 64; seq0 = b * T; Lseq = T; zt = (float*)(scr + SD_ZT) + (size_t)b * 512 * T; }
    else { const int q = task - 4096; b = q >> 5; t0 = ((q >> 3) & 3) * 64; ch0 = (q & 7) * 64; seq0 = NL + b * CL; Lseq = CL; zt = (float*)(scr + SD_ZTC) + (size_t)b * 512 * CL; }
}
DEVI void phase_hy1(const P& p, int l, float* sm) {
    unsigned char* scr = p.ws + OFF_SCR;
    const bf16_t* U = (const bf16_t*)(scr + SD_U);
    const float* cw = p.conv_w + (size_t)l * 3 * 1536; const float* cb = p.conv_b + l * 1536;
    const int tid = ltid();
    const int ntask = 4096 + (l == 0 ? 64 : 0);
    for (int task = blockIdx.x; task < ntask; task += gridDim.x) {
        int b, t0, ch0, seq0, Lseq; float* zt;
        hy_task_geom(task, b, t0, ch0, seq0, Lseq, zt, scr);
        __syncthreads();
        {
            const int tt = tid >> 3, cg = (tid & 7) * 8;
            float a1[8], a2[8];
            conv8(U, cw, cb, seq0, Lseq, t0 + tt, 512 + ch0 + cg, a1);
            conv8(U, cw, cb, seq0, Lseq, t0 + tt, 1024 + ch0 + cg, a2);
#pragma unroll
            for (int j = 0; j < 8; ++j) sm[(cg + j) * 65 + tt] = a1[j] * a2[j];
        }
        __syncthreads();
        {
            const int ch = tid >> 3, t8 = (tid & 7) * 8;
            float4 w0 = {sm[ch * 65 + t8 + 0], sm[ch * 65 + t8 + 1], sm[ch * 65 + t8 + 2], sm[ch * 65 + t8 + 3]};
            float4 w1 = {sm[ch * 65 + t8 + 4], sm[ch * 65 + t8 + 5], sm[ch * 65 + t8 + 6], sm[ch * 65 + t8 + 7]};
            float* dst = zt + (size_t)(ch0 + ch) * Lseq + t0 + t8;
            *(float4*)dst = w0; *(float4*)(dst + 4) = w1;
        }
    }
}
DEVI void phase_hy3(const P& p, int l, float* sm) {
    unsigned char* scr = p.ws + OFF_SCR;
    const bf16_t* U = (const bf16_t*)(scr + SD_U);
    bf16_t* G = (bf16_t*)(p.ws + OFF_YS + 3 * SZ512);
    const float* cw = p.conv_w + (size_t)l * 3 * 1536; const float* cb = p.conv_b + l * 1536;
    const int tid = ltid();
    const int ntask = 4096 + (l == 0 ? 64 : 0);
    for (int task = blockIdx.x; task < ntask; task += gridDim.x) {
        int b, t0, ch0, seq0, Lseq; float* zt;
        hy_task_geom(task, b, t0, ch0, seq0, Lseq, zt, scr);
        __syncthreads();
        {
            const int ch = tid >> 3, t8 = (tid & 7) * 8;
            const float* src = zt + (size_t)(ch0 + ch) * Lseq + t0 + t8;
            const float4 w0 = *(const float4*)src, w1 = *(const float4*)(src + 4);
            float* d = sm + ch * 65 + t8;
            d[0] = w0.x; d[1] = w0.y; d[2] = w0.z; d[3] = w0.w; d[4] = w1.x; d[5] = w1.y; d[6] = w1.z; d[7] = w1.w;
        }
        __syncthreads();
        {
            const int tt = tid >> 3, cg = (tid & 7) * 8;
            float a0[8];
            conv8(U, cw, cb, seq0, Lseq, t0 + tt, ch0 + cg, a0);
            bf16_t* gp = G + (size_t)(seq0 + t0 + tt) * 512 + ch0 + cg;
            U8 gv; gv.u = *(const uint4*)gp;
            float o[8];
#pragma unroll
            for (int j = 0; j < 8; ++j) { const float gg = (j & 1) ? hi_bf(gv.w[j >> 1]) : lo_bf(gv.w[j >> 1]); o[j] = a0[j] * sm[(cg + j) * 65 + tt] * gg; }
            uint4 w; w.x = pk2(o[0], o[1]); w.y = pk2(o[2], o[3]); w.z = pk2(o[4], o[5]); w.w = pk2(o[6], o[7]);
            if (!p.dry) *(uint4*)gp = w;
        }
    }
}


constexpr int HYF_MT = 64;
DEVI void phase_hyf(const P& p, int l, float* sm) {
    const int tid = ltid();
    const float* HT = (const float*)(p.ws + OFF_HH3T) + (size_t)l * 64 * T;
    const float* wout = p.fwout + (size_t)l * 64 * 1024;
    bf16_t* K2 = (bf16_t*)(p.ws + OFF_K2);
    float* L1P = (float*)(p.ws + OFF_L1P);
    float* hs = sm;
    for (int task = blockIdx.x; task < T / HYF_MT; task += gridDim.x) {
        const int m0 = task * HYF_MT;
        __syncthreads();
        for (int e = tid; e < 64 * HYF_MT / 4; e += NTHR) { const int j = e / (HYF_MT / 4), c4 = (e % (HYF_MT / 4)) * 4; *(float4*)(hs + j * HYF_MT + c4) = *(const float4*)(HT + (size_t)j * T + m0 + c4); }
        __syncthreads();
        {
            const int ch = tid;
            const float delta = hy_delta(ch);
            float l1f = 0.f, l1b = 0.f;
#pragma unroll 1
            for (int mb = 0; mb < HYF_MT; mb += 16) {
                float af[16], ab[16];
#pragma unroll
                for (int u = 0; u < 16; ++u) { af[u] = 0.f; ab[u] = 0.f; }
#pragma unroll 2
                for (int j = 0; j < 64; ++j) {
                    const float wf = wout[j * 1024 + ch], wb = wout[j * 1024 + 512 + ch];
#pragma unroll
                    for (int u4 = 0; u4 < 4; ++u4) {
                        const float4 h = *(const float4*)(hs + j * HYF_MT + mb + u4 * 4);
                        af[u4 * 4 + 0] += h.x * wf; af[u4 * 4 + 1] += h.y * wf; af[u4 * 4 + 2] += h.z * wf; af[u4 * 4 + 3] += h.w * wf;
                        ab[u4 * 4 + 0] += h.x * wb; ab[u4 * 4 + 1] += h.y * wb; ab[u4 * 4 + 2] += h.z * wb; ab[u4 * 4 + 3] += h.w * wb;
                    }
                }
#pragma unroll
                for (int u = 0; u < 16; ++u) {
                    const int m = m0 + mb + u;
                    const float dec = expf(-((float)m / (float)(T - 1)) * delta);
                    af[u] *= dec; ab[u] *= dec;
                    l1f += fabsf(af[u]); l1b += (m == 0) ? 0.f : fabsf(ab[u]);
                }
                uint4 o;
                o.x = pk2(af[0], af[1]); o.y = pk2(af[2], af[3]); o.z = pk2(af[4], af[5]); o.w = pk2(af[6], af[7]);
                *(uint4*)(K2 + (size_t)ch * T + m0 + mb) = o;
                o.x = pk2(af[8], af[9]); o.y = pk2(af[10], af[11]); o.z = pk2(af[12], af[13]); o.w = pk2(af[14], af[15]);
                *(uint4*)(K2 + (size_t)ch * T + m0 + mb + 8) = o;
                o.x = pk2(ab[0], ab[1]); o.y = pk2(ab[2], ab[3]); o.z = pk2(ab[4], ab[5]); o.w = pk2(ab[6], ab[7]);
                *(uint4*)(K2 + (size_t)(512 + ch) * T + m0 + mb) = o;
                o.x = pk2(ab[8], ab[9]); o.y = pk2(ab[10], ab[11]); o.z = pk2(ab[12], ab[13]); o.w = pk2(ab[14], ab[15]);
                *(uint4*)(K2 + (size_t)(512 + ch) * T + m0 + mb + 8) = o;
            }
            L1P[(size_t)task * 1024 + ch] = l1f;
            L1P[(size_t)task * 1024 + 512 + ch] = l1b;
        }
    }
}
DEVI void phase_hy2(const P& p, int l, unsigned char* smem) {
    unsigned char* scr = p.ws + OFF_SCR;
    const int tid = ltid();
    float* Ff = (float*)smem; float2* F2 = (float2*)smem;
    float* red = (float*)(smem + (size_t)LFP * 8);
    float* spec = red + 16;
    const float* HT = (const float*)(p.ws + OFF_HH3T) + (size_t)l * 64 * T;
    const float* HC = (const float*)(p.ws + OFF_HH3C);
    const float* wout = p.fwout + (size_t)l * 64 * 1024;
    const int ntask = 512 + (l == 0 ? 512 : 0);
    for (int task = blockIdx.x; task < ntask; task += gridDim.x) {
        __syncthreads();
        if (task < 512) {
            const int ch = task;
            const float delta = hy_delta(ch);
            float l1 = 0.f;
            {
                const bf16_t* K2 = (const bf16_t*)(p.ws + OFF_K2);
                const float* L1P = (const float*)(p.ws + OFF_L1P);
                if (tid < 2 * (T / HYF_MT)) { const int side = tid / (T / HYF_MT), tk = tid % (T / HYF_MT); l1 = L1P[(size_t)tk * 1024 + side * 512 + ch]; }
#pragma unroll
                for (int i = 0; i < 4; ++i) {
                    const int m = (tid + NTHR * i) * 8;
                    U8 hf, hb; hf.u = *(const uint4*)(K2 + (size_t)ch * T + m); hb.u = *(const uint4*)(K2 + (size_t)(512 + ch) * T + m);
#pragma unroll
                    for (int u = 0; u < 8; ++u) {
                        const float af = (u & 1) ? hi_bf(hf.w[u >> 1]) : lo_bf(hf.w[u >> 1]);
                        const float ab = (u & 1) ? hi_bf(hb.w[u >> 1]) : lo_bf(hb.w[u >> 1]);
                        const int mm = m + u;
                        Ff[FIDX(mm)] = af;
                        if (mm >= 1) Ff[FIDX(2 * T - mm)] = ab; else Ff[FIDX(T)] = 0.f;
                    }
                }
            }
            l1 = block_sum(l1, red);
            __syncthreads();
            fft_fwd(F2);
            const float scale = 1.0f / ((float)LF * l1);
            float4* KF = (float4*)(p.ws + OFF_KF) + (size_t)blockIdx.x * 8192;
#pragma unroll 2
            for (int i = 0; i < 16; ++i) {
                const int k = tid + NTHR * i;
                const float2 ck = F2[CIDX(rev14(k))], cm = F2[CIDX(rev14((LF - k) & (LF - 1)))];
                KF[k] = make_float4((ck.x + cm.x) * 0.5f * scale, (ck.y - cm.y) * 0.5f * scale, (ck.y + cm.y) * 0.5f * scale, -(ck.x - cm.x) * 0.5f * scale);
            }
            if (tid == 0) { const float2 c = F2[CIDX(1)]; spec[0] = c.x * scale; spec[1] = c.y * scale; }
            const float fb = p.fbias[l * 512 + ch];
#pragma unroll 1
            for (int b = 0; b < NB; ++b) {
                float* zt = (float*)(scr + SD_ZT) + ((size_t)b * 512 + ch) * T;
                __syncthreads();
#pragma unroll
                for (int i = 0; i < 8; ++i) {
                    const int e = (tid + NTHR * i) * 4;
                    const float4 zv = *(const float4*)(zt + e);
                    const int c0 = CIDX(e >> 1), c1 = CIDX((T + e) >> 1);
                    F2[c0] = make_float2(zv.x, zv.y); F2[c0 + 1] = make_float2(zv.z, zv.w);
                    F2[c1] = make_float2(0.f, 0.f); F2[c1 + 1] = make_float2(0.f, 0.f);
                }
                __syncthreads();
                fft_fwd(F2);
#pragma unroll 2
                for (int i = 0; i < 16; ++i) {
                    const int k = tid + NTHR * i;
                    const int pk = CIDX(rev14(k)), pm = CIDX(rev14((LF - k) & (LF - 1)));
                    const float2 ck = F2[pk], cm = F2[pm];
                    const float4 kf = KF[k];
                    const float2 He = make_float2(kf.x, kf.y), Ho = make_float2(kf.z, kf.w);
                    const float2 E = make_float2((ck.x + cm.x) * 0.5f, (ck.y - cm.y) * 0.5f);
                    const float2 O = make_float2((ck.y + cm.y) * 0.5f, -(ck.x - cm.x) * 0.5f);
                    float2 w2 = twid((float)k * (1.0f / (float)LF)); w2.y = -w2.y;
                    const float2 Ye = cadd(cmul(E, He), cmul(w2, cmul(O, Ho)));
                    const float2 Yo = cadd(cmul(E, Ho), cmul(O, He));
                    F2[pk] = make_float2(Ye.x - Yo.y, Ye.y + Yo.x);
                    F2[pm] = make_float2(Ye.x + Yo.y, -Ye.y + Yo.x);
                }
                if (tid == 0) {
                    const float2 c = F2[CIDX(1)]; const float he = spec[0], ho = spec[1];
                    F2[CIDX(1)] = make_float2(c.x * he - c.y * ho, c.x * ho + c.y * he);
                }
                __syncthreads();
                fft_inv(F2);
#pragma unroll
                for (int i = 0; i < 8; ++i) {
                    const int e = (tid + NTHR * i) * 4;
                    const float4 zv = *(const float4*)(zt + e);
                    const int c0 = CIDX(e >> 1);
                    const float2 y0 = F2[c0], y1 = F2[c0 + 1];
                    const float4 yv = make_float4(y0.x, y0.y, y1.x, y1.y);
                    if (!p.dry) *(float4*)(zt + e) = make_float4(yv.x + zv.x * fb, yv.y + zv.y * fb, yv.z + zv.z * fb, yv.w + zv.w * fb);
                }
            }
        } else {
            const int ch = task - 512;
            const float delta = hy_delta(ch);
            float* hf = Ff; float* hb = Ff + 256; float* zs = Ff + 512;
            {
                const int m = tid & 255, side = tid >> 8;
                float a = 0.f;
#pragma unroll 4
                for (int j = 0; j < 64; ++j) a += HC[j * CL + m] * wout[j * 1024 + side * 512 + ch];
                a *= expf(-((float)m / (float)(CL - 1)) * delta);
                Ff[side * 256 + m] = a;
                float l1 = (side == 1 && m == 0) ? 0.f : fabsf(a);
                zs[tid] = ((const float*)(scr + SD_ZTC))[((size_t)(tid >> 8) * 512 + ch) * CL + (tid & 255)];
                l1 = block_sum(l1, red);
                const int b = tid >> 8, t = tid & 255;
                float y = 0.f;
#pragma unroll 4
                for (int s = 0; s <= t; ++s) y += zs[b * 256 + s] * hf[t - s];
#pragma unroll 4
                for (int s = t + 1; s < CL; ++s) y += zs[b * 256 + s] * hb[s - t];
                const float fb = p.fbias[l * 512 + ch];
                if (!p.dry) ((float*)(scr + SD_ZTC))[((size_t)b * 512 + ch) * CL + t] = y / l1 + zs[tid] * fb;
            }
        }
    }
}

constexpr int NPH = 32;
#ifndef ONLY
#define ONLY -1
#endif
#define CASE(n) case n: if (ONLY < 0 || ONLY == n)
DEVI void run_phase(const P& p, int ph, unsigned char* smem) {
    if (ph == 0) { if (ONLY < 0 || ONLY == 100) phase_prep(p, (float*)smem); return; }
    if (ph == NPH - 1) { if (ONLY < 0 || ONLY == 101) phase_final(p); return; }
    const int l = (ph - 1) / 15, k = (ph - 1) % 15;
    switch (k) {
        CASE(0) phase_hl(p, l); break;
        CASE(1) phase_inproj<0>(p, l, (bf16_t*)smem); break;
        CASE(2) phase_att_a(p, l, (float*)smem); break;
        CASE(3) phase_inproj<1>(p, l, (bf16_t*)smem); break;
        CASE(4) phase_att_b(p, l); break;
        CASE(5) phase_inproj<2>(p, l, (bf16_t*)smem); break;
        CASE(6) phase_gla1(p, l, smem); break;
        CASE(7) phase_gla2(p); break;
        CASE(8) phase_gla3(p, l, smem); break;
        CASE(9) phase_inproj<3>(p, l, (bf16_t*)smem); break;
        CASE(10) { phase_hyf(p, l, (float*)smem); phase_hy1(p, l, (float*)smem); } break;
        CASE(11) phase_hy2(p, l, smem); break;
        CASE(12) phase_hy3(p, l, (float*)smem); break;
        CASE(13) phase_merge(p, l, (bf16_t*)smem); break;
        CASE(14) phase_out(p, l, (bf16_t*)smem); break;
    }
}

#define XB_TMO      128
#define XB_XCNT(j)  (256  + 64 * (j))
#define XB_XSUB(j)  (1280 + 64 * (j))
#define XB_XGEN(j)  (2304 + 64 * (j))
#define XB_TOP      3328
#define XB_TOPGEN   3392
#define XCD_BAR_WORDS 3456
#define XB_SPIN_CAP (1u << 18)
#define LAS __attribute__((address_space(3)))
DEVI unsigned xb_ld(unsigned* p)              { return __hip_atomic_load(p, __ATOMIC_RELAXED, __HIP_MEMORY_SCOPE_AGENT); }
DEVI unsigned xb_add(unsigned* p, unsigned v) { return __hip_atomic_fetch_add(p, v, __ATOMIC_RELAXED, __HIP_MEMORY_SCOPE_AGENT); }
DEVI unsigned xb_xcc_id() { return (unsigned)__builtin_amdgcn_s_getreg((3 << 11) | 20) & 0xFu; }
#define XB_SPIN(cond, bar) do { unsigned _sp = 0; while (cond) { __builtin_amdgcn_s_sleep(1); \
    if ((++_sp & 255u) == 0u) { if (xb_ld(&(bar)[XB_TMO])) break; if (_sp > XB_SPIN_CAP) { atomicAdd(&(bar)[XB_TMO], 1u); break; } } } } while (0)
struct XcdBarrier { unsigned* bar; unsigned x; volatile LAS unsigned* st; };
DEVI XcdBarrier xcd_barrier_post(unsigned* bar, volatile LAS unsigned* st) {
    XcdBarrier b; b.bar = bar; b.x = xb_xcc_id(); b.st = st;
    if (threadIdx.x == 0) (void)xb_add(&bar[XB_XCNT(b.x)], 1u);
    return b;
}
DEVI void xcd_barrier_complete(unsigned* bar, unsigned x, unsigned& nloc, unsigned& nx) {
    const unsigned G = gridDim.x * gridDim.y * gridDim.z;
    unsigned sum, cnt, mine, sp = 0u;
    for (;;) {
        sum = 0u; cnt = 0u; mine = 0u;
#pragma unroll
        for (unsigned j = 0; j < 16; ++j) { const unsigned c = xb_ld(&bar[XB_XCNT(j)]); sum += c; cnt += (c > 0u) ? 1u : 0u; mine = (j == x) ? c : mine; }
        if (sum == G) break;
        __builtin_amdgcn_s_sleep(1);
        if ((++sp & 255u) == 0u) { if (xb_ld(&bar[XB_TMO])) break; if (sp > XB_SPIN_CAP) { atomicAdd(&bar[XB_TMO], 1u); break; } }
    }
    nloc = mine > 0u ? mine : 1u; nx = cnt > 0u ? cnt : 1u;
}
DEVI void xcd_barrier(const XcdBarrier& b) {
    asm volatile("s_waitcnt vmcnt(0)" ::: "memory");
    __syncthreads();
    if (threadIdx.x == 0) {
        unsigned* bar = b.bar;
        __builtin_amdgcn_s_waitcnt(0);
        unsigned nloc = b.st[0], nx = b.st[1];
        if (nloc == 0u) { xcd_barrier_complete(bar, b.x, nloc, nx); b.st[0] = nloc; b.st[1] = nx; }
        const unsigned old = xb_add(&bar[XB_XSUB(b.x)], 1u);
        const unsigned gen = old / nloc;
        if (old + 1u == (gen + 1u) * nloc) {
            __builtin_amdgcn_fence(__ATOMIC_RELEASE, "agent");
            asm volatile("s_waitcnt vmcnt(0)" ::: "memory");
            const unsigned og = xb_add(&bar[XB_TOP], 1u);
            const unsigned tg = og / nx;
            if (og + 1u == (tg + 1u) * nx) xb_add(&bar[XB_TOPGEN], 1u);
            else XB_SPIN(xb_ld(&bar[XB_TOPGEN]) == tg, bar);
            __builtin_amdgcn_fence(__ATOMIC_ACQUIRE, "agent");
            xb_add(&bar[XB_XGEN(b.x)], 1u);
            asm volatile("s_waitcnt vmcnt(0)" ::: "memory");
        } else {
            XB_SPIN(xb_ld(&bar[XB_XGEN(b.x)]) == gen, bar);
            __builtin_amdgcn_fence(__ATOMIC_ACQUIRE, "agent");
            asm volatile("s_waitcnt vmcnt(0)" ::: "memory");
        }
    }
    __syncthreads();
}
constexpr size_t OFF_BAR = WS_END + 1024;
constexpr size_t WS_TOTAL = OFF_BAR + XCD_BAR_WORDS * 4;

__global__ void __launch_bounds__(NTHR) mega(P p) {
    extern __shared__ __attribute__((aligned(16))) unsigned char smem[];
    cg::grid_group grid = cg::this_grid();
#ifndef DBL_MASK
#define DBL_MASK 0
#endif
#ifdef TIMING_A
    unsigned long long* ts = (unsigned long long*)(p.ws + WS_END);
    if (blockIdx.x == 0 && threadIdx.x == 0) ts[0] = __builtin_amdgcn_s_memrealtime();
#endif
    volatile LAS unsigned* xst = (volatile LAS unsigned*)(smem + LDS_BYTES - 16);
    if (threadIdx.x == 0) { xst[0] = 0u; xst[1] = 0u; }
    __syncthreads();
    XcdBarrier xb = xcd_barrier_post((unsigned*)(p.ws + OFF_BAR), xst);
#define GRID_SYNC(ph_) do { if ((ph_) == 0) grid.sync(); else xcd_barrier(xb); } while (0)
    for (int ph = p.ph_lo; ph < p.ph_hi; ++ph) {
        if (DBL_MASK != 0 && ph > 0 && ph < NPH - 1 && ((DBL_MASK >> ((ph - 1) % 15)) & 1)) { P pd = p; int one_ = 1; asm volatile("" : "+s"(one_)); pd.dry = one_; run_phase(pd, ph, smem); GRID_SYNC(1); }
        run_phase(p, ph, smem);
#ifdef TIMING_A
        GRID_SYNC(ph);
        if (blockIdx.x == 0 && threadIdx.x == 0) ts[ph + 1] = __builtin_amdgcn_s_memrealtime();
#else
        if (ph + 1 < p.ph_hi) GRID_SYNC(ph);
#endif
    }
}

#ifdef DIAG_OFF
__global__ void diag_dump(const unsigned char* src, float* out, size_t n) {
    for (size_t i = (size_t)blockIdx.x * blockDim.x + threadIdx.x; i < n; i += (size_t)gridDim.x * blockDim.x) {
#if DIAG_F32
        out[i] = ((const float*)src)[i % (size_t)(DIAG_N)];
#else
        { float v = bf2f(((const bf16_t*)src)[i % (size_t)(DIAG_N)]);
#ifdef EXP_FIN
          if (!(fabsf(v) < 1e30f)) v = 12345.f;
#endif
          out[i] = v; }
#endif
    }
}
#endif
#ifdef TIMING_A
__global__ void timing_tail(const unsigned long long* ts, float* out) {
    float grp[8] = {0, 0, 0, 0, 0, 0, 0, 0};
    const float total = (float)(ts[NPH] - ts[0]);
    for (int ph = 0; ph < NPH; ++ph) {
        const float dt = (float)(ts[ph + 1] - ts[ph]);
        int gi;
        if (ph == 0) gi = 5; else if (ph == NPH - 1) gi = 6;
        else { const int k = (ph - 1) % 15; gi = (k == 1 || k == 3 || k == 5 || k == 9) ? 0 : (k == 13) ? 1 : (k == 2 || k == 4) ? 2 : (k >= 6 && k <= 8) ? 3 : (k >= 10 && k <= 12) ? 4 : (k == 14) ? 7 : 6; }
#pragma unroll
        for (int q = 0; q < 8; ++q) grp[q] += (gi == q) ? dt : 0.f;
    }
    float fa = 0.f, fb = 0.f;
#pragma unroll
    for (int q = 0; q < 8; ++q) { fa += (q == TIMING_A) ? grp[q] : 0.f; fb += (q == TIMING_B) ? grp[q] : 0.f; }
    const float e1 = 1000.f * fa / total, e2 = 50.f * fb / total;
    if (blockIdx.x == 0 && threadIdx.x == 0) out[0] += e1;
    for (size_t i = (size_t)blockIdx.x * blockDim.x + threadIdx.x; i < (size_t)1048576; i += (size_t)gridDim.x * blockDim.x) out[D + i] += e2;
}
#endif
extern "C" void kernel_launch(void* const* d_in, const int* in_sizes, int n_in, void* d_out, int out_size, void* d_ws, size_t ws_size, hipStream_t stream) {
    static int grid = 0;
    if (grid == 0) {
        if (n_in != 27 || ws_size < WS_TOTAL) { fprintf(stderr, "kernel_launch: unexpected n_in %d or ws_size %zu (need %zu)\n", n_in, ws_size, (size_t)WS_TOTAL); grid = -1; return; }
        int dev = 0, cus = 0, per_cu = 0;
        hipGetDevice(&dev);
        hipDeviceGetAttribute(&cus, hipDeviceAttributeMultiprocessorCount, dev);
        if (hipFuncSetAttribute((const void*)mega, hipFuncAttributeMaxDynamicSharedMemorySize, LDS_BYTES) != hipSuccess) { fprintf(stderr, "kernel_launch: hipFuncSetAttribute failed\n"); grid = -1; return; }
        if (hipOccupancyMaxActiveBlocksPerMultiprocessor(&per_cu, (const void*)mega, NTHR, LDS_BYTES) != hipSuccess || per_cu < 1) { fprintf(stderr, "kernel_launch: occupancy query failed (%d)\n", per_cu); grid = -1; return; }
        grid = cus * per_cu; if (grid > MAXGRID) grid = MAXGRID;
        fprintf(stderr, "kernel_launch: grid %d (cus %d x %d)\n", grid, cus, per_cu);
    }
    if (grid < 0) return;
    P p{};
    const float** pp = (const float**)&p;
    for (int i = 0; i < 27; ++i) pp[i] = (const float*)d_in[i];
    p.out = (float*)d_out; p.ws = (unsigned char*)d_ws; p.dry = 0; p.pad_ = 0;
#if N_LAUNCH_MODE == 1
    p.ph_lo = 0; p.ph_hi = NPH;
    if (hipMemsetAsync((unsigned char*)d_ws + OFF_BAR, 0, XCD_BAR_WORDS * 4, stream) != hipSuccess) { fprintf(stderr, "kernel_launch: memset of barrier words failed\n"); return; }
    void* args[] = {&p};
    hipError_t e = hipLaunchCooperativeKernel((const void*)mega, dim3(grid), dim3(NTHR), args, LDS_BYTES, stream);
    if (e != hipSuccess) fprintf(stderr, "cooperative launch failed: %s (grid %d)\n", hipGetErrorString(e), grid);
#ifdef TIMING_A
    hipLaunchKernelGGL(timing_tail, dim3(256), dim3(256), 0, stream, (const unsigned long long*)((unsigned char*)d_ws + WS_END), (float*)d_out);
#endif
#else
#ifndef DIAG_STOP
#define DIAG_STOP NPH
#endif
    for (int ph = 0; ph < DIAG_STOP; ++ph) {
        p.ph_lo = ph; p.ph_hi = ph + 1;
        hipLaunchKernelGGL(mega, dim3(grid), dim3(NTHR), LDS_BYTES, stream, p);
    }
#ifdef DIAG_OFF
    hipLaunchKernelGGL(diag_dump, dim3(1024), dim3(256), 0, stream, (const unsigned char*)d_ws + (size_t)(DIAG_OFF), (float*)d_out, (size_t)out_size);
#endif
#endif
}
```

```cpp
#include <hip/hip_runtime.h>
#include <hip/hip_cooperative_groups.h>
#include <cstdio>
#include <cstdint>
namespace cg = cooperative_groups;

#ifndef N_LAUNCH_MODE
#define N_LAUNCH_MODE 1
#endif

#define DEVI __device__ __forceinline__
typedef unsigned short bf16_t;
typedef short bf16x8 __attribute__((ext_vector_type(8)));
typedef float f32x4 __attribute__((ext_vector_type(4)));
typedef float f32x16 __attribute__((ext_vector_type(16)));

constexpr int D = 1024, T = 16384, NB = 2, NL = NB * T, CL = 256, NC = NB * CL, NR = NL + NC;
constexpr int IN_TOTAL = 11040;
constexpr int COL_A = 0, COL_B = 2048, COL_C = 3328, COL_D = 4896, COL_GM = 6944;
constexpr float EPS = 1e-6f;
constexpr int NTHR = 512;
constexpr int LDS_BYTES = 140 * 1024;

constexpr size_t al256(size_t x) { return (x + 255) & ~(size_t)255; }
constexpr size_t OFF_MOD = 0;
constexpr size_t OFF_ROPE = al256(OFF_MOD + (size_t)2 * 3 * 3072 * 4);
constexpr size_t OFF_HH3T = al256(OFF_ROPE + (size_t)2 * T * 32 * 4);
constexpr size_t OFF_HH3C = al256(OFF_HH3T + (size_t)2 * 64 * T * 4);
constexpr size_t OFF_XC1 = al256(OFF_HH3C + (size_t)64 * CL * 4);
constexpr size_t OFF_WINT = al256(OFF_XC1 + (size_t)NC * D * 4);
constexpr size_t OFF_WBT = al256(OFF_WINT + (size_t)2 * IN_TOTAL * D * 2);
constexpr size_t OFF_WOT = al256(OFF_WBT + (size_t)2 * 4 * D * 512 * 2);
constexpr size_t OFF_HL = al256(OFF_WOT + (size_t)2 * D * D * 2);
constexpr size_t OFF_YS = al256(OFF_HL + (size_t)NR * D * 2);
constexpr size_t SZ512 = (size_t)NR * 512 * 2, SZ256 = (size_t)NR * 256 * 2, SZ128 = (size_t)NR * 128 * 2;
constexpr size_t OFF_SCR = al256(OFF_YS + 4 * SZ512);
constexpr size_t SA_Q = 0, SA_K = SZ512, SA_VT = 2 * SZ512;
constexpr size_t SB_Q = 0, SB_K = SZ512, SB_VT = SZ512 + SZ128;
constexpr size_t SC_Q = 0, SC_K = SZ256, SC_VT = 2 * SZ256, SC_LR = 2 * SZ256 + SZ512;
constexpr size_t SC_SB = al256(SC_LR + (size_t)NR * 32 * 4);
constexpr int NCH = 260;
constexpr size_t SC_GD = al256(SC_SB + (size_t)16 * NCH * 8192 * 2);
constexpr size_t SD_U = 0, SD_ZT = al256((size_t)NR * 1536 * 2), SD_ZTC = al256(SD_ZT + (size_t)NB * 512 * T * 4);
constexpr size_t SD_END = al256(SD_ZTC + (size_t)NB * 512 * CL * 4);
constexpr size_t OFF_KF = OFF_SCR + SD_END;
constexpr int MAXGRID = 256;
constexpr size_t OFF_K2 = al256(OFF_KF + (size_t)MAXGRID * 8192 * 16);
constexpr size_t OFF_L1P = al256(OFF_K2 + (size_t)1024 * T * 2);
constexpr size_t WS_END = al256(OFF_L1P + (size_t)(T / 64) * 1024 * 4);

struct P {
    const float *x, *c, *ctx, *c_ctx, *norm_w, *w_mod, *b_mod, *w_in, *rpb, *sink, *w_alpha_up, *b_alpha, *gla_norm_w,
        *conv_w, *conv_b, *fw1, *fb1, *fw2, *fb2, *fw3, *fb3, *ffreq, *fwout, *fbias, *w_branch, *w_out, *final_norm_w;
    float* out;
    unsigned char* ws;
    int ph_lo, ph_hi;
    int dry, pad_;
};

DEVI int ltid() { int t = threadIdx.x; asm volatile("" : "+v"(t)); return t; }
DEVI float bf2f(bf16_t v) { return __uint_as_float(((unsigned)v) << 16); }
typedef __bf16 bf16v2 __attribute__((ext_vector_type(2)));
typedef float f32v2 __attribute__((ext_vector_type(2)));
DEVI unsigned pk2(float lo, float hi) { f32v2 v = {lo, hi}; bf16v2 b = __builtin_convertvector(v, bf16v2); return __builtin_bit_cast(unsigned, b); }
DEVI bf16_t f2bf(float f) { return (bf16_t)(pk2(f, 0.f) & 0xffff); }
DEVI float lo_bf(unsigned u) { return __uint_as_float(u << 16); }
DEVI float hi_bf(unsigned u) { return __uint_as_float(u & 0xffff0000u); }
DEVI float siluf(float v) { return v * __builtin_amdgcn_rcpf(1.f + __expf(-v)); }
DEVI float sigmf(float v) { return __builtin_amdgcn_rcpf(1.f + __expf(-v)); }
DEVI void row_decode(int row, int& b, int& t, bool& isctx) {
    if (row < NL) { b = row >> 14; t = row & (T - 1); isctx = false; }
    else { int r = row - NL; b = r >> 8; t = r & (CL - 1); isctx = true; }
}
DEVI float wave_sum(float v) {
#pragma unroll
    for (int o = 32; o >= 1; o >>= 1) v += __shfl_xor(v, o);
    return v;
}
DEVI float block_sum(float v, float* red  ) {
    v = wave_sum(v);
    __syncthreads();
    if ((ltid() & 63) == 0) red[ltid() >> 6] = v;
    __syncthreads();
    float s = 0.f;
#pragma unroll
    for (int i = 0; i < NTHR / 64; ++i) s += red[i];
    return s;
}

constexpr int LSTR = 72;
constexpr int GA_EL = 256 * LSTR, GB_EL = 128 * LSTR;
template <int NT> struct GAcc { f32x16 a[2][NT]; };

template <int NT, int DEPTH = 1>
DEVI void gemm_kloop(const bf16_t* __restrict__ A, int lda, const bf16_t* __restrict__ Bt, int ldb, int K, int m0, int n0,
                     bf16_t* sm, GAcc<NT>& acc) {
    const int tid = ltid(), lane = tid & 63, wave = tid >> 6, wm = wave >> 1, wn = wave & 1;
    const int lr = tid >> 3, lc = tid & 7;
    const char* Ab = (const char*)(A + (size_t)m0 * lda); const char* Bb = (const char*)(Bt + (size_t)n0 * ldb);
    const unsigned aoff = (unsigned)(lr * lda + lc * 8) * 2u, boff = (unsigned)(lr * ldb + lc * 8) * 2u;
    uint4 xa0, xa1, xa2, xa3, xb0, xb1 = {0, 0, 0, 0};
    uint4 ya0, ya1, ya2, ya3, yb0, yb1 = {0, 0, 0, 0};
    const int KT = K / 64;
    const int frow = lane & 31, fk = (lane >> 5) * 8;
    const unsigned sa64 = 128u * (unsigned)lda, sb64 = 128u * (unsigned)ldb;
#define GLOAD(P, KTI) { const unsigned ko_ = (unsigned)(KTI) * 128u; P##a0 = *(const uint4*)(Ab + (aoff + ko_)); P##a1 = *(const uint4*)(Ab + (aoff + sa64 + ko_)); P##a2 = *(const uint4*)(Ab + (aoff + 2 * sa64 + ko_)); \
                        P##a3 = *(const uint4*)(Ab + (aoff + 3 * sa64 + ko_)); P##b0 = *(const uint4*)(Bb + (boff + ko_)); if constexpr (NT > 1) P##b1 = *(const uint4*)(Bb + (boff + sb64 + ko_)); }
#define LWRITE(P, BUF) { bf16_t* wa_ = sm + (BUF) * (GA_EL + GB_EL) + lr * LSTR + lc * 8; bf16_t* wb_ = wa_ + GA_EL; \
                        *(uint4*)(wa_) = P##a0; *(uint4*)(wa_ + 64 * LSTR) = P##a1; *(uint4*)(wa_ + 128 * LSTR) = P##a2; *(uint4*)(wa_ + 192 * LSTR) = P##a3; \
                        *(uint4*)(wb_) = P##b0; if constexpr (NT > 1) *(uint4*)(wb_ + 64 * LSTR) = P##b1; }
    auto compute = [&](int buf) {
        const bf16_t* sa = sm + buf * (GA_EL + GB_EL) + (wm * 64 + frow) * LSTR + fk;
        const bf16_t* sb = sm + buf * (GA_EL + GB_EL) + GA_EL + (wn * 32 * NT + frow) * LSTR + fk;
#pragma unroll
        for (int ks = 0; ks < 4; ++ks) {
            bf16x8 tf[2], cf[NT];
#pragma unroll
            for (int mt = 0; mt < 2; ++mt) tf[mt] = *(const bf16x8*)(sa + mt * 32 * LSTR + ks * 16);
#pragma unroll
            for (int nt = 0; nt < NT; ++nt) cf[nt] = *(const bf16x8*)(sb + nt * 32 * LSTR + ks * 16);
#pragma unroll
            for (int mt = 0; mt < 2; ++mt)
#pragma unroll
                for (int nt = 0; nt < NT; ++nt)
                    acc.a[mt][nt] = __builtin_amdgcn_mfma_f32_32x32x16_bf16(cf[nt], tf[mt], acc.a[mt][nt], 0, 0, 0);
        }
    };
    __syncthreads();
    if constexpr (DEPTH == 1) {
        GLOAD(x, 0); LWRITE(x, 0); GLOAD(x, 1);
        __syncthreads();
        for (int kt = 0; kt < KT; ++kt) {
            if (kt + 1 < KT) LWRITE(x, (kt + 1) & 1);
            if (kt + 2 < KT) GLOAD(x, kt + 2);
            compute(kt & 1);
            __syncthreads();
        }
    } else {
        GLOAD(x, 0); LWRITE(x, 0); GLOAD(x, 1); GLOAD(y, 2);
        __syncthreads();
        for (int kt = 0; kt < KT; kt += 2) {
            LWRITE(x, 1);
            if (kt + 3 < KT) GLOAD(x, kt + 3);
            compute(0);
            __syncthreads();
            if (kt + 2 < KT) LWRITE(y, 0);
            if (kt + 4 < KT) GLOAD(y, kt + 4);
            compute(1);
            __syncthreads();
        }
    }
#undef GLOAD
#undef LWRITE
}
DEVI int tile_of(int it) {
    const int per = gridDim.x >> 3;
    if ((gridDim.x & 7) != 0 || per == 0) return it * gridDim.x + blockIdx.x;
    return it * gridDim.x + (blockIdx.x & 7) * per + (blockIdx.x >> 3);
}
template <int NT> DEVI void acc_zero(GAcc<NT>& acc) {
#pragma unroll
    for (int mt = 0; mt < 2; ++mt)
#pragma unroll
        for (int nt = 0; nt < NT; ++nt)
#pragma unroll
            for (int i = 0; i < 16; ++i) acc.a[mt][nt][i] = 0.f;
}
template <int NT, class F> DEVI void acc_foreach(const GAcc<NT>& acc, int m0, int n0, F f) {
    const int lane = ltid() & 63, wave = ltid() >> 6, wm = wave >> 1, wn = wave & 1;
#pragma unroll
    for (int mt = 0; mt < 2; ++mt) {
        const int row = m0 + wm * 64 + mt * 32 + (lane & 31);
#pragma unroll
        for (int nt = 0; nt < NT; ++nt)
#pragma unroll
            for (int q = 0; q < 4; ++q) {
                const int col = n0 + wn * 32 * NT + nt * 32 + q * 8 + (lane >> 5) * 4;
                f(row, col, acc.a[mt][nt][q * 4 + 0], acc.a[mt][nt][q * 4 + 1], acc.a[mt][nt][q * 4 + 2], acc.a[mt][nt][q * 4 + 3]);
            }
    }
}
constexpr int EST = 68;
template <int NT> DEVI void epi_stage(const GAcc<NT>& acc, int mt, float* reg) {
    const int lane = ltid() & 63;
    __syncthreads();
#pragma unroll
    for (int nt = 0; nt < NT; ++nt)
#pragma unroll
        for (int q = 0; q < 4; ++q) {
            float4 w = {acc.a[mt][nt][q * 4 + 0], acc.a[mt][nt][q * 4 + 1], acc.a[mt][nt][q * 4 + 2], acc.a[mt][nt][q * 4 + 3]};
            *(float4*)(reg + (lane & 31) * EST + nt * 32 + q * 8 + (lane >> 5) * 4) = w;
        }
    __syncthreads();
}
template <int NT, class F> DEVI void epi_rows8(const float* reg, F f) {
    const int lane = ltid() & 63;
#pragma unroll
    for (int it = 0; it < 2 * NT; ++it) {
        const int idx = it * 64 + lane, rl = idx / (NT * 4), ch = idx % (NT * 4);
        const float4 a = *(const float4*)(reg + rl * EST + ch * 8), b = *(const float4*)(reg + rl * EST + ch * 8 + 4);
        f(rl, ch * 8, a, b);
    }
}
DEVI void st8bf(bf16_t* p, float4 a, float4 b) { uint4 w; w.x = pk2(a.x, a.y); w.y = pk2(a.z, a.w); w.z = pk2(b.x, b.y); w.w = pk2(b.z, b.w); *(uint4*)p = w; }
DEVI float4 silu4(float4 a) { return make_float4(siluf(a.x), siluf(a.y), siluf(a.z), siluf(a.w)); }
template <int H, int DH> DEVI void epi_vt(const float* reg, bf16_t* VT, int row0  , int colv0) {
    const int lane = ltid() & 63;
    int b, t; bool ic; row_decode(row0, b, t, ic);
    const int tp = lane & 15, cg = lane >> 4;
#pragma unroll 4
    for (int it = 0; it < 16; ++it) {
        const int c = it * 4 + cg, colv = colv0 + c, h = colv / DH, d = colv % DH;
        const float v0 = reg[(2 * tp) * EST + c], v1 = reg[(2 * tp + 1) * EST + c];
        bf16_t* pp = ic ? (VT + (size_t)NB * H * DH * T + ((size_t)(b * H + h) * DH + d) * CL + t + 2 * tp) : (VT + ((size_t)(b * H + h) * DH + d) * T + t + 2 * tp);
        *(unsigned*)pp = pk2(v0, v1);
    }
}
DEVI void st4bf(bf16_t* p, float a, float b, float c, float d) { uint2 w; w.x = pk2(a, b); w.y = pk2(c, d); *(uint2*)p = w; }
template <int H, int DH> DEVI void store_vt(bf16_t* VT, int row, int colv, float v0, float v1, float v2, float v3) {
    int b, t; bool ic; row_decode(row, b, t, ic);
    const int h = colv / DH, d = colv % DH;
    bf16_t* p = ic ? (VT + (size_t)NB * H * DH * T + ((size_t)(b * H + h) * DH + d) * CL + t) : (VT + ((size_t)(b * H + h) * DH + d) * T + t);
    const size_t st = ic ? CL : T;
    p[0] = f2bf(v0); p[st] = f2bf(v1); p[2 * st] = f2bf(v2); p[3 * st] = f2bf(v3);
}

template <int BR>
DEVI void phase_inproj(const P& p, int l, bf16_t* sm) {
    unsigned char* ws = p.ws;
    const bf16_t* HL = (const bf16_t*)(ws + OFF_HL);
    constexpr int colbase = BR == 0 ? COL_A : BR == 1 ? COL_B : BR == 2 ? COL_C : COL_D;
    constexpr int N = BR == 0 ? 2048 : BR == 1 ? 1280 : BR == 2 ? 1568 : 2048;
    const bf16_t* Wt = (const bf16_t*)(ws + OFF_WINT) + ((size_t)l * IN_TOTAL + colbase) * D;
    unsigned char* scr = ws + OFF_SCR;
    bf16_t* YSb = (bf16_t*)(ws + OFF_YS + BR * SZ512);
    const float* rope = (const float*)(ws + OFF_ROPE);
    constexpr int tilesN = (N + 127) / 128;
    const int tilesM = (BR == 3 && l == 1) ? NL / 256 : NR / 256;
    for (int it = 0;; ++it) {
        const int tile = tile_of(it);
        if (it * (int)gridDim.x >= tilesM * tilesN) break;
        if (tile >= tilesM * tilesN) continue;
        const int tm = tile / tilesN, tn = tile % tilesN;
        const int m0 = tm * 256, n0 = tn * 128;
        GAcc<2> acc; acc_zero(acc);
        gemm_kloop<2, 1>(HL, D, Wt, D, D, m0, n0, sm, acc);
        const int lane = ltid() & 63, wave = ltid() >> 6, wm = wave >> 1, wn = wave & 1;
        float* reg = (float*)sm + wave * (32 * EST);
        const int cb = n0 + wn * 64;
#pragma unroll
        for (int mt = 0; mt < 2; ++mt) {
            epi_stage<2>(acc, mt, reg);
            const int rbase = m0 + wm * 64 + mt * 32;
            if constexpr (BR == 0) {
                bf16_t* Q = (bf16_t*)(scr + SA_Q); bf16_t* Kb = (bf16_t*)(scr + SA_K); bf16_t* VT = (bf16_t*)(scr + SA_VT);
                const int seg = cb >> 9, cc0 = cb & 511;
                if (seg == 2) epi_vt<8, 64>(reg, VT, rbase, cc0);
                else epi_rows8<2>(reg, [&](int rl, int cl, float4 a, float4 b) {
                    const size_t o = (size_t)(rbase + rl) * 512 + cc0 + cl;
                    if (seg == 0) st8bf(Q + o, a, b); else if (seg == 1) st8bf(Kb + o, a, b); else st8bf(YSb + o, silu4(a), silu4(b));
                });
            } else if constexpr (BR == 1) {
                bf16_t* Q = (bf16_t*)(scr + SB_Q); bf16_t* Kb = (bf16_t*)(scr + SB_K); bf16_t* VT = (bf16_t*)(scr + SB_VT);
                if (cb >= 640 && cb < 768) epi_vt<2, 64>(reg, VT, rbase, cb - 640);
                else epi_rows8<2>(reg, [&](int rl, int cl, float4 a, float4 b) {
                    const int row = rbase + rl;
                    if (cb < 640) {
                        if (row < NL) {
                            const float4 pa = *(const float4*)(reg + rl * EST + (cl ^ 32)), pb = *(const float4*)(reg + rl * EST + (cl ^ 32) + 4);
                            const int t = row & (T - 1), c = cl & 31;
                            const float4 c0 = *(const float4*)(rope + (size_t)t * 32 + c), c1 = *(const float4*)(rope + (size_t)t * 32 + c + 4);
                            const float4 s0 = *(const float4*)(rope + (size_t)T * 32 + (size_t)t * 32 + c), s1 = *(const float4*)(rope + (size_t)T * 32 + (size_t)t * 32 + c + 4);
                            if (cl < 32) {
                                a = make_float4(a.x * c0.x - pa.x * s0.x, a.y * c0.y - pa.y * s0.y, a.z * c0.z - pa.z * s0.z, a.w * c0.w - pa.w * s0.w);
                                b = make_float4(b.x * c1.x - pb.x * s1.x, b.y * c1.y - pb.y * s1.y, b.z * c1.z - pb.z * s1.z, b.w * c1.w - pb.w * s1.w);
                            } else {
                                a = make_float4(pa.x * s0.x + a.x * c0.x, pa.y * s0.y + a.y * c0.y, pa.z * s0.z + a.z * c0.z, pa.w * s0.w + a.w * c0.w);
                                b = make_float4(pb.x * s1.x + b.x * c1.x, pb.y * s1.y + b.y * c1.y, pb.z * s1.z + b.z * c1.z, pb.w * s1.w + b.w * c1.w);
                            }
                        }
                        if (cb < 512) st8bf(Q + (size_t)row * 512 + cb + cl, a, b);
                        else st8bf(Kb + (size_t)row * 128 + (cb - 512) + cl, a, b);
                    } else st8bf(YSb + (size_t)row * 512 + (cb - 768) + cl, silu4(a), silu4(b));
                });
            } else if constexpr (BR == 2) {
                bf16_t* Q = (bf16_t*)(scr + SC_Q); bf16_t* Kb = (bf16_t*)(scr + SC_K); bf16_t* VT = (bf16_t*)(scr + SC_VT);
                float* LR = (float*)(scr + SC_LR);
                if (cb >= 512 && cb < 1024) epi_vt<4, 128>(reg, VT, rbase, cb - 512);
                else epi_rows8<2>(reg, [&](int rl, int cl, float4 a, float4 b) {
                    const int row = rbase + rl, col = cb + cl;
                    if (col < 256) { const float sc = 0.125f; st8bf(Q + (size_t)row * 256 + col, make_float4(a.x * sc, a.y * sc, a.z * sc, a.w * sc), make_float4(b.x * sc, b.y * sc, b.z * sc, b.w * sc)); }
                    else if (col < 512) st8bf(Kb + (size_t)row * 256 + (col - 256), a, b);
                    else if (col < 1056) { *(float4*)(LR + (size_t)row * 32 + (col - 1024)) = a; *(float4*)(LR + (size_t)row * 32 + (col - 1024) + 4) = b; }
                    else if (col < 1568) st8bf(YSb + (size_t)row * 512 + (col - 1056), silu4(a), silu4(b));
                });
            } else {
                bf16_t* U = (bf16_t*)(scr + SD_U);
                epi_rows8<2>(reg, [&](int rl, int cl, float4 a, float4 b) {
                    const int row = rbase + rl, col = cb + cl;
                    if (col < 1536) st8bf(U + (size_t)row * 1536 + col, a, b);
                    else st8bf(YSb + (size_t)row * 512 + (col - 1536), silu4(a), silu4(b));
                });
            }
        }
    }
}

DEVI void phase_merge(const P& p, int l, bf16_t* sm) {
    unsigned char* ws = p.ws;
    const bf16_t* HL = (const bf16_t*)(ws + OFF_HL);
    const bf16_t* Wgm = (const bf16_t*)(ws + OFF_WINT) + ((size_t)l * IN_TOTAL + COL_GM) * D;
    const bf16_t* Wb = (const bf16_t*)(ws + OFF_WBT) + (size_t)l * 4 * D * 512;
    bf16_t* ACCM = (bf16_t*)(ws + OFF_SCR);
    const int M = (l == 0) ? NR : NL;
    const int tilesM = M / 256, tilesN = D / 128;
    for (int it = 0;; ++it) {
        const int tile = tile_of(it);
        if (it * (int)gridDim.x >= tilesM * tilesN) break;
        if (tile >= tilesM * tilesN) continue;
        const int tm = tile / tilesN, tn = tile % tilesN;
        const int m0 = tm * 256, n0 = tn * 128;
        GAcc<2> tot; acc_zero(tot);
        unsigned totp[2][2][8];
#pragma unroll
        for (int mt = 0; mt < 2; ++mt)
#pragma unroll
            for (int nt = 0; nt < 2; ++nt)
#pragma unroll
                for (int e = 0; e < 8; ++e) totp[mt][nt][e] = 0u;
#pragma unroll 1
        for (int i = 0; i < 4; ++i) {
#ifdef TIMING_A
            gemm_kloop<2>((const bf16_t*)(ws + OFF_YS + i * SZ512), 512, Wb + (size_t)i * D * 512, 512, 512, m0, n0, sm, tot);
            GAcc<2> g; acc_zero(g);
            gemm_kloop<2>(HL, D, Wgm + (size_t)i * D * D, D, D, m0, n0, sm, g);
#pragma unroll
            for (int mt = 0; mt < 2; ++mt)
#pragma unroll
                for (int nt = 0; nt < 2; ++nt)
#pragma unroll
                    for (int e = 0; e < 16; ++e) tot.a[mt][nt][e] += sigmf(g.a[mt][nt][e]);
        }
#else
            unsigned pp[2][2][8];
            {
                GAcc<2> pr; acc_zero(pr);
                gemm_kloop<2>((const bf16_t*)(ws + OFF_YS + i * SZ512), 512, Wb + (size_t)i * D * 512, 512, 512, m0, n0, sm, pr);
#pragma unroll
                for (int mt = 0; mt < 2; ++mt)
#pragma unroll
                    for (int nt = 0; nt < 2; ++nt)
#pragma unroll
                        for (int e = 0; e < 8; ++e) pp[mt][nt][e] = pk2(pr.a[mt][nt][2 * e], pr.a[mt][nt][2 * e + 1]);
            }
            GAcc<2> g; acc_zero(g);
            gemm_kloop<2>(HL, D, Wgm + (size_t)i * D * D, D, D, m0, n0, sm, g);
#pragma unroll
            for (int mt = 0; mt < 2; ++mt)
#pragma unroll
                for (int nt = 0; nt < 2; ++nt)
#pragma unroll
                    for (int e = 0; e < 8; ++e) {
                        const float t0 = lo_bf(totp[mt][nt][e]) + sigmf(g.a[mt][nt][2 * e]) * lo_bf(pp[mt][nt][e]);
                        const float t1 = hi_bf(totp[mt][nt][e]) + sigmf(g.a[mt][nt][2 * e + 1]) * hi_bf(pp[mt][nt][e]);
                        totp[mt][nt][e] = pk2(t0, t1);
                    }
        }
#pragma unroll
        for (int mt = 0; mt < 2; ++mt)
#pragma unroll
            for (int nt = 0; nt < 2; ++nt)
#pragma unroll
                for (int e = 0; e < 8; ++e) { tot.a[mt][nt][2 * e] = lo_bf(totp[mt][nt][e]); tot.a[mt][nt][2 * e + 1] = hi_bf(totp[mt][nt][e]); }
#endif
        {
            const int wave = ltid() >> 6, wm = wave >> 1, wn = wave & 1;
            float* reg = (float*)sm + wave * (32 * EST);
#pragma unroll
            for (int mt = 0; mt < 2; ++mt) {
                epi_stage<2>(tot, mt, reg);
                epi_rows8<2>(reg, [&](int rl, int cl, float4 a, float4 b) { st8bf(ACCM + (size_t)(m0 + wm * 64 + mt * 32 + rl) * D + n0 + wn * 64 + cl, a, b); });
            }
        }
    }
}

DEVI void phase_out(const P& p, int l, bf16_t* sm) {
    unsigned char* ws = p.ws;
    const bf16_t* ACCM = (const bf16_t*)(ws + OFF_SCR);
    const bf16_t* Wo = (const bf16_t*)(ws + OFF_WOT) + (size_t)l * D * D;
    const float* MOD = (const float*)(ws + OFF_MOD) + (size_t)l * 3 * 3072;
    float* XC1 = (float*)(ws + OFF_XC1);
    const int M = (l == 0) ? NR : NL;
    const int tilesM = M / 256, tilesN = D / 128;
    for (int it = 0;; ++it) {
        const int tile = tile_of(it);
        if (it * (int)gridDim.x >= tilesM * tilesN) break;
        if (tile >= tilesM * tilesN) continue;
        const int tm = tile / tilesN, tn = tile % tilesN;
        const int m0 = tm * 256, n0 = tn * 128;
        GAcc<2> acc; acc_zero(acc);
        gemm_kloop<2, 1>(ACCM, D, Wo, D, D, m0, n0, sm, acc);
        {
            const int wave = ltid() >> 6, wm = wave >> 1, wn = wave & 1;
            float* reg = (float*)sm + wave * (32 * EST);
#pragma unroll
            for (int mt = 0; mt < 2; ++mt) {
                epi_stage<2>(acc, mt, reg);
                epi_rows8<2>(reg, [&](int rl, int cl, float4 a, float4 b) {
                    const int row = m0 + wm * 64 + mt * 32 + rl, col = n0 + wn * 64 + cl;
                    const bool ic = row >= NL;
                    const int mi = ic ? 2 : (row >> 14);
                    const float4 g0 = *(const float4*)(MOD + mi * 3072 + 2048 + col), g1 = *(const float4*)(MOD + mi * 3072 + 2048 + col + 4);
                    const float* src; float* dst;
                    if (ic) { src = (l == 0 ? p.ctx : XC1) + (size_t)(row - NL) * D + col; dst = XC1 + (size_t)(row - NL) * D + col; }
                    else { src = (l == 0 ? p.x : p.out) + (size_t)row * D + col; dst = p.out + (size_t)row * D + col; }
                    const float4 x0 = *(const float4*)src, x1 = *(const float4*)(src + 4);
                    if (!p.dry) {
                        *(float4*)dst = make_float4(x0.x + g0.x * a.x, x0.y + g0.y * a.y, x0.z + g0.z * a.z, x0.w + g0.w * a.w);
                        *(float4*)(dst + 4) = make_float4(x1.x + g1.x * b.x, x1.y + g1.y * b.y, x1.z + g1.z * b.z, x1.w + g1.w * b.w);
                    }
                });
            }
        }
    }
}

DEVI void transpose_tile(const float* __restrict__ src, int K, int N, bf16_t* __restrict__ dst, int k0, int n0, float* sm) {
    const int tid = ltid();
    __syncthreads();
    {
        const int kr = tid >> 4, nc = (tid & 15) * 4;
#pragma unroll
        for (int i = 0; i < 2; ++i) {
            const int k = kr + 32 * i;
            float4 v = {0.f, 0.f, 0.f, 0.f};
            if (n0 + nc < N) v = *(const float4*)(src + (size_t)(k0 + k) * N + n0 + nc);
            sm[k * 65 + nc + 0] = v.x; sm[k * 65 + nc + 1] = v.y; sm[k * 65 + nc + 2] = v.z; sm[k * 65 + nc + 3] = v.w;
        }
    }
    __syncthreads();
    {
        const int n = tid >> 3, kc = (tid & 7) * 8;
        if (n0 + n < N) {
            uint4 w;
            w.x = pk2(sm[(kc + 0) * 65 + n], sm[(kc + 1) * 65 + n]); w.y = pk2(sm[(kc + 2) * 65 + n], sm[(kc + 3) * 65 + n]);
            w.z = pk2(sm[(kc + 4) * 65 + n], sm[(kc + 5) * 65 + n]); w.w = pk2(sm[(kc + 6) * 65 + n], sm[(kc + 7) * 65 + n]);
            *(uint4*)(dst + (size_t)(n0 + n) * K + k0 + kc) = w;
        }
    }
}

DEVI void hyena_mlp_task(const P& p, int l, int L, int p0, float* HT, float* sm) {
    const int tid = ltid();
    float* zb = sm;
    float* h1 = sm + 64 * 33;
    float* h2 = h1 + 64 * 65;
    const float* w1 = p.fw1 + (size_t)l * 33 * 64; const float* b1 = p.fb1 + l * 64;
    const float* w2 = p.fw2 + (size_t)l * 64 * 64; const float* b2 = p.fb2 + l * 64;
    const float* w3 = p.fw3 + (size_t)l * 64 * 64; const float* b3 = p.fb3 + l * 64;
    const float* fr = p.ffreq + l * 64;
    __syncthreads();
#pragma unroll 1
    for (int e = tid; e < 64 * 33; e += NTHR) {
        const int pos = e / 33, k = e % 33;
        const int pp = p0 + pos;
        float v;
        if (k == 0) v = (float)pp / (float)(L - 1);
        else {
            const int j = (k - 1) & 15;
            const float f = 1e-4f + (float)j * ((15.0f - 1e-4f) / 15.0f);
            const float wa = 6.283185307179586f * (float)pp / (float)L;
            v = (k <= 16) ? cosf(f * wa) : -sinf(f * wa);
        }
        zb[e] = v;
    }
    __syncthreads();
    const int pos = tid >> 3, fg = (tid & 7) * 8;
    {
        float a[8];
#pragma unroll
        for (int j = 0; j < 8; ++j) a[j] = b1[fg + j];
#pragma unroll 1
        for (int k = 0; k < 33; ++k) {
            const float zv = zb[pos * 33 + k];
#pragma unroll
            for (int j = 0; j < 8; ++j) a[j] += zv * w1[k * 64 + fg + j];
        }
#pragma unroll
        for (int j = 0; j < 8; ++j) h1[pos * 65 + fg + j] = sinf(fr[fg + j] * a[j]);
    }
    __syncthreads();
    {
        float a[8];
#pragma unroll
        for (int j = 0; j < 8; ++j) a[j] = b2[fg + j];
#pragma unroll 2
        for (int k = 0; k < 64; ++k) {
            const float zv = h1[pos * 65 + k];
#pragma unroll
            for (int j = 0; j < 8; ++j) a[j] += zv * w2[k * 64 + fg + j];
        }
#pragma unroll
        for (int j = 0; j < 8; ++j) h2[pos * 65 + fg + j] = sinf(fr[fg + j] * a[j]);
    }
    __syncthreads();
    {
        float a[8];
#pragma unroll
        for (int j = 0; j < 8; ++j) a[j] = b3[fg + j];
#pragma unroll 2
        for (int k = 0; k < 64; ++k) {
            const float zv = h2[pos * 65 + k];
#pragma unroll
            for (int j = 0; j < 8; ++j) a[j] += zv * w3[k * 64 + fg + j];
        }
#pragma unroll
        for (int j = 0; j < 8; ++j) HT[(size_t)(fg + j) * L + p0 + pos] = sinf(fr[fg + j] * a[j]);
    }
}

DEVI void phase_prep(const P& p, float* sm) {
    unsigned char* ws = p.ws;
    const int tid = ltid();
    constexpr int TN_IN = (IN_TOTAL + 63) / 64;
    constexpr int T_WIN = 2 * 16 * TN_IN;
    constexpr int T_WB = 2 * 4 * 8 * 16;
    constexpr int T_WO = 2 * 16 * 16;
    constexpr int T_MOD = 2 * 48;
    constexpr int T_ROPE = T * 32 / NTHR;
    constexpr int T_MLP = 2 * 256 + 4;
    constexpr int E0 = T_WIN, E1 = E0 + T_WB, E2 = E1 + T_WO, E3 = E2 + T_MOD, E4 = E3 + T_ROPE, E5 = E4 + T_MLP;
    for (int task = blockIdx.x; task < E5; task += gridDim.x) {
        if (task < E0) {
            const int l = task / (16 * TN_IN), r = task % (16 * TN_IN), kt = r / TN_IN, nt = r % TN_IN;
            transpose_tile(p.w_in + (size_t)l * D * IN_TOTAL, D, IN_TOTAL, (bf16_t*)(ws + OFF_WINT) + (size_t)l * IN_TOTAL * D, kt * 64, nt * 64, sm);
        } else if (task < E1) {
            const int q = task - E0, li = q / 128, r = q % 128, kt = r / 16, nt = r % 16;
            transpose_tile(p.w_branch + (size_t)li * 512 * D, 512, D, (bf16_t*)(ws + OFF_WBT) + (size_t)li * D * 512, kt * 64, nt * 64, sm);
        } else if (task < E2) {
            const int q = task - E1, l = q / 256, r = q % 256, kt = r / 16, nt = r % 16;
            transpose_tile(p.w_out + (size_t)l * D * D, D, D, (bf16_t*)(ws + OFF_WOT) + (size_t)l * D * D, kt * 64, nt * 64, sm);
        } else if (task < E3) {
            const int q = task - E2, l = q / 48, jb = q % 48;
            float* sc = sm;
            float* red = sm + 3072;
            __syncthreads();
#pragma unroll 1
            for (int e = tid; e < 3072; e += NTHR) {
                const int mi = e >> 10, k = e & 1023;
                const float v = (mi < 2) ? p.c[mi * D + k] : p.c_ctx[k];
                sc[e] = siluf(v);
            }
            __syncthreads();
            const int kg = tid >> 6, jj = tid & 63, j = jb * 64 + jj;
            const float* w = p.w_mod + (size_t)l * D * 3072 + j;
            float a0 = 0.f, a1 = 0.f, a2 = 0.f;
#pragma unroll 8
            for (int k = kg * 128; k < kg * 128 + 128; ++k) {
                const float wv = w[(size_t)k * 3072];
                a0 += sc[k] * wv; a1 += sc[1024 + k] * wv; a2 += sc[2048 + k] * wv;
            }
            red[(0 * 8 + kg) * 64 + jj] = a0; red[(1 * 8 + kg) * 64 + jj] = a1; red[(2 * 8 + kg) * 64 + jj] = a2;
            __syncthreads();
            if (tid < 192) {
                const int mi = tid >> 6, j2 = tid & 63;
                float s = p.b_mod[l * 3072 + jb * 64 + j2];
#pragma unroll
                for (int g = 0; g < 8; ++g) s += red[(mi * 8 + g) * 64 + j2];
                ((float*)(ws + OFF_MOD))[((size_t)l * 3 + mi) * 3072 + jb * 64 + j2] = s;
            }
        } else if (task < E4) {
            const int e = (task - E3) * NTHR + tid;
            const int t = e >> 5, c = e & 31;
            const float inv = powf(10000.0f, -(float)(c & 15) / 16.0f);
            const float pos = (c < 16) ? (float)(t >> 6) : (float)(t & 63);
            const float ang = pos * inv;
            float* rope = (float*)(ws + OFF_ROPE);
            rope[e] = cosf(ang); rope[(size_t)T * 32 + e] = sinf(ang);
        } else {
            const int q = task - E4;
            if (q < 512) { const int l = q >> 8; hyena_mlp_task(p, l, T, (q & 255) * 64, (float*)(ws + OFF_HH3T) + (size_t)l * 64 * T, sm); }
            else hyena_mlp_task(p, 0, CL, (q - 512) * 64, (float*)(ws + OFF_HH3C), sm);
        }
    }
}

DEVI void phase_hl(const P& p, int l) {
    unsigned char* ws = p.ws;
    const int lane = ltid() & 63, wave = ltid() >> 6;
    const float* MOD = (const float*)(ws + OFF_MOD) + (size_t)l * 3 * 3072;
    const float* nw = p.norm_w + l * D;
    bf16_t* HL = (bf16_t*)(ws + OFF_HL);
    const float* XC1 = (const float*)(ws + OFF_XC1);
    for (int row = blockIdx.x * 8 + wave; row < NR; row += gridDim.x * 8) {
        const float* src; int mi;
        if (row < NL) { src = (l == 0 ? p.x : p.out) + (size_t)row * D; mi = row >> 14; }
        else { src = (l == 0 ? p.ctx : XC1) + (size_t)(row - NL) * D; mi = 2; }
        float4 v[4]; float ss = 0.f;
#pragma unroll
        for (int i = 0; i < 4; ++i) { v[i] = *(const float4*)(src + lane * 4 + 256 * i); ss += v[i].x * v[i].x + v[i].y * v[i].y + v[i].z * v[i].z + v[i].w * v[i].w; }
        ss = wave_sum(ss);
        const float rs = rsqrtf(ss * (1.0f / D) + EPS);
        const float* sh = MOD + mi * 3072; const float* sc = sh + 1024;
#pragma unroll
        for (int i = 0; i < 4; ++i) {
            const int c = lane * 4 + 256 * i;
            const float4 w = *(const float4*)(nw + c), s1 = *(const float4*)(sc + c), s0 = *(const float4*)(sh + c);
            st4bf(HL + (size_t)row * D + c, v[i].x * rs * w.x * (1.f + s1.x) + s0.x, v[i].y * rs * w.y * (1.f + s1.y) + s0.y,
                  v[i].z * rs * w.z * (1.f + s1.z) + s0.z, v[i].w * rs * w.w * (1.f + s1.w) + s0.w);
        }
    }
}
DEVI void phase_final(const P& p) {
    const int lane = ltid() & 63, wave = ltid() >> 6;
    for (int row = blockIdx.x * 8 + wave; row < NL; row += gridDim.x * 8) {
        float* src = p.out + (size_t)row * D;
        float4 v[4]; float ss = 0.f;
#pragma unroll
        for (int i = 0; i < 4; ++i) { v[i] = *(const float4*)(src + lane * 4 + 256 * i); ss += v[i].x * v[i].x + v[i].y * v[i].y + v[i].z * v[i].z + v[i].w * v[i].w; }
        ss = wave_sum(ss);
        const float rs = rsqrtf(ss * (1.0f / D) + EPS);
#pragma unroll
        for (int i = 0; i < 4; ++i) {
            const int c = lane * 4 + 256 * i;
            const float4 w = *(const float4*)(p.final_norm_w + c);
            float4 r = {v[i].x * rs * w.x, v[i].y * rs * w.y, v[i].z * rs * w.z, v[i].w * rs * w.w};
            *(float4*)(src + c) = r;
        }
    }
}

union U8 { bf16x8 v; uint4 u; uint2 h[2]; unsigned w[4]; };
struct AttSt { float m, l; f32x4 o[4]; };
constexpr float L2E = 1.4426950408889634f;
constexpr float NEG_INF = -__builtin_huge_valf();

DEVI float rows_max(float x) {
    const unsigned u = __float_as_uint(x);
    auto r = __builtin_amdgcn_permlane16_swap(u, u, false, false);
    const float a = fmaxf(__uint_as_float(r[0]), __uint_as_float(r[1]));
    const unsigned v = __float_as_uint(a);
    auto t = __builtin_amdgcn_permlane32_swap(v, v, false, false);
    return fmaxf(__uint_as_float(t[0]), __uint_as_float(t[1]));
}
DEVI float rows_sum(float x) {
    const unsigned u = __float_as_uint(x);
    auto r = __builtin_amdgcn_permlane16_swap(u, u, false, false);
    const float a = __uint_as_float(r[0]) + __uint_as_float(r[1]);
    const unsigned v = __float_as_uint(a);
    auto t = __builtin_amdgcn_permlane32_swap(v, v, false, false);
    return __uint_as_float(t[0]) + __uint_as_float(t[1]);
}
struct KVF { bf16x8 ka, kb, kc, kd; U8 v0, v1, v2, v3; };
DEVI void att_load(KVF& f, const bf16_t* k0p, const bf16_t* k1p, const bf16_t* v0p, const bf16_t* v1p, size_t ldv) {
    f.ka = *(const bf16x8*)k0p; f.kb = *(const bf16x8*)(k0p + 32);
    f.kc = *(const bf16x8*)k1p; f.kd = *(const bf16x8*)(k1p + 32);
    f.v0.u = *(const uint4*)(v0p); f.v1.u = *(const uint4*)(v0p + 16 * ldv);
    f.v2.u = *(const uint4*)(v0p + 32 * ldv); f.v3.u = *(const uint4*)(v0p + 48 * ldv);
}
DEVI void att_load2(KVF& f, const char* kb, unsigned k0, unsigned k1, const char* vb, unsigned v0, unsigned vstep) {
    f.ka = *(const bf16x8*)(kb + k0); f.kb = *(const bf16x8*)(kb + (k0 + 64u));
    f.kc = *(const bf16x8*)(kb + k1); f.kd = *(const bf16x8*)(kb + (k1 + 64u));
    f.v0.u = *(const uint4*)(vb + v0); f.v1.u = *(const uint4*)(vb + (v0 + vstep));
    f.v2.u = *(const uint4*)(vb + (v0 + 2u * vstep)); f.v3.u = *(const uint4*)(vb + (v0 + 3u * vstep));
}
DEVI void att_compute(AttSt& st, const bf16x8& q0, const bf16x8& q1, const KVF& f, f32x4 b0, f32x4 b1, float scale2) {
    f32x4 s0 = {0.f, 0.f, 0.f, 0.f}, s1 = {0.f, 0.f, 0.f, 0.f};
    s0 = __builtin_amdgcn_mfma_f32_16x16x32_bf16(f.ka, q0, s0, 0, 0, 0);
    s0 = __builtin_amdgcn_mfma_f32_16x16x32_bf16(f.kb, q1, s0, 0, 0, 0);
    s1 = __builtin_amdgcn_mfma_f32_16x16x32_bf16(f.kc, q0, s1, 0, 0, 0);
    s1 = __builtin_amdgcn_mfma_f32_16x16x32_bf16(f.kd, q1, s1, 0, 0, 0);
    s0 = s0 * scale2 + b0; s1 = s1 * scale2 + b1;
    float mx = fmaxf(fmaxf(fmaxf(s0[0], s0[1]), fmaxf(s0[2], s0[3])), fmaxf(fmaxf(s1[0], s1[1]), fmaxf(s1[2], s1[3])));
    mx = rows_max(mx);
    if (__any(mx > st.m + 8.0f)) {
        const float mn = fmaxf(st.m, mx);
        const float alpha = __builtin_amdgcn_exp2f(st.m - mn);
        st.l *= alpha; st.m = mn;
        st.o[0] = st.o[0] * alpha; st.o[1] = st.o[1] * alpha; st.o[2] = st.o[2] * alpha; st.o[3] = st.o[3] * alpha;
    }
    const float mref = st.m;
    float pa[8];
#pragma unroll
    for (int i = 0; i < 4; ++i) { pa[i] = __builtin_amdgcn_exp2f(s0[i] - mref); pa[4 + i] = __builtin_amdgcn_exp2f(s1[i] - mref); }
    st.l += ((pa[0] + pa[1]) + (pa[2] + pa[3])) + ((pa[4] + pa[5]) + (pa[6] + pa[7]));
    U8 pf; pf.w[0] = pk2(pa[0], pa[1]); pf.w[1] = pk2(pa[2], pa[3]); pf.w[2] = pk2(pa[4], pa[5]); pf.w[3] = pk2(pa[6], pa[7]);
    st.o[0] = __builtin_amdgcn_mfma_f32_16x16x32_bf16(f.v0.v, pf.v, st.o[0], 0, 0, 0);
    st.o[1] = __builtin_amdgcn_mfma_f32_16x16x32_bf16(f.v1.v, pf.v, st.o[1], 0, 0, 0);
    st.o[2] = __builtin_amdgcn_mfma_f32_16x16x32_bf16(f.v2.v, pf.v, st.o[2], 0, 0, 0);
    st.o[3] = __builtin_amdgcn_mfma_f32_16x16x32_bf16(f.v3.v, pf.v, st.o[3], 0, 0, 0);
}
#define ATT_PIPELINE(n_)                                              \
    { KVF fa_, fb_;                                                   \
      LOADS(fa_, 0);                                                  \
      int s_ = 0;                                                     \
      for (; s_ + 2 < (n_); s_ += 2) {        \
          LOADS(fb_, s_ + 1);                                         \
          COMPS(fa_, s_);                                             \
          LOADS(fa_, s_ + 2);                                         \
          COMPS(fb_, s_ + 1);                                         \
      }                                                               \
      if (s_ + 1 < (n_)) { LOADS(fb_, s_ + 1); COMPS(fa_, s_); COMPS(fb_, s_ + 1); } \
      else { COMPS(fa_, s_); } }
DEVI void att_finish(const AttSt& st, float extra_l, bf16_t* G  , int dry) {
    const int lane = ltid() & 63, g = lane >> 4;
    float lt = rows_sum(st.l);
    lt += extra_l;
    const float inv = 1.f / lt;
#pragma unroll
    for (int dt = 0; dt < 4; ++dt) {
        bf16_t* gp = G + dt * 16 + 4 * g;
        const uint2 gv = *(const uint2*)gp;
        if (!dry) st4bf(gp, st.o[dt][0] * inv * lo_bf(gv.x), st.o[dt][1] * inv * hi_bf(gv.x), st.o[dt][2] * inv * lo_bf(gv.y), st.o[dt][3] * inv * hi_bf(gv.y));
    }
}

DEVI void phase_att_a(const P& p, int l, float* smf) {
    unsigned char* ws = p.ws; unsigned char* scr = ws + OFF_SCR;
    const bf16_t* Q = (const bf16_t*)(scr + SA_Q); const bf16_t* K = (const bf16_t*)(scr + SA_K); const bf16_t* VT = (const bf16_t*)(scr + SA_VT);
    const bf16_t* VTC = VT + (size_t)NB * 8 * 64 * T;
    bf16_t* G = (bf16_t*)(ws + OFF_YS);
    const int tid = ltid(), lane = tid & 63, h = tid >> 6, q = lane & 15, g = lane >> 4;
    __syncthreads();
    for (int e = tid; e < 8 * 465; e += NTHR) smf[e] = p.rpb[(size_t)l * 8 * 465 + e] * L2E;
    __syncthreads();
    const float* tab = smf + h * 465;
    const float scale2 = 0.125f * L2E;
    const int ntask = 2048 + (l == 0 ? 32 : 0);
    for (int it = 0; it * (int)gridDim.x < ntask; ++it) {
        const int task = tile_of(it);
        if (task >= ntask) continue;
        AttSt st; st.m = -1e30f; st.l = 0.f;
#pragma unroll
        for (int dt = 0; dt < 4; ++dt) st.o[dt] = (f32x4){0.f, 0.f, 0.f, 0.f};
        int b, qrow;
        const bool lat = task < 2048;
        int r = 0, j = 0;
        if (lat) { b = task >> 10; r = (task >> 2) & 255; j = task & 3; qrow = b * T + r * 64 + j * 16 + q; }
        else { const int tt = task - 2048; b = tt >> 4; qrow = NL + b * CL + (tt & 15) * 16 + q; }
        const bf16_t* qp = Q + (size_t)qrow * 512 + h * 64 + g * 8;
        const bf16x8 q0 = *(const bf16x8*)qp, q1 = *(const bf16x8*)(qp + 32);
        {
            const int rs = min(max(r - 4, 0), 248), kc0 = min(max(j * 16 - 8, 0), 32);
            const int qc = j * 16 + q, cs = min(max(qc - 8, 0), 48);
            const int nloc = lat ? 8 : 0, nst = nloc + 8;
            const bf16_t* Kc = K + (size_t)(NL + b * CL) * 512 + h * 64 + g * 8;
            const bf16_t* Vc = VTC + ((size_t)(b * 8 + h) * 64 + (lane & 15)) * CL + 8 * g;
            const int kmap = 8 * ((lane & 15) >> 2) + (lane & 3);
            const char* KnB = (const char*)(K + (size_t)b * T * 512); const char* VnB = (const char*)(VT + (size_t)(b * 8) * 64 * T);
            const char* KcB = (const char*)(K + (size_t)(NL + b * CL) * 512); const char* VcB = (const char*)(VTC + (size_t)(b * 8) * 64 * CL);
            const unsigned kln = (unsigned)((kc0 + kmap) * 512 + h * 64 + g * 8) * 2u, vln = (unsigned)((h * 64 + (lane & 15)) * T + kc0 + 8 * g) * 2u;
            const unsigned klc = (unsigned)(kmap * 512 + h * 64 + g * 8) * 2u, vlc = (unsigned)((h * 64 + (lane & 15)) * CL + 8 * g) * 2u;
#define LOADS(F, S) { const int s2_ = (S); if (s2_ < nloc) { const unsigned k0_ = kln + (unsigned)(rs + s2_) * 65536u; \
                        att_load2(F, KnB, k0_, k0_ + 4096u, VnB, vln + (unsigned)(rs + s2_) * 128u, (unsigned)(16 * T * 2)); } \
                      else { const unsigned c_ = (unsigned)(s2_ - nloc); const unsigned k0_ = klc + c_ * 32768u; att_load2(F, KcB, k0_, k0_ + 4096u, VcB, vlc + c_ * 64u, (unsigned)(16 * CL * 2)); } }
            int ia[4], ib[4]; bool va_[4], vb_[4];
#pragma unroll
            for (int i = 0; i < 4; ++i) { const int kc_a = kc0 + 8 * g + i, kc_b = kc_a + 4;
                va_[i] = (kc_a >= cs && kc_a < cs + 16); vb_[i] = (kc_b >= cs && kc_b < cs + 16);
                ia[i] = min(max(kc_a - qc + 15, 0), 30); ib[i] = min(max(kc_b - qc + 15, 0), 30); }
#define COMPS(F, S) { const int s2_ = (S); f32x4 b0 = {0.f, 0.f, 0.f, 0.f}, b1 = {0.f, 0.f, 0.f, 0.f}; \
                      if (s2_ < nloc) { const float* trw = tab + (rs + s2_ - r + 7) * 31; \
                        _Pragma("unroll") for (int i = 0; i < 4; ++i) { b0[i] = va_[i] ? trw[ia[i]] : NEG_INF; b1[i] = vb_[i] ? trw[ib[i]] : NEG_INF; } } \
                      att_compute(st, q0, q1, F, b0, b1, scale2); }
            ATT_PIPELINE(nst)
#undef LOADS
#undef COMPS
        }
        att_finish(st, 0.f, G + (size_t)qrow * 512 + h * 64, p.dry);
    }
}

DEVI void phase_att_b(const P& p, int l) {
    unsigned char* ws = p.ws; unsigned char* scr = ws + OFF_SCR;
    const bf16_t* Q = (const bf16_t*)(scr + SB_Q); const bf16_t* K = (const bf16_t*)(scr + SB_K); const bf16_t* VT = (const bf16_t*)(scr + SB_VT);
    const bf16_t* VTC = VT + (size_t)NB * 2 * 64 * T;
    bf16_t* G = (bf16_t*)(ws + OFF_YS + SZ512);
    const int tid = ltid(), lane = tid & 63, h = tid >> 6, kvh = h >> 2, q = lane & 15, g = lane >> 4;
    const float scale2 = 0.125f * L2E;
    const float sink2 = p.sink[l * 8 + h] * L2E;
    const int ntask = 2048 + (l == 0 ? 32 : 0);
    for (int it = 0; it * (int)gridDim.x < ntask; ++it) {
        const int task = tile_of(it);
        if (task >= ntask) continue;
        AttSt st; st.m = -1e30f; st.l = 0.f;
#pragma unroll
        for (int dt = 0; dt < 4; ++dt) st.o[dt] = (f32x4){0.f, 0.f, 0.f, 0.f};
        int b, qrow;
        const bool lat = task < 2048;
        int q0t = 0;
        if (lat) { b = task >> 10; q0t = (task & 1023) * 16; qrow = b * T + q0t + q; }
        else { const int tt = task - 2048; b = tt >> 4; qrow = NL + b * CL + (tt & 15) * 16 + q; }
        const bf16_t* qp = Q + (size_t)qrow * 512 + h * 64 + g * 8;
        const bf16x8 q0 = *(const bf16x8*)qp, q1 = *(const bf16x8*)(qp + 32);
        {
            const int tq = q0t + q;
            const int nloc = lat ? 9 : 0, nst = nloc + 8;
            const bf16_t* Kc = K + (size_t)(NL + b * CL) * 128 + kvh * 64 + g * 8;
            const bf16_t* Vc = VTC + ((size_t)(b * 2 + kvh) * 64 + (lane & 15)) * CL + 8 * g;
            const int kmap = 8 * ((lane & 15) >> 2) + (lane & 3);
            const bf16_t* vbase = VT + ((size_t)(b * 2 + kvh) * 64 + (lane & 15)) * T;
            const char* KnB = (const char*)(K + (size_t)b * T * 128); const char* VnB = (const char*)(VT + (size_t)(b * 2) * 64 * T);
            const char* KcB = (const char*)(K + (size_t)(NL + b * CL) * 128); const char* VcB = (const char*)(VTC + (size_t)(b * 2) * 64 * CL);
            const unsigned kl2 = (unsigned)(kvh * 64 + g * 8) * 2u, vl2 = (unsigned)((kvh * 64 + (lane & 15)) * T) * 2u;
            const unsigned klc = (unsigned)(kmap * 128 + kvh * 64 + g * 8) * 2u, vlc = (unsigned)((kvh * 64 + (lane & 15)) * CL + 8 * g) * 2u;
#define LOADS(F, S) { const int s2_ = (S); if (s2_ < nloc) { const int tbase = q0t - 128 + 32 * s2_; \
                        const int ta = min(max(tbase + kmap, 0), T - 1), tb = min(max(tbase + kmap + 4, 0), T - 1); \
                        const int va = min(max(tbase + 8 * g, 0), T - 8); \
                        att_load2(F, KnB, kl2 + (unsigned)ta * 256u, kl2 + (unsigned)tb * 256u, VnB, vl2 + (unsigned)va * 2u, (unsigned)(16 * T * 2)); } \
                      else { const unsigned c_ = (unsigned)(s2_ - nloc); const unsigned k0_ = klc + c_ * 8192u; att_load2(F, KcB, k0_, k0_ + 1024u, VcB, vlc + c_ * 64u, (unsigned)(16 * CL * 2)); } }
#define COMPS(F, S) { const int s2_ = (S); f32x4 b0 = {0.f, 0.f, 0.f, 0.f}, b1 = {0.f, 0.f, 0.f, 0.f}; \
                      if (s2_ < nloc && (s2_ == 0 || s2_ == 8 || q0t < 128 || q0t + 160 > T)) { const int tbase = q0t - 128 + 32 * s2_; \
                        _Pragma("unroll") for (int i = 0; i < 4; ++i) { const int t0 = tbase + 8 * g + i, t1 = t0 + 4; \
                          b0[i] = (t0 >= 0 && t0 < T && abs(tq - t0) <= 128) ? 0.f : NEG_INF; \
                          b1[i] = (t1 >= 0 && t1 < T && abs(tq - t1) <= 128) ? 0.f : NEG_INF; } } \
                      att_compute(st, q0, q1, F, b0, b1, scale2); }
            ATT_PIPELINE(nst)
#undef LOADS
#undef COMPS
        }
        att_finish(st, __builtin_amdgcn_exp2f(sink2 - st.m), G + (size_t)qrow * 512 + h * 64, p.dry);
    }
}

constexpr int GL_CUM = 0;
constexpr int GL_LR = 32768;
constexpr int GL_T0 = GL_LR + 8192;
constexpr int GL_TSZ = 64 * LSTR * 2;
constexpr int GL_X = GL_T0 + 4 * GL_TSZ;

DEVI float logsigmoidf(float x) { return fminf(x, 0.f) - __logf(1.0f + __expf(-fabsf(x))); }

DEVI void gla_cum(const P& p, int l, int h, int rowbase, unsigned char* sm) {
    const int tid = ltid();
    float* cum = (float*)(sm + GL_CUM); float* lrs = (float*)(sm + GL_LR);
    const float* LR = (const float*)(p.ws + OFF_SCR + SC_LR);
    __syncthreads();
    { const int t = tid >> 3, c4 = (tid & 7) * 4; *(float4*)(lrs + t * 32 + c4) = *(const float4*)(LR + (size_t)(rowbase + t) * 32 + c4); }
    __syncthreads();
    const int d = tid & 63, tg = tid >> 6;
    float* tot = lrs + 64 * 32;
    tot = (float*)(sm + GL_X);
    float la[2][8];
#pragma unroll
    for (int dir = 0; dir < 2; ++dir) {
        const float* W = p.w_alpha_up + ((size_t)(l * 2 + dir) * 16) * 256 + h * 64 + d;
        float w[16];
#pragma unroll
        for (int r = 0; r < 16; ++r) w[r] = W[r * 256];
        const float bia = p.b_alpha[(l * 2 + dir) * 256 + h * 64 + d];
#pragma unroll
        for (int tt = 0; tt < 8; ++tt) {
            const int t = tg * 8 + tt;
            float x = bia;
#pragma unroll
            for (int r = 0; r < 16; ++r) x += lrs[t * 32 + dir * 16 + r] * w[r];
            la[dir][tt] = logsigmoidf(x) * (1.0f / 16.0f);
        }
    }
#pragma unroll
    for (int tt = 1; tt < 8; ++tt) la[0][tt] += la[0][tt - 1];
#pragma unroll
    for (int tt = 6; tt >= 0; --tt) la[1][tt] += la[1][tt + 1];
    tot[(0 * 8 + tg) * 64 + d] = la[0][7];
    tot[(1 * 8 + tg) * 64 + d] = la[1][0];
    __syncthreads();
    float of = 0.f, ob = 0.f;
#pragma unroll
    for (int g2 = 0; g2 < 8; ++g2) {
        const float a = tot[(0 * 8 + g2) * 64 + d], b = tot[(1 * 8 + g2) * 64 + d];
        of += (g2 < tg) ? a : 0.f;
        ob += (g2 > tg) ? b : 0.f;
    }
#pragma unroll
    for (int tt = 0; tt < 8; ++tt) {
        const int t = tg * 8 + tt;
        cum[t * 64 + d] = la[0][tt] + of;
        cum[(64 + t) * 64 + d] = la[1][tt] + ob;
    }
    __syncthreads();
}
DEVI void gla_chunk_geom(int b, int c, int& rowbase, size_t& vt_off  , size_t& vld, int& ci_f, int& ci_b) {
    if (c < 4) { rowbase = NL + b * CL + c * 64; vld = CL; ci_f = c; ci_b = 3 - c; }
    else { rowbase = b * T + (c - 4) * 64; vld = T; ci_f = c; ci_b = 4 + 255 - (c - 4); }
}
DEVI const bf16_t* gla_vt_ptr(const bf16_t* VT, int b, int h, int c) {
    if (c < 4) return VT + (size_t)NB * 4 * 128 * T + ((size_t)(b * 4 + h) * 128) * CL + c * 64;
    return VT + ((size_t)(b * 4 + h) * 128) * T + (size_t)(c - 4) * 64;
}

DEVI void phase_gla1(const P& p, int l, unsigned char* sm) {
    unsigned char* scr = p.ws + OFF_SCR;
    const bf16_t* KG = (const bf16_t*)(scr + SC_K); const bf16_t* VT = (const bf16_t*)(scr + SC_VT);
    bf16_t* SB = (bf16_t*)(scr + SC_SB); float* GD = (float*)(scr + SC_GD);
    const int tid = ltid(), lane = tid & 63, wave = tid >> 6;
    const float* cum = (const float*)(sm + GL_CUM);
    bf16_t* kdT = (bf16_t*)(sm + GL_T0);
    for (int task = blockIdx.x; task < 8 * NCH; task += gridDim.x) {
        const int bh = task / NCH, c = task % NCH, b = bh >> 2, h = bh & 3;
        int rowbase, ci_f, ci_b; size_t vo, vld;
        gla_chunk_geom(b, c, rowbase, vo, vld, ci_f, ci_b);
        gla_cum(p, l, h, rowbase, sm);
        {
            const int d = tid & 63, tg = tid >> 6;
            const float ce_f = cum[63 * 64 + d], ce_b = cum[64 * 64 + d];
            float vf[8], vb[8];
#pragma unroll
            for (int j = 0; j < 8; ++j) {
                const int t = tg * 8 + j;
                const float kf = bf2f(KG[(size_t)(rowbase + t) * 256 + h * 64 + d]);
                vf[j] = kf * __expf(ce_f - cum[t * 64 + d]);
                vb[j] = kf * __expf(ce_b - cum[(64 + t) * 64 + d]);
            }
            uint4 wf, wb;
            wf.x = pk2(vf[0], vf[1]); wf.y = pk2(vf[2], vf[3]); wf.z = pk2(vf[4], vf[5]); wf.w = pk2(vf[6], vf[7]);
            wb.x = pk2(vb[0], vb[1]); wb.y = pk2(vb[2], vb[3]); wb.z = pk2(vb[4], vb[5]); wb.w = pk2(vb[6], vb[7]);
            *(uint4*)(kdT + d * LSTR + tg * 8) = wf;
            *(uint4*)(kdT + (64 + d) * LSTR + tg * 8) = wb;
        }
        __syncthreads();
        {
            const int dir = wave >> 2, dvt = wave & 3;
            const bf16_t* vp = gla_vt_ptr(VT, b, h, c) + (size_t)(dvt * 32 + (lane & 31)) * vld + (lane >> 5) * 8;
            const bf16_t* ap = kdT + (dir * 64 + (lane & 31)) * LSTR + (lane >> 5) * 8;
            f32x16 acc[2];
#pragma unroll
            for (int i = 0; i < 16; ++i) { acc[0][i] = 0.f; acc[1][i] = 0.f; }
#pragma unroll
            for (int ks = 0; ks < 4; ++ks) {
                const bf16x8 vb = *(const bf16x8*)(vp + ks * 16);
#pragma unroll
                for (int mt = 0; mt < 2; ++mt) {
                    const bf16x8 ka = *(const bf16x8*)(ap + mt * 32 * LSTR + ks * 16);
                    acc[mt] = __builtin_amdgcn_mfma_f32_32x32x16_bf16(ka, vb, acc[mt], 0, 0, 0);
                }
            }
            const int bhd = bh * 2 + dir, ci = dir ? ci_b : ci_f;
            bf16_t* out = SB + ((size_t)bhd * NCH + ci) * 8192 + (size_t)(dvt * 32 + (lane & 31)) * 64;
#ifdef EXP_C
            for (int mt = 0; mt < 2; ++mt) for (int i = 0; i < 16; ++i) { const int dk = mt * 32 + (i & 3) + 8 * (i >> 2) + 4 * (lane >> 5); acc[mt][i] = bf2f(kdT[(dir * 64 + dk) * LSTR + ((dvt * 32 + (lane & 31)) & 63)]); }
#endif
#pragma unroll
            for (int mt = 0; mt < 2; ++mt)
#pragma unroll
                for (int q4 = 0; q4 < 4; ++q4)
                    st4bf(out + mt * 32 + q4 * 8 + (lane >> 5) * 4, acc[mt][q4 * 4 + 0], acc[mt][q4 * 4 + 1], acc[mt][q4 * 4 + 2], acc[mt][q4 * 4 + 3]);
        }
        if (tid < 128) {
            const int dir = tid >> 6, d = tid & 63;
            const int bhd = bh * 2 + dir, ci = dir ? ci_b : ci_f;
            GD[((size_t)bhd * NCH + ci) * 64 + d] = __expf(dir ? cum[64 * 64 + d] : cum[63 * 64 + d]);
        }
    }
}

DEVI void phase_gla2(const P& p) {
    unsigned char* scr = p.ws + OFF_SCR;
    bf16_t* SB = (bf16_t*)(scr + SC_SB); const float* GD = (const float*)(scr + SC_GD);
    for (int idx = blockIdx.x * NTHR + ltid(); idx < 16 * 8192; idx += gridDim.x * NTHR) {
        const int bhd = idx >> 13, e = idx & 8191, dk = e & 63;
        bf16_t* base = SB + (size_t)bhd * NCH * 8192 + e;
        const float* gd = GD + (size_t)bhd * NCH * 64 + dk;
        float S = 0.f;
#pragma unroll 1
        for (int ci = 0; ci < NCH; ci += 13) {
            float kv[13], g[13];
#pragma unroll
            for (int u = 0; u < 13; ++u) { kv[u] = bf2f(base[(size_t)(ci + u) * 8192]); g[u] = gd[(ci + u) * 64]; }
#pragma unroll
            for (int u = 0; u < 13; ++u) { if (!p.dry) base[(size_t)(ci + u) * 8192] = f2bf(S); S = g[u] * S + kv[u]; }
        }
    }
}

DEVI void phase_gla3(const P& p, int l, unsigned char* sm) {
    unsigned char* scr = p.ws + OFF_SCR;
    const bf16_t* QG = (const bf16_t*)(scr + SC_Q); const bf16_t* KG = (const bf16_t*)(scr + SC_K); const bf16_t* VT = (const bf16_t*)(scr + SC_VT);
    const bf16_t* SB = (const bf16_t*)(scr + SC_SB);
    bf16_t* G = (bf16_t*)(p.ws + OFF_YS + 2 * SZ512);
    const float* gnw = p.gla_norm_w + l * 128;
    const int tid = ltid(), lane = tid & 63, wave = tid >> 6, q = lane & 15, g = lane >> 4;
    const float* cum = (const float*)(sm + GL_CUM);
    bf16_t* tiles = (bf16_t*)(sm + GL_T0);
    float* X = (float*)(sm + GL_X);
    const int c_lo = (l == 0) ? 0 : 4;
    const int nper = NCH - c_lo;
    for (int task = blockIdx.x; task < 8 * nper; task += gridDim.x) {
        const int bh = task / nper, c = c_lo + task % nper, b = bh >> 2, h = bh & 3;
        int rowbase, ci_f, ci_b; size_t vo, vld;
        gla_chunk_geom(b, c, rowbase, vo, vld, ci_f, ci_b);
        gla_cum(p, l, h, rowbase, sm);
        {
            const int t = tid >> 3, dg = (tid & 7) * 8;
            U8 qv, kv; qv.u = *(const uint4*)(QG + (size_t)(rowbase + t) * 256 + h * 64 + dg); kv.u = *(const uint4*)(KG + (size_t)(rowbase + t) * 256 + h * 64 + dg);
            float o[4][8];
#pragma unroll
            for (int j = 0; j < 8; ++j) {
                const int d = dg + j;
                const float qf = (j & 1) ? hi_bf(qv.w[j >> 1]) : lo_bf(qv.w[j >> 1]);
                const float kf = (j & 1) ? hi_bf(kv.w[j >> 1]) : lo_bf(kv.w[j >> 1]);
                const float cf = cum[t * 64 + d], cb = cum[(64 + t) * 64 + d];
                o[0][j] = qf * __expf(cf); o[1][j] = kf * __expf(-cf); o[2][j] = qf * __expf(cb); o[3][j] = kf * __expf(-cb);
            }
#pragma unroll
            for (int k = 0; k < 4; ++k) {
                uint4 w; w.x = pk2(o[k][0], o[k][1]); w.y = pk2(o[k][2], o[k][3]); w.z = pk2(o[k][4], o[k][5]); w.w = pk2(o[k][6], o[k][7]);
                *(uint4*)(tiles + k * 64 * LSTR + t * LSTR + dg) = w;
            }
        }
        __syncthreads();
        const int qi = wave & 3, dir = wave >> 2;
        f32x4 O[8];
#pragma unroll
        for (int i = 0; i < 8; ++i) O[i] = (f32x4){0.f, 0.f, 0.f, 0.f};
        {
            const bf16_t* Qd = tiles + (dir * 2) * 64 * LSTR; const bf16_t* Kd = tiles + (dir * 2 + 1) * 64 * LSTR;
            const bf16x8 qf0 = *(const bf16x8*)(Qd + (qi * 16 + q) * LSTR + g * 8), qf1 = *(const bf16x8*)(Qd + (qi * 16 + q) * LSTR + 32 + g * 8);
            const int iq = qi * 16 + q;
            U8 pf[2];
#pragma unroll
            for (int jt = 0; jt < 4; ++jt) {
                const bf16_t* kp = Kd + (jt * 16 + (lane & 15)) * LSTR + g * 8;
                f32x4 s = {0.f, 0.f, 0.f, 0.f};
                s = __builtin_amdgcn_mfma_f32_16x16x32_bf16(*(const bf16x8*)kp, qf0, s, 0, 0, 0);
                s = __builtin_amdgcn_mfma_f32_16x16x32_bf16(*(const bf16x8*)(kp + 32), qf1, s, 0, 0, 0);
#pragma unroll
                for (int i = 0; i < 4; ++i) { const int jk = jt * 16 + 4 * g + i; const bool ok = dir ? (jk >= iq) : (jk <= iq); s[i] = ok ? s[i] : 0.f; }
                pf[jt >> 1].w[(jt & 1) * 2 + 0] = pk2(s[0], s[1]); pf[jt >> 1].w[(jt & 1) * 2 + 1] = pk2(s[2], s[3]);
            }
            const bf16_t* vp = gla_vt_ptr(VT, b, h, c) + (size_t)(lane & 15) * vld + 4 * g;
            const int bhd = bh * 2 + dir, ci = dir ? ci_b : ci_f;
            const bf16_t* sp = SB + ((size_t)bhd * NCH + ci) * 8192 + (size_t)(lane & 15) * 64 + g * 8;
#pragma unroll
            for (int dvt = 0; dvt < 8; ++dvt) {
#pragma unroll
                for (int st = 0; st < 2; ++st) {
                    U8 vf; vf.h[0] = *(const uint2*)(vp + (size_t)dvt * 16 * vld + st * 32); vf.h[1] = *(const uint2*)(vp + (size_t)dvt * 16 * vld + st * 32 + 16);
                    O[dvt] = __builtin_amdgcn_mfma_f32_16x16x32_bf16(vf.v, pf[st].v, O[dvt], 0, 0, 0);
                }
                O[dvt] = __builtin_amdgcn_mfma_f32_16x16x32_bf16(*(const bf16x8*)(sp + dvt * 16 * 64), qf0, O[dvt], 0, 0, 0);
                O[dvt] = __builtin_amdgcn_mfma_f32_16x16x32_bf16(*(const bf16x8*)(sp + dvt * 16 * 64 + 32), qf1, O[dvt], 0, 0, 0);
            }
        }
        if (dir == 1) {
#pragma unroll
            for (int dvt = 0; dvt < 8; ++dvt)
#pragma unroll
                for (int i = 0; i < 4; ++i) X[(qi * 128 + dvt * 16 + 4 * g + i) * 16 + q] = O[dvt][i];
        }
        __syncthreads();
        if (dir == 0) {
            float ss = 0.f;
#pragma unroll
            for (int dvt = 0; dvt < 8; ++dvt)
#pragma unroll
                for (int i = 0; i < 4; ++i) { O[dvt][i] += X[(qi * 128 + dvt * 16 + 4 * g + i) * 16 + q]; ss += O[dvt][i] * O[dvt][i]; }
            ss = rows_sum(ss);
            const float rs = rsqrtf(ss * (1.0f / 128.0f) + EPS);
            bf16_t* gp = G + (size_t)(rowbase + qi * 16 + q) * 512 + h * 128;
#pragma unroll
            for (int dvt = 0; dvt < 8; ++dvt) {
                const int dv = dvt * 16 + 4 * g;
                const float4 w = *(const float4*)(gnw + dv);
                const uint2 gv = *(const uint2*)(gp + dv);
                if (!p.dry) st4bf(gp + dv, O[dvt][0] * rs * w.x * lo_bf(gv.x), O[dvt][1] * rs * w.y * hi_bf(gv.x), O[dvt][2] * rs * w.z * lo_bf(gv.y), O[dvt][3] * rs * w.w * hi_bf(gv.y));
            }
        }
    }
}

constexpr int LF = 16384;
DEVI int CIDX(int p) { return p + (p >> 4); }
DEVI int FIDX(int m) { return 2 * CIDX(m >> 1) + (m & 1); }
constexpr int LFP = LF + LF / 16;
DEVI float2 cmul(float2 a, float2 b) { return make_float2(a.x * b.x - a.y * b.y, a.x * b.y + a.y * b.x); }
DEVI float2 cadd(float2 a, float2 b) { return make_float2(a.x + b.x, a.y + b.y); }
DEVI float2 csub(float2 a, float2 b) { return make_float2(a.x - b.x, a.y - b.y); }
DEVI float2 twid(float frac) { return make_float2(__builtin_amdgcn_cosf(frac), __builtin_amdgcn_sinf(frac)); }

DEVI void fft_fwd(float2* F) {
    const int tid = ltid();
#pragma unroll 1
    for (int s = LF / 2; s >= 2; s >>= 2) {
        const int h = s >> 1;
        const int lh = 31 - __clz(h);
        const float inv2s = 1.0f / (float)(2 * s);
#pragma unroll 2
        for (int qq = tid; qq < LF / 4; qq += NTHR) {
            const int blk = qq >> lh, j = qq & (h - 1);
            const int i = blk * (2 * s) + j;
            const int i0 = CIDX(i), i1 = CIDX(i + h), i2 = CIDX(i + s), i3 = CIDX(i + s + h);
            const float2 x0 = F[i0], x1 = F[i1], x2 = F[i2], x3 = F[i3];
            float2 w1 = twid((float)j * inv2s); w1.y = -w1.y;
            const float2 w2 = cmul(w1, w1);
            const float2 y0 = cadd(x0, x2), y2 = cmul(csub(x0, x2), w1);
            const float2 y1 = cadd(x1, x3); const float2 tt = csub(x1, x3);
            const float2 y3 = cmul(make_float2(tt.y, -tt.x), w1);
            F[i0] = cadd(y0, y1); F[i1] = cmul(csub(y0, y1), w2);
            F[i2] = cadd(y2, y3); F[i3] = cmul(csub(y2, y3), w2);
        }
        __syncthreads();
    }
}
DEVI void fft_inv(float2* F) {
    const int tid = ltid();
#pragma unroll 1
    for (int h = 1; h <= LF / 4; h <<= 2) {
        const int s = 2 * h;
        const int lh = 31 - __clz(h);
        const float inv2s = 1.0f / (float)(2 * s);
#pragma unroll 2
        for (int qq = tid; qq < LF / 4; qq += NTHR) {
            const int blk = qq >> lh, j = qq & (h - 1);
            const int i = blk * (2 * s) + j;
            const int i0 = CIDX(i), i1 = CIDX(i + h), i2 = CIDX(i + s), i3 = CIDX(i + s + h);
            const float2 x0 = F[i0], x1 = F[i1], x2 = F[i2], x3 = F[i3];
            const float2 w1 = twid((float)j * inv2s);
            const float2 w2 = cmul(w1, w1);
            const float2 a1 = cmul(x1, w2), a3 = cmul(x3, w2);
            const float2 u0 = cadd(x0, a1), u1 = csub(x0, a1), u2 = cadd(x2, a3), u3 = csub(x2, a3);
            const float2 b2 = cmul(u2, w1); const float2 t3 = cmul(u3, w1); const float2 b3 = make_float2(-t3.y, t3.x);
            F[i0] = cadd(u0, b2); F[i2] = csub(u0, b2); F[i1] = cadd(u1, b3); F[i3] = csub(u1, b3);
        }
        __syncthreads();
    }
}
DEVI int rev14(int k) { return (int)(__brev((unsigned)k) >> 18); }
DEVI float hy_delta(int ch) {
    const float a = -3.0701134573253946f, b = -15.350567286626973f;
    return fabsf(a + (b - a) * ((float)ch / 511.0f));
}

DEVI void conv8(const bf16_t* U, const float* cw, const float* cb, int seq0, int Lseq, int t, int col0, float* out) {
    U8 r[3];
#pragma unroll
    for (int i = 0; i < 3; ++i) {
        const int tt = t - 1 + i;
        if (tt >= 0 && tt < Lseq) r[i].u = *(const uint4*)(U + (size_t)(seq0 + tt) * 1536 + col0);
        else r[i].u = make_uint4(0, 0, 0, 0);
    }
#pragma unroll
    for (int j = 0; j < 8; ++j) {
        float a = cb[col0 + j];
#pragma unroll
        for (int i = 0; i < 3; ++i) { const float uv = (j & 1) ? hi_bf(r[i].w[j >> 1]) : lo_bf(r[i].w[j >> 1]); a += uv * cw[i * 1536 + col0 + j]; }
        out[j] = a;
    }
}
DEVI void hy_task_geom(int task, int& b, int& t0, int& ch0, int& seq0, int& Lseq, float*& zt, unsigned char* scr) {
    if (task < 4096) { b = task >> 11; t0 = ((task >> 3) & 255) * 64; ch0 = (task & 7) * 64; seq0 = b * T; Lseq = T; zt = (float*)(scr + SD_ZT) + (size_t)b * 512 * T; }
    else { const int q = task - 4096; b = q >> 5; t0 = ((q >> 3) & 3) * 64; ch0 = (q & 7) * 64; seq0 = NL + b * CL; Lseq = CL; zt = (float*)(scr + SD_ZTC) + (size_t)b * 512 * CL; }
}
DEVI void phase_hy1(const P& p, int l, float* sm) {
    unsigned char* scr = p.ws + OFF_SCR;
    const bf16_t* U = (const bf16_t*)(scr + SD_U);
    const float* cw = p.conv_w + (size_t)l * 3 * 1536; const float* cb = p.conv_b + l * 1536;
    const int tid = ltid();
    const int ntask = 4096 + (l == 0 ? 64 : 0);
    for (int task = blockIdx.x; task < ntask; task += gridDim.x) {
        int b, t0, ch0, seq0, Lseq; float* zt;
        hy_task_geom(task, b, t0, ch0, seq0, Lseq, zt, scr);
        __syncthreads();
        {
            const int tt = tid >> 3, cg = (tid & 7) * 8;
            float a1[8], a2[8];
            conv8(U, cw, cb, seq0, Lseq, t0 + tt, 512 + ch0 + cg, a1);
            conv8(U, cw, cb, seq0, Lseq, t0 + tt, 1024 + ch0 + cg, a2);
#pragma unroll
            for (int j = 0; j < 8; ++j) sm[(cg + j) * 65 + tt] = a1[j] * a2[j];
        }
        __syncthreads();
        {
            const int ch = tid >> 3, t8 = (tid & 7) * 8;
            float4 w0 = {sm[ch * 65 + t8 + 0], sm[ch * 65 + t8 + 1], sm[ch * 65 + t8 + 2], sm[ch * 65 + t8 + 3]};
            float4 w1 = {sm[ch * 65 + t8 + 4], sm[ch * 65 + t8 + 5], sm[ch * 65 + t8 + 6], sm[ch * 65 + t8 + 7]};
            float* dst = zt + (size_t)(ch0 + ch) * Lseq + t0 + t8;
            *(float4*)dst = w0; *(float4*)(dst + 4) = w1;
        }
    }
}
DEVI void phase_hy3(const P& p, int l, float* sm) {
    unsigned char* scr = p.ws + OFF_SCR;
    const bf16_t* U = (const bf16_t*)(scr + SD_U);
    bf16_t* G = (bf16_t*)(p.ws + OFF_YS + 3 * SZ512);
    const float* cw = p.conv_w + (size_t)l * 3 * 1536; const float* cb = p.conv_b + l * 1536;
    const int tid = ltid();
    const int ntask = 4096 + (l == 0 ? 64 : 0);
    for (int task = blockIdx.x; task < ntask; task += gridDim.x) {
        int b, t0, ch0, seq0, Lseq; float* zt;
        hy_task_geom(task, b, t0, ch0, seq0, Lseq, zt, scr);
        __syncthreads();
        {
            const int ch = tid >> 3, t8 = (tid & 7) * 8;
            const float* src = zt + (size_t)(ch0 + ch) * Lseq + t0 + t8;
            const float4 w0 = *(const float4*)src, w1 = *(const float4*)(src + 4);
            float* d = sm + ch * 65 + t8;
            d[0] = w0.x; d[1] = w0.y; d[2] = w0.z; d[3] = w0.w; d[4] = w1.x; d[5] = w1.y; d[6] = w1.z; d[7] = w1.w;
        }
        __syncthreads();
        {
            const int tt = tid >> 3, cg = (tid & 7) * 8;
            float a0[8];
            conv8(U, cw, cb, seq0, Lseq, t0 + tt, ch0 + cg, a0);
            bf16_t* gp = G + (size_t)(seq0 + t0 + tt) * 512 + ch0 + cg;
            U8 gv; gv.u = *(const uint4*)gp;
            float o[8];
#pragma unroll
            for (int j = 0; j < 8; ++j) { const float gg = (j & 1) ? hi_bf(gv.w[j >> 1]) : lo_bf(gv.w[j >> 1]); o[j] = a0[j] * sm[(cg + j) * 65 + tt] * gg; }
            uint4 w; w.x = pk2(o[0], o[1]); w.y = pk2(o[2], o[3]); w.z = pk2(o[4], o[5]); w.w = pk2(o[6], o[7]);
            if (!p.dry) *(uint4*)gp = w;
        }
    }
}


constexpr int HYF_MT = 64;
DEVI void phase_hyf(const P& p, int l, float* sm) {
    const int tid = ltid();
    const float* HT = (const float*)(p.ws + OFF_HH3T) + (size_t)l * 64 * T;
    const float* wout = p.fwout + (size_t)l * 64 * 1024;
    bf16_t* K2 = (bf16_t*)(p.ws + OFF_K2);
    float* L1P = (float*)(p.ws + OFF_L1P);
    float* hs = sm;
    for (int task = blockIdx.x; task < T / HYF_MT; task += gridDim.x) {
        const int m0 = task * HYF_MT;
        __syncthreads();
        for (int e = tid; e < 64 * HYF_MT / 4; e += NTHR) { const int j = e / (HYF_MT / 4), c4 = (e % (HYF_MT / 4)) * 4; *(float4*)(hs + j * HYF_MT + c4) = *(const float4*)(HT + (size_t)j * T + m0 + c4); }
        __syncthreads();
        {
            const int ch = tid;
            const float delta = hy_delta(ch);
            float l1f = 0.f, l1b = 0.f;
#pragma unroll 1
            for (int mb = 0; mb < HYF_MT; mb += 16) {
                float af[16], ab[16];
#pragma unroll
                for (int u = 0; u < 16; ++u) { af[u] = 0.f; ab[u] = 0.f; }
#pragma unroll 2
                for (int j = 0; j < 64; ++j) {
                    const float wf = wout[j * 1024 + ch], wb = wout[j * 1024 + 512 + ch];
#pragma unroll
                    for (int u4 = 0; u4 < 4; ++u4) {
                        const float4 h = *(const float4*)(hs + j * HYF_MT + mb + u4 * 4);
                        af[u4 * 4 + 0] += h.x * wf; af[u4 * 4 + 1] += h.y * wf; af[u4 * 4 + 2] += h.z * wf; af[u4 * 4 + 3] += h.w * wf;
                        ab[u4 * 4 + 0] += h.x * wb; ab[u4 * 4 + 1] += h.y * wb; ab[u4 * 4 + 2] += h.z * wb; ab[u4 * 4 + 3] += h.w * wb;
                    }
                }
#pragma unroll
                for (int u = 0; u < 16; ++u) {
                    const int m = m0 + mb + u;
                    const float dec = __expf(-((float)m * (1.0f / (float)(T - 1))) * delta);
                    af[u] *= dec; ab[u] *= dec;
                    l1f += fabsf(af[u]); l1b += (m == 0) ? 0.f : fabsf(ab[u]);
                }
                uint4 o;
                o.x = pk2(af[0], af[1]); o.y = pk2(af[2], af[3]); o.z = pk2(af[4], af[5]); o.w = pk2(af[6], af[7]);
                *(uint4*)(K2 + (size_t)ch * T + m0 + mb) = o;
                o.x = pk2(af[8], af[9]); o.y = pk2(af[10], af[11]); o.z = pk2(af[12], af[13]); o.w = pk2(af[14], af[15]);
                *(uint4*)(K2 + (size_t)ch * T + m0 + mb + 8) = o;
                o.x = pk2(ab[0], ab[1]); o.y = pk2(ab[2], ab[3]); o.z = pk2(ab[4], ab[5]); o.w = pk2(ab[6], ab[7]);
                *(uint4*)(K2 + (size_t)(512 + ch) * T + m0 + mb) = o;
                o.x = pk2(ab[8], ab[9]); o.y = pk2(ab[10], ab[11]); o.z = pk2(ab[12], ab[13]); o.w = pk2(ab[14], ab[15]);
                *(uint4*)(K2 + (size_t)(512 + ch) * T + m0 + mb + 8) = o;
            }
            L1P[(size_t)task * 1024 + ch] = l1f;
            L1P[(size_t)task * 1024 + 512 + ch] = l1b;
        }
    }
}
DEVI void phase_hy2(const P& p, int l, unsigned char* smem) {
    unsigned char* scr = p.ws + OFF_SCR;
    const int tid = ltid();
    float* Ff = (float*)smem; float2* F2 = (float2*)smem;
    float* red = (float*)(smem + (size_t)LFP * 8);
    float* spec = red + 16;
    const float* HT = (const float*)(p.ws + OFF_HH3T) + (size_t)l * 64 * T;
    const float* HC = (const float*)(p.ws + OFF_HH3C);
    const float* wout = p.fwout + (size_t)l * 64 * 1024;
    const int ntask = 512 + (l == 0 ? 512 : 0);
    for (int task = blockIdx.x; task < ntask; task += gridDim.x) {
        __syncthreads();
        if (task < 512) {
            const int ch = task;
            const float delta = hy_delta(ch);
            float l1 = 0.f;
            {
                const bf16_t* K2 = (const bf16_t*)(p.ws + OFF_K2);
                const float* L1P = (const float*)(p.ws + OFF_L1P);
                if (tid < 2 * (T / HYF_MT)) { const int side = tid / (T / HYF_MT), tk = tid % (T / HYF_MT); l1 = L1P[(size_t)tk * 1024 + side * 512 + ch]; }
#pragma unroll
                for (int i = 0; i < 4; ++i) {
                    const int m = (tid + NTHR * i) * 8;
                    U8 hf, hb; hf.u = *(const uint4*)(K2 + (size_t)ch * T + m); hb.u = *(const uint4*)(K2 + (size_t)(512 + ch) * T + m);
#pragma unroll
                    for (int u = 0; u < 8; ++u) {
                        const float af = (u & 1) ? hi_bf(hf.w[u >> 1]) : lo_bf(hf.w[u >> 1]);
                        const float ab = (u & 1) ? hi_bf(hb.w[u >> 1]) : lo_bf(hb.w[u >> 1]);
                        const int mm = m + u;
                        Ff[FIDX(mm)] = af;
                        if (mm >= 1) Ff[FIDX(2 * T - mm)] = ab; else Ff[FIDX(T)] = 0.f;
                    }
                }
            }
            l1 = block_sum(l1, red);
            __syncthreads();
            fft_fwd(F2);
            const float scale = 1.0f / ((float)LF * l1);
            float4* KF = (float4*)(p.ws + OFF_KF) + (size_t)blockIdx.x * 8192;
#pragma unroll 2
            for (int i = 0; i < 16; ++i) {
                const int k = tid + NTHR * i;
                const float2 ck = F2[CIDX(rev14(k))], cm = F2[CIDX(rev14((LF - k) & (LF - 1)))];
                KF[k] = make_float4((ck.x + cm.x) * 0.5f * scale, (ck.y - cm.y) * 0.5f * scale, (ck.y + cm.y) * 0.5f * scale, -(ck.x - cm.x) * 0.5f * scale);
            }
            if (tid == 0) { const float2 c = F2[CIDX(1)]; spec[0] = c.x * scale; spec[1] = c.y * scale; }
            const float fb = p.fbias[l * 512 + ch];
#pragma unroll 1
            for (int b = 0; b < NB; ++b) {
                float* zt = (float*)(scr + SD_ZT) + ((size_t)b * 512 + ch) * T;
                __syncthreads();
#pragma unroll
                for (int i = 0; i < 8; ++i) {
                    const int e = (tid + NTHR * i) * 4;
                    const float4 zv = *(const float4*)(zt + e);
                    const int c0 = CIDX(e >> 1), c1 = CIDX((T + e) >> 1);
                    F2[c0] = make_float2(zv.x, zv.y); F2[c0 + 1] = make_float2(zv.z, zv.w);
                    F2[c1] = make_float2(0.f, 0.f); F2[c1 + 1] = make_float2(0.f, 0.f);
                }
                __syncthreads();
                fft_fwd(F2);
#pragma unroll 2
                for (int i = 0; i < 16; ++i) {
                    const int k = tid + NTHR * i;
                    const int pk = CIDX(rev14(k)), pm = CIDX(rev14((LF - k) & (LF - 1)));
                    const float2 ck = F2[pk], cm = F2[pm];
                    const float4 kf = KF[k];
                    const float2 He = make_float2(kf.x, kf.y), Ho = make_float2(kf.z, kf.w);
                    const float2 E = make_float2((ck.x + cm.x) * 0.5f, (ck.y - cm.y) * 0.5f);
                    const float2 O = make_float2((ck.y + cm.y) * 0.5f, -(ck.x - cm.x) * 0.5f);
                    float2 w2 = twid((float)k * (1.0f / (float)LF)); w2.y = -w2.y;
                    const float2 Ye = cadd(cmul(E, He), cmul(w2, cmul(O, Ho)));
                    const float2 Yo = cadd(cmul(E, Ho), cmul(O, He));
                    F2[pk] = make_float2(Ye.x - Yo.y, Ye.y + Yo.x);
                    F2[pm] = make_float2(Ye.x + Yo.y, -Ye.y + Yo.x);
                }
                if (tid == 0) {
                    const float2 c = F2[CIDX(1)]; const float he = spec[0], ho = spec[1];
                    F2[CIDX(1)] = make_float2(c.x * he - c.y * ho, c.x * ho + c.y * he);
                }
                __syncthreads();
                fft_inv(F2);
#pragma unroll
                for (int i = 0; i < 8; ++i) {
                    const int e = (tid + NTHR * i) * 4;
                    const float4 zv = *(const float4*)(zt + e);
                    const int c0 = CIDX(e >> 1);
                    const float2 y0 = F2[c0], y1 = F2[c0 + 1];
                    const float4 yv = make_float4(y0.x, y0.y, y1.x, y1.y);
                    if (!p.dry) *(float4*)(zt + e) = make_float4(yv.x + zv.x * fb, yv.y + zv.y * fb, yv.z + zv.z * fb, yv.w + zv.w * fb);
                }
            }
        } else {
            const int ch = task - 512;
            const float delta = hy_delta(ch);
            float* hf = Ff; float* hb = Ff + 256; float* zs = Ff + 512;
            {
                const int m = tid & 255, side = tid >> 8;
                float a = 0.f;
#pragma unroll 4
                for (int j = 0; j < 64; ++j) a += HC[j * CL + m] * wout[j * 1024 + side * 512 + ch];
                a *= expf(-((float)m / (float)(CL - 1)) * delta);
                Ff[side * 256 + m] = a;
                float l1 = (side == 1 && m == 0) ? 0.f : fabsf(a);
                zs[tid] = ((const float*)(scr + SD_ZTC))[((size_t)(tid >> 8) * 512 + ch) * CL + (tid & 255)];
                l1 = block_sum(l1, red);
                const int b = tid >> 8, t = tid & 255;
                float y = 0.f;
#pragma unroll 4
                for (int s = 0; s <= t; ++s) y += zs[b * 256 + s] * hf[t - s];
#pragma unroll 4
                for (int s = t + 1; s < CL; ++s) y += zs[b * 256 + s] * hb[s - t];
                const float fb = p.fbias[l * 512 + ch];
                if (!p.dry) ((float*)(scr + SD_ZTC))[((size_t)b * 512 + ch) * CL + t] = y / l1 + zs[tid] * fb;
            }
        }
    }
}

constexpr int NPH = 32;
#ifndef ONLY
#define ONLY -1
#endif
#define CASE(n) case n: if (ONLY < 0 || ONLY == n)
DEVI void run_phase(const P& p, int ph, unsigned char* smem) {
    if (ph == 0) { if (ONLY < 0 || ONLY == 100) phase_prep(p, (float*)smem); return; }
    if (ph == NPH - 1) { if (ONLY < 0 || ONLY == 101) phase_final(p); return; }
    const int l = (ph - 1) / 15, k = (ph - 1) % 15;
    switch (k) {
        CASE(0) phase_hl(p, l); break;
        CASE(1) phase_inproj<0>(p, l, (bf16_t*)smem); break;
        CASE(2) phase_att_a(p, l, (float*)smem); break;
        CASE(3) phase_inproj<1>(p, l, (bf16_t*)smem); break;
        CASE(4) phase_att_b(p, l); break;
        CASE(5) phase_inproj<2>(p, l, (bf16_t*)smem); break;
        CASE(6) phase_gla1(p, l, smem); break;
        CASE(7) phase_gla2(p); break;
        CASE(8) phase_gla3(p, l, smem); break;
        CASE(9) phase_inproj<3>(p, l, (bf16_t*)smem); break;
        CASE(10) { phase_hyf(p, l, (float*)smem); phase_hy1(p, l, (float*)smem); } break;
        CASE(11) phase_hy2(p, l, smem); break;
        CASE(12) phase_hy3(p, l, (float*)smem); break;
        CASE(13) phase_merge(p, l, (bf16_t*)smem); break;
        CASE(14) phase_out(p, l, (bf16_t*)smem); break;
    }
}

#define XB_TMO      128
#define XB_XCNT(j)  (256  + 64 * (j))
#define XB_XSUB(j)  (1280 + 64 * (j))
#define XB_XGEN(j)  (2304 + 64 * (j))
#define XB_TOP      3328
#define XB_TOPGEN   3392
#define XCD_BAR_WORDS 3456
#define XB_SPIN_CAP (1u << 18)
#define LAS __attribute__((address_space(3)))
DEVI unsigned xb_ld(unsigned* p)              { return __hip_atomic_load(p, __ATOMIC_RELAXED, __HIP_MEMORY_SCOPE_AGENT); }
DEVI unsigned xb_add(unsigned* p, unsigned v) { return __hip_atomic_fetch_add(p, v, __ATOMIC_RELAXED, __HIP_MEMORY_SCOPE_AGENT); }
DEVI unsigned xb_xcc_id() { return (unsigned)__builtin_amdgcn_s_getreg((3 << 11) | 20) & 0xFu; }
#define XB_SPIN(cond, bar) do { unsigned _sp = 0; while (cond) { __builtin_amdgcn_s_sleep(1); \
    if ((++_sp & 255u) == 0u) { if (xb_ld(&(bar)[XB_TMO])) break; if (_sp > XB_SPIN_CAP) { atomicAdd(&(bar)[XB_TMO], 1u); break; } } } } while (0)
struct XcdBarrier { unsigned* bar; unsigned x; volatile LAS unsigned* st; };
DEVI XcdBarrier xcd_barrier_post(unsigned* bar, volatile LAS unsigned* st) {
    XcdBarrier b; b.bar = bar; b.x = xb_xcc_id(); b.st = st;
    if (threadIdx.x == 0) (void)xb_add(&bar[XB_XCNT(b.x)], 1u);
    return b;
}
DEVI void xcd_barrier_complete(unsigned* bar, unsigned x, unsigned& nloc, unsigned& nx) {
    const unsigned G = gridDim.x * gridDim.y * gridDim.z;
    unsigned sum, cnt, mine, sp = 0u;
    for (;;) {
        sum = 0u; cnt = 0u; mine = 0u;
#pragma unroll
        for (unsigned j = 0; j < 16; ++j) { const unsigned c = xb_ld(&bar[XB_XCNT(j)]); sum += c; cnt += (c > 0u) ? 1u : 0u; mine = (j == x) ? c : mine; }
        if (sum == G) break;
        __builtin_amdgcn_s_sleep(1);
        if ((++sp & 255u) == 0u) { if (xb_ld(&bar[XB_TMO])) break; if (sp > XB_SPIN_CAP) { atomicAdd(&bar[XB_TMO], 1u); break; } }
    }
    nloc = mine > 0u ? mine : 1u; nx = cnt > 0u ? cnt : 1u;
}
DEVI void xcd_barrier(const XcdBarrier& b) {
    asm volatile("s_waitcnt vmcnt(0)" ::: "memory");
    __syncthreads();
    if (threadIdx.x == 0) {
        unsigned* bar = b.bar;
        __builtin_amdgcn_s_waitcnt(0);
        unsigned nloc = b.st[0], nx = b.st[1];
        if (nloc == 0u) { xcd_barrier_complete(bar, b.x, nloc, nx); b.st[0] = nloc; b.st[1] = nx; }
        const unsigned old = xb_add(&bar[XB_XSUB(b.x)], 1u);
        const unsigned gen = old / nloc;
        if (old + 1u == (gen + 1u) * nloc) {
            __builtin_amdgcn_fence(__ATOMIC_RELEASE, "agent");
            asm volatile("s_waitcnt vmcnt(0)" ::: "memory");
            const unsigned og = xb_add(&bar[XB_TOP], 1u);
            const unsigned tg = og / nx;
            if (og + 1u == (tg + 1u) * nx) xb_add(&bar[XB_TOPGEN], 1u);
            else XB_SPIN(xb_ld(&bar[XB_TOPGEN]) == tg, bar);
            __builtin_amdgcn_fence(__ATOMIC_ACQUIRE, "agent");
            xb_add(&bar[XB_XGEN(b.x)], 1u);
            asm volatile("s_waitcnt vmcnt(0)" ::: "memory");
        } else {
            XB_SPIN(xb_ld(&bar[XB_XGEN(b.x)]) == gen, bar);
            __builtin_amdgcn_fence(__ATOMIC_ACQUIRE, "agent");
            asm volatile("s_waitcnt vmcnt(0)" ::: "memory");
        }
    }
    __syncthreads();
}
constexpr size_t OFF_BAR = WS_END + 1024;
constexpr size_t WS_TOTAL = OFF_BAR + XCD_BAR_WORDS * 4;

__global__ void __launch_bounds__(NTHR) mega(P p) {
    extern __shared__ __attribute__((aligned(16))) unsigned char smem[];
    cg::grid_group grid = cg::this_grid();
#ifndef DBL_MASK
#define DBL_MASK 0
#endif
#ifdef TIMING_A
    unsigned long long* ts = (unsigned long long*)(p.ws + WS_END);
    if (blockIdx.x == 0 && threadIdx.x == 0) ts[0] = __builtin_amdgcn_s_memrealtime();
#endif
    volatile LAS unsigned* xst = (volatile LAS unsigned*)(smem + LDS_BYTES - 16);
    if (threadIdx.x == 0) { xst[0] = 0u; xst[1] = 0u; }
    __syncthreads();
    XcdBarrier xb = xcd_barrier_post((unsigned*)(p.ws + OFF_BAR), xst);
#define GRID_SYNC(ph_) do { if ((ph_) == 0) grid.sync(); else xcd_barrier(xb); } while (0)
    for (int ph = p.ph_lo; ph < p.ph_hi; ++ph) {
        if (DBL_MASK != 0 && ph > 0 && ph < NPH - 1 && ((DBL_MASK >> ((ph - 1) % 15)) & 1)) { P pd = p; int one_ = 1; asm volatile("" : "+s"(one_)); pd.dry = one_; run_phase(pd, ph, smem); GRID_SYNC(1); }
        run_phase(p, ph, smem);
#ifdef TIMING_A
        GRID_SYNC(ph);
        if (blockIdx.x == 0 && threadIdx.x == 0) ts[ph + 1] = __builtin_amdgcn_s_memrealtime();
#else
        if (ph + 1 < p.ph_hi) GRID_SYNC(ph);
#endif
    }
}

#ifdef DIAG_OFF
__global__ void diag_dump(const unsigned char* src, float* out, size_t n) {
    for (size_t i = (size_t)blockIdx.x * blockDim.x + threadIdx.x; i < n; i += (size_t)gridDim.x * blockDim.x) {
#if DIAG_F32
        out[i] = ((const float*)src)[i % (size_t)(DIAG_N)];
#else
        { float v = bf2f(((const bf16_t*)src)[i % (size_t)(DIAG_N)]);
#ifdef EXP_FIN
          if (!(fabsf(v) < 1e30f)) v = 12345.f;
#endif
          out[i] = v; }
#endif
    }
}
#endif
#ifdef TIMING_A
__global__ void timing_tail(const unsigned long long* ts, float* out) {
    float grp[8] = {0, 0, 0, 0, 0, 0, 0, 0};
    const float total = (float)(ts[NPH] - ts[0]);
    for (int ph = 0; ph < NPH; ++ph) {
        const float dt = (float)(ts[ph + 1] - ts[ph]);
        int gi;
        if (ph == 0) gi = 5; else if (ph == NPH - 1) gi = 6;
        else { const int k = (ph - 1) % 15; gi = (k == 1 || k == 3 || k == 5 || k == 9) ? 0 : (k == 13) ? 1 : (k == 2 || k == 4) ? 2 : (k >= 6 && k <= 8) ? 3 : (k >= 10 && k <= 12) ? 4 : (k == 14) ? 7 : 6; }
#pragma unroll
        for (int q = 0; q < 8; ++q) grp[q] += (gi == q) ? dt : 0.f;
    }
    float fa = 0.f, fb = 0.f;
#pragma unroll
    for (int q = 0; q < 8; ++q) { fa += (q == TIMING_A) ? grp[q] : 0.f; fb += (q == TIMING_B) ? grp[q] : 0.f; }
    const float e1 = 1000.f * fa / total, e2 = 50.f * fb / total;
    if (blockIdx.x == 0 && threadIdx.x == 0) out[0] += e1;
    for (size_t i = (size_t)blockIdx.x * blockDim.x + threadIdx.x; i < (size_t)1048576; i += (size_t)gridDim.x * blockDim.x) out[D + i] += e2;
}
#endif
extern "C" void kernel_launch(void* const* d_in, const int* in_sizes, int n_in, void* d_out, int out_size, void* d_ws, size_t ws_size, hipStream_t stream) {
    static int grid = 0;
    if (grid == 0) {
        if (n_in != 27 || ws_size < WS_TOTAL) { fprintf(stderr, "kernel_launch: unexpected n_in %d or ws_size %zu (need %zu)\n", n_in, ws_size, (size_t)WS_TOTAL); grid = -1; return; }
        int dev = 0, cus = 0, per_cu = 0;
        hipGetDevice(&dev);
        hipDeviceGetAttribute(&cus, hipDeviceAttributeMultiprocessorCount, dev);
        if (hipFuncSetAttribute((const void*)mega, hipFuncAttributeMaxDynamicSharedMemorySize, LDS_BYTES) != hipSuccess) { fprintf(stderr, "kernel_launch: hipFuncSetAttribute failed\n"); grid = -1; return; }
        if (hipOccupancyMaxActiveBlocksPerMultiprocessor(&per_cu, (const void*)mega, NTHR, LDS_BYTES) != hipSuccess || per_cu < 1) { fprintf(stderr, "kernel_launch: occupancy query failed (%d)\n", per_cu); grid = -1; return; }
        grid = cus * per_cu; if (grid > MAXGRID) grid = MAXGRID;
        fprintf(stderr, "kernel_launch: grid %d (cus %d x %d)\n", grid, cus, per_cu);
    }
    if (grid < 0) return;
    P p{};
    const float** pp = (const float**)&p;
    for (int i = 0; i < 27; ++i) pp[i] = (const float*)d_in[i];
    p.out = (float*)d_out; p.ws = (unsigned char*)d_ws; p.dry = 0; p.pad_ = 0;
#if N_LAUNCH_MODE == 1
    p.ph_lo = 0; p.ph_hi = NPH;
    if (hipMemsetAsync((unsigned char*)d_ws + OFF_BAR, 0, XCD_BAR_WORDS * 4, stream) != hipSuccess) { fprintf(stderr, "kernel_launch: memset of barrier words failed\n"); return; }
    void* args[] = {&p};
    hipError_t e = hipLaunchCooperativeKernel((const void*)mega, dim3(grid), dim3(NTHR), args, LDS_BYTES, stream);
    if (e != hipSuccess) fprintf(stderr, "cooperative launch failed: %s (grid %d)\n", hipGetErrorString(e), grid);
#ifdef TIMING_A
    hipLaunchKernelGGL(timing_tail, dim3(256), dim3(256), 0, stream, (const unsigned long long*)((unsigned char*)d_ws + WS_END), (float*)d_out);
#endif
#else
#ifndef DIAG_STOP
#define DIAG_STOP NPH
#endif
    for (int ph = 0; ph < DIAG_STOP; ++ph) {
        p.ph_lo = ph; p.ph_hi = ph + 1;
        hipLaunchKernelGGL(mega, dim3(grid), dim3(NTHR), LDS_BYTES, stream, p);
    }
#ifdef DIAG_OFF
    hipLaunchKernelGGL(diag_dump, dim3(1024), dim3(256), 0, stream, (const unsigned char*)d_ws + (size_t)(DIAG_OFF), (float*)d_out, (size_t)out_size);
#endif
#endif
}
```

```cpp
#include <hip/hip_runtime.h>
#include <hip/hip_cooperative_groups.h>
#include <cstdio>
#include <cstdint>
namespace cg = cooperative_groups;

#ifndef N_LAUNCH_MODE
#define N_LAUNCH_MODE 1
#endif

#define DEVI __device__ __forceinline__
typedef unsigned short bf16_t;
typedef short bf16x8 __attribute__((ext_vector_type(8)));
typedef float f32x4 __attribute__((ext_vector_type(4)));
typedef float f32x16 __attribute__((ext_vector_type(16)));

constexpr int D = 1024, T = 16384, NB = 2, NL = NB * T, CL = 256, NC = NB * CL, NR = NL + NC;
constexpr int IN_TOTAL = 11040;
constexpr int COL_A = 0, COL_B = 2048, COL_C = 3328, COL_D = 4896, COL_GM = 6944;
constexpr float EPS = 1e-6f;
constexpr int NTHR = 512;
constexpr int LDS_BYTES = 140 * 1024;

constexpr size_t al256(size_t x) { return (x + 255) & ~(size_t)255; }
constexpr size_t OFF_MOD = 0;
constexpr size_t OFF_ROPE = al256(OFF_MOD + (size_t)2 * 3 * 3072 * 4);
constexpr size_t OFF_HH3T = al256(OFF_ROPE + (size_t)2 * T * 32 * 4);
constexpr size_t OFF_HH3C = al256(OFF_HH3T + (size_t)2 * 64 * T * 4);
constexpr size_t OFF_XC1 = al256(OFF_HH3C + (size_t)64 * CL * 4);
constexpr size_t OFF_WINT = al256(OFF_XC1 + (size_t)NC * D * 4);
constexpr size_t OFF_WBT = al256(OFF_WINT + (size_t)2 * IN_TOTAL * D * 2);
constexpr size_t OFF_WOT = al256(OFF_WBT + (size_t)2 * 4 * D * 512 * 2);
constexpr size_t OFF_HL = al256(OFF_WOT + (size_t)2 * D * D * 2);
constexpr size_t OFF_YS = al256(OFF_HL + (size_t)NR * D * 2);
constexpr size_t SZ512 = (size_t)NR * 512 * 2, SZ256 = (size_t)NR * 256 * 2, SZ128 = (size_t)NR * 128 * 2;
constexpr size_t OFF_SCR = al256(OFF_YS + 4 * SZ512);
constexpr size_t SA_Q = 0, SA_K = SZ512, SA_VT = 2 * SZ512;
constexpr size_t SB_Q = 0, SB_K = SZ512, SB_VT = SZ512 + SZ128;
constexpr size_t SC_Q = 0, SC_K = SZ256, SC_VT = 2 * SZ256, SC_LR = 2 * SZ256 + SZ512;
constexpr size_t SC_SB = al256(SC_LR + (size_t)NR * 32 * 4);
constexpr int NCH = 260;
constexpr size_t SC_GD = al256(SC_SB + (size_t)16 * NCH * 8192 * 2);
constexpr size_t SD_U = 0, SD_ZT = al256((size_t)NR * 1536 * 2), SD_ZTC = al256(SD_ZT + (size_t)NB * 512 * T * 4);
constexpr size_t SD_END = al256(SD_ZTC + (size_t)NB * 512 * CL * 4);
constexpr size_t OFF_KF = OFF_SCR + SD_END;
constexpr int MAXGRID = 256;
constexpr size_t OFF_K2 = al256(OFF_KF + (size_t)MAXGRID * 8192 * 16);
constexpr size_t OFF_L1P = al256(OFF_K2 + (size_t)1024 * T * 2);
constexpr size_t WS_END = al256(OFF_L1P + (size_t)(T / 64) * 1024 * 4);

struct P {
    const float *x, *c, *ctx, *c_ctx, *norm_w, *w_mod, *b_mod, *w_in, *rpb, *sink, *w_alpha_up, *b_alpha, *gla_norm_w,
        *conv_w, *conv_b, *fw1, *fb1, *fw2, *fb2, *fw3, *fb3, *ffreq, *fwout, *fbias, *w_branch, *w_out, *final_norm_w;
    float* out;
    unsigned char* ws;
    int ph_lo, ph_hi;
    int dry, pad_;
};

DEVI int ltid() { int t = threadIdx.x; asm volatile("" : "+v"(t)); return t; }
DEVI float bf2f(bf16_t v) { return __uint_as_float(((unsigned)v) << 16); }
typedef __bf16 bf16v2 __attribute__((ext_vector_type(2)));
typedef float f32v2 __attribute__((ext_vector_type(2)));
DEVI unsigned pk2(float lo, float hi) { f32v2 v = {lo, hi}; bf16v2 b = __builtin_convertvector(v, bf16v2); return __builtin_bit_cast(unsigned, b); }
DEVI bf16_t f2bf(float f) { return (bf16_t)(pk2(f, 0.f) & 0xffff); }
DEVI float lo_bf(unsigned u) { return __uint_as_float(u << 16); }
DEVI float hi_bf(unsigned u) { return __uint_as_float(u & 0xffff0000u); }
DEVI float siluf(float v) { return v * __builtin_amdgcn_rcpf(1.f + __expf(-v)); }
DEVI float sigmf(float v) { return __builtin_amdgcn_rcpf(1.f + __expf(-v)); }
DEVI void row_decode(int row, int& b, int& t, bool& isctx) {
    if (row < NL) { b = row >> 14; t = row & (T - 1); isctx = false; }
    else { int r = row - NL; b = r >> 8; t = r & (CL - 1); isctx = true; }
}
DEVI float wave_sum(float v) {
#pragma unroll
    for (int o = 32; o >= 1; o >>= 1) v += __shfl_xor(v, o);
    return v;
}
DEVI float block_sum(float v, float* red  ) {
    v = wave_sum(v);
    __syncthreads();
    if ((ltid() & 63) == 0) red[ltid() >> 6] = v;
    __syncthreads();
    float s = 0.f;
#pragma unroll
    for (int i = 0; i < NTHR / 64; ++i) s += red[i];
    return s;
}

constexpr int LSTR = 72;
constexpr int GA_EL = 256 * LSTR, GB_EL = 128 * LSTR;
template <int NT> struct GAcc { f32x16 a[2][NT]; };

template <int NT, int DEPTH = 1>
DEVI void gemm_kloop(const bf16_t* __restrict__ A, int lda, const bf16_t* __restrict__ Bt, int ldb, int K, int m0, int n0,
                     bf16_t* sm, GAcc<NT>& acc) {
    const int tid = ltid(), lane = tid & 63, wave = tid >> 6, wm = wave >> 1, wn = wave & 1;
    const int lr = tid >> 3, lc = tid & 7;
    const char* Ab = (const char*)(A + (size_t)m0 * lda); const char* Bb = (const char*)(Bt + (size_t)n0 * ldb);
    const unsigned aoff = (unsigned)(lr * lda + lc * 8) * 2u, boff = (unsigned)(lr * ldb + lc * 8) * 2u;
    uint4 xa0, xa1, xa2, xa3, xb0, xb1 = {0, 0, 0, 0};
    uint4 ya0, ya1, ya2, ya3, yb0, yb1 = {0, 0, 0, 0};
    const int KT = K / 64;
    const int frow = lane & 31, fk = (lane >> 5) * 8;
    const unsigned sa64 = 128u * (unsigned)lda, sb64 = 128u * (unsigned)ldb;
#define GLOAD(P, KTI) { const unsigned ko_ = (unsigned)(KTI) * 128u; P##a0 = *(const uint4*)(Ab + (aoff + ko_)); P##a1 = *(const uint4*)(Ab + (aoff + sa64 + ko_)); P##a2 = *(const uint4*)(Ab + (aoff + 2 * sa64 + ko_)); \
                        P##a3 = *(const uint4*)(Ab + (aoff + 3 * sa64 + ko_)); P##b0 = *(const uint4*)(Bb + (boff + ko_)); if constexpr (NT > 1) P##b1 = *(const uint4*)(Bb + (boff + sb64 + ko_)); }
#define LWRITE(P, BUF) { bf16_t* wa_ = sm + (BUF) * (GA_EL + GB_EL) + lr * LSTR + lc * 8; bf16_t* wb_ = wa_ + GA_EL; \
                        *(uint4*)(wa_) = P##a0; *(uint4*)(wa_ + 64 * LSTR) = P##a1; *(uint4*)(wa_ + 128 * LSTR) = P##a2; *(uint4*)(wa_ + 192 * LSTR) = P##a3; \
                        *(uint4*)(wb_) = P##b0; if constexpr (NT > 1) *(uint4*)(wb_ + 64 * LSTR) = P##b1; }
    auto compute = [&](int buf) {
        const bf16_t* sa = sm + buf * (GA_EL + GB_EL) + (wm * 64 + frow) * LSTR + fk;
        const bf16_t* sb = sm + buf * (GA_EL + GB_EL) + GA_EL + (wn * 32 * NT + frow) * LSTR + fk;
#pragma unroll
        for (int ks = 0; ks < 4; ++ks) {
            bf16x8 tf[2], cf[NT];
#pragma unroll
            for (int mt = 0; mt < 2; ++mt) tf[mt] = *(const bf16x8*)(sa + mt * 32 * LSTR + ks * 16);
#pragma unroll
            for (int nt = 0; nt < NT; ++nt) cf[nt] = *(const bf16x8*)(sb + nt * 32 * LSTR + ks * 16);
#pragma unroll
            for (int mt = 0; mt < 2; ++mt)
#pragma unroll
                for (int nt = 0; nt < NT; ++nt)
                    acc.a[mt][nt] = __builtin_amdgcn_mfma_f32_32x32x16_bf16(cf[nt], tf[mt], acc.a[mt][nt], 0, 0, 0);
        }
    };
    __syncthreads();
    if constexpr (DEPTH == 1) {
        GLOAD(x, 0); LWRITE(x, 0); GLOAD(x, 1);
        __syncthreads();
        for (int kt = 0; kt < KT; ++kt) {
            if (kt + 1 < KT) LWRITE(x, (kt + 1) & 1);
            if (kt + 2 < KT) GLOAD(x, kt + 2);
            __builtin_amdgcn_sched_barrier(0);
            compute(kt & 1);
            __syncthreads();
        }
    } else {
        GLOAD(x, 0); LWRITE(x, 0); GLOAD(x, 1); GLOAD(y, 2);
        __syncthreads();
        for (int kt = 0; kt < KT; kt += 2) {
            LWRITE(x, 1);
            if (kt + 3 < KT) GLOAD(x, kt + 3);
            compute(0);
            __syncthreads();
            if (kt + 2 < KT) LWRITE(y, 0);
            if (kt + 4 < KT) GLOAD(y, kt + 4);
            compute(1);
            __syncthreads();
        }
    }
#undef GLOAD
#undef LWRITE
}
DEVI int tile_of(int it) {
    const int per = gridDim.x >> 3;
    if ((gridDim.x & 7) != 0 || per == 0) return it * gridDim.x + blockIdx.x;
    return it * gridDim.x + (blockIdx.x & 7) * per + (blockIdx.x >> 3);
}
template <int NT> DEVI void acc_zero(GAcc<NT>& acc) {
#pragma unroll
    for (int mt = 0; mt < 2; ++mt)
#pragma unroll
        for (int nt = 0; nt < NT; ++nt)
#pragma unroll
            for (int i = 0; i < 16; ++i) acc.a[mt][nt][i] = 0.f;
}
template <int NT, class F> DEVI void acc_foreach(const GAcc<NT>& acc, int m0, int n0, F f) {
    const int lane = ltid() & 63, wave = ltid() >> 6, wm = wave >> 1, wn = wave & 1;
#pragma unroll
    for (int mt = 0; mt < 2; ++mt) {
        const int row = m0 + wm * 64 + mt * 32 + (lane & 31);
#pragma unroll
        for (int nt = 0; nt < NT; ++nt)
#pragma unroll
            for (int q = 0; q < 4; ++q) {
                const int col = n0 + wn * 32 * NT + nt * 32 + q * 8 + (lane >> 5) * 4;
                f(row, col, acc.a[mt][nt][q * 4 + 0], acc.a[mt][nt][q * 4 + 1], acc.a[mt][nt][q * 4 + 2], acc.a[mt][nt][q * 4 + 3]);
            }
    }
}
constexpr int EST = 68;
template <int NT> DEVI void epi_stage(const GAcc<NT>& acc, int mt, float* reg) {
    const int lane = ltid() & 63;
    __syncthreads();
#pragma unroll
    for (int nt = 0; nt < NT; ++nt)
#pragma unroll
        for (int q = 0; q < 4; ++q) {
            float4 w = {acc.a[mt][nt][q * 4 + 0], acc.a[mt][nt][q * 4 + 1], acc.a[mt][nt][q * 4 + 2], acc.a[mt][nt][q * 4 + 3]};
            *(float4*)(reg + (lane & 31) * EST + nt * 32 + q * 8 + (lane >> 5) * 4) = w;
        }
    __syncthreads();
}
template <int NT, class F> DEVI void epi_rows8(const float* reg, F f) {
    const int lane = ltid() & 63;
#pragma unroll
    for (int it = 0; it < 2 * NT; ++it) {
        const int idx = it * 64 + lane, rl = idx / (NT * 4), ch = idx % (NT * 4);
        const float4 a = *(const float4*)(reg + rl * EST + ch * 8), b = *(const float4*)(reg + rl * EST + ch * 8 + 4);
        f(rl, ch * 8, a, b);
    }
}
DEVI void st8bf(bf16_t* p, float4 a, float4 b) { uint4 w; w.x = pk2(a.x, a.y); w.y = pk2(a.z, a.w); w.z = pk2(b.x, b.y); w.w = pk2(b.z, b.w); *(uint4*)p = w; }
DEVI float4 silu4(float4 a) { return make_float4(siluf(a.x), siluf(a.y), siluf(a.z), siluf(a.w)); }
template <int H, int DH> DEVI void epi_vt(const float* reg, bf16_t* VT, int row0  , int colv0) {
    const int lane = ltid() & 63;
    int b, t; bool ic; row_decode(row0, b, t, ic);
    const int tp = lane & 15, cg = lane >> 4;
#pragma unroll 4
    for (int it = 0; it < 16; ++it) {
        const int c = it * 4 + cg, colv = colv0 + c, h = colv / DH, d = colv % DH;
        const float v0 = reg[(2 * tp) * EST + c], v1 = reg[(2 * tp + 1) * EST + c];
        bf16_t* pp = ic ? (VT + (size_t)NB * H * DH * T + ((size_t)(b * H + h) * DH + d) * CL + t + 2 * tp) : (VT + ((size_t)(b * H + h) * DH + d) * T + t + 2 * tp);
        *(unsigned*)pp = pk2(v0, v1);
    }
}
DEVI void st4bf(bf16_t* p, float a, float b, float c, float d) { uint2 w; w.x = pk2(a, b); w.y = pk2(c, d); *(uint2*)p = w; }
template <int H, int DH> DEVI void store_vt(bf16_t* VT, int row, int colv, float v0, float v1, float v2, float v3) {
    int b, t; bool ic; row_decode(row, b, t, ic);
    const int h = colv / DH, d = colv % DH;
    bf16_t* p = ic ? (VT + (size_t)NB * H * DH * T + ((size_t)(b * H + h) * DH + d) * CL + t) : (VT + ((size_t)(b * H + h) * DH + d) * T + t);
    const size_t st = ic ? CL : T;
    p[0] = f2bf(v0); p[st] = f2bf(v1); p[2 * st] = f2bf(v2); p[3 * st] = f2bf(v3);
}

template <int BR>
DEVI void phase_inproj(const P& p, int l, bf16_t* sm) {
    unsigned char* ws = p.ws;
    const bf16_t* HL = (const bf16_t*)(ws + OFF_HL);
    constexpr int colbase = BR == 0 ? COL_A : BR == 1 ? COL_B : BR == 2 ? COL_C : COL_D;
    constexpr int N = BR == 0 ? 2048 : BR == 1 ? 1280 : BR == 2 ? 1568 : 2048;
    const bf16_t* Wt = (const bf16_t*)(ws + OFF_WINT) + ((size_t)l * IN_TOTAL + colbase) * D;
    unsigned char* scr = ws + OFF_SCR;
    bf16_t* YSb = (bf16_t*)(ws + OFF_YS + BR * SZ512);
    const float* rope = (const float*)(ws + OFF_ROPE);
    constexpr int tilesN = (N + 127) / 128;
    const int tilesM = (BR == 3 && l == 1) ? NL / 256 : NR / 256;
    for (int it = 0;; ++it) {
        const int tile = tile_of(it);
        if (it * (int)gridDim.x >= tilesM * tilesN) break;
        if (tile >= tilesM * tilesN) continue;
        const int tm = tile / tilesN, tn = tile % tilesN;
        const int m0 = tm * 256, n0 = tn * 128;
        GAcc<2> acc; acc_zero(acc);
        gemm_kloop<2, 1>(HL, D, Wt, D, D, m0, n0, sm, acc);
        const int lane = ltid() & 63, wave = ltid() >> 6, wm = wave >> 1, wn = wave & 1;
        float* reg = (float*)sm + wave * (32 * EST);
        const int cb = n0 + wn * 64;
#pragma unroll
        for (int mt = 0; mt < 2; ++mt) {
            epi_stage<2>(acc, mt, reg);
            const int rbase = m0 + wm * 64 + mt * 32;
            if constexpr (BR == 0) {
                bf16_t* Q = (bf16_t*)(scr + SA_Q); bf16_t* Kb = (bf16_t*)(scr + SA_K); bf16_t* VT = (bf16_t*)(scr + SA_VT);
                const int seg = cb >> 9, cc0 = cb & 511;
                if (seg == 2) epi_vt<8, 64>(reg, VT, rbase, cc0);
                else epi_rows8<2>(reg, [&](int rl, int cl, float4 a, float4 b) {
                    const size_t o = (size_t)(rbase + rl) * 512 + cc0 + cl;
                    if (seg == 0) st8bf(Q + o, a, b); else if (seg == 1) st8bf(Kb + o, a, b); else st8bf(YSb + o, silu4(a), silu4(b));
                });
            } else if constexpr (BR == 1) {
                bf16_t* Q = (bf16_t*)(scr + SB_Q); bf16_t* Kb = (bf16_t*)(scr + SB_K); bf16_t* VT = (bf16_t*)(scr + SB_VT);
                if (cb >= 640 && cb < 768) epi_vt<2, 64>(reg, VT, rbase, cb - 640);
                else epi_rows8<2>(reg, [&](int rl, int cl, float4 a, float4 b) {
                    const int row = rbase + rl;
                    if (cb < 640) {
                        if (row < NL) {
                            const float4 pa = *(const float4*)(reg + rl * EST + (cl ^ 32)), pb = *(const float4*)(reg + rl * EST + (cl ^ 32) + 4);
                            const int t = row & (T - 1), c = cl & 31;
                            const float4 c0 = *(const float4*)(rope + (size_t)t * 32 + c), c1 = *(const float4*)(rope + (size_t)t * 32 + c + 4);
                            const float4 s0 = *(const float4*)(rope + (size_t)T * 32 + (size_t)t * 32 + c), s1 = *(const float4*)(rope + (size_t)T * 32 + (size_t)t * 32 + c + 4);
                            if (cl < 32) {
                                a = make_float4(a.x * c0.x - pa.x * s0.x, a.y * c0.y - pa.y * s0.y, a.z * c0.z - pa.z * s0.z, a.w * c0.w - pa.w * s0.w);
                                b = make_float4(b.x * c1.x - pb.x * s1.x, b.y * c1.y - pb.y * s1.y, b.z * c1.z - pb.z * s1.z, b.w * c1.w - pb.w * s1.w);
                            } else {
                                a = make_float4(pa.x * s0.x + a.x * c0.x, pa.y * s0.y + a.y * c0.y, pa.z * s0.z + a.z * c0.z, pa.w * s0.w + a.w * c0.w);
                                b = make_float4(pb.x * s1.x + b.x * c1.x, pb.y * s1.y + b.y * c1.y, pb.z * s1.z + b.z * c1.z, pb.w * s1.w + b.w * c1.w);
                            }
                        }
                        if (cb < 512) st8bf(Q + (size_t)row * 512 + cb + cl, a, b);
                        else st8bf(Kb + (size_t)row * 128 + (cb - 512) + cl, a, b);
                    } else st8bf(YSb + (size_t)row * 512 + (cb - 768) + cl, silu4(a), silu4(b));
                });
            } else if constexpr (BR == 2) {
                bf16_t* Q = (bf16_t*)(scr + SC_Q); bf16_t* Kb = (bf16_t*)(scr + SC_K); bf16_t* VT = (bf16_t*)(scr + SC_VT);
                float* LR = (float*)(scr + SC_LR);
                if (cb >= 512 && cb < 1024) epi_vt<4, 128>(reg, VT, rbase, cb - 512);
                else epi_rows8<2>(reg, [&](int rl, int cl, float4 a, float4 b) {
                    const int row = rbase + rl, col = cb + cl;
                    if (col < 256) { const float sc = 0.125f; st8bf(Q + (size_t)row * 256 + col, make_float4(a.x * sc, a.y * sc, a.z * sc, a.w * sc), make_float4(b.x * sc, b.y * sc, b.z * sc, b.w * sc)); }
                    else if (col < 512) st8bf(Kb + (size_t)row * 256 + (col - 256), a, b);
                    else if (col < 1056) { *(float4*)(LR + (size_t)row * 32 + (col - 1024)) = a; *(float4*)(LR + (size_t)row * 32 + (col - 1024) + 4) = b; }
                    else if (col < 1568) st8bf(YSb + (size_t)row * 512 + (col - 1056), silu4(a), silu4(b));
                });
            } else {
                bf16_t* U = (bf16_t*)(scr + SD_U);
                epi_rows8<2>(reg, [&](int rl, int cl, float4 a, float4 b) {
                    const int row = rbase + rl, col = cb + cl;
                    if (col < 1536) st8bf(U + (size_t)row * 1536 + col, a, b);
                    else st8bf(YSb + (size_t)row * 512 + (col - 1536), silu4(a), silu4(b));
                });
            }
        }
    }
}

DEVI void phase_merge(const P& p, int l, bf16_t* sm) {
    unsigned char* ws = p.ws;
    const bf16_t* HL = (const bf16_t*)(ws + OFF_HL);
    const bf16_t* Wgm = (const bf16_t*)(ws + OFF_WINT) + ((size_t)l * IN_TOTAL + COL_GM) * D;
    const bf16_t* Wb = (const bf16_t*)(ws + OFF_WBT) + (size_t)l * 4 * D * 512;
    bf16_t* ACCM = (bf16_t*)(ws + OFF_SCR);
    const int M = (l == 0) ? NR : NL;
    const int tilesM = M / 256, tilesN = D / 128;
    for (int it = 0;; ++it) {
        const int tile = tile_of(it);
        if (it * (int)gridDim.x >= tilesM * tilesN) break;
        if (tile >= tilesM * tilesN) continue;
        const int tm = tile / tilesN, tn = tile % tilesN;
        const int m0 = tm * 256, n0 = tn * 128;
        GAcc<2> tot; acc_zero(tot);
        unsigned totp[2][2][8];
#pragma unroll
        for (int mt = 0; mt < 2; ++mt)
#pragma unroll
            for (int nt = 0; nt < 2; ++nt)
#pragma unroll
                for (int e = 0; e < 8; ++e) totp[mt][nt][e] = 0u;
#pragma unroll 1
        for (int i = 0; i < 4; ++i) {
#ifdef TIMING_A
            gemm_kloop<2>((const bf16_t*)(ws + OFF_YS + i * SZ512), 512, Wb + (size_t)i * D * 512, 512, 512, m0, n0, sm, tot);
            GAcc<2> g; acc_zero(g);
            gemm_kloop<2>(HL, D, Wgm + (size_t)i * D * D, D, D, m0, n0, sm, g);
#pragma unroll
            for (int mt = 0; mt < 2; ++mt)
#pragma unroll
                for (int nt = 0; nt < 2; ++nt)
#pragma unroll
                    for (int e = 0; e < 16; ++e) tot.a[mt][nt][e] += sigmf(g.a[mt][nt][e]);
        }
#else
            unsigned pp[2][2][8];
            {
                GAcc<2> pr; acc_zero(pr);
                gemm_kloop<2>((const bf16_t*)(ws + OFF_YS + i * SZ512), 512, Wb + (size_t)i * D * 512, 512, 512, m0, n0, sm, pr);
#pragma unroll
                for (int mt = 0; mt < 2; ++mt)
#pragma unroll
                    for (int nt = 0; nt < 2; ++nt)
#pragma unroll
                        for (int e = 0; e < 8; ++e) pp[mt][nt][e] = pk2(pr.a[mt][nt][2 * e], pr.a[mt][nt][2 * e + 1]);
            }
            GAcc<2> g; acc_zero(g);
            gemm_kloop<2>(HL, D, Wgm + (size_t)i * D * D, D, D, m0, n0, sm, g);
#pragma unroll
            for (int mt = 0; mt < 2; ++mt)
#pragma unroll
                for (int nt = 0; nt < 2; ++nt)
#pragma unroll
                    for (int e = 0; e < 8; ++e) {
                        const float t0 = lo_bf(totp[mt][nt][e]) + sigmf(g.a[mt][nt][2 * e]) * lo_bf(pp[mt][nt][e]);
                        const float t1 = hi_bf(totp[mt][nt][e]) + sigmf(g.a[mt][nt][2 * e + 1]) * hi_bf(pp[mt][nt][e]);
                        totp[mt][nt][e] = pk2(t0, t1);
                    }
        }
#pragma unroll
        for (int mt = 0; mt < 2; ++mt)
#pragma unroll
            for (int nt = 0; nt < 2; ++nt)
#pragma unroll
                for (int e = 0; e < 8; ++e) { tot.a[mt][nt][2 * e] = lo_bf(totp[mt][nt][e]); tot.a[mt][nt][2 * e + 1] = hi_bf(totp[mt][nt][e]); }
#endif
        {
            const int wave = ltid() >> 6, wm = wave >> 1, wn = wave & 1;
            float* reg = (float*)sm + wave * (32 * EST);
#pragma unroll
            for (int mt = 0; mt < 2; ++mt) {
                epi_stage<2>(tot, mt, reg);
                epi_rows8<2>(reg, [&](int rl, int cl, float4 a, float4 b) { st8bf(ACCM + (size_t)(m0 + wm * 64 + mt * 32 + rl) * D + n0 + wn * 64 + cl, a, b); });
            }
        }
    }
}

DEVI void phase_out(const P& p, int l, bf16_t* sm) {
    unsigned char* ws = p.ws;
    const bf16_t* ACCM = (const bf16_t*)(ws + OFF_SCR);
    const bf16_t* Wo = (const bf16_t*)(ws + OFF_WOT) + (size_t)l * D * D;
    const float* MOD = (const float*)(ws + OFF_MOD) + (size_t)l * 3 * 3072;
    float* XC1 = (float*)(ws + OFF_XC1);
    const int M = (l == 0) ? NR : NL;
    const int tilesM = M / 256, tilesN = D / 128;
    for (int it = 0;; ++it) {
        const int tile = tile_of(it);
        if (it * (int)gridDim.x >= tilesM * tilesN) break;
        if (tile >= tilesM * tilesN) continue;
        const int tm = tile / tilesN, tn = tile % tilesN;
        const int m0 = tm * 256, n0 = tn * 128;
        GAcc<2> acc; acc_zero(acc);
        gemm_kloop<2, 1>(ACCM, D, Wo, D, D, m0, n0, sm, acc);
        {
            const int wave = ltid() >> 6, wm = wave >> 1, wn = wave & 1;
            float* reg = (float*)sm + wave * (32 * EST);
#pragma unroll
            for (int mt = 0; mt < 2; ++mt) {
                epi_stage<2>(acc, mt, reg);
                epi_rows8<2>(reg, [&](int rl, int cl, float4 a, float4 b) {
                    const int row = m0 + wm * 64 + mt * 32 + rl, col = n0 + wn * 64 + cl;
                    const bool ic = row >= NL;
                    const int mi = ic ? 2 : (row >> 14);
                    const float4 g0 = *(const float4*)(MOD + mi * 3072 + 2048 + col), g1 = *(const float4*)(MOD + mi * 3072 + 2048 + col + 4);
                    const float* src; float* dst;
                    if (ic) { src = (l == 0 ? p.ctx : XC1) + (size_t)(row - NL) * D + col; dst = XC1 + (size_t)(row - NL) * D + col; }
                    else { src = (l == 0 ? p.x : p.out) + (size_t)row * D + col; dst = p.out + (size_t)row * D + col; }
                    const float4 x0 = *(const float4*)src, x1 = *(const float4*)(src + 4);
                    if (!p.dry) {
                        *(float4*)dst = make_float4(x0.x + g0.x * a.x, x0.y + g0.y * a.y, x0.z + g0.z * a.z, x0.w + g0.w * a.w);
                        *(float4*)(dst + 4) = make_float4(x1.x + g1.x * b.x, x1.y + g1.y * b.y, x1.z + g1.z * b.z, x1.w + g1.w * b.w);
                    }
                });
            }
        }
    }
}

DEVI void transpose_tile(const float* __restrict__ src, int K, int N, bf16_t* __restrict__ dst, int k0, int n0, float* sm) {
    const int tid = ltid();
    __syncthreads();
    {
        const int kr = tid >> 4, nc = (tid & 15) * 4;
#pragma unroll
        for (int i = 0; i < 2; ++i) {
            const int k = kr + 32 * i;
            float4 v = {0.f, 0.f, 0.f, 0.f};
            if (n0 + nc < N) v = *(const float4*)(src + (size_t)(k0 + k) * N + n0 + nc);
            sm[k * 65 + nc + 0] = v.x; sm[k * 65 + nc + 1] = v.y; sm[k * 65 + nc + 2] = v.z; sm[k * 65 + nc + 3] = v.w;
        }
    }
    __syncthreads();
    {
        const int n = tid >> 3, kc = (tid & 7) * 8;
        if (n0 + n < N) {
            uint4 w;
            w.x = pk2(sm[(kc + 0) * 65 + n], sm[(kc + 1) * 65 + n]); w.y = pk2(sm[(kc + 2) * 65 + n], sm[(kc + 3) * 65 + n]);
            w.z = pk2(sm[(kc + 4) * 65 + n], sm[(kc + 5) * 65 + n]); w.w = pk2(sm[(kc + 6) * 65 + n], sm[(kc + 7) * 65 + n]);
            *(uint4*)(dst + (size_t)(n0 + n) * K + k0 + kc) = w;
        }
    }
}

DEVI void hyena_mlp_task(const P& p, int l, int L, int p0, float* HT, float* sm) {
    const int tid = ltid();
    float* zb = sm;
    float* h1 = sm + 64 * 33;
    float* h2 = h1 + 64 * 65;
    const float* w1 = p.fw1 + (size_t)l * 33 * 64; const float* b1 = p.fb1 + l * 64;
    const float* w2 = p.fw2 + (size_t)l * 64 * 64; const float* b2 = p.fb2 + l * 64;
    const float* w3 = p.fw3 + (size_t)l * 64 * 64; const float* b3 = p.fb3 + l * 64;
    const float* fr = p.ffreq + l * 64;
    __syncthreads();
#pragma unroll 1
    for (int e = tid; e < 64 * 33; e += NTHR) {
        const int pos = e / 33, k = e % 33;
        const int pp = p0 + pos;
        float v;
        if (k == 0) v = (float)pp / (float)(L - 1);
        else {
            const int j = (k - 1) & 15;
            const float f = 1e-4f + (float)j * ((15.0f - 1e-4f) / 15.0f);
            const float wa = 6.283185307179586f * (float)pp / (float)L;
            v = (k <= 16) ? cosf(f * wa) : -sinf(f * wa);
        }
        zb[e] = v;
    }
    __syncthreads();
    const int pos = tid >> 3, fg = (tid & 7) * 8;
    {
        float a[8];
#pragma unroll
        for (int j = 0; j < 8; ++j) a[j] = b1[fg + j];
#pragma unroll 1
        for (int k = 0; k < 33; ++k) {
            const float zv = zb[pos * 33 + k];
#pragma unroll
            for (int j = 0; j < 8; ++j) a[j] += zv * w1[k * 64 + fg + j];
        }
#pragma unroll
        for (int j = 0; j < 8; ++j) h1[pos * 65 + fg + j] = sinf(fr[fg + j] * a[j]);
    }
    __syncthreads();
    {
        float a[8];
#pragma unroll
        for (int j = 0; j < 8; ++j) a[j] = b2[fg + j];
#pragma unroll 2
        for (int k = 0; k < 64; ++k) {
            const float zv = h1[pos * 65 + k];
#pragma unroll
            for (int j = 0; j < 8; ++j) a[j] += zv * w2[k * 64 + fg + j];
        }
#pragma unroll
        for (int j = 0; j < 8; ++j) h2[pos * 65 + fg + j] = sinf(fr[fg + j] * a[j]);
    }
    __syncthreads();
    {
        float a[8];
#pragma unroll
        for (int j = 0; j < 8; ++j) a[j] = b3[fg + j];
#pragma unroll 2
        for (int k = 0; k < 64; ++k) {
            const float zv = h2[pos * 65 + k];
#pragma unroll
            for (int j = 0; j < 8; ++j) a[j] += zv * w3[k * 64 + fg + j];
        }
#pragma unroll
        for (int j = 0; j < 8; ++j) HT[(size_t)(fg + j) * L + p0 + pos] = sinf(fr[fg + j] * a[j]);
    }
}

DEVI void phase_prep(const P& p, float* sm) {
    unsigned char* ws = p.ws;
    const int tid = ltid();
    constexpr int TN_IN = (IN_TOTAL + 63) / 64;
    constexpr int T_WIN = 2 * 16 * TN_IN;
    constexpr int T_WB = 2 * 4 * 8 * 16;
    constexpr int T_WO = 2 * 16 * 16;
    constexpr int T_MOD = 2 * 48;
    constexpr int T_ROPE = T * 32 / NTHR;
    constexpr int T_MLP = 2 * 256 + 4;
    constexpr int E0 = T_WIN, E1 = E0 + T_WB, E2 = E1 + T_WO, E3 = E2 + T_MOD, E4 = E3 + T_ROPE, E5 = E4 + T_MLP;
    for (int task = blockIdx.x; task < E5; task += gridDim.x) {
        if (task < E0) {
            const int l = task / (16 * TN_IN), r = task % (16 * TN_IN), kt = r / TN_IN, nt = r % TN_IN;
            transpose_tile(p.w_in + (size_t)l * D * IN_TOTAL, D, IN_TOTAL, (bf16_t*)(ws + OFF_WINT) + (size_t)l * IN_TOTAL * D, kt * 64, nt * 64, sm);
        } else if (task < E1) {
            const int q = task - E0, li = q / 128, r = q % 128, kt = r / 16, nt = r % 16;
            transpose_tile(p.w_branch + (size_t)li * 512 * D, 512, D, (bf16_t*)(ws + OFF_WBT) + (size_t)li * D * 512, kt * 64, nt * 64, sm);
        } else if (task < E2) {
            const int q = task - E1, l = q / 256, r = q % 256, kt = r / 16, nt = r % 16;
            transpose_tile(p.w_out + (size_t)l * D * D, D, D, (bf16_t*)(ws + OFF_WOT) + (size_t)l * D * D, kt * 64, nt * 64, sm);
        } else if (task < E3) {
            const int q = task - E2, l = q / 48, jb = q % 48;
            float* sc = sm;
            float* red = sm + 3072;
            __syncthreads();
#pragma unroll 1
            for (int e = tid; e < 3072; e += NTHR) {
                const int mi = e >> 10, k = e & 1023;
                const float v = (mi < 2) ? p.c[mi * D + k] : p.c_ctx[k];
                sc[e] = siluf(v);
            }
            __syncthreads();
            const int kg = tid >> 6, jj = tid & 63, j = jb * 64 + jj;
            const float* w = p.w_mod + (size_t)l * D * 3072 + j;
            float a0 = 0.f, a1 = 0.f, a2 = 0.f;
#pragma unroll 8
            for (int k = kg * 128; k < kg * 128 + 128; ++k) {
                const float wv = w[(size_t)k * 3072];
                a0 += sc[k] * wv; a1 += sc[1024 + k] * wv; a2 += sc[2048 + k] * wv;
            }
            red[(0 * 8 + kg) * 64 + jj] = a0; red[(1 * 8 + kg) * 64 + jj] = a1; red[(2 * 8 + kg) * 64 + jj] = a2;
            __syncthreads();
            if (tid < 192) {
                const int mi = tid >> 6, j2 = tid & 63;
                float s = p.b_mod[l * 3072 + jb * 64 + j2];
#pragma unroll
                for (int g = 0; g < 8; ++g) s += red[(mi * 8 + g) * 64 + j2];
                ((float*)(ws + OFF_MOD))[((size_t)l * 3 + mi) * 3072 + jb * 64 + j2] = s;
            }
        } else if (task < E4) {
            const int e = (task - E3) * NTHR + tid;
            const int t = e >> 5, c = e & 31;
            const float inv = powf(10000.0f, -(float)(c & 15) / 16.0f);
            const float pos = (c < 16) ? (float)(t >> 6) : (float)(t & 63);
            const float ang = pos * inv;
            float* rope = (float*)(ws + OFF_ROPE);
            rope[e] = cosf(ang); rope[(size_t)T * 32 + e] = sinf(ang);
        } else {
            const int q = task - E4;
            if (q < 512) { const int l = q >> 8; hyena_mlp_task(p, l, T, (q & 255) * 64, (float*)(ws + OFF_HH3T) + (size_t)l * 64 * T, sm); }
            else hyena_mlp_task(p, 0, CL, (q - 512) * 64, (float*)(ws + OFF_HH3C), sm);
        }
    }
}

DEVI void phase_hl(const P& p, int l) {
    unsigned char* ws = p.ws;
    const int lane = ltid() & 63, wave = ltid() >> 6;
    const float* MOD = (const float*)(ws + OFF_MOD) + (size_t)l * 3 * 3072;
    const float* nw = p.norm_w + l * D;
    bf16_t* HL = (bf16_t*)(ws + OFF_HL);
    const float* XC1 = (const float*)(ws + OFF_XC1);
    for (int row = blockIdx.x * 8 + wave; row < NR; row += gridDim.x * 8) {
        const float* src; int mi;
        if (row < NL) { src = (l == 0 ? p.x : p.out) + (size_t)row * D; mi = row >> 14; }
        else { src = (l == 0 ? p.ctx : XC1) + (size_t)(row - NL) * D; mi = 2; }
        float4 v[4]; float ss = 0.f;
#pragma unroll
        for (int i = 0; i < 4; ++i) { v[i] = *(const float4*)(src + lane * 4 + 256 * i); ss += v[i].x * v[i].x + v[i].y * v[i].y + v[i].z * v[i].z + v[i].w * v[i].w; }
        ss = wave_sum(ss);
        const float rs = rsqrtf(ss * (1.0f / D) + EPS);
        const float* sh = MOD + mi * 3072; const float* sc = sh + 1024;
#pragma unroll
        for (int i = 0; i < 4; ++i) {
            const int c = lane * 4 + 256 * i;
            const float4 w = *(const float4*)(nw + c), s1 = *(const float4*)(sc + c), s0 = *(const float4*)(sh + c);
            st4bf(HL + (size_t)row * D + c, v[i].x * rs * w.x * (1.f + s1.x) + s0.x, v[i].y * rs * w.y * (1.f + s1.y) + s0.y,
                  v[i].z * rs * w.z * (1.f + s1.z) + s0.z, v[i].w * rs * w.w * (1.f + s1.w) + s0.w);
        }
    }
}
DEVI void phase_final(const P& p) {
    const int lane = ltid() & 63, wave = ltid() >> 6;
    for (int row = blockIdx.x * 8 + wave; row < NL; row += gridDim.x * 8) {
        float* src = p.out + (size_t)row * D;
        float4 v[4]; float ss = 0.f;
#pragma unroll
        for (int i = 0; i < 4; ++i) { v[i] = *(const float4*)(src + lane * 4 + 256 * i); ss += v[i].x * v[i].x + v[i].y * v[i].y + v[i].z * v[i].z + v[i].w * v[i].w; }
        ss = wave_sum(ss);
        const float rs = rsqrtf(ss * (1.0f / D) + EPS);
#pragma unroll
        for (int i = 0; i < 4; ++i) {
            const int c = lane * 4 + 256 * i;
            const float4 w = *(const float4*)(p.final_norm_w + c);
            float4 r = {v[i].x * rs * w.x, v[i].y * rs * w.y, v[i].z * rs * w.z, v[i].w * rs * w.w};
            *(float4*)(src + c) = r;
        }
    }
}

union U8 { bf16x8 v; uint4 u; uint2 h[2]; unsigned w[4]; };
struct AttSt { float m, l; f32x4 o[4]; };
constexpr float L2E = 1.4426950408889634f;
constexpr float NEG_INF = -__builtin_huge_valf();

DEVI float rows_max(float x) {
    const unsigned u = __float_as_uint(x);
    auto r = __builtin_amdgcn_permlane16_swap(u, u, false, false);
    const float a = fmaxf(__uint_as_float(r[0]), __uint_as_float(r[1]));
    const unsigned v = __float_as_uint(a);
    auto t = __builtin_amdgcn_permlane32_swap(v, v, false, false);
    return fmaxf(__uint_as_float(t[0]), __uint_as_float(t[1]));
}
DEVI float rows_sum(float x) {
    const unsigned u = __float_as_uint(x);
    auto r = __builtin_amdgcn_permlane16_swap(u, u, false, false);
    const float a = __uint_as_float(r[0]) + __uint_as_float(r[1]);
    const unsigned v = __float_as_uint(a);
    auto t = __builtin_amdgcn_permlane32_swap(v, v, false, false);
    return __uint_as_float(t[0]) + __uint_as_float(t[1]);
}
struct KVF { bf16x8 ka, kb, kc, kd; U8 v0, v1, v2, v3; };
DEVI void att_load(KVF& f, const bf16_t* k0p, const bf16_t* k1p, const bf16_t* v0p, const bf16_t* v1p, size_t ldv) {
    f.ka = *(const bf16x8*)k0p; f.kb = *(const bf16x8*)(k0p + 32);
    f.kc = *(const bf16x8*)k1p; f.kd = *(const bf16x8*)(k1p + 32);
    f.v0.u = *(const uint4*)(v0p); f.v1.u = *(const uint4*)(v0p + 16 * ldv);
    f.v2.u = *(const uint4*)(v0p + 32 * ldv); f.v3.u = *(const uint4*)(v0p + 48 * ldv);
}
DEVI void att_load2(KVF& f, const char* kb, unsigned k0, unsigned k1, const char* vb, unsigned v0, unsigned vstep) {
    f.ka = *(const bf16x8*)(kb + k0); f.kb = *(const bf16x8*)(kb + (k0 + 64u));
    f.kc = *(const bf16x8*)(kb + k1); f.kd = *(const bf16x8*)(kb + (k1 + 64u));
    f.v0.u = *(const uint4*)(vb + v0); f.v1.u = *(const uint4*)(vb + (v0 + vstep));
    f.v2.u = *(const uint4*)(vb + (v0 + 2u * vstep)); f.v3.u = *(const uint4*)(vb + (v0 + 3u * vstep));
}
DEVI void att_compute(AttSt& st, const bf16x8& q0, const bf16x8& q1, const KVF& f, f32x4 b0, f32x4 b1, float scale2) {
    f32x4 s0 = {0.f, 0.f, 0.f, 0.f}, s1 = {0.f, 0.f, 0.f, 0.f};
    s0 = __builtin_amdgcn_mfma_f32_16x16x32_bf16(f.ka, q0, s0, 0, 0, 0);
    s0 = __builtin_amdgcn_mfma_f32_16x16x32_bf16(f.kb, q1, s0, 0, 0, 0);
    s1 = __builtin_amdgcn_mfma_f32_16x16x32_bf16(f.kc, q0, s1, 0, 0, 0);
    s1 = __builtin_amdgcn_mfma_f32_16x16x32_bf16(f.kd, q1, s1, 0, 0, 0);
    s0 = s0 * scale2 + b0; s1 = s1 * scale2 + b1;
    float mx = fmaxf(fmaxf(fmaxf(s0[0], s0[1]), fmaxf(s0[2], s0[3])), fmaxf(fmaxf(s1[0], s1[1]), fmaxf(s1[2], s1[3])));
    mx = rows_max(mx);
    if (__any(mx > st.m + 8.0f)) {
        const float mn = fmaxf(st.m, mx);
        const float alpha = __builtin_amdgcn_exp2f(st.m - mn);
        st.l *= alpha; st.m = mn;
        st.o[0] = st.o[0] * alpha; st.o[1] = st.o[1] * alpha; st.o[2] = st.o[2] * alpha; st.o[3] = st.o[3] * alpha;
    }
    const float mref = st.m;
    float pa[8];
#pragma unroll
    for (int i = 0; i < 4; ++i) { pa[i] = __builtin_amdgcn_exp2f(s0[i] - mref); pa[4 + i] = __builtin_amdgcn_exp2f(s1[i] - mref); }
    st.l += ((pa[0] + pa[1]) + (pa[2] + pa[3])) + ((pa[4] + pa[5]) + (pa[6] + pa[7]));
    U8 pf; pf.w[0] = pk2(pa[0], pa[1]); pf.w[1] = pk2(pa[2], pa[3]); pf.w[2] = pk2(pa[4], pa[5]); pf.w[3] = pk2(pa[6], pa[7]);
    st.o[0] = __builtin_amdgcn_mfma_f32_16x16x32_bf16(f.v0.v, pf.v, st.o[0], 0, 0, 0);
    st.o[1] = __builtin_amdgcn_mfma_f32_16x16x32_bf16(f.v1.v, pf.v, st.o[1], 0, 0, 0);
    st.o[2] = __builtin_amdgcn_mfma_f32_16x16x32_bf16(f.v2.v, pf.v, st.o[2], 0, 0, 0);
    st.o[3] = __builtin_amdgcn_mfma_f32_16x16x32_bf16(f.v3.v, pf.v, st.o[3], 0, 0, 0);
}
#define ATT_PIPELINE(n_)                                              \
    { KVF fa_, fb_;                                                   \
      LOADS(fa_, 0);                                                  \
      int s_ = 0;                                                     \
      for (; s_ + 2 < (n_); s_ += 2) {        \
          LOADS(fb_, s_ + 1);                                         \
          COMPS(fa_, s_);                                             \
          LOADS(fa_, s_ + 2);                                         \
          COMPS(fb_, s_ + 1);                                         \
      }                                                               \
      if (s_ + 1 < (n_)) { LOADS(fb_, s_ + 1); COMPS(fa_, s_); COMPS(fb_, s_ + 1); } \
      else { COMPS(fa_, s_); } }
DEVI void att_finish(const AttSt& st, float extra_l, bf16_t* G  , int dry) {
    const int lane = ltid() & 63, g = lane >> 4;
    float lt = rows_sum(st.l);
    lt += extra_l;
    const float inv = 1.f / lt;
#pragma unroll
    for (int dt = 0; dt < 4; ++dt) {
        bf16_t* gp = G + dt * 16 + 4 * g;
        const uint2 gv = *(const uint2*)gp;
        if (!dry) st4bf(gp, st.o[dt][0] * inv * lo_bf(gv.x), st.o[dt][1] * inv * hi_bf(gv.x), st.o[dt][2] * inv * lo_bf(gv.y), st.o[dt][3] * inv * hi_bf(gv.y));
    }
}

DEVI void phase_att_a(const P& p, int l, float* smf) {
    unsigned char* ws = p.ws; unsigned char* scr = ws + OFF_SCR;
    const bf16_t* Q = (const bf16_t*)(scr + SA_Q); const bf16_t* K = (const bf16_t*)(scr + SA_K); const bf16_t* VT = (const bf16_t*)(scr + SA_VT);
    const bf16_t* VTC = VT + (size_t)NB * 8 * 64 * T;
    bf16_t* G = (bf16_t*)(ws + OFF_YS);
    const int tid = ltid(), lane = tid & 63, h = tid >> 6, q = lane & 15, g = lane >> 4;
    __syncthreads();
    for (int e = tid; e < 8 * 465; e += NTHR) smf[e] = p.rpb[(size_t)l * 8 * 465 + e] * L2E;
    __syncthreads();
    const float* tab = smf + h * 465;
    const float scale2 = 0.125f * L2E;
    const int ntask = 2048 + (l == 0 ? 32 : 0);
    for (int it = 0; it * (int)gridDim.x < ntask; ++it) {
        const int task = tile_of(it);
        if (task >= ntask) continue;
        AttSt st; st.m = -1e30f; st.l = 0.f;
#pragma unroll
        for (int dt = 0; dt < 4; ++dt) st.o[dt] = (f32x4){0.f, 0.f, 0.f, 0.f};
        int b, qrow;
        const bool lat = task < 2048;
        int r = 0, j = 0;
        if (lat) { b = task >> 10; r = (task >> 2) & 255; j = task & 3; qrow = b * T + r * 64 + j * 16 + q; }
        else { const int tt = task - 2048; b = tt >> 4; qrow = NL + b * CL + (tt & 15) * 16 + q; }
        const bf16_t* qp = Q + (size_t)qrow * 512 + h * 64 + g * 8;
        const bf16x8 q0 = *(const bf16x8*)qp, q1 = *(const bf16x8*)(qp + 32);
        {
            const int rs = min(max(r - 4, 0), 248), kc0 = min(max(j * 16 - 8, 0), 32);
            const int qc = j * 16 + q, cs = min(max(qc - 8, 0), 48);
            const int nloc = lat ? 8 : 0, nst = nloc + 8;
            const bf16_t* Kc = K + (size_t)(NL + b * CL) * 512 + h * 64 + g * 8;
            const bf16_t* Vc = VTC + ((size_t)(b * 8 + h) * 64 + (lane & 15)) * CL + 8 * g;
            const int kmap = 8 * ((lane & 15) >> 2) + (lane & 3);
            const char* KnB = (const char*)(K + (size_t)b * T * 512); const char* VnB = (const char*)(VT + (size_t)(b * 8) * 64 * T);
            const char* KcB = (const char*)(K + (size_t)(NL + b * CL) * 512); const char* VcB = (const char*)(VTC + (size_t)(b * 8) * 64 * CL);
            const unsigned kln = (unsigned)((kc0 + kmap) * 512 + h * 64 + g * 8) * 2u, vln = (unsigned)((h * 64 + (lane & 15)) * T + kc0 + 8 * g) * 2u;
            const unsigned klc = (unsigned)(kmap * 512 + h * 64 + g * 8) * 2u, vlc = (unsigned)((h * 64 + (lane & 15)) * CL + 8 * g) * 2u;
#define LOADS(F, S) { const int s2_ = (S); if (s2_ < nloc) { const unsigned k0_ = kln + (unsigned)(rs + s2_) * 65536u; \
                        att_load2(F, KnB, k0_, k0_ + 4096u, VnB, vln + (unsigned)(rs + s2_) * 128u, (unsigned)(16 * T * 2)); } \
                      else { const unsigned c_ = (unsigned)(s2_ - nloc); const unsigned k0_ = klc + c_ * 32768u; att_load2(F, KcB, k0_, k0_ + 4096u, VcB, vlc + c_ * 64u, (unsigned)(16 * CL * 2)); } }
            int ia[4], ib[4]; bool va_[4], vb_[4];
#pragma unroll
            for (int i = 0; i < 4; ++i) { const int kc_a = kc0 + 8 * g + i, kc_b = kc_a + 4;
                va_[i] = (kc_a >= cs && kc_a < cs + 16); vb_[i] = (kc_b >= cs && kc_b < cs + 16);
                ia[i] = min(max(kc_a - qc + 15, 0), 30); ib[i] = min(max(kc_b - qc + 15, 0), 30); }
#define COMPS(F, S) { const int s2_ = (S); f32x4 b0 = {0.f, 0.f, 0.f, 0.f}, b1 = {0.f, 0.f, 0.f, 0.f}; \
                      if (s2_ < nloc) { const float* trw = tab + (rs + s2_ - r + 7) * 31; \
                        _Pragma("unroll") for (int i = 0; i < 4; ++i) { b0[i] = va_[i] ? trw[ia[i]] : NEG_INF; b1[i] = vb_[i] ? trw[ib[i]] : NEG_INF; } } \
                      att_compute(st, q0, q1, F, b0, b1, scale2); }
            ATT_PIPELINE(nst)
#undef LOADS
#undef COMPS
        }
        att_finish(st, 0.f, G + (size_t)qrow * 512 + h * 64, p.dry);
    }
}

DEVI void phase_att_b(const P& p, int l) {
    unsigned char* ws = p.ws; unsigned char* scr = ws + OFF_SCR;
    const bf16_t* Q = (const bf16_t*)(scr + SB_Q); const bf16_t* K = (const bf16_t*)(scr + SB_K); const bf16_t* VT = (const bf16_t*)(scr + SB_VT);
    const bf16_t* VTC = VT + (size_t)NB * 2 * 64 * T;
    bf16_t* G = (bf16_t*)(ws + OFF_YS + SZ512);
    const int tid = ltid(), lane = tid & 63, h = tid >> 6, kvh = h >> 2, q = lane & 15, g = lane >> 4;
    const float scale2 = 0.125f * L2E;
    const float sink2 = p.sink[l * 8 + h] * L2E;
    const int ntask = 2048 + (l == 0 ? 32 : 0);
    for (int it = 0; it * (int)gridDim.x < ntask; ++it) {
        const int task = tile_of(it);
        if (task >= ntask) continue;
        AttSt st; st.m = -1e30f; st.l = 0.f;
#pragma unroll
        for (int dt = 0; dt < 4; ++dt) st.o[dt] = (f32x4){0.f, 0.f, 0.f, 0.f};
        int b, qrow;
        const bool lat = task < 2048;
        int q0t = 0;
        if (lat) { b = task >> 10; q0t = (task & 1023) * 16; qrow = b * T + q0t + q; }
        else { const int tt = task - 2048; b = tt >> 4; qrow = NL + b * CL + (tt & 15) * 16 + q; }
        const bf16_t* qp = Q + (size_t)qrow * 512 + h * 64 + g * 8;
        const bf16x8 q0 = *(const bf16x8*)qp, q1 = *(const bf16x8*)(qp + 32);
        {
            const int tq = q0t + q;
            const int nloc = lat ? 9 : 0, nst = nloc + 8;
            const bf16_t* Kc = K + (size_t)(NL + b * CL) * 128 + kvh * 64 + g * 8;
            const bf16_t* Vc = VTC + ((size_t)(b * 2 + kvh) * 64 + (lane & 15)) * CL + 8 * g;
            const int kmap = 8 * ((lane & 15) >> 2) + (lane & 3);
            const bf16_t* vbase = VT + ((size_t)(b * 2 + kvh) * 64 + (lane & 15)) * T;
            const char* KnB = (const char*)(K + (size_t)b * T * 128); const char* VnB = (const char*)(VT + (size_t)(b * 2) * 64 * T);
            const char* KcB = (const char*)(K + (size_t)(NL + b * CL) * 128); const char* VcB = (const char*)(VTC + (size_t)(b * 2) * 64 * CL);
            const unsigned kl2 = (unsigned)(kvh * 64 + g * 8) * 2u, vl2 = (unsigned)((kvh * 64 + (lane & 15)) * T) * 2u;
            const unsigned klc = (unsigned)(kmap * 128 + kvh * 64 + g * 8) * 2u, vlc = (unsigned)((kvh * 64 + (lane & 15)) * CL + 8 * g) * 2u;
#define LOADS(F, S) { const int s2_ = (S); if (s2_ < nloc) { const int tbase = q0t - 128 + 32 * s2_; \
                        const int ta = min(max(tbase + kmap, 0), T - 1), tb = min(max(tbase + kmap + 4, 0), T - 1); \
                        const int va = min(max(tbase + 8 * g, 0), T - 8); \
                        att_load2(F, KnB, kl2 + (unsigned)ta * 256u, kl2 + (unsigned)tb * 256u, VnB, vl2 + (unsigned)va * 2u, (unsigned)(16 * T * 2)); } \
                      else { const unsigned c_ = (unsigned)(s2_ - nloc); const unsigned k0_ = klc + c_ * 8192u; att_load2(F, KcB, k0_, k0_ + 1024u, VcB, vlc + c_ * 64u, (unsigned)(16 * CL * 2)); } }
#define COMPS(F, S) { const int s2_ = (S); f32x4 b0 = {0.f, 0.f, 0.f, 0.f}, b1 = {0.f, 0.f, 0.f, 0.f}; \
                      if (s2_ < nloc && (s2_ == 0 || s2_ == 8 || q0t < 128 || q0t + 160 > T)) { const int tbase = q0t - 128 + 32 * s2_; \
                        _Pragma("unroll") for (int i = 0; i < 4; ++i) { const int t0 = tbase + 8 * g + i, t1 = t0 + 4; \
                          b0[i] = (t0 >= 0 && t0 < T && abs(tq - t0) <= 128) ? 0.f : NEG_INF; \
                          b1[i] = (t1 >= 0 && t1 < T && abs(tq - t1) <= 128) ? 0.f : NEG_INF; } } \
                      att_compute(st, q0, q1, F, b0, b1, scale2); }
            ATT_PIPELINE(nst)
#undef LOADS
#undef COMPS
        }
        att_finish(st, __builtin_amdgcn_exp2f(sink2 - st.m), G + (size_t)qrow * 512 + h * 64, p.dry);
    }
}

constexpr int GL_CUM = 0;
constexpr int GL_LR = 32768;
constexpr int GL_T0 = GL_LR + 8192;
constexpr int GL_TSZ = 64 * LSTR * 2;
constexpr int GL_X = GL_T0 + 4 * GL_TSZ;

DEVI float logsigmoidf(float x) { return fminf(x, 0.f) - __logf(1.0f + __expf(-fabsf(x))); }

DEVI void gla_cum(const P& p, int l, int h, int rowbase, unsigned char* sm) {
    const int tid = ltid();
    float* cum = (float*)(sm + GL_CUM); float* lrs = (float*)(sm + GL_LR);
    const float* LR = (const float*)(p.ws + OFF_SCR + SC_LR);
    __syncthreads();
    { const int t = tid >> 3, c4 = (tid & 7) * 4; *(float4*)(lrs + t * 32 + c4) = *(const float4*)(LR + (size_t)(rowbase + t) * 32 + c4); }
    __syncthreads();
    const int d = tid & 63, tg = tid >> 6;
    float* tot = lrs + 64 * 32;
    tot = (float*)(sm + GL_X);
    float la[2][8];
#pragma unroll
    for (int dir = 0; dir < 2; ++dir) {
        const float* W = p.w_alpha_up + ((size_t)(l * 2 + dir) * 16) * 256 + h * 64 + d;
        float w[16];
#pragma unroll
        for (int r = 0; r < 16; ++r) w[r] = W[r * 256];
        const float bia = p.b_alpha[(l * 2 + dir) * 256 + h * 64 + d];
#pragma unroll
        for (int tt = 0; tt < 8; ++tt) {
            const int t = tg * 8 + tt;
            float x = bia;
#pragma unroll
            for (int r = 0; r < 16; ++r) x += lrs[t * 32 + dir * 16 + r] * w[r];
            la[dir][tt] = logsigmoidf(x) * (1.0f / 16.0f);
        }
    }
#pragma unroll
    for (int tt = 1; tt < 8; ++tt) la[0][tt] += la[0][tt - 1];
#pragma unroll
    for (int tt = 6; tt >= 0; --tt) la[1][tt] += la[1][tt + 1];
    tot[(0 * 8 + tg) * 64 + d] = la[0][7];
    tot[(1 * 8 + tg) * 64 + d] = la[1][0];
    __syncthreads();
    float of = 0.f, ob = 0.f;
#pragma unroll
    for (int g2 = 0; g2 < 8; ++g2) {
        const float a = tot[(0 * 8 + g2) * 64 + d], b = tot[(1 * 8 + g2) * 64 + d];
        of += (g2 < tg) ? a : 0.f;
        ob += (g2 > tg) ? b : 0.f;
    }
#pragma unroll
    for (int tt = 0; tt < 8; ++tt) {
        const int t = tg * 8 + tt;
        cum[t * 64 + d] = la[0][tt] + of;
        cum[(64 + t) * 64 + d] = la[1][tt] + ob;
    }
    __syncthreads();
}
DEVI void gla_chunk_geom(int b, int c, int& rowbase, size_t& vt_off  , size_t& vld, int& ci_f, int& ci_b) {
    if (c < 4) { rowbase = NL + b * CL + c * 64; vld = CL; ci_f = c; ci_b = 3 - c; }
    else { rowbase = b * T + (c - 4) * 64; vld = T; ci_f = c; ci_b = 4 + 255 - (c - 4); }
}
DEVI const bf16_t* gla_vt_ptr(const bf16_t* VT, int b, int h, int c) {
    if (c < 4) return VT + (size_t)NB * 4 * 128 * T + ((size_t)(b * 4 + h) * 128) * CL + c * 64;
    return VT + ((size_t)(b * 4 + h) * 128) * T + (size_t)(c - 4) * 64;
}

DEVI void phase_gla1(const P& p, int l, unsigned char* sm) {
    unsigned char* scr = p.ws + OFF_SCR;
    const bf16_t* KG = (const bf16_t*)(scr + SC_K); const bf16_t* VT = (const bf16_t*)(scr + SC_VT);
    bf16_t* SB = (bf16_t*)(scr + SC_SB); float* GD = (float*)(scr + SC_GD);
    const int tid = ltid(), lane = tid & 63, wave = tid >> 6;
    const float* cum = (const float*)(sm + GL_CUM);
    bf16_t* kdT = (bf16_t*)(sm + GL_T0);
    for (int task = blockIdx.x; task < 8 * NCH; task += gridDim.x) {
        const int bh = task / NCH, c = task % NCH, b = bh >> 2, h = bh & 3;
        int rowbase, ci_f, ci_b; size_t vo, vld;
        gla_chunk_geom(b, c, rowbase, vo, vld, ci_f, ci_b);
        gla_cum(p, l, h, rowbase, sm);
        {
            const int d = tid & 63, tg = tid >> 6;
            const float ce_f = cum[63 * 64 + d], ce_b = cum[64 * 64 + d];
            float vf[8], vb[8];
#pragma unroll
            for (int j = 0; j < 8; ++j) {
                const int t = tg * 8 + j;
                const float kf = bf2f(KG[(size_t)(rowbase + t) * 256 + h * 64 + d]);
                vf[j] = kf * __expf(ce_f - cum[t * 64 + d]);
                vb[j] = kf * __expf(ce_b - cum[(64 + t) * 64 + d]);
            }
            uint4 wf, wb;
            wf.x = pk2(vf[0], vf[1]); wf.y = pk2(vf[2], vf[3]); wf.z = pk2(vf[4], vf[5]); wf.w = pk2(vf[6], vf[7]);
            wb.x = pk2(vb[0], vb[1]); wb.y = pk2(vb[2], vb[3]); wb.z = pk2(vb[4], vb[5]); wb.w = pk2(vb[6], vb[7]);
            *(uint4*)(kdT + d * LSTR + tg * 8) = wf;
            *(uint4*)(kdT + (64 + d) * LSTR + tg * 8) = wb;
        }
        __syncthreads();
        {
            const int dir = wave >> 2, dvt = wave & 3;
            const bf16_t* vp = gla_vt_ptr(VT, b, h, c) + (size_t)(dvt * 32 + (lane & 31)) * vld + (lane >> 5) * 8;
            const bf16_t* ap = kdT + (dir * 64 + (lane & 31)) * LSTR + (lane >> 5) * 8;
            f32x16 acc[2];
#pragma unroll
            for (int i = 0; i < 16; ++i) { acc[0][i] = 0.f; acc[1][i] = 0.f; }
#pragma unroll
            for (int ks = 0; ks < 4; ++ks) {
                const bf16x8 vb = *(const bf16x8*)(vp + ks * 16);
#pragma unroll
                for (int mt = 0; mt < 2; ++mt) {
                    const bf16x8 ka = *(const bf16x8*)(ap + mt * 32 * LSTR + ks * 16);
                    acc[mt] = __builtin_amdgcn_mfma_f32_32x32x16_bf16(ka, vb, acc[mt], 0, 0, 0);
                }
            }
            const int bhd = bh * 2 + dir, ci = dir ? ci_b : ci_f;
            bf16_t* out = SB + ((size_t)bhd * NCH + ci) * 8192 + (size_t)(dvt * 32 + (lane & 31)) * 64;
#ifdef EXP_C
            for (int mt = 0; mt < 2; ++mt) for (int i = 0; i < 16; ++i) { const int dk = mt * 32 + (i & 3) + 8 * (i >> 2) + 4 * (lane >> 5); acc[mt][i] = bf2f(kdT[(dir * 64 + dk) * LSTR + ((dvt * 32 + (lane & 31)) & 63)]); }
#endif
#pragma unroll
            for (int mt = 0; mt < 2; ++mt)
#pragma unroll
                for (int q4 = 0; q4 < 4; ++q4)
                    st4bf(out + mt * 32 + q4 * 8 + (lane >> 5) * 4, acc[mt][q4 * 4 + 0], acc[mt][q4 * 4 + 1], acc[mt][q4 * 4 + 2], acc[mt][q4 * 4 + 3]);
        }
        if (tid < 128) {
            const int dir = tid >> 6, d = tid & 63;
            const int bhd = bh * 2 + dir, ci = dir ? ci_b : ci_f;
            GD[((size_t)bhd * NCH + ci) * 64 + d] = __expf(dir ? cum[64 * 64 + d] : cum[63 * 64 + d]);
        }
    }
}

DEVI void phase_gla2(const P& p) {
    unsigned char* scr = p.ws + OFF_SCR;
    bf16_t* SB = (bf16_t*)(scr + SC_SB); const float* GD = (const float*)(scr + SC_GD);
    for (int idx = blockIdx.x * NTHR + ltid(); idx < 16 * 8192; idx += gridDim.x * NTHR) {
        const int bhd = idx >> 13, e = idx & 8191, dk = e & 63;
        bf16_t* base = SB + (size_t)bhd * NCH * 8192 + e;
        const float* gd = GD + (size_t)bhd * NCH * 64 + dk;
        float S = 0.f;
#pragma unroll 1
        for (int ci = 0; ci < NCH; ci += 13) {
            float kv[13], g[13];
#pragma unroll
            for (int u = 0; u < 13; ++u) { kv[u] = bf2f(base[(size_t)(ci + u) * 8192]); g[u] = gd[(ci + u) * 64]; }
#pragma unroll
            for (int u = 0; u < 13; ++u) { if (!p.dry) base[(size_t)(ci + u) * 8192] = f2bf(S); S = g[u] * S + kv[u]; }
        }
    }
}

DEVI void phase_gla3(const P& p, int l, unsigned char* sm) {
    unsigned char* scr = p.ws + OFF_SCR;
    const bf16_t* QG = (const bf16_t*)(scr + SC_Q); const bf16_t* KG = (const bf16_t*)(scr + SC_K); const bf16_t* VT = (const bf16_t*)(scr + SC_VT);
    const bf16_t* SB = (const bf16_t*)(scr + SC_SB);
    bf16_t* G = (bf16_t*)(p.ws + OFF_YS + 2 * SZ512);
    const float* gnw = p.gla_norm_w + l * 128;
    const int tid = ltid(), lane = tid & 63, wave = tid >> 6, q = lane & 15, g = lane >> 4;
    const float* cum = (const float*)(sm + GL_CUM);
    bf16_t* tiles = (bf16_t*)(sm + GL_T0);
    float* X = (float*)(sm + GL_X);
    const int c_lo = (l == 0) ? 0 : 4;
    const int nper = NCH - c_lo;
    for (int task = blockIdx.x; task < 8 * nper; task += gridDim.x) {
        const int bh = task / nper, c = c_lo + task % nper, b = bh >> 2, h = bh & 3;
        int rowbase, ci_f, ci_b; size_t vo, vld;
        gla_chunk_geom(b, c, rowbase, vo, vld, ci_f, ci_b);
        gla_cum(p, l, h, rowbase, sm);
        {
            const int t = tid >> 3, dg = (tid & 7) * 8;
            U8 qv, kv; qv.u = *(const uint4*)(QG + (size_t)(rowbase + t) * 256 + h * 64 + dg); kv.u = *(const uint4*)(KG + (size_t)(rowbase + t) * 256 + h * 64 + dg);
            float o[4][8];
#pragma unroll
            for (int j = 0; j < 8; ++j) {
                const int d = dg + j;
                const float qf = (j & 1) ? hi_bf(qv.w[j >> 1]) : lo_bf(qv.w[j >> 1]);
                const float kf = (j & 1) ? hi_bf(kv.w[j >> 1]) : lo_bf(kv.w[j >> 1]);
                const float cf = cum[t * 64 + d], cb = cum[(64 + t) * 64 + d];
                o[0][j] = qf * __expf(cf); o[1][j] = kf * __expf(-cf); o[2][j] = qf * __expf(cb); o[3][j] = kf * __expf(-cb);
            }
#pragma unroll
            for (int k = 0; k < 4; ++k) {
                uint4 w; w.x = pk2(o[k][0], o[k][1]); w.y = pk2(o[k][2], o[k][3]); w.z = pk2(o[k][4], o[k][5]); w.w = pk2(o[k][6], o[k][7]);
                *(uint4*)(tiles + k * 64 * LSTR + t * LSTR + dg) = w;
            }
        }
        __syncthreads();
        const int qi = wave & 3, dir = wave >> 2;
        f32x4 O[8];
#pragma unroll
        for (int i = 0; i < 8; ++i) O[i] = (f32x4){0.f, 0.f, 0.f, 0.f};
        {
            const bf16_t* Qd = tiles + (dir * 2) * 64 * LSTR; const bf16_t* Kd = tiles + (dir * 2 + 1) * 64 * LSTR;
            const bf16x8 qf0 = *(const bf16x8*)(Qd + (qi * 16 + q) * LSTR + g * 8), qf1 = *(const bf16x8*)(Qd + (qi * 16 + q) * LSTR + 32 + g * 8);
            const int iq = qi * 16 + q;
            U8 pf[2];
#pragma unroll
            for (int jt = 0; jt < 4; ++jt) {
                const bf16_t* kp = Kd + (jt * 16 + (lane & 15)) * LSTR + g * 8;
                f32x4 s = {0.f, 0.f, 0.f, 0.f};
                s = __builtin_amdgcn_mfma_f32_16x16x32_bf16(*(const bf16x8*)kp, qf0, s, 0, 0, 0);
                s = __builtin_amdgcn_mfma_f32_16x16x32_bf16(*(const bf16x8*)(kp + 32), qf1, s, 0, 0, 0);
#pragma unroll
                for (int i = 0; i < 4; ++i) { const int jk = jt * 16 + 4 * g + i; const bool ok = dir ? (jk >= iq) : (jk <= iq); s[i] = ok ? s[i] : 0.f; }
                pf[jt >> 1].w[(jt & 1) * 2 + 0] = pk2(s[0], s[1]); pf[jt >> 1].w[(jt & 1) * 2 + 1] = pk2(s[2], s[3]);
            }
            const bf16_t* vp = gla_vt_ptr(VT, b, h, c) + (size_t)(lane & 15) * vld + 4 * g;
            const int bhd = bh * 2 + dir, ci = dir ? ci_b : ci_f;
            const bf16_t* sp = SB + ((size_t)bhd * NCH + ci) * 8192 + (size_t)(lane & 15) * 64 + g * 8;
#pragma unroll
            for (int dvt = 0; dvt < 8; ++dvt) {
#pragma unroll
                for (int st = 0; st < 2; ++st) {
                    U8 vf; vf.h[0] = *(const uint2*)(vp + (size_t)dvt * 16 * vld + st * 32); vf.h[1] = *(const uint2*)(vp + (size_t)dvt * 16 * vld + st * 32 + 16);
                    O[dvt] = __builtin_amdgcn_mfma_f32_16x16x32_bf16(vf.v, pf[st].v, O[dvt], 0, 0, 0);
                }
                O[dvt] = __builtin_amdgcn_mfma_f32_16x16x32_bf16(*(const bf16x8*)(sp + dvt * 16 * 64), qf0, O[dvt], 0, 0, 0);
                O[dvt] = __builtin_amdgcn_mfma_f32_16x16x32_bf16(*(const bf16x8*)(sp + dvt * 16 * 64 + 32), qf1, O[dvt], 0, 0, 0);
            }
        }
        if (dir == 1) {
#pragma unroll
            for (int dvt = 0; dvt < 8; ++dvt)
#pragma unroll
                for (int i = 0; i < 4; ++i) X[(qi * 128 + dvt * 16 + 4 * g + i) * 16 + q] = O[dvt][i];
        }
        __syncthreads();
        if (dir == 0) {
            float ss = 0.f;
#pragma unroll
            for (int dvt = 0; dvt < 8; ++dvt)
#pragma unroll
                for (int i = 0; i < 4; ++i) { O[dvt][i] += X[(qi * 128 + dvt * 16 + 4 * g + i) * 16 + q]; ss += O[dvt][i] * O[dvt][i]; }
            ss = rows_sum(ss);
            const float rs = rsqrtf(ss * (1.0f / 128.0f) + EPS);
            bf16_t* gp = G + (size_t)(rowbase + qi * 16 + q) * 512 + h * 128;
#pragma unroll
            for (int dvt = 0; dvt < 8; ++dvt) {
                const int dv = dvt * 16 + 4 * g;
                const float4 w = *(const float4*)(gnw + dv);
                const uint2 gv = *(const uint2*)(gp + dv);
                if (!p.dry) st4bf(gp + dv, O[dvt][0] * rs * w.x * lo_bf(gv.x), O[dvt][1] * rs * w.y * hi_bf(gv.x), O[dvt][2] * rs * w.z * lo_bf(gv.y), O[dvt][3] * rs * w.w * hi_bf(gv.y));
            }
        }
    }
}

constexpr int LF = 16384;
DEVI int CIDX(int p) { return p + (p >> 4); }
DEVI int FIDX(int m) { return 2 * CIDX(m >> 1) + (m & 1); }
constexpr int LFP = LF + LF / 16;
DEVI float2 cmul(float2 a, float2 b) { return make_float2(a.x * b.x - a.y * b.y, a.x * b.y + a.y * b.x); }
DEVI float2 cadd(float2 a, float2 b) { return make_float2(a.x + b.x, a.y + b.y); }
DEVI float2 csub(float2 a, float2 b) { return make_float2(a.x - b.x, a.y - b.y); }
DEVI float2 twid(float frac) { return make_float2(__builtin_amdgcn_cosf(frac), __builtin_amdgcn_sinf(frac)); }

DEVI void fft_fwd(float2* F) {
    const int tid = ltid();
#pragma unroll 1
    for (int s = LF / 2; s >= 2; s >>= 2) {
        const int h = s >> 1;
        const int lh = 31 - __clz(h);
        const float inv2s = 1.0f / (float)(2 * s);
#pragma unroll 2
        for (int qq = tid; qq < LF / 4; qq += NTHR) {
            const int blk = qq >> lh, j = qq & (h - 1);
            const int i = blk * (2 * s) + j;
            const int i0 = CIDX(i), i1 = CIDX(i + h), i2 = CIDX(i + s), i3 = CIDX(i + s + h);
            const float2 x0 = F[i0], x1 = F[i1], x2 = F[i2], x3 = F[i3];
            float2 w1 = twid((float)j * inv2s); w1.y = -w1.y;
            const float2 w2 = cmul(w1, w1);
            const float2 y0 = cadd(x0, x2), y2 = cmul(csub(x0, x2), w1);
            const float2 y1 = cadd(x1, x3); const float2 tt = csub(x1, x3);
            const float2 y3 = cmul(make_float2(tt.y, -tt.x), w1);
            F[i0] = cadd(y0, y1); F[i1] = cmul(csub(y0, y1), w2);
            F[i2] = cadd(y2, y3); F[i3] = cmul(csub(y2, y3), w2);
        }
        __syncthreads();
    }
}
DEVI void fft_inv(float2* F) {
    const int tid = ltid();
#pragma unroll 1
    for (int h = 1; h <= LF / 4; h <<= 2) {
        const int s = 2 * h;
        const int lh = 31 - __clz(h);
        const float inv2s = 1.0f / (float)(2 * s);
#pragma unroll 2
        for (int qq = tid; qq < LF / 4; qq += NTHR) {
            const int blk = qq >> lh, j = qq & (h - 1);
            const int i = blk * (2 * s) + j;
            const int i0 = CIDX(i), i1 = CIDX(i + h), i2 = CIDX(i + s), i3 = CIDX(i + s + h);
            const float2 x0 = F[i0], x1 = F[i1], x2 = F[i2], x3 = F[i3];
            const float2 w1 = twid((float)j * inv2s);
            const float2 w2 = cmul(w1, w1);
            const float2 a1 = cmul(x1, w2), a3 = cmul(x3, w2);
            const float2 u0 = cadd(x0, a1), u1 = csub(x0, a1), u2 = cadd(x2, a3), u3 = csub(x2, a3);
            const float2 b2 = cmul(u2, w1); const float2 t3 = cmul(u3, w1); const float2 b3 = make_float2(-t3.y, t3.x);
            F[i0] = cadd(u0, b2); F[i2] = csub(u0, b2); F[i1] = cadd(u1, b3); F[i3] = csub(u1, b3);
        }
        __syncthreads();
    }
}
DEVI int rev14(int k) { return (int)(__brev((unsigned)k) >> 18); }
DEVI float hy_delta(int ch) {
    const float a = -3.0701134573253946f, b = -15.350567286626973f;
    return fabsf(a + (b - a) * ((float)ch / 511.0f));
}

DEVI void conv8(const bf16_t* U, const float* cw, const float* cb, int seq0, int Lseq, int t, int col0, float* out) {
    U8 r[3];
#pragma unroll
    for (int i = 0; i < 3; ++i) {
        const int tt = t - 1 + i;
        if (tt >= 0 && tt < Lseq) r[i].u = *(const uint4*)(U + (size_t)(seq0 + tt) * 1536 + col0);
        else r[i].u = make_uint4(0, 0, 0, 0);
    }
#pragma unroll
    for (int j = 0; j < 8; ++j) {
        float a = cb[col0 + j];
#pragma unroll
        for (int i = 0; i < 3; ++i) { const float uv = (j & 1) ? hi_bf(r[i].w[j >> 1]) : lo_bf(r[i].w[j >> 1]); a += uv * cw[i * 1536 + col0 + j]; }
        out[j] = a;
    }
}
DEVI void hy_task_geom(int task, int& b, int& t0, int& ch0, int& seq0, int& Lseq, float*& zt, unsigned char* scr) {
    if (task < 4096) { b = task >> 11; t0 = ((task >> 3) & 255) * 64; ch0 = (task & 7) * 64; seq0 = b * T; Lseq = T; zt = (float*)(scr + SD_ZT) + (size_t)b * 512 * T; }
    else { const int q = task - 4096; b = q >> 5; t0 = ((q >> 3) & 3) * 64; ch0 = (q & 7) * 64; seq0 = NL + b * CL; Lseq = CL; zt = (float*)(scr + SD_ZTC) + (size_t)b * 512 * CL; }
}
DEVI void phase_hy1(const P& p, int l, float* sm) {
    unsigned char* scr = p.ws + OFF_SCR;
    const bf16_t* U = (const bf16_t*)(scr + SD_U);
    const float* cw = p.conv_w + (size_t)l * 3 * 1536; const float* cb = p.conv_b + l * 1536;
    const int tid = ltid();
    const int ntask = 4096 + (l == 0 ? 64 : 0);
    for (int task = blockIdx.x; task < ntask; task += gridDim.x) {
        int b, t0, ch0, seq0, Lseq; float* zt;
        hy_task_geom(task, b, t0, ch0, seq0, Lseq, zt, scr);
        __syncthreads();
        {
            const int tt = tid >> 3, cg = (tid & 7) * 8;
            float a1[8], a2[8];
            conv8(U, cw, cb, seq0, Lseq, t0 + tt, 512 + ch0 + cg, a1);
            conv8(U, cw, cb, seq0, Lseq, t0 + tt, 1024 + ch0 + cg, a2);
#pragma unroll
            for (int j = 0; j < 8; ++j) sm[(cg + j) * 65 + tt] = a1[j] * a2[j];
        }
        __syncthreads();
        {
            const int ch = tid >> 3, t8 = (tid & 7) * 8;
            float4 w0 = {sm[ch * 65 + t8 + 0], sm[ch * 65 + t8 + 1], sm[ch * 65 + t8 + 2], sm[ch * 65 + t8 + 3]};
            float4 w1 = {sm[ch * 65 + t8 + 4], sm[ch * 65 + t8 + 5], sm[ch * 65 + t8 + 6], sm[ch * 65 + t8 + 7]};
            float* dst = zt + (size_t)(ch0 + ch) * Lseq + t0 + t8;
            *(float4*)dst = w0; *(float4*)(dst + 4) = w1;
        }
    }
}
DEVI void phase_hy3(const P& p, int l, float* sm) {
    unsigned char* scr = p.ws + OFF_SCR;
    const bf16_t* U = (const bf16_t*)(scr + SD_U);
    bf16_t* G = (bf16_t*)(p.ws + OFF_YS + 3 * SZ512);
    const float* cw = p.conv_w + (size_t)l * 3 * 1536; const float* cb = p.conv_b + l * 1536;
    const int tid = ltid();
    const int ntask = 4096 + (l == 0 ? 64 : 0);
    for (int task = blockIdx.x; task < ntask; task += gridDim.x) {
        int b, t0, ch0, seq0, Lseq; float* zt;
        hy_task_geom(task, b, t0, ch0, seq0, Lseq, zt, scr);
        __syncthreads();
        {
            const int ch = tid >> 3, t8 = (tid & 7) * 8;
            const float* src = zt + (size_t)(ch0 + ch) * Lseq + t0 + t8;
            const float4 w0 = *(const float4*)src, w1 = *(const float4*)(src + 4);
            float* d = sm + ch * 65 + t8;
            d[0] = w0.x; d[1] = w0.y; d[2] = w0.z; d[3] = w0.w; d[4] = w1.x; d[5] = w1.y; d[6] = w1.z; d[7] = w1.w;
        }
        __syncthreads();
        {
            const int tt = tid >> 3, cg = (tid & 7) * 8;
            float a0[8];
            conv8(U, cw, cb, seq0, Lseq, t0 + tt, ch0 + cg, a0);
            bf16_t* gp = G + (size_t)(seq0 + t0 + tt) * 512 + ch0 + cg;
            U8 gv; gv.u = *(const uint4*)gp;
            float o[8];
#pragma unroll
            for (int j = 0; j < 8; ++j) { const float gg = (j & 1) ? hi_bf(gv.w[j >> 1]) : lo_bf(gv.w[j >> 1]); o[j] = a0[j] * sm[(cg + j) * 65 + tt] * gg; }
            uint4 w; w.x = pk2(o[0], o[1]); w.y = pk2(o[2], o[3]); w.z = pk2(o[4], o[5]); w.w = pk2(o[6], o[7]);
            if (!p.dry) *(uint4*)gp = w;
        }
    }
}


constexpr int HYF_MT = 64;
DEVI void phase_hyf(const P& p, int l, float* sm) {
    const int tid = ltid();
    const float* HT = (const float*)(p.ws + OFF_HH3T) + (size_t)l * 64 * T;
    const float* wout = p.fwout + (size_t)l * 64 * 1024;
    bf16_t* K2 = (bf16_t*)(p.ws + OFF_K2);
    float* L1P = (float*)(p.ws + OFF_L1P);
    float* hs = sm;
    for (int task = blockIdx.x; task < T / HYF_MT; task += gridDim.x) {
        const int m0 = task * HYF_MT;
        __syncthreads();
        for (int e = tid; e < 64 * HYF_MT / 4; e += NTHR) { const int j = e / (HYF_MT / 4), c4 = (e % (HYF_MT / 4)) * 4; *(float4*)(hs + j * HYF_MT + c4) = *(const float4*)(HT + (size_t)j * T + m0 + c4); }
        __syncthreads();
        {
            const int ch = tid;
            const float delta = hy_delta(ch);
            float l1f = 0.f, l1b = 0.f;
#pragma unroll 1
            for (int mb = 0; mb < HYF_MT; mb += 16) {
                float af[16], ab[16];
#pragma unroll
                for (int u = 0; u < 16; ++u) { af[u] = 0.f; ab[u] = 0.f; }
#pragma unroll 2
                for (int j = 0; j < 64; ++j) {
                    const float wf = wout[j * 1024 + ch], wb = wout[j * 1024 + 512 + ch];
#pragma unroll
                    for (int u4 = 0; u4 < 4; ++u4) {
                        const float4 h = *(const float4*)(hs + j * HYF_MT + mb + u4 * 4);
                        af[u4 * 4 + 0] += h.x * wf; af[u4 * 4 + 1] += h.y * wf; af[u4 * 4 + 2] += h.z * wf; af[u4 * 4 + 3] += h.w * wf;
                        ab[u4 * 4 + 0] += h.x * wb; ab[u4 * 4 + 1] += h.y * wb; ab[u4 * 4 + 2] += h.z * wb; ab[u4 * 4 + 3] += h.w * wb;
                    }
                }
#pragma unroll
                for (int u = 0; u < 16; ++u) {
                    const int m = m0 + mb + u;
                    const float dec = __expf(-((float)m * (1.0f / (float)(T - 1))) * delta);
                    af[u] *= dec; ab[u] *= dec;
                    l1f += fabsf(af[u]); l1b += (m == 0) ? 0.f : fabsf(ab[u]);
                }
                uint4 o;
                o.x = pk2(af[0], af[1]); o.y = pk2(af[2], af[3]); o.z = pk2(af[4], af[5]); o.w = pk2(af[6], af[7]);
                *(uint4*)(K2 + (size_t)ch * T + m0 + mb) = o;
                o.x = pk2(af[8], af[9]); o.y = pk2(af[10], af[11]); o.z = pk2(af[12], af[13]); o.w = pk2(af[14], af[15]);
                *(uint4*)(K2 + (size_t)ch * T + m0 + mb + 8) = o;
                o.x = pk2(ab[0], ab[1]); o.y = pk2(ab[2], ab[3]); o.z = pk2(ab[4], ab[5]); o.w = pk2(ab[6], ab[7]);
                *(uint4*)(K2 + (size_t)(512 + ch) * T + m0 + mb) = o;
                o.x = pk2(ab[8], ab[9]); o.y = pk2(ab[10], ab[11]); o.z = pk2(ab[12], ab[13]); o.w = pk2(ab[14], ab[15]);
                *(uint4*)(K2 + (size_t)(512 + ch) * T + m0 + mb + 8) = o;
            }
            L1P[(size_t)task * 1024 + ch] = l1f;
            L1P[(size_t)task * 1024 + 512 + ch] = l1b;
        }
    }
}
DEVI void phase_hy2(const P& p, int l, unsigned char* smem) {
    unsigned char* scr = p.ws + OFF_SCR;
    const int tid = ltid();
    float* Ff = (float*)smem; float2* F2 = (float2*)smem;
    float* red = (float*)(smem + (size_t)LFP * 8);
    float* spec = red + 16;
    const float* HT = (const float*)(p.ws + OFF_HH3T) + (size_t)l * 64 * T;
    const float* HC = (const float*)(p.ws + OFF_HH3C);
    const float* wout = p.fwout + (size_t)l * 64 * 1024;
    const int ntask = 512 + (l == 0 ? 512 : 0);
    for (int task = blockIdx.x; task < ntask; task += gridDim.x) {
        __syncthreads();
        if (task < 512) {
            const int ch = task;
            const float delta = hy_delta(ch);
            float l1 = 0.f;
            {
                const bf16_t* K2 = (const bf16_t*)(p.ws + OFF_K2);
                const float* L1P = (const float*)(p.ws + OFF_L1P);
                if (tid < 2 * (T / HYF_MT)) { const int side = tid / (T / HYF_MT), tk = tid % (T / HYF_MT); l1 = L1P[(size_t)tk * 1024 + side * 512 + ch]; }
#pragma unroll
                for (int i = 0; i < 4; ++i) {
                    const int m = (tid + NTHR * i) * 8;
                    U8 hf, hb; hf.u = *(const uint4*)(K2 + (size_t)ch * T + m); hb.u = *(const uint4*)(K2 + (size_t)(512 + ch) * T + m);
#pragma unroll
                    for (int u = 0; u < 8; ++u) {
                        const float af = (u & 1) ? hi_bf(hf.w[u >> 1]) : lo_bf(hf.w[u >> 1]);
                        const float ab = (u & 1) ? hi_bf(hb.w[u >> 1]) : lo_bf(hb.w[u >> 1]);
                        const int mm = m + u;
                        Ff[FIDX(mm)] = af;
                        if (mm >= 1) Ff[FIDX(2 * T - mm)] = ab; else Ff[FIDX(T)] = 0.f;
                    }
                }
            }
            l1 = block_sum(l1, red);
            __syncthreads();
            fft_fwd(F2);
            const float scale = 1.0f / ((float)LF * l1);
            float4* KF = (float4*)(p.ws + OFF_KF) + (size_t)blockIdx.x * 8192;
#pragma unroll 2
            for (int i = 0; i < 16; ++i) {
                const int k = tid + NTHR * i;
                const float2 ck = F2[CIDX(rev14(k))], cm = F2[CIDX(rev14((LF - k) & (LF - 1)))];
                KF[k] = make_float4((ck.x + cm.x) * 0.5f * scale, (ck.y - cm.y) * 0.5f * scale, (ck.y + cm.y) * 0.5f * scale, -(ck.x - cm.x) * 0.5f * scale);
            }
            if (tid == 0) { const float2 c = F2[CIDX(1)]; spec[0] = c.x * scale; spec[1] = c.y * scale; }
            const float fb = p.fbias[l * 512 + ch];
#pragma unroll 1
            for (int b = 0; b < NB; ++b) {
                float* zt = (float*)(scr + SD_ZT) + ((size_t)b * 512 + ch) * T;
                __syncthreads();
#pragma unroll
                for (int i = 0; i < 8; ++i) {
                    const int e = (tid + NTHR * i) * 4;
                    const float4 zv = *(const float4*)(zt + e);
                    const int c0 = CIDX(e >> 1), c1 = CIDX((T + e) >> 1);
                    F2[c0] = make_float2(zv.x, zv.y); F2[c0 + 1] = make_float2(zv.z, zv.w);
                    F2[c1] = make_float2(0.f, 0.f); F2[c1 + 1] = make_float2(0.f, 0.f);
                }
                __syncthreads();
                fft_fwd(F2);
#pragma unroll 2
                for (int i = 0; i < 16; ++i) {
                    const int k = tid + NTHR * i;
                    const int pk = CIDX(rev14(k)), pm = CIDX(rev14((LF - k) & (LF - 1)));
                    const float2 ck = F2[pk], cm = F2[pm];
                    const float4 kf = KF[k];
                    const float2 He = make_float2(kf.x, kf.y), Ho = make_float2(kf.z, kf.w);
                    const float2 E = make_float2((ck.x + cm.x) * 0.5f, (ck.y - cm.y) * 0.5f);
                    const float2 O = make_float2((ck.y + cm.y) * 0.5f, -(ck.x - cm.x) * 0.5f);
                    float2 w2 = twid((float)k * (1.0f / (float)LF)); w2.y = -w2.y;
                    const float2 Ye = cadd(cmul(E, He), cmul(w2, cmul(O, Ho)));
                    const float2 Yo = cadd(cmul(E, Ho), cmul(O, He));
                    F2[pk] = make_float2(Ye.x - Yo.y, Ye.y + Yo.x);
                    F2[pm] = make_float2(Ye.x + Yo.y, -Ye.y + Yo.x);
                }
                if (tid == 0) {
                    const float2 c = F2[CIDX(1)]; const float he = spec[0], ho = spec[1];
                    F2[CIDX(1)] = make_float2(c.x * he - c.y * ho, c.x * ho + c.y * he);
                }
                __syncthreads();
                fft_inv(F2);
#pragma unroll
                for (int i = 0; i < 8; ++i) {
                    const int e = (tid + NTHR * i) * 4;
                    const float4 zv = *(const float4*)(zt + e);
                    const int c0 = CIDX(e >> 1);
                    const float2 y0 = F2[c0], y1 = F2[c0 + 1];
                    const float4 yv = make_float4(y0.x, y0.y, y1.x, y1.y);
                    if (!p.dry) *(float4*)(zt + e) = make_float4(yv.x + zv.x * fb, yv.y + zv.y * fb, yv.z + zv.z * fb, yv.w + zv.w * fb);
                }
            }
        } else {
            const int ch = task - 512;
            const float delta = hy_delta(ch);
            float* hf = Ff; float* hb = Ff + 256; float* zs = Ff + 512;
            {
                const int m = tid & 255, side = tid >> 8;
                float a = 0.f;
#pragma unroll 4
                for (int j = 0; j < 64; ++j) a += HC[j * CL + m] * wout[j * 1024 + side * 512 + ch];
                a *= expf(-((float)m / (float)(CL - 1)) * delta);
                Ff[side * 256 + m] = a;
                float l1 = (side == 1 && m == 0) ? 0.f : fabsf(a);
                zs[tid] = ((const float*)(scr + SD_ZTC))[((size_t)(tid >> 8) * 512 + ch) * CL + (tid & 255)];
                l1 = block_sum(l1, red);
                const int b = tid >> 8, t = tid & 255;
                float y = 0.f;
#pragma unroll 4
                for (int s = 0; s <= t; ++s) y += zs[b * 256 + s] * hf[t - s];
#pragma unroll 4
                for (int s = t + 1; s < CL; ++s) y += zs[b * 256 + s] * hb[s - t];
                const float fb = p.fbias[l * 512 + ch];
                if (!p.dry) ((float*)(scr + SD_ZTC))[((size_t)b * 512 + ch) * CL + t] = y / l1 + zs[tid] * fb;
            }
        }
    }
}

constexpr int NPH = 32;
#ifndef ONLY
#define ONLY -1
#endif
#define CASE(n) case n: if (ONLY < 0 || ONLY == n)
DEVI void run_phase(const P& p, int ph, unsigned char* smem) {
    if (ph == 0) { if (ONLY < 0 || ONLY == 100) phase_prep(p, (float*)smem); return; }
    if (ph == NPH - 1) { if (ONLY < 0 || ONLY == 101) phase_final(p); return; }
    const int l = (ph - 1) / 15, k = (ph - 1) % 15;
    switch (k) {
        CASE(0) phase_hl(p, l); break;
        CASE(1) phase_inproj<0>(p, l, (bf16_t*)smem); break;
        CASE(2) phase_att_a(p, l, (float*)smem); break;
        CASE(3) phase_inproj<1>(p, l, (bf16_t*)smem); break;
        CASE(4) phase_att_b(p, l); break;
        CASE(5) phase_inproj<2>(p, l, (bf16_t*)smem); break;
        CASE(6) phase_gla1(p, l, smem); break;
        CASE(7) phase_gla2(p); break;
        CASE(8) phase_gla3(p, l, smem); break;
        CASE(9) phase_inproj<3>(p, l, (bf16_t*)smem); break;
        CASE(10) { phase_hyf(p, l, (float*)smem); phase_hy1(p, l, (float*)smem); } break;
        CASE(11) phase_hy2(p, l, smem); break;
        CASE(12) phase_hy3(p, l, (float*)smem); break;
        CASE(13) phase_merge(p, l, (bf16_t*)smem); break;
        CASE(14) phase_out(p, l, (bf16_t*)smem); break;
    }
}

#define XB_TMO      128
#define XB_XCNT(j)  (256  + 64 * (j))
#define XB_XSUB(j)  (1280 + 64 * (j))
#define XB_XGEN(j)  (2304 + 64 * (j))
#define XB_TOP      3328
#define XB_TOPGEN   3392
#define XCD_BAR_WORDS 3456
#define XB_SPIN_CAP (1u << 18)
#define LAS __attribute__((address_space(3)))
DEVI unsigned xb_ld(unsigned* p)              { return __hip_atomic_load(p, __ATOMIC_RELAXED, __HIP_MEMORY_SCOPE_AGENT); }
DEVI unsigned xb_add(unsigned* p, unsigned v) { return __hip_atomic_fetch_add(p, v, __ATOMIC_RELAXED, __HIP_MEMORY_SCOPE_AGENT); }
DEVI unsigned xb_xcc_id() { return (unsigned)__builtin_amdgcn_s_getreg((3 << 11) | 20) & 0xFu; }
#define XB_SPIN(cond, bar) do { unsigned _sp = 0; while (cond) { __builtin_amdgcn_s_sleep(1); \
    if ((++_sp & 255u) == 0u) { if (xb_ld(&(bar)[XB_TMO])) break; if (_sp > XB_SPIN_CAP) { atomicAdd(&(bar)[XB_TMO], 1u); break; } } } } while (0)
struct XcdBarrier { unsigned* bar; unsigned x; volatile LAS unsigned* st; };
DEVI XcdBarrier xcd_barrier_post(unsigned* bar, volatile LAS unsigned* st) {
    XcdBarrier b; b.bar = bar; b.x = xb_xcc_id(); b.st = st;
    if (threadIdx.x == 0) (void)xb_add(&bar[XB_XCNT(b.x)], 1u);
    return b;
}
DEVI void xcd_barrier_complete(unsigned* bar, unsigned x, unsigned& nloc, unsigned& nx) {
    const unsigned G = gridDim.x * gridDim.y * gridDim.z;
    unsigned sum, cnt, mine, sp = 0u;
    for (;;) {
        sum = 0u; cnt = 0u; mine = 0u;
#pragma unroll
        for (unsigned j = 0; j < 16; ++j) { const unsigned c = xb_ld(&bar[XB_XCNT(j)]); sum += c; cnt += (c > 0u) ? 1u : 0u; mine = (j == x) ? c : mine; }
        if (sum == G) break;
        __builtin_amdgcn_s_sleep(1);
        if ((++sp & 255u) == 0u) { if (xb_ld(&bar[XB_TMO])) break; if (sp > XB_SPIN_CAP) { atomicAdd(&bar[XB_TMO], 1u); break; } }
    }
    nloc = mine > 0u ? mine : 1u; nx = cnt > 0u ? cnt : 1u;
}
DEVI void xcd_barrier(const XcdBarrier& b) {
    asm volatile("s_waitcnt vmcnt(0)" ::: "memory");
    __syncthreads();
    if (threadIdx.x == 0) {
        unsigned* bar = b.bar;
        __builtin_amdgcn_s_waitcnt(0);
        unsigned nloc = b.st[0], nx = b.st[1];
        if (nloc == 0u) { xcd_barrier_complete(bar, b.x, nloc, nx); b.st[0] = nloc; b.st[1] = nx; }
        const unsigned old = xb_add(&bar[XB_XSUB(b.x)], 1u);
        const unsigned gen = old / nloc;
        if (old + 1u == (gen + 1u) * nloc) {
            __builtin_amdgcn_fence(__ATOMIC_RELEASE, "agent");
            asm volatile("s_waitcnt vmcnt(0)" ::: "memory");
            const unsigned og = xb_add(&bar[XB_TOP], 1u);
            const unsigned tg = og / nx;
            if (og + 1u == (tg + 1u) * nx) xb_add(&bar[XB_TOPGEN], 1u);
            else XB_SPIN(xb_ld(&bar[XB_TOPGEN]) == tg, bar);
            __builtin_amdgcn_fence(__ATOMIC_ACQUIRE, "agent");
            xb_add(&bar[XB_XGEN(b.x)], 1u);
            asm volatile("s_waitcnt vmcnt(0)" ::: "memory");
        } else {
            XB_SPIN(xb_ld(&bar[XB_XGEN(b.x)]) == gen, bar);
            __builtin_amdgcn_fence(__ATOMIC_ACQUIRE, "agent");
            asm volatile("s_waitcnt vmcnt(0)" ::: "memory");
        }
    }
    __syncthreads();
}
constexpr size_t OFF_BAR = WS_END + 1024;
constexpr size_t WS_TOTAL = OFF_BAR + XCD_BAR_WORDS * 4;

__global__ void __launch_bounds__(NTHR) mega(P p) {
    extern __shared__ __attribute__((aligned(16))) unsigned char smem[];
    cg::grid_group grid = cg::this_grid();
#ifndef DBL_MASK
#define DBL_MASK 0
#endif
#ifdef TIMING_A
    unsigned long long* ts = (unsigned long long*)(p.ws + WS_END);
    if (blockIdx.x == 0 && threadIdx.x == 0) ts[0] = __builtin_amdgcn_s_memrealtime();
#endif
    volatile LAS unsigned* xst = (volatile LAS unsigned*)(smem + LDS_BYTES - 16);
    if (threadIdx.x == 0) { xst[0] = 0u; xst[1] = 0u; }
    __syncthreads();
    XcdBarrier xb = xcd_barrier_post((unsigned*)(p.ws + OFF_BAR), xst);
#define GRID_SYNC(ph_) do { if ((ph_) == 0) grid.sync(); else xcd_barrier(xb); } while (0)
    for (int ph = p.ph_lo; ph < p.ph_hi; ++ph) {
        if (DBL_MASK != 0 && ph > 0 && ph < NPH - 1 && ((DBL_MASK >> ((ph - 1) % 15)) & 1)) { P pd = p; int one_ = 1; asm volatile("" : "+s"(one_)); pd.dry = one_; run_phase(pd, ph, smem); GRID_SYNC(1); }
        run_phase(p, ph, smem);
#ifdef TIMING_A
        GRID_SYNC(ph);
        if (blockIdx.x == 0 && threadIdx.x == 0) ts[ph + 1] = __builtin_amdgcn_s_memrealtime();
#else
        if (ph + 1 < p.ph_hi) GRID_SYNC(ph);
#endif
    }
}

#ifdef DIAG_OFF
__global__ void diag_dump(const unsigned char* src, float* out, size_t n) {
    for (size_t i = (size_t)blockIdx.x * blockDim.x + threadIdx.x; i < n; i += (size_t)gridDim.x * blockDim.x) {
#if DIAG_F32
        out[i] = ((const float*)src)[i % (size_t)(DIAG_N)];
#else
        { float v = bf2f(((const bf16_t*)src)[i % (size_t)(DIAG_N)]);
#ifdef EXP_FIN
          if (!(fabsf(v) < 1e30f)) v = 12345.f;
#endif
          out[i] = v; }
#endif
    }
}
#endif
#ifdef TIMING_A
__global__ void timing_tail(const unsigned long long* ts, float* out) {
    float grp[8] = {0, 0, 0, 0, 0, 0, 0, 0};
    const float total = (float)(ts[NPH] - ts[0]);
    for (int ph = 0; ph < NPH; ++ph) {
        const float dt = (float)(ts[ph + 1] - ts[ph]);
        int gi;
        if (ph == 0) gi = 5; else if (ph == NPH - 1) gi = 6;
        else { const int k = (ph - 1) % 15; gi = (k == 1 || k == 3 || k == 5 || k == 9) ? 0 : (k == 13) ? 1 : (k == 2 || k == 4) ? 2 : (k >= 6 && k <= 8) ? 3 : (k >= 10 && k <= 12) ? 4 : (k == 14) ? 7 : 6; }
#pragma unroll
        for (int q = 0; q < 8; ++q) grp[q] += (gi == q) ? dt : 0.f;
    }
    float fa = 0.f, fb = 0.f;
#pragma unroll
    for (int q = 0; q < 8; ++q) { fa += (q == TIMING_A) ? grp[q] : 0.f; fb += (q == TIMING_B) ? grp[q] : 0.f; }
    const float e1 = 1000.f * fa / total, e2 = 50.f * fb / total;
    if (blockIdx.x == 0 && threadIdx.x == 0) out[0] += e1;
    for (size_t i = (size_t)blockIdx.x * blockDim.x + threadIdx.x; i < (size_t)1048576; i += (size_t)gridDim.x * blockDim.x) out[D + i] += e2;
}
#endif
extern "C" void kernel_launch(void* const* d_in, const int* in_sizes, int n_in, void* d_out, int out_size, void* d_ws, size_t ws_size, hipStream_t stream) {
    static int grid = 0;
    if (grid == 0) {
        if (n_in != 27 || ws_size < WS_TOTAL) { fprintf(stderr, "kernel_launch: unexpected n_in %d or ws_size %zu (need %zu)\n", n_in, ws_size, (size_t)WS_TOTAL); grid = -1; return; }
        int dev = 0, cus = 0, per_cu = 0;
        hipGetDevice(&dev);
        hipDeviceGetAttribute(&cus, hipDeviceAttributeMultiprocessorCount, dev);
        if (hipFuncSetAttribute((const void*)mega, hipFuncAttributeMaxDynamicSharedMemorySize, LDS_BYTES) != hipSuccess) { fprintf(stderr, "kernel_launch: hipFuncSetAttribute failed\n"); grid = -1; return; }
        if (hipOccupancyMaxActiveBlocksPerMultiprocessor(&per_cu, (const void*)mega, NTHR, LDS_BYTES) != hipSuccess || per_cu < 1) { fprintf(stderr, "kernel_launch: occupancy query failed (%d)\n", per_cu); grid = -1; return; }
        grid = cus * per_cu; if (grid > MAXGRID) grid = MAXGRID;
        fprintf(stderr, "kernel_launch: grid %d (cus %d x %d)\n", grid, cus, per_cu);
    }
    if (grid < 0) return;
    P p{};
    const float** pp = (const float**)&p;
    for (int i = 0; i < 27; ++i) pp[i] = (const float*)d_in[i];
    p.out = (float*)d_out; p.ws = (unsigned char*)d_ws; p.dry = 0; p.pad_ = 0;
#if N_LAUNCH_MODE == 1
    p.ph_lo = 0; p.ph_hi = NPH;
    if (hipMemsetAsync((unsigned char*)d_ws + OFF_BAR, 0, XCD_BAR_WORDS * 4, stream) != hipSuccess) { fprintf(stderr, "kernel_launch: memset of barrier words failed\n"); return; }
    void* args[] = {&p};
    hipError_t e = hipLaunchCooperativeKernel((const void*)mega, dim3(grid), dim3(NTHR), args, LDS_BYTES, stream);
    if (e != hipSuccess) fprintf(stderr, "cooperative launch failed: %s (grid %d)\n", hipGetErrorString(e), grid);
#ifdef TIMING_A
    hipLaunchKernelGGL(timing_tail, dim3(256), dim3(256), 0, stream, (const unsigned long long*)((unsigned char*)d_ws + WS_END), (float*)d_out);
#endif
#else
#ifndef DIAG_STOP
#define DIAG_STOP NPH
#endif
    for (int ph = 0; ph < DIAG_STOP; ++ph) {
        p.ph_lo = ph; p.ph_hi = ph + 1;
        hipLaunchKernelGGL(mega, dim3(grid), dim3(NTHR), LDS_BYTES, stream, p);
    }
#ifdef DIAG_OFF
    hipLaunchKernelGGL(diag_dump, dim3(1024), dim3(256), 0, stream, (const unsigned char*)d_ws + (size_t)(DIAG_OFF), (float*)d_out, (size_t)out_size);
#endif
#endif
}
```
